# Optimizing an MI355X kernel written in HIP

```python
import jax, jax.numpy as jnp
from jax import lax
import numpy as np

D_MODEL = 1024
BATCH = 16
SEQ = 4096
DEPTH = 2

CTX_LEN = 256
GRID_W = 64
HEAD_DIM = 64
ATTN_W = D_MODEL // 2
N_HEADS = ATTN_W // HEAD_DIM
Q_PER_KV = 4
KV_HEADS = N_HEADS // Q_PER_KV
KV_W = KV_HEADS * HEAD_DIM
POOL_W = D_MODEL // 2
POOL_WINDOWS = (2, 4, 8, 16)
POOL_GROUPS = len(POOL_WINDOWS)
POOL_GW = POOL_W // POOL_GROUPS
N_BRANCH = 3
BRANCH_W = 512
WINDOW = 128
BLOCK = 128
D_FF = 128 * ((8 * D_MODEL // 3 + 127) // 128)
ROPE_THETA = 10000.0
EPS = 1e-6
NEG = -1e30
SM_SCALE = HEAD_DIM ** -0.5
IN_SPLITS = (POOL_W, ATTN_W, KV_W, KV_W, ATTN_W, KV_W, KV_W)
IN_W = sum(IN_SPLITS)

kernel_name = "hybrid_pool_window_global_gqa_dit"


def rms_norm(x, g):
    xf = x.astype(jnp.float32)
    y = xf * lax.rsqrt(jnp.mean(xf * xf, axis=-1, keepdims=True) + EPS)
    return (y * g.astype(jnp.float32)).astype(x.dtype)


def modulate(x, g, shift, scale):
    return rms_norm(x, g) * (1 + scale) + shift


def heads(t, n):
    return t.reshape(t.shape[:-1] + (n, HEAD_DIM))


def split_in(z):
    offs = np.cumsum((0,) + IN_SPLITS)
    return [z[..., int(offs[i]):int(offs[i + 1])] for i in range(len(IN_SPLITS))]


def axial_rope_tables(n_tok):
    rows = n_tok // GRID_W
    row = jnp.repeat(jnp.arange(rows), GRID_W).astype(jnp.float32)
    col = jnp.tile(jnp.arange(GRID_W), rows).astype(jnp.float32)
    half = HEAD_DIM // 2
    inv = ROPE_THETA ** (-jnp.arange(0, half, 2, dtype=jnp.float32) / half)
    ang = jnp.stack([row[:, None] * inv, col[:, None] * inv], axis=1)
    return jnp.cos(ang)[:, None], jnp.sin(ang)[:, None]


def apply_rope(x, cos, sin):
    shp = x.shape
    xs = x.astype(jnp.float32).reshape(shp[:-1] + (2, 2, HEAD_DIM // 4))
    x1, x2 = xs[..., 0, :], xs[..., 1, :]
    out = jnp.stack([x1 * cos - x2 * sin, x2 * cos + x1 * sin], axis=-2)
    return out.reshape(shp).astype(x.dtype)


def multiscale_pool(u, w_grp, scale):
    Bn, L, _ = u.shape
    uf = u.astype(jnp.float32)
    cs = jnp.concatenate([jnp.zeros_like(uf[:, :1]), jnp.cumsum(uf, axis=1)], axis=1)
    t = jnp.arange(L)
    outs = []
    for gi, w in enumerate(POOL_WINDOWS):
        sl = slice(gi * POOL_GW, (gi + 1) * POOL_GW)
        lo = jnp.clip(t - w // 2, 0, L)
        hi = jnp.clip(t + w // 2, 0, L)
        csg = cs[..., sl]
        s = jnp.take(csg, hi, axis=1) - jnp.take(csg, lo, axis=1)
        cnt = (hi - lo).astype(jnp.float32)[None, :, None]
        outs.append(s / cnt - uf[..., sl])
    p = jnp.stack(outs, axis=2).astype(u.dtype)
    y = jnp.einsum('blgc,gcd->blgd', p, w_grp).reshape(Bn, L, POOL_W)
    return y * scale


def window_attention(q, k, v, kc, vc, sink):
    Bn, L = q.shape[0], q.shape[1]
    nb = L // BLOCK
    pad = ((0, 0), (WINDOW, WINDOW), (0, 0), (0, 0))
    kp = jnp.pad(k, pad).reshape(Bn, nb + 2, BLOCK, KV_HEADS, HEAD_DIM)
    vp = jnp.pad(v, pad).reshape(Bn, nb + 2, BLOCK, KV_HEADS, HEAD_DIM)
    kwin = jnp.concatenate([kp[:, :-2], kp[:, 1:-1], kp[:, 2:]], axis=2).swapaxes(0, 1)
    vwin = jnp.concatenate([vp[:, :-2], vp[:, 1:-1], vp[:, 2:]], axis=2).swapaxes(0, 1)
    qb = q.reshape(Bn, nb, BLOCK, KV_HEADS, Q_PER_KV, HEAD_DIM).swapaxes(0, 1)
    rel = (jnp.arange(3 * BLOCK)[None, :] - BLOCK) - jnp.arange(BLOCK)[:, None]
    band = jnp.abs(rel) <= WINDOW
    sink_l = sink.reshape(1, KV_HEADS, Q_PER_KV, 1, 1).astype(jnp.float32)
    n_win = 3 * BLOCK
    n_ctx = kc.shape[1]

    def step(args):
        bi, qi, ki, vi = args
        kpos = bi * BLOCK - BLOCK + jnp.arange(n_win)
        valid = band & ((kpos >= 0) & (kpos < L))[None, :]
        s_lat = jnp.einsum('bqkgd,bskd->bkgqs', qi, ki).astype(jnp.float32) * SM_SCALE
        s_lat = jnp.where(valid, s_lat, NEG)
        s_ctx = jnp.einsum('bqkgd,bskd->bkgqs', qi, kc).astype(jnp.float32) * SM_SCALE
        s_snk = jnp.broadcast_to(sink_l, s_lat.shape[:-1] + (1,))
        p = jax.nn.softmax(jnp.concatenate([s_lat, s_ctx, s_snk], axis=-1), axis=-1).astype(v.dtype)
        return (jnp.einsum('bkgqs,bskd->bqkgd', p[..., :n_win], vi)
                + jnp.einsum('bkgqs,bskd->bqkgd', p[..., n_win:n_win + n_ctx], vc))

    o = lax.map(step, (jnp.arange(nb), qb, kwin, vwin))
    return o.swapaxes(0, 1).reshape(Bn, L, ATTN_W)


def global_attention(q, k, v, kc, vc):
    Bn, L = q.shape[0], q.shape[1]
    nb = L // BLOCK
    kall = jnp.concatenate([k, kc], axis=1)
    vall = jnp.concatenate([v, vc], axis=1)
    qb = q.reshape(Bn, nb, BLOCK, KV_HEADS, Q_PER_KV, HEAD_DIM).swapaxes(0, 1)

    def step(qi):
        s = jnp.einsum('bqkgd,bskd->bkgqs', qi, kall).astype(jnp.float32) * SM_SCALE
        p = jax.nn.softmax(s, axis=-1).astype(vall.dtype)
        return jnp.einsum('bkgqs,bskd->bqkgd', p, vall)

    o = lax.map(step, qb)
    return o.swapaxes(0, 1).reshape(Bn, L, ATTN_W)


def context_attention(qc, kc, vc, sink):
    s = jnp.einsum('bqkgd,bskd->bkgqs', qc, kc).astype(jnp.float32) * SM_SCALE
    if sink is not None:
        sk = jnp.broadcast_to(sink.reshape(1, KV_HEADS, Q_PER_KV, 1, 1).astype(jnp.float32), s.shape[:-1] + (1,))
        s = jnp.concatenate([s, sk], axis=-1)
    p = jax.nn.softmax(s, axis=-1)[..., :kc.shape[1]].astype(vc.dtype)
    o = jnp.einsum('bkgqs,bskd->bqkgd', p, vc)
    return o.reshape(qc.shape[0], qc.shape[1], ATTN_W)


def merge_branches(h, ys, w_branch, w_gate, b_gate, w_out):
    merged = jax.nn.sigmoid(h @ w_gate[0] + b_gate[0]) * (ys[0] @ w_branch[0])
    for i in range(1, N_BRANCH):
        merged = merged + jax.nn.sigmoid(h @ w_gate[i] + b_gate[i]) * (ys[i] @ w_branch[i])
    return merged @ w_out


def dwconv3(u, w, b):
    up = jnp.pad(u, ((0, 0), (1, 1), (0, 0)))
    return up[:, :-2] * w[0] + up[:, 1:-1] * w[1] + up[:, 2:] * w[2] + b


def conv_glu(h, w_g, w_v, cw, cb, w_d):
    a = dwconv3(h @ w_g, cw, cb)
    return (jax.nn.silu(a) * (h @ w_v)) @ w_d


def setup_inputs(seed: int = 0) -> dict:
    key = jax.random.key(seed)
    ks = jax.random.split(key, 24)
    f32 = jnp.float32
    nrm = lambda k, shp, s: jax.random.normal(k, shp, f32) * s
    D = D_MODEL
    return {
        "x": nrm(ks[0], (BATCH, SEQ, D), 1.0),
        "c": nrm(ks[1], (BATCH, D), 1.0),
        "ctx": nrm(ks[2], (BATCH, CTX_LEN, D), 1.0),
        "c_ctx": nrm(ks[3], (D,), 1.0),
        "w_mod": nrm(ks[4], (DEPTH, D, 6 * D), 0.5 * D ** -0.5),
        "b_mod": nrm(ks[5], (DEPTH, 6 * D), 0.02),
        "norm1_g": 1.0 + nrm(ks[6], (DEPTH, D), 0.02),
        "norm2_g": 1.0 + nrm(ks[7], (DEPTH, D), 0.02),
        "w_in": nrm(ks[8], (DEPTH, D, IN_W), D ** -0.5),
        "w_pool_grp": nrm(ks[9], (DEPTH, POOL_GROUPS, POOL_GW, POOL_GW), POOL_GW ** -0.5),
        "pool_scale": 1.0 + nrm(ks[10], (DEPTH, POOL_W), 0.02),
        "win_sink": nrm(ks[11], (DEPTH, N_HEADS), 0.5),
        "q_norm_g": 1.0 + nrm(ks[12], (DEPTH, HEAD_DIM), 0.02),
        "k_norm_g": 1.0 + nrm(ks[13], (DEPTH, HEAD_DIM), 0.02),
        "w_branch": nrm(ks[14], (DEPTH, N_BRANCH, BRANCH_W, D), BRANCH_W ** -0.5),
        "w_gate": nrm(ks[15], (DEPTH, N_BRANCH, D, D), D ** -0.5),
        "b_gate": nrm(ks[16], (DEPTH, N_BRANCH, D), 0.02),
        "w_out": nrm(ks[17], (DEPTH, D, D), D ** -0.5),
        "w_ff_gate": nrm(ks[18], (DEPTH, D, D_FF), D ** -0.5),
        "w_ff_val": nrm(ks[19], (DEPTH, D, D_FF), D ** -0.5),
        "conv_w": nrm(ks[20], (DEPTH, 3, D_FF), 3 ** -0.5),
        "conv_b": nrm(ks[21], (DEPTH, D_FF), 0.02),
        "w_ff_down": nrm(ks[22], (DEPTH, D_FF, D), D_FF ** -0.5),
        "final_g": 1.0 + nrm(ks[23], (D,), 0.02),
    }


def reference(x, c, ctx, c_ctx, w_mod, b_mod, norm1_g, norm2_g, w_in, w_pool_grp, pool_scale,
              win_sink, q_norm_g, k_norm_g, w_branch, w_gate, b_gate, w_out,
              w_ff_gate, w_ff_val, conv_w, conv_b, w_ff_down, final_g):
    Bn, L, _ = x.shape
    C = ctx.shape[1]
    cos, sin = axial_rope_tables(L)
    for l in range(DEPTH):
        last = l == DEPTH - 1
        mod = (jax.nn.silu(c) @ w_mod[l] + b_mod[l]).reshape(Bn, 6, 1, D_MODEL)
        mod_c = (jax.nn.silu(c_ctx) @ w_mod[l] + b_mod[l]).reshape(6, 1, 1, D_MODEL)

        h = modulate(x, norm1_g[l], mod[:, 0], mod[:, 1])
        hc = modulate(ctx, norm1_g[l], mod_c[0], mod_c[1])
        p_l, wq_l, wk_l, wv_l, gq_l, gk_l, gv_l = split_in(h @ w_in[l])
        p_c, wq_c, wk_c, wv_c, gq_c, gk_c, gv_c = split_in(hc @ w_in[l])

        wkc = heads(wk_c, KV_HEADS)
        wvc = heads(wv_c, KV_HEADS)
        gkc = rms_norm(heads(gk_c, KV_HEADS), k_norm_g[l])
        gvc = heads(gv_c, KV_HEADS)

        wq = apply_rope(heads(wq_l, N_HEADS), cos, sin).reshape(Bn, L, KV_HEADS, Q_PER_KV, HEAD_DIM)
        wk = apply_rope(heads(wk_l, KV_HEADS), cos, sin)
        gq = apply_rope(rms_norm(heads(gq_l, N_HEADS), q_norm_g[l]), cos, sin).reshape(Bn, L, KV_HEADS, Q_PER_KV, HEAD_DIM)
        gk = apply_rope(rms_norm(heads(gk_l, KV_HEADS), k_norm_g[l]), cos, sin)

        y_pool = multiscale_pool(p_l, w_pool_grp[l], pool_scale[l])
        y_win = window_attention(wq, wk, heads(wv_l, KV_HEADS), wkc, wvc, win_sink[l])
        y_glob = global_attention(gq, gk, heads(gv_l, KV_HEADS), gkc, gvc)
        x = x + mod[:, 2] * merge_branches(h, (y_pool, y_win, y_glob), w_branch[l], w_gate[l], b_gate[l], w_out[l])

        if not last:
            qcw = heads(wq_c, N_HEADS).reshape(Bn, C, KV_HEADS, Q_PER_KV, HEAD_DIM)
            qcg = rms_norm(heads(gq_c, N_HEADS), q_norm_g[l]).reshape(Bn, C, KV_HEADS, Q_PER_KV, HEAD_DIM)
            yc_pool = multiscale_pool(p_c, w_pool_grp[l], pool_scale[l])
            yc_win = context_attention(qcw, wkc, wvc, win_sink[l])
            yc_glob = context_attention(qcg, gkc, gvc, None)
            ctx = ctx + mod_c[2] * merge_branches(hc, (yc_pool, yc_win, yc_glob), w_branch[l], w_gate[l], b_gate[l], w_out[l])
            h2c = modulate(ctx, norm2_g[l], mod_c[3], mod_c[4])
            ctx = ctx + mod_c[5] * conv_glu(h2c, w_ff_gate[l], w_ff_val[l], conv_w[l], conv_b[l], w_ff_down[l])

        h2 = modulate(x, norm2_g[l], mod[:, 3], mod[:, 4])
        x = x + mod[:, 5] * conv_glu(h2, w_ff_gate[l], w_ff_val[l], conv_w[l], conv_b[l], w_ff_down[l])
    return rms_norm(x, final_g)
```

```cpp
#include <hip/hip_runtime.h>
#include <hip/hip_cooperative_groups.h>
#include <hip/hip_bf16.h>
#include <cstdio>
#include <cstdint>
#include <cmath>
namespace cg = cooperative_groups;

#ifndef MK_SPLIT
#define MK_SPLIT 0
#endif

constexpr int DM_ = 1024, NB = 16, SEQ = 4096, CTX = 256, NLAT = NB * SEQ, NCTX = NB * CTX, NTOK = NLAT + NCTX;
constexpr int ZP = 2048, GP = 3072, YP = 1536, FF = 2816, AVP = 2 * FF;
constexpr float EPS = 1e-6f;
constexpr float LOG2E = 1.4426950408889634f;
constexpr float C2 = 0.125f * LOG2E;

namespace pg8 {
#define PG8_LAS __attribute__((address_space(3)))
typedef unsigned short bf16_t;
typedef short bf16x8 __attribute__((ext_vector_type(8)));
typedef float f32x4 __attribute__((ext_vector_type(4)));
typedef unsigned u32x4 __attribute__((ext_vector_type(4)));
typedef unsigned u32x2 __attribute__((ext_vector_type(2)));
constexpr int BM = 256, BK = 64, HALF = 128, HTB = HALF * BK * 2, STAGE_BYTES = 8 * HTB, NXCD = 8, WGM = 8;

__host__ __device__ __forceinline__ int lds_byte(int r, int c) { const int st = (r >> 4) * 2 + (c >> 5), rr = r & 15, cc = c & 31, ob = rr * 64 + cc * 2; return st * 1024 + (ob ^ (((ob >> 9) & 1) << 5)); }
__host__ __device__ __forceinline__ void stage_rc(int b, int& R, int& C) { const int st = b / 1024, sb = b % 1024, swz = sb ^ (((sb >> 9) & 1) << 5); R = (st >> 1) * 16 + swz / 64; C = (st & 1) * 32 + (swz % 64) / 2; }
__host__ __device__ __forceinline__ int perm32(int rho) { const int n = rho >> 4, i = rho & 15; return 8 * (i >> 2) + 4 * n + (i & 3); }

struct Unit { int pm, pn, g; };
struct Gemm { const bf16_t* A; const bf16_t* Bt; int lda, ldb, K; long a_goff, b_goff; };

struct Order {
    int nM, nN, nwg, G, c, sub, gmode;
    __device__ __forceinline__ void init(int nM_, int nN_, int G_, int c_, int sub_, int gmode_) { nM = nM_; nN = nN_; nwg = nM * nN; G = G_; c = c_; sub = sub_; gmode = gmode_; }
    __device__ __forceinline__ bool next(int i, Unit& u) const {
        const int ti = (sub == 1) ? i : i / sub;
        const long L = (long)ti * G + c; if (L >= nwg) return false;
        int wgid = (int)L; { const int q = nwg / NXCD, r = nwg % NXCD, xcd = wgid % NXCD, off = wgid / NXCD; wgid = (xcd < r ? xcd * (q + 1) : r * (q + 1) + (xcd - r) * q) + off; }
        const int nig = WGM * nN, gid = wgid / nig, fm = gid * WGM, gsz = (nM - fm) < WGM ? (nM - fm) : WGM;
        u.pm = fm + ((wgid % nig) % gsz); u.pn = (wgid % nig) / gsz;
        u.g = (gmode == 0) ? 0 : ((gmode == 1) ? u.pn : (i - ti * sub));
        return true;
    }
};

typedef float f32x2_t __attribute__((ext_vector_type(2))); typedef __bf16 bf16x2_t __attribute__((ext_vector_type(2)));
__device__ __forceinline__ unsigned cvt_pk_bf16(float lo, float hi) { f32x2_t v = {lo, hi}; bf16x2_t b = __builtin_convertvector(v, bf16x2_t); return __builtin_bit_cast(unsigned, b); }
__device__ __forceinline__ float bf_lo(unsigned w) { return __uint_as_float(w << 16); }
__device__ __forceinline__ float bf_hi(unsigned w) { return __uint_as_float(w & 0xffff0000u); }
__device__ __forceinline__ float sigmoidf_(float x) { return __builtin_amdgcn_rcpf(1.0f + __builtin_amdgcn_exp2f(-x * 1.4426950408889634f)); }

struct EpiBf16 {
    static constexpr bool PERM = true;
    bf16_t* O; int ldc; const float* colscale;
    __device__ __forceinline__ void operator()(const f32x4 (&acc)[2][2][4][2], const Unit& u, int wr, int wc, int fr, int fq) const {
        const int row0 = u.pm * BM + wr * 64 + fr; const int col0 = u.pn * BM + wc * 32 + 8 * fq;
        f32x4 sv[2][2];
#pragma unroll
        for (int bj = 0; bj < 2; ++bj)
#pragma unroll
            for (int n = 0; n < 2; ++n) sv[bj][n] = colscale ? *(const f32x4*)(colscale + col0 + bj * HALF + 4 * n) : (f32x4){1.f, 1.f, 1.f, 1.f};
#pragma unroll
        for (int ai = 0; ai < 2; ++ai)
#pragma unroll
            for (int m = 0; m < 4; ++m) { bf16_t* rowp = O + (size_t)(row0 + ai * HALF + m * 16) * ldc + col0;
#pragma unroll
                for (int bj = 0; bj < 2; ++bj) { const f32x4 v0 = acc[ai][bj][m][0] * sv[bj][0], v1 = acc[ai][bj][m][1] * sv[bj][1];
                    u32x4 w; w.x = cvt_pk_bf16(v0[0], v0[1]); w.y = cvt_pk_bf16(v0[2], v0[3]); w.z = cvt_pk_bf16(v1[0], v1[1]); w.w = cvt_pk_bf16(v1[2], v1[3]);
                    *(u32x4*)(rowp + bj * HALF) = w; } }
    }
};
struct EpiIn {
    static constexpr bool PERM = true;
    bf16_t* Z; bf16_t* Gt; const float* bgate;
    __device__ __forceinline__ void operator()(const f32x4 (&acc)[2][2][4][2], const Unit& u, int wr, int wc, int fr, int fq) const {
        const int row0 = u.pm * BM + wr * 64 + fr; const bool isz = u.pn < 8;
        const int col0 = (isz ? u.pn * BM : (u.pn - 8) * BM) + wc * 32 + 8 * fq;
        bf16_t* base = isz ? Z : Gt; const int ldc = isz ? ZP : GP;
        f32x4 bv[2][2];
#pragma unroll
        for (int bj = 0; bj < 2; ++bj)
#pragma unroll
            for (int n = 0; n < 2; ++n) bv[bj][n] = isz ? (f32x4){0.f, 0.f, 0.f, 0.f} : *(const f32x4*)(bgate + col0 + bj * HALF + 4 * n);
#pragma unroll
        for (int ai = 0; ai < 2; ++ai)
#pragma unroll
            for (int m = 0; m < 4; ++m) { bf16_t* rowp = base + (size_t)(row0 + ai * HALF + m * 16) * ldc + col0;
#pragma unroll
                for (int bj = 0; bj < 2; ++bj) { f32x4 v0 = acc[ai][bj][m][0] + bv[bj][0], v1 = acc[ai][bj][m][1] + bv[bj][1];
                    if (!isz) {
#pragma unroll
                        for (int e = 0; e < 4; ++e) { v0[e] = sigmoidf_(v0[e]); v1[e] = sigmoidf_(v1[e]); } }
                    u32x4 w; w.x = cvt_pk_bf16(v0[0], v0[1]); w.y = cvt_pk_bf16(v0[2], v0[3]); w.z = cvt_pk_bf16(v1[0], v1[1]); w.w = cvt_pk_bf16(v1[2], v1[3]);
                    *(u32x4*)(rowp + bj * HALF) = w; } }
    }
};
struct EpiMerge {
    static constexpr bool PERM = true;
    const bf16_t* Gt; bf16_t* Mrg;
    __device__ __forceinline__ void operator()(const f32x4 (&acc)[2][2][4][2], const Unit& u, int wr, int wc, int fr, int fq) const {
        const int row0 = u.pm * BM + wr * 64 + fr; const int col0 = u.pn * BM + wc * 32 + 8 * fq;
#pragma unroll
        for (int ai = 0; ai < 2; ++ai)
#pragma unroll
            for (int m = 0; m < 4; ++m) { const size_t row = (size_t)(row0 + ai * HALF + m * 16);
#pragma unroll
                for (int bj = 0; bj < 2; ++bj) {
                    const u32x4 gw = *(const u32x4*)(Gt + row * GP + u.g * 1024 + col0 + bj * HALF);
                    bf16_t* mp = Mrg + row * 1024 + col0 + bj * HALF;
                    const f32x4 a0 = acc[ai][bj][m][0], a1 = acc[ai][bj][m][1];
                    float v[8];
                    v[0] = bf_lo(gw.x) * a0[0]; v[1] = bf_hi(gw.x) * a0[1]; v[2] = bf_lo(gw.y) * a0[2]; v[3] = bf_hi(gw.y) * a0[3];
                    v[4] = bf_lo(gw.z) * a1[0]; v[5] = bf_hi(gw.z) * a1[1]; v[6] = bf_lo(gw.w) * a1[2]; v[7] = bf_hi(gw.w) * a1[3];
                    if (u.g != 0) { const u32x4 ow = *(const u32x4*)mp;
                        v[0] += bf_lo(ow.x); v[1] += bf_hi(ow.x); v[2] += bf_lo(ow.y); v[3] += bf_hi(ow.y); v[4] += bf_lo(ow.z); v[5] += bf_hi(ow.z); v[6] += bf_lo(ow.w); v[7] += bf_hi(ow.w); }
                    u32x4 w; w.x = cvt_pk_bf16(v[0], v[1]); w.y = cvt_pk_bf16(v[2], v[3]); w.z = cvt_pk_bf16(v[4], v[5]); w.w = cvt_pk_bf16(v[6], v[7]);
                    *(u32x4*)mp = w; } }
    }
};
struct EpiRes {
    static constexpr bool PERM = false;
    const float* base_lat; const float* base_ctx; float* out_lat; float* out_ctx; const float* modl; int gate_idx;
    __device__ __forceinline__ void operator()(const f32x4 (&acc)[2][2][4][2], const Unit& u, int wr, int wc, int fr, int fq) const {
        const bool lat = u.pm < (NLAT / BM);
        const int prow = lat ? u.pm * BM : (u.pm * BM - NLAT);
        const float* base = lat ? base_lat : base_ctx; float* out = lat ? out_lat : out_ctx;
        const int b = lat ? (u.pm * BM) / SEQ : NB;
        const int col0 = u.pn * BM + wc * 32 + 4 * fq;
        const float* gp = modl + (size_t)(b * 6 + gate_idx) * 1024 + col0;
        f32x4 gv[2][2];
#pragma unroll
        for (int bj = 0; bj < 2; ++bj)
#pragma unroll
            for (int n = 0; n < 2; ++n) gv[bj][n] = *(const f32x4*)(gp + bj * HALF + n * 16);
#pragma unroll
        for (int ai = 0; ai < 2; ++ai)
#pragma unroll
            for (int m = 0; m < 4; ++m) { const size_t off = (size_t)(prow + ai * HALF + wr * 64 + m * 16 + fr) * 1024 + col0;
#pragma unroll
                for (int bj = 0; bj < 2; ++bj)
#pragma unroll
                    for (int n = 0; n < 2; ++n) { const f32x4 bs = *(const f32x4*)(base + off + bj * HALF + n * 16);
                        *(f32x4*)(out + off + bj * HALF + n * 16) = bs + gv[bj][n] * acc[ai][bj][m][n]; } }
    }
};

template <class Epi, bool ALIGN_EPI>
__device__ __forceinline__ void gemm_phase(PG8_LAS unsigned char* lds, const Gemm g, const Order& S, const Epi& E) {
    int tid = threadIdx.x; asm volatile("" : "+v"(tid));
    const int wid = __builtin_amdgcn_readfirstlane(tid >> 6), lane = tid & 63, wr = wid >> 2, wc = wid & 3, fr = lane & 15, fq = lane >> 4;
    const int K = g.K, nt = K / BK;
    unsigned voffA[2], voffB[2];
#pragma unroll
    for (int i = 0; i < 2; ++i) { int R, C; stage_rc(tid * 16 + i * 8192, R, C); const int Rb = Epi::PERM ? ((R & ~31) + perm32(R & 31)) : R;
        voffA[i] = (unsigned)(R * g.lda + C) * 2u; voffB[i] = (unsigned)(Rb * g.ldb + C) * 2u; }
    const size_t kstep = (size_t)(BK * 2);
    const size_t hstepA = (size_t)HALF * g.lda * 2, hstepB = (size_t)HALF * g.ldb * 2;
    const size_t tstepA = 2 * hstepA, tstepB = 2 * hstepB;
    const unsigned ldsw = (unsigned)wid * 1024u;
    const int aoff = lds_byte(wr * 64 + fr, fq * 8), boff = lds_byte(wc * 32 + fr, fq * 8);
#define PG8_UA(u) ((const char*)g.A + (size_t)(u).pm * tstepA + (size_t)((long)(u).g * g.a_goff * 2))
#define PG8_UB(u) ((const char*)g.Bt + (size_t)(u).pn * tstepB + (size_t)((long)(u).g * g.b_goff * 2))
#define PG8_SA(b, h) (((b) * 2 + (h)) * HTB)
#define PG8_SB(b, h) ((4 + (b) * 2 + (h)) * HTB)
#define PG8_STAGE(bufoff, gbase, voff) do { _Pragma("unroll") for (int _i = 0; _i < 2; ++_i) \
        __builtin_amdgcn_global_load_lds((const unsigned*)((const char*)(gbase) + (voff)[_i]), (PG8_LAS unsigned*)(lds + (bufoff) + ldsw + _i * 8192), 16, 0, 0); } while (0)
#define PG8_LDA(dst, b, h) do { _Pragma("unroll") for (int m = 0; m < 4; ++m) _Pragma("unroll") for (int k = 0; k < 2; ++k) dst[m][k] = *(const PG8_LAS bf16x8*)(lds + PG8_SA(b, h) + aoff + m * 2048 + k * 1024); } while (0)
#define PG8_LDB(dst, b, h) do { _Pragma("unroll") for (int n = 0; n < 2; ++n) _Pragma("unroll") for (int k = 0; k < 2; ++k) dst[n][k] = *(const PG8_LAS bf16x8*)(lds + PG8_SB(b, h) + boff + n * 2048 + k * 1024); } while (0)
#define PG8_MMA(ai, bj, At, Bt) do { __builtin_amdgcn_s_setprio(1); _Pragma("unroll") for (int m = 0; m < 4; ++m) _Pragma("unroll") for (int n = 0; n < 2; ++n) _Pragma("unroll") for (int k = 0; k < 2; ++k) \
        acc[ai][bj][m][n] = __builtin_amdgcn_mfma_f32_16x16x32_bf16(Bt[n][k], At[m][k], acc[ai][bj][m][n], 0, 0, 0); __builtin_amdgcn_s_setprio(0); } while (0)
#define PG8_WAIT_V(n) asm volatile("s_waitcnt vmcnt(" #n ")" ::: "memory")
#define PG8_WAIT_L(n) asm volatile("s_waitcnt lgkmcnt(" #n ")" ::: "memory")
#define PG8_BAR __builtin_amdgcn_s_barrier()
#define PG8_SCHED __builtin_amdgcn_sched_barrier(0)
    Unit cur, nxt; int ui = 0;
    if (!S.next(0, cur)) return;
    f32x4 acc[2][2][4][2];
#pragma unroll
    for (int a = 0; a < 2; ++a)
#pragma unroll
        for (int b = 0; b < 2; ++b)
#pragma unroll
            for (int m = 0; m < 4; ++m)
#pragma unroll
                for (int n = 0; n < 2; ++n) acc[a][b][m][n] = (f32x4){0.f, 0.f, 0.f, 0.f};
    bf16x8 At[4][2], B0[2][2], B1[2][2];
    const char* cA = PG8_UA(cur); const char* cB = PG8_UB(cur);
    PG8_STAGE(PG8_SB(0, 0), cB, voffB); PG8_STAGE(PG8_SB(0, 1), cB + hstepB, voffB); PG8_STAGE(PG8_SA(0, 0), cA, voffA); PG8_STAGE(PG8_SA(0, 1), cA + hstepA, voffA);
    if (wr == 1) PG8_BAR;
    PG8_WAIT_V(2); PG8_BAR;
    PG8_STAGE(PG8_SB(1, 0), cB + kstep, voffB); PG8_STAGE(PG8_SA(1, 0), cA + kstep, voffA); PG8_STAGE(PG8_SB(1, 1), cB + hstepB + kstep, voffB);
    PG8_WAIT_V(6); PG8_BAR;
    for (;;) {
        const bool has_next = S.next(ui + 1, nxt);
        const char* nA = has_next ? PG8_UA(nxt) : cA; const char* nB = has_next ? PG8_UB(nxt) : cB;
        for (int t = 0; t < nt; t += 2) {
            const bool last = (t == nt - 2);
            const char* a1 = cA + (size_t)(t + 1) * kstep;
            const char* a2 = last ? nA : cA + (size_t)(t + 2) * kstep; const char* b2 = last ? nB : cB + (size_t)(t + 2) * kstep;
            const char* a3 = a2 + kstep; const char* b3 = b2 + kstep;
            PG8_LDB(B0, 0, 0); PG8_LDB(B1, 0, 1); PG8_SCHED; PG8_LDA(At, 0, 0); PG8_STAGE(PG8_SA(1, 1), a1 + hstepA, voffA);
            PG8_WAIT_V(8); PG8_WAIT_L(0); PG8_BAR; PG8_MMA(0, 0, At, B0); PG8_MMA(0, 1, At, B1); PG8_BAR; PG8_SCHED;
            PG8_LDA(At, 0, 1); PG8_STAGE(PG8_SB(0, 0), b2, voffB); PG8_STAGE(PG8_SB(0, 1), b2 + hstepB, voffB); PG8_STAGE(PG8_SA(0, 0), a2, voffA);
            PG8_WAIT_V(8); PG8_WAIT_L(0); PG8_BAR; PG8_MMA(1, 0, At, B0); PG8_MMA(1, 1, At, B1); PG8_BAR; PG8_SCHED;
            PG8_LDB(B0, 1, 0); PG8_LDB(B1, 1, 1); PG8_SCHED; PG8_LDA(At, 1, 0); PG8_STAGE(PG8_SA(0, 1), a2 + hstepA, voffA);
            PG8_WAIT_V(8); PG8_WAIT_L(0); PG8_BAR; PG8_MMA(0, 0, At, B0); PG8_MMA(0, 1, At, B1); PG8_BAR; PG8_SCHED;
            PG8_LDA(At, 1, 1); PG8_STAGE(PG8_SB(1, 0), b3, voffB); PG8_STAGE(PG8_SB(1, 1), b3 + hstepB, voffB); PG8_STAGE(PG8_SA(1, 0), a3, voffA);
            PG8_WAIT_V(8); PG8_WAIT_L(0); PG8_BAR; PG8_MMA(1, 0, At, B0); PG8_MMA(1, 1, At, B1); PG8_BAR; PG8_SCHED;
        }
        if constexpr (ALIGN_EPI) { if (wr == 0) PG8_BAR; }
        E(acc, cur, wr, wc, fr, fq);
        if (!has_next) break;
#pragma unroll
        for (int a = 0; a < 2; ++a)
#pragma unroll
            for (int b = 0; b < 2; ++b)
#pragma unroll
                for (int m = 0; m < 4; ++m)
#pragma unroll
                    for (int n = 0; n < 2; ++n) acc[a][b][m][n] = (f32x4){0.f, 0.f, 0.f, 0.f};
        cur = nxt; cA = nA; cB = nB; ++ui;
        if constexpr (ALIGN_EPI) { if (wr == 1) PG8_BAR; }
    }
    PG8_WAIT_V(0);
    if constexpr (!ALIGN_EPI) { if (wr == 0) PG8_BAR; }
    PG8_BAR;
#undef PG8_UA
#undef PG8_UB
#undef PG8_SA
#undef PG8_SB
#undef PG8_STAGE
#undef PG8_LDA
#undef PG8_LDB
#undef PG8_MMA
#undef PG8_WAIT_V
#undef PG8_WAIT_L
#undef PG8_BAR
#undef PG8_SCHED
}
}

namespace attn_body {
using bf16 = __hip_bfloat16;
using bf16x8 = __attribute__((ext_vector_type(8))) short;
using s16x4 = __attribute__((ext_vector_type(4))) short;
using f32x16 = __attribute__((ext_vector_type(16))) float;
using u32x4 = __attribute__((ext_vector_type(4))) unsigned;
constexpr int D = 64, NW = 8, QBLK = 32, QB = QBLK * NW, KVBLK = 64;
__device__ __forceinline__ int crow(int r, int hi) { return (r & 3) + 8 * (r >> 2) + 4 * hi; }
#define SBAR() __builtin_amdgcn_sched_barrier(0)
__device__ __forceinline__ void wmask(f32x16& p0, f32x16& p1, int d0) {
    const float NEG = -INFINITY;
#pragma unroll
    for (int r = 0; r < 16; ++r) { const int d = d0 + (r & 3) + 8 * (r >> 2); if (d > 128 || d < -128) p0[r] = NEG; if (d + 32 > 128 || d + 32 < -128) p1[r] = NEG; }
}
constexpr int NSLOT = 3, SLOTB = 8192;
constexpr int LDS_K = 0, LDS_V = NSLOT * SLOTB, LDS_WS = 2 * NSLOT * SLOTB, LDS_OST = LDS_WS + NW * 64 * 4, LDS_BYTES = LDS_OST + NW * 4096;
__device__ __forceinline__ void glds16(const void* gsrc, unsigned lds_dst) { unsigned keep;
    asm volatile("s_mov_b32 %0, m0\n\ts_mov_b32 m0, %2\n\ts_nop 0\n\tglobal_load_lds_dwordx4 %1, off\n\ts_mov_b32 m0, %0" : "=&s"(keep) : "v"(gsrc), "s"(lds_dst) : "memory"); }
__device__ __forceinline__ float max3f(float a, float b, float c) { float r; asm("v_max3_f32 %0, %1, %2, %3" : "=v"(r) : "v"(a), "v"(b), "v"(c)); return r; }
__device__ __forceinline__ float max2f(float a, float b) { float r; asm("v_max_f32_e32 %0, %1, %2" : "=v"(r) : "v"(a), "v"(b)); return r; }
__device__ __forceinline__ float fadd_s(float a, float b) { float r; asm("v_add_f32_e32 %0, %1, %2" : "=v"(r) : "v"(a), "v"(b)); return r; }
__device__ __forceinline__ float fsub_s(float a, float b) { float r; asm("v_sub_f32_e32 %0, %1, %2" : "=v"(r) : "v"(a), "v"(b)); return r; }
typedef float f32x2_t __attribute__((ext_vector_type(2))); typedef __bf16 bf16x2_t __attribute__((ext_vector_type(2)));
__device__ __forceinline__ unsigned cvtpk_s(float lo, float hi) { f32x2_t v = {lo, hi}; bf16x2_t b = __builtin_convertvector(v, bf16x2_t); return __builtin_bit_cast(unsigned, b); }
#define WAIT_BAR(N) asm volatile("s_waitcnt vmcnt(" #N ") lgkmcnt(0)\n\ts_barrier" ::: "memory")

__device__ __forceinline__ void qkt(f32x16& p0, f32x16& p1, const char* Kslot, const bf16x8* qr, const f32x16& negm, int r32, int hi) {
    const char* kb = Kslot + hi * 1024 + r32 * 16;
#pragma unroll
    for (int d0 = 0; d0 < 4; ++d0) {
        const bf16x8 b0 = *reinterpret_cast<const bf16x8*>(kb + d0 * 2048);
        const bf16x8 b1 = *reinterpret_cast<const bf16x8*>(kb + d0 * 2048 + 512);
        if (d0 == 0) { p0 = __builtin_amdgcn_mfma_f32_32x32x16_bf16(b0, qr[0], negm, 0, 0, 0); p1 = __builtin_amdgcn_mfma_f32_32x32x16_bf16(b1, qr[0], negm, 0, 0, 0); }
        else { p0 = __builtin_amdgcn_mfma_f32_32x32x16_bf16(b0, qr[d0], p0, 0, 0, 0); p1 = __builtin_amdgcn_mfma_f32_32x32x16_bf16(b1, qr[d0], p1, 0, 0, 0); } }
}
typedef __attribute__((address_space(3))) const char* lds_cptr;
typedef short v4i16_t __attribute__((ext_vector_type(4)));
__device__ __forceinline__ void kload8(bf16x8* kf, lds_cptr kp) {
    kf[0] = *(const __attribute__((address_space(3))) bf16x8*)(kp);        kf[1] = *(const __attribute__((address_space(3))) bf16x8*)(kp + 512);
    kf[2] = *(const __attribute__((address_space(3))) bf16x8*)(kp + 2048); kf[3] = *(const __attribute__((address_space(3))) bf16x8*)(kp + 2560);
    kf[4] = *(const __attribute__((address_space(3))) bf16x8*)(kp + 4096); kf[5] = *(const __attribute__((address_space(3))) bf16x8*)(kp + 4608);
    kf[6] = *(const __attribute__((address_space(3))) bf16x8*)(kp + 6144); kf[7] = *(const __attribute__((address_space(3))) bf16x8*)(kp + 6656);
}
__device__ __forceinline__ void kload2(bf16x8* kf, lds_cptr kp, int j) { kf[2 * j] = *(const __attribute__((address_space(3))) bf16x8*)(kp + j * 2048); kf[2 * j + 1] = *(const __attribute__((address_space(3))) bf16x8*)(kp + j * 2048 + 512); }
__device__ __forceinline__ s16x4 vtr(lds_cptr p) { return __builtin_bit_cast(s16x4, __builtin_amdgcn_ds_read_tr16_b64_v4i16((__attribute__((address_space(3))) v4i16_t*)p)); }
__device__ __forceinline__ float rowmax(const f32x16& p0, const f32x16& p1) {
    float a = max3f(p0[0], p0[1], p1[0]), b = max3f(p0[2], p0[3], p1[1]); a = max3f(a, p1[2], p1[3]);
#pragma unroll
    for (int r = 4; r < 16; r += 4) { a = max3f(a, p0[r], p0[r + 1]); b = max3f(b, p0[r + 2], p0[r + 3]); a = max3f(a, p1[r], p1[r + 1]); b = max3f(b, p1[r + 2], p1[r + 3]); }
    const float m = max2f(a, b);
    auto rr = __builtin_amdgcn_permlane32_swap(__float_as_uint(m), __float_as_uint(m), false, false);
    return max2f(__uint_as_float(rr[0]), __uint_as_float(rr[1]));
}
__device__ __forceinline__ void pv(f32x16* o, int vb, bf16x8 pa0, bf16x8 pa1, bf16x8 pa2, bf16x8 pa3) {
#pragma unroll
    for (int d0 = 0; d0 < 2; ++d0) { s16x4 lo[4], hi[4];
#pragma unroll
        for (int ks = 0; ks < 4; ++ks) {
            asm volatile("ds_read_b64_tr_b16 %0,%1 offset:%c2" : "=&v"(lo[ks]) : "v"(vb), "i"(d0 * 4096 + ks * 1024) : "memory");
            asm volatile("ds_read_b64_tr_b16 %0,%1 offset:%c2" : "=&v"(hi[ks]) : "v"(vb), "i"(d0 * 4096 + ks * 1024 + 512) : "memory"); }
        asm volatile("s_waitcnt lgkmcnt(0)" ::: "memory"); SBAR();
#define PK(k) (bf16x8){lo[k][0], lo[k][1], lo[k][2], lo[k][3], hi[k][0], hi[k][1], hi[k][2], hi[k][3]}
        o[d0] = __builtin_amdgcn_mfma_f32_32x32x16_bf16(pa0, PK(0), o[d0], 0, 0, 0);
        o[d0] = __builtin_amdgcn_mfma_f32_32x32x16_bf16(pa1, PK(1), o[d0], 0, 0, 0);
        o[d0] = __builtin_amdgcn_mfma_f32_32x32x16_bf16(pa2, PK(2), o[d0], 0, 0, 0);
        o[d0] = __builtin_amdgcn_mfma_f32_32x32x16_bf16(pa3, PK(3), o[d0], 0, 0, 0);
#undef PK
    }
}
template <int THRL, bool WMASK> __device__ __forceinline__ void attn_unit(const bf16* Qw0, const bf16* __restrict__ Kc, const bf16* __restrict__ Vc, long dlat, int NT, int kd0,
                                                                         bool has_sink, float sinkl2, bf16* Ow0, char* shm) {
    int tid = threadIdx.x; asm volatile("" : "+v"(tid));
    const int lane = tid & 63, r32 = lane & 31, hi = lane >> 5; const int wid = __builtin_amdgcn_readfirstlane(tid >> 6);
    const bf16* Qw = Qw0 + (long)(wid * QBLK) * ZP;
    const unsigned lds0 = (unsigned)(uintptr_t)shm;
    float* wsf = (float*)(shm + LDS_WS) + wid * 64;
    const bf16* ksrc = Kc + (long)lane * ZP + wid * 8;
    const bf16* vsrc = Vc + (long)(16 * (wid & 3) + (lane >> 2)) * ZP + (wid >> 2) * 32 + (lane & 3) * 8;
    const unsigned kdst = lds0 + LDS_K + wid * 1024, vdst = lds0 + LDS_V + wid * 1024;
#define TOFF(t) (((t) < 4) ? (long)(t) * (KVBLK * ZP) : dlat + (long)((t) - 4) * (KVBLK * ZP))
#define DMA_K(t, slot) glds16(ksrc + TOFF(t), (unsigned)__builtin_amdgcn_readfirstlane(kdst + (slot)))
#define DMA_V(t, slot) glds16(vsrc + TOFF(t), (unsigned)__builtin_amdgcn_readfirstlane(vdst + (slot)))
    const int vb0 = (int)(lds0 + LDS_V) + ((lane >> 4) & 1) * 32 + (lane & 3) * 8 + (4 * hi + ((lane & 15) >> 2)) * 64;
    const char* Kbase = shm + LDS_K; bf16x8 kf[8];
    const lds_cptr shm3 = (lds_cptr)shm; const lds_cptr kp0 = shm3 + LDS_K + hi * 1024 + r32 * 16; const lds_cptr vp0 = shm3 + LDS_V + ((lane >> 4) & 1) * 32 + (lane & 3) * 8 + (4 * hi + ((lane & 15) >> 2)) * 64;
    DMA_K(0, 0); DMA_V(0, 0); DMA_K(1, SLOTB);
    bf16x8 qr[4];
#pragma unroll
    for (int d0 = 0; d0 < 4; ++d0) qr[d0] = *reinterpret_cast<const bf16x8*>(&Qw[(long)r32 * ZP + d0 * 16 + hi * 8]);
    float mhat = 0.f, l_reg = 0.f; f32x16 o[2]; o[0] = f32x16{}; o[1] = f32x16{}; f32x16 negm = f32x16{}; asm volatile("" : "+v"(negm));
    const int qrel = wid * QBLK + r32;
#define CMASK(P0, P1, t) do { if constexpr (WMASK) { if ((t) >= 4) wmask(P0, P1, kd0 + ((t) - 4) * KVBLK - qrel + 4 * hi); } } while (0)
    bool resc = false;
#define START(P0, P1) do { const float rm = rowmax(P0, P1); resc = false; \
    { const float dl = rm; mhat = fadd_s(mhat, dl); \
      _Pragma("unroll") for (int r = 0; r < 16; ++r) { P0[r] = fsub_s(P0[r], dl); P1[r] = fsub_s(P1[r], dl); } \
      _Pragma("unroll") for (int r = 0; r < 16; ++r) negm[r] = -mhat; asm volatile("" : "+v"(negm)); } \
    _Pragma("unroll") for (int r = 0; r < 16; ++r) P0[r] = __builtin_amdgcn_exp2f(P0[r]); } while (0)
#define RESC() do { if (resc) { asm volatile("s_waitcnt lgkmcnt(0)" ::: "memory"); \
      _Pragma("unroll") for (int d_ = 0; d_ < 2; ++d_) _Pragma("unroll") for (int r = 0; r < 16; ++r) o[d_][r] *= wsf[crow(r, hi)]; } } while (0)
    f32x16 pA0, pA1, pB0, pB1;
    int sl_prev = 0, sl_cur = 0, sl_next = SLOTB;
#define ROT() do { sl_prev = sl_cur; sl_cur = sl_next; sl_next = (sl_next == (NSLOT - 1) * SLOTB) ? 0 : sl_next + SLOTB; } while (0)
    DMA_K(2, 2 * SLOTB);
    WAIT_BAR(3);
    qkt(pA0, pA1, Kbase, qr, negm, r32, hi); asm volatile("s_nop 15\n\ts_nop 7" : "+v"(pA0), "+v"(pA1));
    START(pA0, pA1);
    _Pragma("unroll") for (int r = 0; r < 16; ++r) pA1[r] = __builtin_amdgcn_exp2f(pA1[r]);
    WAIT_BAR(0);
    DMA_K(3, 0); DMA_V(1, SLOTB);
    ROT();
    kload8(kf, kp0 + sl_cur);
    WAIT_BAR(2);
    s16x4 vlo[8], vhi[8]; u32x4 pw0, pw1, pw2, pw3;
#define PKW(P, B) cvtpk_s(P[B], P[B + 1])
#define PAF(k) __builtin_bit_cast(bf16x8, pw##k)
#define VFR(i) (bf16x8){vlo[i][0], vlo[i][1], vlo[i][2], vlo[i][3], vhi[i][0], vhi[i][1], vhi[i][2], vhi[i][3]}
#define PIN(x) asm volatile("" : "+v"(x))
#define MX3(a, b, c) __builtin_fmaxf(__builtin_fmaxf((a), (b)), (c))
#define GAPA(MF, A0, A1, A2, A3, W0, W1, PW) do { MF; sacc += A0; sacc += A1; sacc += A2; sacc += A3; PIN(sacc); W0; W1; PIN(PW); SBAR(); } while (0)
#define EX(v) __builtin_amdgcn_exp2f(v)
#define GAPB(MF, X, B) do { MF; X[B] = EX(X[B]); X[B + 1] = EX(X[B + 1]); X[B + 2] = EX(X[B + 2]); X[B + 3] = EX(X[B + 3]); PIN(X); SBAR(); } while (0)
#define VRD(i) do { vlo[i] = vtr(vp_ + (((i) >> 2) * 4096 + ((i) & 3) * 1024)); vhi[i] = vtr(vp_ + (((i) >> 2) * 4096 + ((i) & 3) * 1024 + 512)); } while (0)
#define KRD(G, j) do { if (G) { kload2(kf, kp0 + sl_next, j); SBAR(); } } while (0)
#define STEP(C0, C1, P0, P1, t, GK, GV, GL) do { SBAR(); \
    const lds_cptr vp_ = vp0 + sl_prev; \
    VRD(0); SBAR(); float sacc = (P0[0] + P0[1]); \
    GAPA(C0 = __builtin_amdgcn_mfma_f32_32x32x16_bf16(kf[0], qr[0], negm, 0, 0, 0), P0[2], P0[3], P0[4], P0[5],     pw0[0] = PKW(P0, 0), pw0[1] = PKW(P0, 2), pw0); \
    VRD(4); SBAR(); GAPA(C1 = __builtin_amdgcn_mfma_f32_32x32x16_bf16(kf[1], qr[0], negm, 0, 0, 0), P0[6], P0[7], P0[8], P0[9],     pw0[2] = PKW(P0, 4), pw0[3] = PKW(P0, 6), pw0); \
    VRD(1); SBAR(); GAPA(C0 = __builtin_amdgcn_mfma_f32_32x32x16_bf16(kf[2], qr[1], C0, 0, 0, 0),   P0[10], P0[11], P0[12], P0[13], pw1[0] = PKW(P0, 8), pw1[1] = PKW(P0, 10), pw1); \
    VRD(5); SBAR(); GAPA(C1 = __builtin_amdgcn_mfma_f32_32x32x16_bf16(kf[3], qr[1], C1, 0, 0, 0),   P0[14], P0[15], P1[0], P1[1],   pw1[2] = PKW(P0, 12), pw1[3] = PKW(P0, 14), pw1); \
    VRD(2); SBAR(); GAPA(C0 = __builtin_amdgcn_mfma_f32_32x32x16_bf16(kf[4], qr[2], C0, 0, 0, 0),   P1[2], P1[3], P1[4], P1[5],     pw2[0] = PKW(P1, 0), pw2[1] = PKW(P1, 2), pw2); \
    VRD(6); SBAR(); GAPA(C1 = __builtin_amdgcn_mfma_f32_32x32x16_bf16(kf[5], qr[2], C1, 0, 0, 0),   P1[6], P1[7], P1[8], P1[9],     pw2[2] = PKW(P1, 4), pw2[3] = PKW(P1, 6), pw2); \
    VRD(3); SBAR(); GAPA(C0 = __builtin_amdgcn_mfma_f32_32x32x16_bf16(kf[6], qr[3], C0, 0, 0, 0),   P1[10], P1[11], P1[12], P1[13], pw3[0] = PKW(P1, 8), pw3[1] = PKW(P1, 10), pw3); \
    VRD(7); SBAR(); GAPA(C1 = __builtin_amdgcn_mfma_f32_32x32x16_bf16(kf[7], qr[3], C1, 0, 0, 0),   P1[14], P1[15], 0.f, 0.f,       pw3[2] = PKW(P1, 12), pw3[3] = PKW(P1, 14), pw3); \
    l_reg += sacc; \
    if (GK) { DMA_K((t) + 3, sl_cur); } if (GV) { DMA_V((t) + 1, sl_next); } \
    CMASK(C0, C1, t); \
    { float a = MX3(C0[0], C0[1], C1[0]), b = MX3(C0[2], C0[3], C1[1]); a = MX3(a, C1[2], C1[3]); \
      _Pragma("unroll") for (int r = 4; r < 16; r += 4) { a = MX3(a, C0[r], C0[r + 1]); b = MX3(b, C0[r + 2], C0[r + 3]); a = MX3(a, C1[r], C1[r + 1]); b = MX3(b, C1[r + 2], C1[r + 3]); } \
      float rm = __builtin_fmaxf(a, b); { auto rr = __builtin_amdgcn_permlane32_swap(__float_as_uint(rm), __float_as_uint(rm), false, false); rm = __builtin_fmaxf(__uint_as_float(rr[0]), __uint_as_float(rr[1])); } \
      resc = false; \
      if (__builtin_expect(__any(rm > (float)THRL), 0)) { const float dl = __builtin_fmaxf(rm, 0.f); mhat += dl; \
        _Pragma("unroll") for (int r = 0; r < 16; ++r) { C0[r] -= dl; C1[r] -= dl; } \
        _Pragma("unroll") for (int r = 0; r < 16; ++r) negm[r] = -mhat; asm volatile("" : "+v"(negm)); \
        const float f = __builtin_amdgcn_exp2f(-dl); l_reg *= f; if (hi == 0) wsf[r32] = f; resc = true; } } \
    SBAR(); \
    GAPB(o[0] = __builtin_amdgcn_mfma_f32_32x32x16_bf16(PAF(0), VFR(0), o[0], 0, 0, 0), C0, 0); \
    GAPB(o[1] = __builtin_amdgcn_mfma_f32_32x32x16_bf16(PAF(0), VFR(4), o[1], 0, 0, 0), C0, 4); \
    KRD(GL, 0); GAPB(o[0] = __builtin_amdgcn_mfma_f32_32x32x16_bf16(PAF(1), VFR(1), o[0], 0, 0, 0), C0, 8); \
    KRD(GL, 1); GAPB(o[1] = __builtin_amdgcn_mfma_f32_32x32x16_bf16(PAF(1), VFR(5), o[1], 0, 0, 0), C0, 12); \
    KRD(GL, 2); GAPB(o[0] = __builtin_amdgcn_mfma_f32_32x32x16_bf16(PAF(2), VFR(2), o[0], 0, 0, 0), C1, 0); \
    KRD(GL, 3); GAPB(o[1] = __builtin_amdgcn_mfma_f32_32x32x16_bf16(PAF(2), VFR(6), o[1], 0, 0, 0), C1, 4); \
    GAPB(o[0] = __builtin_amdgcn_mfma_f32_32x32x16_bf16(PAF(3), VFR(3), o[0], 0, 0, 0), C1, 8); \
    GAPB(o[1] = __builtin_amdgcn_mfma_f32_32x32x16_bf16(PAF(3), VFR(7), o[1], 0, 0, 0), C1, 12); \
    } while (0)
    int t = 1;
    for (; t + 5 < NT; t += 2) {
        STEP(pB0, pB1, pA0, pA1, t, true, true, true);     WAIT_BAR(2); RESC(); ROT();
        STEP(pA0, pA1, pB0, pB1, t + 1, true, true, true); WAIT_BAR(2); RESC(); ROT();
    }
#define ENDW(tt) do { if ((tt) + 3 < NT) { WAIT_BAR(2); } else if ((tt) + 2 < NT) { WAIT_BAR(1); } else { WAIT_BAR(0); } } while (0)
    for (; t + 1 < NT; t += 2) {
        STEP(pB0, pB1, pA0, pA1, t, (t + 3 < NT), (t + 1 < NT), (t + 1 < NT));         ENDW(t);     RESC(); ROT();
        STEP(pA0, pA1, pB0, pB1, t + 1, (t + 4 < NT), (t + 2 < NT), (t + 2 < NT));     ENDW(t + 1); RESC(); ROT();
    }
    STEP(pB0, pB1, pA0, pA1, NT - 1, false, false, false); RESC();
    { float sacc = pB0[0] + pB0[1]; _Pragma("unroll") for (int r = 2; r < 16; ++r) sacc += pB0[r]; _Pragma("unroll") for (int r = 0; r < 16; ++r) sacc += pB1[r]; l_reg += sacc;
      pw0 = (u32x4){PKW(pB0, 0), PKW(pB0, 2), PKW(pB0, 4), PKW(pB0, 6)}; pw1 = (u32x4){PKW(pB0, 8), PKW(pB0, 10), PKW(pB0, 12), PKW(pB0, 14)}; pw2 = (u32x4){PKW(pB1, 0), PKW(pB1, 2), PKW(pB1, 4), PKW(pB1, 6)}; pw3 = (u32x4){PKW(pB1, 8), PKW(pB1, 10), PKW(pB1, 12), PKW(pB1, 14)};
      SBAR(); pv(o, vb0 + sl_cur, PAF(0), PAF(1), PAF(2), PAF(3)); }
#undef PKW
#undef PAF
#undef VFR
#undef PIN
#undef MX3
#undef GAPA
#undef GAPB
#undef EX
#undef VRD
#undef KRD
#undef STEP
#undef ENDW
    { auto rr = __builtin_amdgcn_permlane32_swap(__float_as_uint(l_reg), __float_as_uint(l_reg), false, false); l_reg = __uint_as_float(rr[0]) + __uint_as_float(rr[1]); }
    if (has_sink) l_reg += __builtin_amdgcn_exp2f(sinkl2 - mhat);
    if (hi == 0) wsf[32 + r32] = l_reg; asm volatile("s_waitcnt lgkmcnt(0)" ::: "memory");
    float rli[16];
#pragma unroll
    for (int r = 0; r < 16; ++r) rli[r] = __builtin_amdgcn_rcpf(wsf[32 + crow(r, hi)]);
    bf16* Ow = Ow0 + (long)(wid * QBLK) * YP;
    { bf16* stg = (bf16*)(shm + LDS_OST) + wid * 2048;
#pragma unroll
      for (int r = 0; r < 16; ++r) { const int orow = crow(r, hi);
#pragma unroll
        for (int d0 = 0; d0 < 2; ++d0) stg[orow * 64 + d0 * 32 + r32] = __float2bfloat16(o[d0][r] * rli[r]); }
      asm volatile("s_waitcnt lgkmcnt(0)" ::: "memory");
#pragma unroll
      for (int i = 0; i < 4; ++i) { const int row = i * 8 + (lane >> 3), ch = lane & 7; const u32x4 v = *(const u32x4*)(stg + row * 64 + ch * 8); *(u32x4*)(Ow + (long)row * YP + ch * 8) = v; } }
    asm volatile("s_waitcnt lgkmcnt(0)\n\ts_barrier" ::: "memory");
#undef DMA_K
#undef DMA_V
#undef TOFF
#undef CMASK
#undef START
#undef RESC
#undef ROT
}
constexpr int ATTN_LDS_BYTES = LDS_BYTES;
#undef SBAR
#undef WAIT_BAR
}

constexpr int NWAVES = 8, NTHREADS = NWAVES * 64;
constexpr int RING_BYTES = 131072, LDS_BYTES = 147456;
#define LAS __attribute__((address_space(3)))
typedef unsigned short bf16;
typedef unsigned v4u __attribute__((ext_vector_type(4)));
typedef unsigned v2u __attribute__((ext_vector_type(2)));
typedef float f32x4 __attribute__((ext_vector_type(4)));
using pg8::cvt_pk_bf16; using pg8::bf_lo; using pg8::bf_hi;

constexpr size_t MiB = 1u << 20;
constexpr size_t WS_MOD = 0;
constexpr size_t WS_W = 2 * MiB;
constexpr size_t LW_IN = 0;
constexpr size_t LW_POOL = LW_IN + (size_t)5120 * 1024 * 2;
constexpr size_t LW_BR = LW_POOL + (size_t)512 * 256 * 2;
constexpr size_t LW_OUT = LW_BR + (size_t)3072 * 512 * 2;
constexpr size_t LW_FF = LW_OUT + (size_t)1024 * 1024 * 2;
constexpr size_t LW_DN = LW_FF + (size_t)5632 * 1024 * 2;
constexpr size_t LW_BYTES = LW_DN + (size_t)1024 * 2816 * 2;
constexpr size_t WS_XC = WS_W + ((2 * LW_BYTES + MiB - 1) / MiB) * MiB;
constexpr size_t WS_ARENA = WS_XC + (size_t)NCTX * 1024 * 4;
constexpr size_t AR_Z = 0, AR_G = (size_t)NTOK * ZP * 2, AR_Y = AR_G + (size_t)NTOK * GP * 2, AR_H = AR_Y;
constexpr size_t AR_MRG = AR_Z;
constexpr size_t AR_AV = 0, AR_H2 = (size_t)NTOK * AVP * 2;
constexpr size_t WS_END = WS_ARENA + (size_t)NTOK * 6656 * 2;
static_assert(AR_Y + (size_t)NTOK * YP * 2 == (size_t)NTOK * 6656 * 2 && AR_H2 + (size_t)NTOK * 1024 * 2 == (size_t)NTOK * 6656 * 2, "arena views");

struct Args {
    const float *x, *c, *ctx, *c_ctx, *w_mod, *b_mod, *norm1_g, *norm2_g, *w_in, *w_pool_grp, *pool_scale, *win_sink, *q_norm_g, *k_norm_g,
                *w_branch, *w_gate, *b_gate, *w_out, *w_ff_gate, *w_ff_val, *conv_w, *conv_b, *w_ff_down, *final_g;
    float* out; unsigned char* ws; int ph_lo, ph_hi;
};

__device__ __forceinline__ float wave_sum(float v) {
#pragma unroll
    for (int o = 1; o < 64; o <<= 1) v += __shfl_xor(v, o);
    return v;
}
__device__ __forceinline__ void transpose_item(const float* W, int K, int N, bf16* WT, int ldw, int row_off, LAS float* scr, int item, int lane) {
    const int nblk = N / 32, kb = item / nblk, nb = item % nblk, k0 = 64 * kb, n0 = 32 * nb;
#pragma unroll 8
    for (int i = 0; i < 32; ++i) { const int kk = 2 * i + (lane >> 5); scr[kk * 33 + (lane & 31)] = W[(size_t)(k0 + kk) * N + n0 + (lane & 31)]; }
    asm volatile("s_waitcnt lgkmcnt(0)" ::: "memory");
    const int c = lane & 7;
#pragma unroll
    for (int j = 0; j < 4; ++j) { const int n = (lane >> 3) + 8 * j; const LAS float* s = scr + (8 * c) * 33 + n;
        v4u o; o.x = cvt_pk_bf16(s[0 * 33], s[1 * 33]); o.y = cvt_pk_bf16(s[2 * 33], s[3 * 33]); o.z = cvt_pk_bf16(s[4 * 33], s[5 * 33]); o.w = cvt_pk_bf16(s[6 * 33], s[7 * 33]);
        *(v4u*)(WT + (size_t)(row_off + n0 + n) * ldw + k0 + 8 * c) = o; }
    asm volatile("s_waitcnt lgkmcnt(0)" ::: "memory");
}

__device__ __forceinline__ void prologue(const Args& A, LAS unsigned char* lds, int G, int vcu, int tid, int lane, int wave) {
    float* mod = (float*)(A.ws + WS_MOD);
    if ((int)blockIdx.x < 192) {
        LAS float* S = (LAS float*)lds; LAS float* part = (LAS float*)(lds + 17 * 1024 * 4);
        for (int idx = tid; idx < 17 * 1024; idx += NTHREADS) { const int r = idx >> 10, k = idx & 1023; const float v = (r < 16) ? A.c[r * 1024 + k] : A.c_ctx[k];
            S[idx] = v / (1.0f + __builtin_amdgcn_exp2f(-v * LOG2E)); }
        __syncthreads();
        for (int u = blockIdx.x; u < 192; u += G) {
            const int l = u / 96, n0 = (u % 96) * 64;
            float acc[17];
#pragma unroll
            for (int r = 0; r < 17; ++r) acc[r] = 0.f;
            const float* W = A.w_mod + (size_t)l * 1024 * 6144 + n0 + lane;
#pragma unroll 4
            for (int kk = 0; kk < 128; ++kk) { const int k = kk * 8 + wave; const float w = W[(size_t)k * 6144];
#pragma unroll
                for (int r = 0; r < 17; ++r) acc[r] += S[r * 1024 + k] * w; }
#pragma unroll
            for (int r = 0; r < 17; ++r) part[(wave * 17 + r) * 64 + lane] = acc[r];
            __syncthreads();
            for (int idx = tid; idx < 17 * 64; idx += NTHREADS) { const int r = idx >> 6, j = idx & 63; float s = 0.f;
#pragma unroll
                for (int w = 0; w < 8; ++w) s += part[(w * 17 + r) * 64 + j];
                mod[(size_t)(l * 17 + r) * 6144 + n0 + j] = s + A.b_mod[l * 6144 + n0 + j]; }
            __syncthreads();
        }
    }
    __syncthreads();
    LAS float* scr = (LAS float*)(lds + wave * 16384);
    const int gw = vcu * NWAVES + wave, NGW = G * NWAVES;
    constexpr int I_IN = 16 * 64, I_GATE = 16 * 32, I_BR = 8 * 32, I_OUT = 16 * 32, I_FF = 16 * 88, I_DN = 44 * 32;
    constexpr int PER_LAYER = I_IN + 3 * I_GATE + 3 * I_BR + I_OUT + 2 * I_FF + I_DN;
    for (int it = gw; it < 2 * PER_LAYER; it += NGW) {
        const int l = it / PER_LAYER; int r = it % PER_LAYER;
        unsigned char* wl = A.ws + WS_W + (size_t)l * LW_BYTES;
        if (r < I_IN) { transpose_item(A.w_in + (size_t)l * 1024 * 2048, 1024, 2048, (bf16*)(wl + LW_IN), 1024, 0, scr, r, lane); continue; } r -= I_IN;
        if (r < 3 * I_GATE) { const int i = r / I_GATE; transpose_item(A.w_gate + ((size_t)l * 3 + i) * 1024 * 1024, 1024, 1024, (bf16*)(wl + LW_IN), 1024, 2048 + i * 1024, scr, r % I_GATE, lane); continue; } r -= 3 * I_GATE;
        if (r < 3 * I_BR) { const int i = r / I_BR; transpose_item(A.w_branch + ((size_t)l * 3 + i) * 512 * 1024, 512, 1024, (bf16*)(wl + LW_BR), 512, i * 1024, scr, r % I_BR, lane); continue; } r -= 3 * I_BR;
        if (r < I_OUT) { transpose_item(A.w_out + (size_t)l * 1024 * 1024, 1024, 1024, (bf16*)(wl + LW_OUT), 1024, 0, scr, r, lane); continue; } r -= I_OUT;
        if (r < I_FF) { transpose_item(A.w_ff_gate + (size_t)l * 1024 * FF, 1024, FF, (bf16*)(wl + LW_FF), 1024, 0, scr, r, lane); continue; } r -= I_FF;
        if (r < I_FF) { transpose_item(A.w_ff_val + (size_t)l * 1024 * FF, 1024, FF, (bf16*)(wl + LW_FF), 1024, FF, scr, r, lane); continue; } r -= I_FF;
        transpose_item(A.w_ff_down + (size_t)l * FF * 1024, FF, 1024, (bf16*)(wl + LW_DN), FF, 0, scr, r, lane);
    }
    for (int idx = vcu * NTHREADS + tid; idx < 2 * 512 * 256; idx += G * NTHREADS) {
        const int l = idx / (512 * 256), e = idx % (512 * 256), n = e >> 8, k = e & 255, g = n >> 7, gk = 2 * (n >> 8) + (k >> 7);
        const float v = (gk == g) ? A.w_pool_grp[(((size_t)l * 4 + g) * 128 + (k & 127)) * 128 + (n & 127)] : 0.f;
        ((bf16*)(A.ws + WS_W + (size_t)l * LW_BYTES + LW_POOL))[e] = (bf16)(cvt_pk_bf16(v, 0.f) & 0xffffu);
    }
}

__device__ __forceinline__ void norm_rows(const float* xlat, const float* xctx, const float* gvec, const float* modl, int which, int nrows, bf16* H, int gw, int NGW, int lane) {
    asm volatile("" : "+v"(lane));
    for (int row = gw; row < nrows; row += NGW) {
        const bool lat = row < NLAT;
        const float* src = lat ? xlat + (size_t)row * 1024 : xctx + (size_t)(row - NLAT) * 1024;
        const int b = lat ? (row >> 12) : NB;
        const float* shp = modl + (size_t)(b * 6 + which * 3) * 1024; const float* scp = shp + 1024;
        f32x4 v[4]; float ss = 0.f;
#pragma unroll
        for (int j = 0; j < 4; ++j) { v[j] = *(const f32x4*)(src + 4 * lane + 256 * j); ss += (v[j].x * v[j].x + v[j].y * v[j].y) + (v[j].z * v[j].z + v[j].w * v[j].w); }
        const float rstd = __builtin_amdgcn_rsqf(wave_sum(ss) * (1.f / 1024.f) + EPS);
#pragma unroll
        for (int j = 0; j < 4; ++j) { const int c0 = 4 * lane + 256 * j;
            const f32x4 g = *(const f32x4*)(gvec + c0), sh = *(const f32x4*)(shp + c0), sc = *(const f32x4*)(scp + c0);
            const f32x4 y = (v[j] * rstd * g) * (sc + 1.0f) + sh;
            v2u w; w.x = cvt_pk_bf16(y.x, y.y); w.y = cvt_pk_bf16(y.z, y.w);
            *(v2u*)(H + (size_t)row * 1024 + c0) = w; }
    }
}
__device__ __forceinline__ void final_norm_rows(float* x, const float* gvec, int gw, int NGW, int lane) {
    asm volatile("" : "+v"(lane));
    for (int row = gw; row < NLAT; row += NGW) {
        float* src = x + (size_t)row * 1024;
        f32x4 v[4]; float ss = 0.f;
#pragma unroll
        for (int j = 0; j < 4; ++j) { v[j] = *(const f32x4*)(src + 4 * lane + 256 * j); ss += (v[j].x * v[j].x + v[j].y * v[j].y) + (v[j].z * v[j].z + v[j].w * v[j].w); }
        const float rstd = __builtin_amdgcn_rsqf(wave_sum(ss) * (1.f / 1024.f) + EPS);
#pragma unroll
        for (int j = 0; j < 4; ++j) { const int c0 = 4 * lane + 256 * j; const f32x4 g = *(const f32x4*)(gvec + c0); *(f32x4*)(src + c0) = v[j] * rstd * g; }
    }
}

__device__ __forceinline__ void unpack8(const v4u w, float* v) { v[0] = bf_lo(w.x); v[1] = bf_hi(w.x); v[2] = bf_lo(w.y); v[3] = bf_hi(w.y); v[4] = bf_lo(w.z); v[5] = bf_hi(w.z); v[6] = bf_lo(w.w); v[7] = bf_hi(w.w); }
__device__ __forceinline__ v4u pack8(const float* v) { v4u w; w.x = cvt_pk_bf16(v[0], v[1]); w.y = cvt_pk_bf16(v[2], v[3]); w.z = cvt_pk_bf16(v[4], v[5]); w.w = cvt_pk_bf16(v[6], v[7]); return w; }
__device__ __forceinline__ void qk_proc(float* v, bool do_norm, const float* g, bool do_rope, bool hi_half, const float* cs, const float* sn, float scale) {
    float ss = 0.f;
#pragma unroll
    for (int i = 0; i < 8; ++i) ss += v[i] * v[i];
    ss += __shfl_xor(ss, 1); ss += __shfl_xor(ss, 2); ss += __shfl_xor(ss, 4);
    const float rstd = __builtin_amdgcn_rsqf(ss * (1.f / 64.f) + EPS);
#pragma unroll
    for (int i = 0; i < 8; ++i) { const float nv = v[i] * rstd * g[i]; v[i] = do_norm ? nv : v[i]; }
#pragma unroll
    for (int i = 0; i < 8; ++i) { const float pvv = __shfl_xor(v[i], 2);
        const float rv = hi_half ? (v[i] * cs[i] + pvv * sn[i]) : (v[i] * cs[i] - pvv * sn[i]);
        v[i] = (do_rope ? rv : v[i]) * scale; }
}
__device__ __forceinline__ void elem_phase(const Args& A, int layer, int nrows, bf16* Z, bf16* Y, int gw, int NGW, int lane) {
    asm volatile("" : "+v"(lane));
    const int j8 = lane & 7; const bool hi_half = (j8 >> 1) & 1; const int axis = j8 >> 2, fbase = (j8 & 1) * 8;
    float inv[8], qg[8], kg[8];
#pragma unroll
    for (int i = 0; i < 8; ++i) { inv[i] = __builtin_amdgcn_exp2f(-(float)(fbase + i) * (13.287712379549449f / 16.0f)) * 0.15915494309189535f;
        qg[i] = A.q_norm_g[layer * 64 + j8 * 8 + i]; kg[i] = A.k_norm_g[layer * 64 + j8 * 8 + i]; }
    for (int row = gw; row < nrows; row += NGW) {
        const bool lat = row < NLAT;
        const int t = lat ? (row & (SEQ - 1)) : ((row - NLAT) & (CTX - 1));
        const int L = lat ? SEQ : CTX;
        bf16* zrow = Z + (size_t)row * ZP;
        {
            const int g = lane >> 4, w2 = 1 << g; int lo = t - w2; lo = lo < 0 ? 0 : lo; int hi = t + w2; hi = hi > L ? L : hi;
            float acc[8];
#pragma unroll
            for (int i = 0; i < 8; ++i) acc[i] = 0.f;
            const bf16* zc = Z + (size_t)(row - t) * ZP + lane * 8;
            for (int jj = lo; jj < hi; ++jj) { float u[8]; unpack8(*(const v4u*)(zc + (size_t)jj * ZP), u);
#pragma unroll
                for (int i = 0; i < 8; ++i) acc[i] += u[i]; }
            float own[8]; unpack8(*(const v4u*)(zrow + lane * 8), own);
            const float rc = 1.0f / (float)(hi - lo);
#pragma unroll
            for (int i = 0; i < 8; ++i) acc[i] = acc[i] * rc - own[i];
            *(v4u*)(Y + (size_t)row * YP + lane * 8) = pack8(acc);
        }
        float cs[8], sn[8];
        { const float pos = (float)(axis ? (t & 63) : (t >> 6));
#pragma unroll
          for (int i = 0; i < 8; ++i) { float r = pos * inv[i]; r = r - __builtin_floorf(r); cs[i] = __builtin_amdgcn_cosf(r); sn[i] = __builtin_amdgcn_sinf(r); } }
        float v[8];
        unpack8(*(const v4u*)(zrow + 512 + lane * 8), v); qk_proc(v, false, qg, lat, hi_half, cs, sn, C2); *(v4u*)(zrow + 512 + lane * 8) = pack8(v);
        unpack8(*(const v4u*)(zrow + 1280 + lane * 8), v); qk_proc(v, true, qg, lat, hi_half, cs, sn, C2); *(v4u*)(zrow + 1280 + lane * 8) = pack8(v);
        { const int l5 = lane & 31; const bool isg = l5 >= 16; const int col = isg ? 1792 + (l5 - 16) * 8 : 1024 + l5 * 8;
          unpack8(*(const v4u*)(zrow + col), v); qk_proc(v, isg, kg, lat, hi_half, cs, sn, 1.0f);
          if (lane < 32) *(v4u*)(zrow + col) = pack8(v); }
    }
}

__device__ __forceinline__ void elem2_phase(const Args& A, int layer, int nrows, bf16* AV, int gtid, int NT) {
    asm volatile("" : "+v"(gtid));
    const int items = (nrows / 16) * 352;
    const float* cw = A.conv_w + (size_t)layer * 3 * FF; const float* cb = A.conv_b + (size_t)layer * FF;
    for (int it = gtid; it < items; it += NT) {
        const int c8 = it % 352, ch = it / 352, r0 = ch * 16, col = c8 * 8;
        const bool lat = r0 < NLAT; const int L = lat ? SEQ : CTX; const int t0 = lat ? (r0 & (SEQ - 1)) : ((r0 - NLAT) & (CTX - 1));
        float w0[8], w1[8], w2[8], bb[8];
#pragma unroll
        for (int i = 0; i < 8; ++i) { w0[i] = cw[col + i]; w1[i] = cw[FF + col + i]; w2[i] = cw[2 * FF + col + i]; bb[i] = cb[col + i]; }
        bf16* ap = AV + (size_t)r0 * AVP + col;
        const v4u zero = {0u, 0u, 0u, 0u};
        v4u prev = (t0 == 0) ? zero : *(const v4u*)(ap - AVP);
        v4u cur = *(const v4u*)ap;
#pragma unroll 4
        for (int i = 0; i < 16; ++i) {
            const v4u nxt = (t0 + i + 1 == L) ? zero : *(const v4u*)(ap + (size_t)(i + 1) * AVP);
            const v4u vv = *(const v4u*)(ap + (size_t)i * AVP + FF);
            float p[8], c[8], n[8], v[8], o[8]; unpack8(prev, p); unpack8(cur, c); unpack8(nxt, n); unpack8(vv, v);
#pragma unroll
            for (int e = 0; e < 8; ++e) { const float a = p[e] * w0[e] + c[e] * w1[e] + n[e] * w2[e] + bb[e]; o[e] = a * pg8::sigmoidf_(a) * v[e]; }
            *(v4u*)(ap + (size_t)i * AVP + FF) = pack8(o);
            prev = cur; cur = nxt;
        }
    }
}

__device__ __forceinline__ void attention_phase(const Args& A, int layer, bool last, bf16* Z, bf16* Y, char* shm, int G, int vcu) {
    using abf = attn_body::bf16;
    const float* sink = A.win_sink + layer * 8;
    const int NU = NB * 8 * 16, per = (NU + G - 1) / G;
    int u0 = vcu * per, u1 = u0 + per; if (u1 > NU) u1 = NU;
    for (int u = u0; u < u1; ++u) {
        const int qb = u & 15, h = (u >> 4) & 7, b = u >> 7, kvh = h >> 2;
        const size_t qrow = (size_t)b * SEQ + qb * 256, crow0 = (size_t)NLAT + (size_t)b * CTX;
        const abf* Q = (const abf*)Z + qrow * ZP + 1280 + h * 64;
        const abf* Kc = (const abf*)Z + crow0 * ZP + 1792 + kvh * 64; const abf* Vc = (const abf*)Z + crow0 * ZP + 1920 + kvh * 64;
        const long dlat = ((long)b * SEQ - (long)crow0) * ZP;
        attn_body::attn_unit<8, false>(Q, Kc, Vc, dlat, 68, 0, false, 0.f, (abf*)Y + qrow * YP + 1024 + h * 64, shm);
    }
    for (int u = u0; u < u1; ++u) {
        const int qb = u & 15, h = (u >> 4) & 7, b = u >> 7, kvh = h >> 2;
        const size_t qrow = (size_t)b * SEQ + qb * 256, crow0 = (size_t)NLAT + (size_t)b * CTX;
        int tl0 = 4 * qb - 2; tl0 = tl0 < 0 ? 0 : tl0; int tl1 = 4 * qb + 6; tl1 = tl1 > 64 ? 64 : tl1;
        const abf* Q = (const abf*)Z + qrow * ZP + 512 + h * 64;
        const abf* Kc = (const abf*)Z + crow0 * ZP + 1024 + kvh * 64; const abf* Vc = (const abf*)Z + crow0 * ZP + 1152 + kvh * 64;
        const long dlat = ((long)b * SEQ + tl0 * 64 - (long)crow0) * ZP;
        attn_body::attn_unit<8, true>(Q, Kc, Vc, dlat, 4 + (tl1 - tl0), tl0 * 64 - qb * 256, true, sink[h] * LOG2E, (abf*)Y + qrow * YP + 512 + h * 64, shm);
    }
    if (!last) {
        const int NUC = 2 * NB * 8;
        for (int u = vcu; u < NUC; u += G) {
            const int mixer = u & 1, h = (u >> 1) & 7, b = u >> 4, kvh = h >> 2;
            const size_t crow0 = (size_t)NLAT + (size_t)b * CTX;
            const int qc = mixer ? 1280 : 512, kc = mixer ? 1792 : 1024, vc = mixer ? 1920 : 1152, oc = mixer ? 1024 : 512;
            attn_body::attn_unit<8, false>((const abf*)Z + crow0 * ZP + qc + h * 64, (const abf*)Z + crow0 * ZP + kc + kvh * 64, (const abf*)Z + crow0 * ZP + vc + kvh * 64, 0, 4, 0,
                                           mixer == 0, sink[h] * LOG2E, (abf*)Y + crow0 * YP + oc + h * 64, shm);
        }
    }
}

__global__ void __launch_bounds__(NTHREADS, 2) fwd_megakernel(Args A) {
    extern __shared__ __attribute__((aligned(16))) unsigned char lds_raw[];
    LAS unsigned char* lds = (LAS unsigned char*)lds_raw;
    const int tid = threadIdx.x, lane = tid & 63, wave = __builtin_amdgcn_readfirstlane(tid >> 6);
    const int G = gridDim.x; const int bx = blockIdx.x; const int vcu = (G % 8 == 0) ? (bx % 8) * (G / 8) + bx / 8 : bx;
    const int gw = vcu * NWAVES + wave, NGW = G * NWAVES;
    const int lo = A.ph_lo, hi = A.ph_hi;
    int ph = 0;
#if MK_SPLIT
#define SEAM() do { ++ph; } while (0)
#else
    cg::grid_group grid = cg::this_grid();
#define SEAM() do { ++ph; grid.sync(); } while (0)
#endif
#define IN() (lo <= ph && ph < hi)
    unsigned char* ws = A.ws;
    float* mod = (float*)(ws + WS_MOD);
    float* XC = (float*)(ws + WS_XC);
    unsigned char* ar = ws + WS_ARENA;
    bf16* Z = (bf16*)(ar + AR_Z); bf16* Gt = (bf16*)(ar + AR_G); bf16* Y = (bf16*)(ar + AR_Y); bf16* H = (bf16*)(ar + AR_H);
    bf16* Mrg = (bf16*)(ar + AR_MRG); bf16* AV = (bf16*)(ar + AR_AV); bf16* H2 = (bf16*)(ar + AR_H2);

    if (IN()) prologue(A, lds, G, vcu, tid, lane, wave);
    SEAM();
    for (int l = 0; l < 2; ++l) {
        const bool last = (l == 1);
        const int nrows_mix = NTOK, nrows_x = last ? NLAT : NTOK;
        const int nM_mix = nrows_mix / 256, nM_x = nrows_x / 256;
        const float* modl = mod + (size_t)l * 17 * 6144;
        const unsigned char* wl = ws + WS_W + (size_t)l * LW_BYTES;
        const float* xlat_in = (l == 0) ? A.x : A.out; const float* xctx_in = (l == 0) ? A.ctx : XC;
        if (IN()) norm_rows(xlat_in, xctx_in, A.norm1_g + l * 1024, modl, 0, nrows_mix, H, gw, NGW, lane);
        SEAM();
        if (IN()) { pg8::Gemm g{H, (const bf16*)(wl + LW_IN), 1024, 1024, 1024, 0, 0}; pg8::Order S; S.init(nM_mix, 20, G, bx, 1, 0);
            pg8::EpiIn E{Z, Gt, A.b_gate + (size_t)l * 3072};
            pg8::gemm_phase<pg8::EpiIn, true>(lds, g, S, E); }
        SEAM();
        if (IN()) elem_phase(A, l, nrows_mix, Z, Y, gw, NGW, lane);
        SEAM();
        if (IN()) { attention_phase(A, l, last, Z, Y, (char*)lds_raw, G, vcu);
            pg8::Gemm g{Y, (const bf16*)(wl + LW_POOL), YP, 256, 256, 256, 0}; pg8::Order S; S.init(nM_x, 2, G, bx, 1, 1);
            pg8::EpiBf16 E{Y, YP, A.pool_scale + (size_t)l * 512};
            pg8::gemm_phase<pg8::EpiBf16, true>(lds, g, S, E); }
        SEAM();
        if (IN()) { pg8::Gemm g{Y, (const bf16*)(wl + LW_BR), YP, 512, 512, 512, (long)1024 * 512}; pg8::Order S; S.init(nM_x, 4, G, bx, 3, 2);
            pg8::EpiMerge E{Gt, Mrg};
            pg8::gemm_phase<pg8::EpiMerge, true>(lds, g, S, E); }
        SEAM();
        if (IN()) { pg8::Gemm g{Mrg, (const bf16*)(wl + LW_OUT), 1024, 1024, 1024, 0, 0}; pg8::Order S; S.init(nM_x, 4, G, bx, 1, 0);
            pg8::EpiRes E{xlat_in, xctx_in, A.out, XC, modl, 2};
            pg8::gemm_phase<pg8::EpiRes, true>(lds, g, S, E); }
        SEAM();
        if (IN()) norm_rows(A.out, XC, A.norm2_g + l * 1024, modl, 1, nrows_x, H2, gw, NGW, lane);
        SEAM();
        if (IN()) { pg8::Gemm g{H2, (const bf16*)(wl + LW_FF), 1024, 1024, 1024, 0, 0}; pg8::Order S; S.init(nM_x, 22, G, bx, 1, 0);
            pg8::EpiBf16 E{AV, AVP, nullptr};
            pg8::gemm_phase<pg8::EpiBf16, true>(lds, g, S, E); }
        SEAM();
        if (IN()) elem2_phase(A, l, nrows_x, AV, vcu * NTHREADS + tid, G * NTHREADS);
        SEAM();
        if (IN()) { pg8::Gemm g{AV + FF, (const bf16*)(wl + LW_DN), AVP, FF, FF, 0, 0}; pg8::Order S; S.init(nM_x, 4, G, bx, 1, 0);
            pg8::EpiRes E{A.out, XC, A.out, XC, modl, 5};
            pg8::gemm_phase<pg8::EpiRes, true>(lds, g, S, E); }
        SEAM();
    }
    if (IN()) final_norm_rows(A.out, A.final_g, gw, NGW, lane);
#undef IN
#undef SEAM
}
constexpr int N_PHASES = 22;

extern "C" void kernel_launch(void* const* d_in, const int* in_sizes, int n_in, void* d_out, int out_size, void* d_ws, size_t ws_size, hipStream_t stream) {
    static int grid = 0;
    if (grid == 0) {
        if (n_in != 24 || out_size != NLAT * 1024 || ws_size < WS_END) { fprintf(stderr, "kernel_launch: unexpected shapes (n_in %d out %d ws %zu need %zu)\n", n_in, out_size, ws_size, (size_t)WS_END); grid = -1; return; }
        int dev = 0, cus = 0, per_cu = 0;
        hipGetDevice(&dev); hipDeviceGetAttribute(&cus, hipDeviceAttributeMultiprocessorCount, dev);
        if (hipFuncSetAttribute((const void*)fwd_megakernel, hipFuncAttributeMaxDynamicSharedMemorySize, LDS_BYTES) != hipSuccess) { fprintf(stderr, "kernel_launch: hipFuncSetAttribute failed\n"); grid = -1; return; }
        hipOccupancyMaxActiveBlocksPerMultiprocessor(&per_cu, (const void*)fwd_megakernel, NTHREADS, LDS_BYTES);
        (void)hipGetLastError();
        if (per_cu < 1) { fprintf(stderr, "kernel_launch: occupancy query says %d blocks per CU\n", per_cu); per_cu = 1; }
        grid = cus;
    }
    if (grid < 0) return;
    Args a{};
    const float** p = (const float**)&a;
    for (int i = 0; i < 24; ++i) p[i] = (const float*)d_in[i];
    a.out = (float*)d_out; a.ws = (unsigned char*)d_ws;
#if MK_SPLIT
    for (int ph = 0; ph < N_PHASES; ++ph) { a.ph_lo = ph; a.ph_hi = ph + 1; hipLaunchKernelGGL(fwd_megakernel, dim3(grid), dim3(NTHREADS), LDS_BYTES, stream, a); }
#else
    a.ph_lo = 0; a.ph_hi = N_PHASES;
    void* args[] = {&a};
    hipError_t e = hipLaunchCooperativeKernel((const void*)fwd_megakernel, dim3(grid), dim3(NTHREADS), args, LDS_BYTES, stream);
    if (e != hipSuccess) fprintf(stderr, "cooperative launch failed: %s (grid %d)\n", hipGetErrorString(e), grid);
#endif
}
```

```cpp
#include <hip/hip_runtime.h>
#include <hip/hip_cooperative_groups.h>
#include <hip/hip_bf16.h>
#include <cstdio>
#include <cstdint>
#include <cmath>
namespace cg = cooperative_groups;

#ifndef DUP_MASK
#define DUP_MASK 0
#endif
#ifndef MK_SPLIT
#define MK_SPLIT 0
#endif

constexpr int DM_ = 1024, NB = 16, SEQ = 4096, CTX = 256, NLAT = NB * SEQ, NCTX = NB * CTX, NTOK = NLAT + NCTX;
constexpr int ZP = 2048, GP = 3072, YP = 1536, FF = 2816, AVP = 2 * FF;
constexpr float EPS = 1e-6f;
constexpr float LOG2E = 1.4426950408889634f;
constexpr float C2 = 0.125f * LOG2E;

namespace pg8 {
#define PG8_LAS __attribute__((address_space(3)))
typedef unsigned short bf16_t;
typedef short bf16x8 __attribute__((ext_vector_type(8)));
typedef float f32x4 __attribute__((ext_vector_type(4)));
typedef unsigned u32x4 __attribute__((ext_vector_type(4)));
typedef unsigned u32x2 __attribute__((ext_vector_type(2)));
constexpr int BM = 256, BK = 64, HALF = 128, HTB = HALF * BK * 2, STAGE_BYTES = 8 * HTB, NXCD = 8, WGM = 8;

__host__ __device__ __forceinline__ int lds_byte(int r, int c) { const int st = (r >> 4) * 2 + (c >> 5), rr = r & 15, cc = c & 31, ob = rr * 64 + cc * 2; return st * 1024 + (ob ^ (((ob >> 9) & 1) << 5)); }
__host__ __device__ __forceinline__ void stage_rc(int b, int& R, int& C) { const int st = b / 1024, sb = b % 1024, swz = sb ^ (((sb >> 9) & 1) << 5); R = (st >> 1) * 16 + swz / 64; C = (st & 1) * 32 + (swz % 64) / 2; }
__host__ __device__ __forceinline__ int perm32(int rho) { const int n = rho >> 4, i = rho & 15; return 8 * (i >> 2) + 4 * n + (i & 3); }

struct Unit { int pm, pn, g; };
struct Gemm { const bf16_t* A; const bf16_t* Bt; int lda, ldb, K; long a_goff, b_goff; };

struct Order {
    int nM, nN, nwg, G, c, sub, gmode;
    __device__ __forceinline__ void init(int nM_, int nN_, int G_, int c_, int sub_, int gmode_) { nM = nM_; nN = nN_; nwg = nM * nN; G = G_; c = c_; sub = sub_; gmode = gmode_; }
    __device__ __forceinline__ bool next(int i, Unit& u) const {
        const int ti = (sub == 1) ? i : i / sub;
        const long L = (long)ti * G + c; if (L >= nwg) return false;
        int wgid = (int)L; { const int q = nwg / NXCD, r = nwg % NXCD, xcd = wgid % NXCD, off = wgid / NXCD; wgid = (xcd < r ? xcd * (q + 1) : r * (q + 1) + (xcd - r) * q) + off; }
        const int nig = WGM * nN, gid = wgid / nig, fm = gid * WGM, gsz = (nM - fm) < WGM ? (nM - fm) : WGM;
        u.pm = fm + ((wgid % nig) % gsz); u.pn = (wgid % nig) / gsz;
        u.g = (gmode == 0) ? 0 : ((gmode == 1) ? u.pn : (i - ti * sub));
        return true;
    }
};

typedef float f32x2_t __attribute__((ext_vector_type(2))); typedef __bf16 bf16x2_t __attribute__((ext_vector_type(2)));
__device__ __forceinline__ unsigned cvt_pk_bf16(float lo, float hi) { f32x2_t v = {lo, hi}; bf16x2_t b = __builtin_convertvector(v, bf16x2_t); return __builtin_bit_cast(unsigned, b); }
__device__ __forceinline__ float bf_lo(unsigned w) { return __uint_as_float(w << 16); }
__device__ __forceinline__ float bf_hi(unsigned w) { return __uint_as_float(w & 0xffff0000u); }
__device__ __forceinline__ float sigmoidf_(float x) { return __builtin_amdgcn_rcpf(1.0f + __builtin_amdgcn_exp2f(-x * 1.4426950408889634f)); }

struct EpiBf16 {
    static constexpr bool PERM = true;
    bf16_t* O; int ldc; const float* colscale;
    __device__ __forceinline__ void operator()(const f32x4 (&acc)[2][2][4][2], const Unit& u, int wr, int wc, int fr, int fq) const {
        const int row0 = u.pm * BM + wr * 64 + fr; const int col0 = u.pn * BM + wc * 32 + 8 * fq;
        f32x4 sv[2][2];
#pragma unroll
        for (int bj = 0; bj < 2; ++bj)
#pragma unroll
            for (int n = 0; n < 2; ++n) sv[bj][n] = colscale ? *(const f32x4*)(colscale + col0 + bj * HALF + 4 * n) : (f32x4){1.f, 1.f, 1.f, 1.f};
#pragma unroll
        for (int ai = 0; ai < 2; ++ai)
#pragma unroll
            for (int m = 0; m < 4; ++m) { bf16_t* rowp = O + (size_t)(row0 + ai * HALF + m * 16) * ldc + col0;
#pragma unroll
                for (int bj = 0; bj < 2; ++bj) { const f32x4 v0 = acc[ai][bj][m][0] * sv[bj][0], v1 = acc[ai][bj][m][1] * sv[bj][1];
                    u32x4 w; w.x = cvt_pk_bf16(v0[0], v0[1]); w.y = cvt_pk_bf16(v0[2], v0[3]); w.z = cvt_pk_bf16(v1[0], v1[1]); w.w = cvt_pk_bf16(v1[2], v1[3]);
                    *(u32x4*)(rowp + bj * HALF) = w; } }
    }
};
struct EpiIn {
    static constexpr bool PERM = true;
    bf16_t* Z; bf16_t* Gt; const float* bgate;
    __device__ __forceinline__ void operator()(const f32x4 (&acc)[2][2][4][2], const Unit& u, int wr, int wc, int fr, int fq) const {
        const int row0 = u.pm * BM + wr * 64 + fr; const bool isz = u.pn < 8;
        const int col0 = (isz ? u.pn * BM : (u.pn - 8) * BM) + wc * 32 + 8 * fq;
        bf16_t* base = isz ? Z : Gt; const int ldc = isz ? ZP : GP;
        f32x4 bv[2][2];
#pragma unroll
        for (int bj = 0; bj < 2; ++bj)
#pragma unroll
            for (int n = 0; n < 2; ++n) bv[bj][n] = isz ? (f32x4){0.f, 0.f, 0.f, 0.f} : *(const f32x4*)(bgate + col0 + bj * HALF + 4 * n);
#pragma unroll
        for (int ai = 0; ai < 2; ++ai)
#pragma unroll
            for (int m = 0; m < 4; ++m) { bf16_t* rowp = base + (size_t)(row0 + ai * HALF + m * 16) * ldc + col0;
#pragma unroll
                for (int bj = 0; bj < 2; ++bj) { f32x4 v0 = acc[ai][bj][m][0] + bv[bj][0], v1 = acc[ai][bj][m][1] + bv[bj][1];
                    if (!isz) {
#pragma unroll
                        for (int e = 0; e < 4; ++e) { v0[e] = sigmoidf_(v0[e]); v1[e] = sigmoidf_(v1[e]); } }
                    u32x4 w; w.x = cvt_pk_bf16(v0[0], v0[1]); w.y = cvt_pk_bf16(v0[2], v0[3]); w.z = cvt_pk_bf16(v1[0], v1[1]); w.w = cvt_pk_bf16(v1[2], v1[3]);
                    *(u32x4*)(rowp + bj * HALF) = w; } }
    }
};
struct EpiMerge {
    static constexpr bool PERM = true;
    const bf16_t* Gt; bf16_t* Mrg;
    __device__ __forceinline__ void operator()(const f32x4 (&acc)[2][2][4][2], const Unit& u, int wr, int wc, int fr, int fq) const {
        const int row0 = u.pm * BM + wr * 64 + fr; const int col0 = u.pn * BM + wc * 32 + 8 * fq;
#pragma unroll
        for (int ai = 0; ai < 2; ++ai)
#pragma unroll
            for (int m = 0; m < 4; ++m) { const size_t row = (size_t)(row0 + ai * HALF + m * 16);
#pragma unroll
                for (int bj = 0; bj < 2; ++bj) {
                    const u32x4 gw = *(const u32x4*)(Gt + row * GP + u.g * 1024 + col0 + bj * HALF);
                    bf16_t* mp = Mrg + row * 1024 + col0 + bj * HALF;
                    const f32x4 a0 = acc[ai][bj][m][0], a1 = acc[ai][bj][m][1];
                    float v[8];
                    v[0] = bf_lo(gw.x) * a0[0]; v[1] = bf_hi(gw.x) * a0[1]; v[2] = bf_lo(gw.y) * a0[2]; v[3] = bf_hi(gw.y) * a0[3];
                    v[4] = bf_lo(gw.z) * a1[0]; v[5] = bf_hi(gw.z) * a1[1]; v[6] = bf_lo(gw.w) * a1[2]; v[7] = bf_hi(gw.w) * a1[3];
                    if (u.g != 0) { const u32x4 ow = *(const u32x4*)mp;
                        v[0] += bf_lo(ow.x); v[1] += bf_hi(ow.x); v[2] += bf_lo(ow.y); v[3] += bf_hi(ow.y); v[4] += bf_lo(ow.z); v[5] += bf_hi(ow.z); v[6] += bf_lo(ow.w); v[7] += bf_hi(ow.w); }
                    u32x4 w; w.x = cvt_pk_bf16(v[0], v[1]); w.y = cvt_pk_bf16(v[2], v[3]); w.z = cvt_pk_bf16(v[4], v[5]); w.w = cvt_pk_bf16(v[6], v[7]);
                    *(u32x4*)mp = w; } }
    }
};
struct EpiRes {
    static constexpr bool PERM = false;
    const float* base_lat; const float* base_ctx; float* out_lat; float* out_ctx; const float* modl; int gate_idx;
    __device__ __forceinline__ void operator()(const f32x4 (&acc)[2][2][4][2], const Unit& u, int wr, int wc, int fr, int fq) const {
        const bool lat = u.pm < (NLAT / BM);
        const int prow = lat ? u.pm * BM : (u.pm * BM - NLAT);
        const float* base = lat ? base_lat : base_ctx; float* out = lat ? out_lat : out_ctx;
        const int b = lat ? (u.pm * BM) / SEQ : NB;
        const int col0 = u.pn * BM + wc * 32 + 4 * fq;
        const float* gp = modl + (size_t)(b * 6 + gate_idx) * 1024 + col0;
        f32x4 gv[2][2];
#pragma unroll
        for (int bj = 0; bj < 2; ++bj)
#pragma unroll
            for (int n = 0; n < 2; ++n) gv[bj][n] = *(const f32x4*)(gp + bj * HALF + n * 16);
#pragma unroll
        for (int ai = 0; ai < 2; ++ai)
#pragma unroll
            for (int m = 0; m < 4; ++m) { const size_t off = (size_t)(prow + ai * HALF + wr * 64 + m * 16 + fr) * 1024 + col0;
#pragma unroll
                for (int bj = 0; bj < 2; ++bj)
#pragma unroll
                    for (int n = 0; n < 2; ++n) { const f32x4 bs = *(const f32x4*)(base + off + bj * HALF + n * 16);
                        *(f32x4*)(out + off + bj * HALF + n * 16) = bs + gv[bj][n] * acc[ai][bj][m][n]; } }
    }
};

template <class Epi, bool ALIGN_EPI>
__device__ __forceinline__ void gemm_phase(PG8_LAS unsigned char* lds, const Gemm g, const Order& S, const Epi& E) {
    int tid = threadIdx.x; asm volatile("" : "+v"(tid));
    const int wid = __builtin_amdgcn_readfirstlane(tid >> 6), lane = tid & 63, wr = wid >> 2, wc = wid & 3, fr = lane & 15, fq = lane >> 4;
    const int K = g.K, nt = K / BK;
    unsigned voffA[2], voffB[2];
#pragma unroll
    for (int i = 0; i < 2; ++i) { int R, C; stage_rc(tid * 16 + i * 8192, R, C); const int Rb = Epi::PERM ? ((R & ~31) + perm32(R & 31)) : R;
        voffA[i] = (unsigned)(R * g.lda + C) * 2u; voffB[i] = (unsigned)(Rb * g.ldb + C) * 2u; }
    const size_t kstep = (size_t)(BK * 2);
    const size_t hstepA = (size_t)HALF * g.lda * 2, hstepB = (size_t)HALF * g.ldb * 2;
    const size_t tstepA = 2 * hstepA, tstepB = 2 * hstepB;
    const unsigned ldsw = (unsigned)wid * 1024u;
    const int aoff = lds_byte(wr * 64 + fr, fq * 8), boff = lds_byte(wc * 32 + fr, fq * 8);
#define PG8_UA(u) ((const char*)g.A + (size_t)(u).pm * tstepA + (size_t)((long)(u).g * g.a_goff * 2))
#define PG8_UB(u) ((const char*)g.Bt + (size_t)(u).pn * tstepB + (size_t)((long)(u).g * g.b_goff * 2))
#define PG8_SA(b, h) (((b) * 2 + (h)) * HTB)
#define PG8_SB(b, h) ((4 + (b) * 2 + (h)) * HTB)
#define PG8_STAGE(bufoff, gbase, voff) do { _Pragma("unroll") for (int _i = 0; _i < 2; ++_i) \
        __builtin_amdgcn_global_load_lds((const unsigned*)((const char*)(gbase) + (voff)[_i]), (PG8_LAS unsigned*)(lds + (bufoff) + ldsw + _i * 8192), 16, 0, 0); } while (0)
#define PG8_LDA(dst, b, h) do { _Pragma("unroll") for (int m = 0; m < 4; ++m) _Pragma("unroll") for (int k = 0; k < 2; ++k) dst[m][k] = *(const PG8_LAS bf16x8*)(lds + PG8_SA(b, h) + aoff + m * 2048 + k * 1024); } while (0)
#define PG8_LDB(dst, b, h) do { _Pragma("unroll") for (int n = 0; n < 2; ++n) _Pragma("unroll") for (int k = 0; k < 2; ++k) dst[n][k] = *(const PG8_LAS bf16x8*)(lds + PG8_SB(b, h) + boff + n * 2048 + k * 1024); } while (0)
#define PG8_MMA(ai, bj, At, Bt) do { __builtin_amdgcn_s_setprio(1); _Pragma("unroll") for (int m = 0; m < 4; ++m) _Pragma("unroll") for (int n = 0; n < 2; ++n) _Pragma("unroll") for (int k = 0; k < 2; ++k) \
        acc[ai][bj][m][n] = __builtin_amdgcn_mfma_f32_16x16x32_bf16(Bt[n][k], At[m][k], acc[ai][bj][m][n], 0, 0, 0); __builtin_amdgcn_s_setprio(0); } while (0)
#define PG8_WAIT_V(n) asm volatile("s_waitcnt vmcnt(" #n ")" ::: "memory")
#define PG8_WAIT_L(n) asm volatile("s_waitcnt lgkmcnt(" #n ")" ::: "memory")
#define PG8_BAR __builtin_amdgcn_s_barrier()
#define PG8_SCHED __builtin_amdgcn_sched_barrier(0)
    Unit cur, nxt; int ui = 0;
    if (!S.next(0, cur)) return;
    f32x4 acc[2][2][4][2];
#pragma unroll
    for (int a = 0; a < 2; ++a)
#pragma unroll
        for (int b = 0; b < 2; ++b)
#pragma unroll
            for (int m = 0; m < 4; ++m)
#pragma unroll
                for (int n = 0; n < 2; ++n) acc[a][b][m][n] = (f32x4){0.f, 0.f, 0.f, 0.f};
    bf16x8 At[4][2], B0[2][2], B1[2][2];
    const char* cA = PG8_UA(cur); const char* cB = PG8_UB(cur);
    PG8_STAGE(PG8_SB(0, 0), cB, voffB); PG8_STAGE(PG8_SB(0, 1), cB + hstepB, voffB); PG8_STAGE(PG8_SA(0, 0), cA, voffA); PG8_STAGE(PG8_SA(0, 1), cA + hstepA, voffA);
    if (wr == 1) PG8_BAR;
    PG8_WAIT_V(2); PG8_BAR;
    PG8_STAGE(PG8_SB(1, 0), cB + kstep, voffB); PG8_STAGE(PG8_SA(1, 0), cA + kstep, voffA); PG8_STAGE(PG8_SB(1, 1), cB + hstepB + kstep, voffB);
    PG8_WAIT_V(6); PG8_BAR;
    for (;;) {
        const bool has_next = S.next(ui + 1, nxt);
        const char* nA = has_next ? PG8_UA(nxt) : cA; const char* nB = has_next ? PG8_UB(nxt) : cB;
        for (int t = 0; t < nt; t += 2) {
            const bool last = (t == nt - 2);
            const char* a1 = cA + (size_t)(t + 1) * kstep;
            const char* a2 = last ? nA : cA + (size_t)(t + 2) * kstep; const char* b2 = last ? nB : cB + (size_t)(t + 2) * kstep;
            const char* a3 = a2 + kstep; const char* b3 = b2 + kstep;
            PG8_LDB(B0, 0, 0); PG8_LDB(B1, 0, 1); PG8_SCHED; PG8_LDA(At, 0, 0); PG8_STAGE(PG8_SA(1, 1), a1 + hstepA, voffA);
            PG8_WAIT_V(8); PG8_WAIT_L(0); PG8_BAR; PG8_MMA(0, 0, At, B0); PG8_MMA(0, 1, At, B1); PG8_BAR; PG8_SCHED;
            PG8_LDA(At, 0, 1); PG8_STAGE(PG8_SB(0, 0), b2, voffB); PG8_STAGE(PG8_SB(0, 1), b2 + hstepB, voffB); PG8_STAGE(PG8_SA(0, 0), a2, voffA);
            PG8_WAIT_V(8); PG8_WAIT_L(0); PG8_BAR; PG8_MMA(1, 0, At, B0); PG8_MMA(1, 1, At, B1); PG8_BAR; PG8_SCHED;
            PG8_LDB(B0, 1, 0); PG8_LDB(B1, 1, 1); PG8_SCHED; PG8_LDA(At, 1, 0); PG8_STAGE(PG8_SA(0, 1), a2 + hstepA, voffA);
            PG8_WAIT_V(8); PG8_WAIT_L(0); PG8_BAR; PG8_MMA(0, 0, At, B0); PG8_MMA(0, 1, At, B1); PG8_BAR; PG8_SCHED;
            PG8_LDA(At, 1, 1); PG8_STAGE(PG8_SB(1, 0), b3, voffB); PG8_STAGE(PG8_SB(1, 1), b3 + hstepB, voffB); PG8_STAGE(PG8_SA(1, 0), a3, voffA);
            PG8_WAIT_V(8); PG8_WAIT_L(0); PG8_BAR; PG8_MMA(1, 0, At, B0); PG8_MMA(1, 1, At, B1); PG8_BAR; PG8_SCHED;
        }
        if constexpr (ALIGN_EPI) { if (wr == 0) PG8_BAR; }
        E(acc, cur, wr, wc, fr, fq);
        if (!has_next) break;
#pragma unroll
        for (int a = 0; a < 2; ++a)
#pragma unroll
            for (int b = 0; b < 2; ++b)
#pragma unroll
                for (int m = 0; m < 4; ++m)
#pragma unroll
                    for (int n = 0; n < 2; ++n) acc[a][b][m][n] = (f32x4){0.f, 0.f, 0.f, 0.f};
        cur = nxt; cA = nA; cB = nB; ++ui;
        if constexpr (ALIGN_EPI) { if (wr == 1) PG8_BAR; }
    }
    PG8_WAIT_V(0);
    if constexpr (!ALIGN_EPI) { if (wr == 0) PG8_BAR; }
    PG8_BAR;
#undef PG8_UA
#undef PG8_UB
#undef PG8_SA
#undef PG8_SB
#undef PG8_STAGE
#undef PG8_LDA
#undef PG8_LDB
#undef PG8_MMA
#undef PG8_WAIT_V
#undef PG8_WAIT_L
#undef PG8_BAR
#undef PG8_SCHED
}
}

namespace attn_body {
using bf16 = __hip_bfloat16;
using bf16x8 = __attribute__((ext_vector_type(8))) short;
using s16x4 = __attribute__((ext_vector_type(4))) short;
using f32x16 = __attribute__((ext_vector_type(16))) float;
using u32x4 = __attribute__((ext_vector_type(4))) unsigned;
constexpr int D = 64, NW = 8, QBLK = 32, QB = QBLK * NW, KVBLK = 64;
__device__ __forceinline__ int crow(int r, int hi) { return (r & 3) + 8 * (r >> 2) + 4 * hi; }
#define SBAR() __builtin_amdgcn_sched_barrier(0)
__device__ __forceinline__ void wmask(f32x16& p0, f32x16& p1, int d0) {
    const float NEG = -INFINITY;
#pragma unroll
    for (int r = 0; r < 16; ++r) { const int d = d0 + (r & 3) + 8 * (r >> 2); if (d > 128 || d < -128) p0[r] = NEG; if (d + 32 > 128 || d + 32 < -128) p1[r] = NEG; }
}
constexpr int NSLOT = 3, SLOTB = 8192;
constexpr int LDS_K = 0, LDS_V = NSLOT * SLOTB, LDS_WS = 2 * NSLOT * SLOTB, LDS_OST = LDS_WS + NW * 64 * 4, LDS_BYTES = LDS_OST + NW * 4096;
__device__ __forceinline__ void glds16(const void* gsrc, unsigned lds_dst) { unsigned keep;
    asm volatile("s_mov_b32 %0, m0\n\ts_mov_b32 m0, %2\n\ts_nop 0\n\tglobal_load_lds_dwordx4 %1, off\n\ts_mov_b32 m0, %0" : "=&s"(keep) : "v"(gsrc), "s"(lds_dst) : "memory"); }
__device__ __forceinline__ float max3f(float a, float b, float c) { float r; asm("v_max3_f32 %0, %1, %2, %3" : "=v"(r) : "v"(a), "v"(b), "v"(c)); return r; }
__device__ __forceinline__ float max2f(float a, float b) { float r; asm("v_max_f32_e32 %0, %1, %2" : "=v"(r) : "v"(a), "v"(b)); return r; }
__device__ __forceinline__ float fadd_s(float a, float b) { float r; asm("v_add_f32_e32 %0, %1, %2" : "=v"(r) : "v"(a), "v"(b)); return r; }
__device__ __forceinline__ float fsub_s(float a, float b) { float r; asm("v_sub_f32_e32 %0, %1, %2" : "=v"(r) : "v"(a), "v"(b)); return r; }
typedef float f32x2_t __attribute__((ext_vector_type(2))); typedef __bf16 bf16x2_t __attribute__((ext_vector_type(2)));
__device__ __forceinline__ unsigned cvtpk_s(float lo, float hi) { f32x2_t v = {lo, hi}; bf16x2_t b = __builtin_convertvector(v, bf16x2_t); return __builtin_bit_cast(unsigned, b); }
#define WAIT_BAR(N) asm volatile("s_waitcnt vmcnt(" #N ") lgkmcnt(0)\n\ts_barrier" ::: "memory")

__device__ __forceinline__ void qkt(f32x16& p0, f32x16& p1, const char* Kslot, const bf16x8* qr, const f32x16& negm, int r32, int hi) {
    const char* kb = Kslot + hi * 1024 + r32 * 16;
#pragma unroll
    for (int d0 = 0; d0 < 4; ++d0) {
        const bf16x8 b0 = *reinterpret_cast<const bf16x8*>(kb + d0 * 2048);
        const bf16x8 b1 = *reinterpret_cast<const bf16x8*>(kb + d0 * 2048 + 512);
        if (d0 == 0) { p0 = __builtin_amdgcn_mfma_f32_32x32x16_bf16(b0, qr[0], negm, 0, 0, 0); p1 = __builtin_amdgcn_mfma_f32_32x32x16_bf16(b1, qr[0], negm, 0, 0, 0); }
        else { p0 = __builtin_amdgcn_mfma_f32_32x32x16_bf16(b0, qr[d0], p0, 0, 0, 0); p1 = __builtin_amdgcn_mfma_f32_32x32x16_bf16(b1, qr[d0], p1, 0, 0, 0); } }
}
typedef __attribute__((address_space(3))) const char* lds_cptr;
typedef short v4i16_t __attribute__((ext_vector_type(4)));
__device__ __forceinline__ void kload8(bf16x8* kf, lds_cptr kp) {
    kf[0] = *(const __attribute__((address_space(3))) bf16x8*)(kp);        kf[1] = *(const __attribute__((address_space(3))) bf16x8*)(kp + 512);
    kf[2] = *(const __attribute__((address_space(3))) bf16x8*)(kp + 2048); kf[3] = *(const __attribute__((address_space(3))) bf16x8*)(kp + 2560);
    kf[4] = *(const __attribute__((address_space(3))) bf16x8*)(kp + 4096); kf[5] = *(const __attribute__((address_space(3))) bf16x8*)(kp + 4608);
    kf[6] = *(const __attribute__((address_space(3))) bf16x8*)(kp + 6144); kf[7] = *(const __attribute__((address_space(3))) bf16x8*)(kp + 6656);
}
__device__ __forceinline__ void kload2(bf16x8* kf, lds_cptr kp, int j) { kf[2 * j] = *(const __attribute__((address_space(3))) bf16x8*)(kp + j * 2048); kf[2 * j + 1] = *(const __attribute__((address_space(3))) bf16x8*)(kp + j * 2048 + 512); }
__device__ __forceinline__ s16x4 vtr(lds_cptr p) { return __builtin_bit_cast(s16x4, __builtin_amdgcn_ds_read_tr16_b64_v4i16((__attribute__((address_space(3))) v4i16_t*)p)); }
__device__ __forceinline__ float rowmax(const f32x16& p0, const f32x16& p1) {
    float a = max3f(p0[0], p0[1], p1[0]), b = max3f(p0[2], p0[3], p1[1]); a = max3f(a, p1[2], p1[3]);
#pragma unroll
    for (int r = 4; r < 16; r += 4) { a = max3f(a, p0[r], p0[r + 1]); b = max3f(b, p0[r + 2], p0[r + 3]); a = max3f(a, p1[r], p1[r + 1]); b = max3f(b, p1[r + 2], p1[r + 3]); }
    const float m = max2f(a, b);
    auto rr = __builtin_amdgcn_permlane32_swap(__float_as_uint(m), __float_as_uint(m), false, false);
    return max2f(__uint_as_float(rr[0]), __uint_as_float(rr[1]));
}
__device__ __forceinline__ void pv(f32x16* o, int vb, bf16x8 pa0, bf16x8 pa1, bf16x8 pa2, bf16x8 pa3) {
#pragma unroll
    for (int d0 = 0; d0 < 2; ++d0) { s16x4 lo[4], hi[4];
#pragma unroll
        for (int ks = 0; ks < 4; ++ks) {
            asm volatile("ds_read_b64_tr_b16 %0,%1 offset:%c2" : "=&v"(lo[ks]) : "v"(vb), "i"(d0 * 4096 + ks * 1024) : "memory");
            asm volatile("ds_read_b64_tr_b16 %0,%1 offset:%c2" : "=&v"(hi[ks]) : "v"(vb), "i"(d0 * 4096 + ks * 1024 + 512) : "memory"); }
        asm volatile("s_waitcnt lgkmcnt(0)" ::: "memory"); SBAR();
#define PK(k) (bf16x8){lo[k][0], lo[k][1], lo[k][2], lo[k][3], hi[k][0], hi[k][1], hi[k][2], hi[k][3]}
        o[d0] = __builtin_amdgcn_mfma_f32_32x32x16_bf16(pa0, PK(0), o[d0], 0, 0, 0);
        o[d0] = __builtin_amdgcn_mfma_f32_32x32x16_bf16(pa1, PK(1), o[d0], 0, 0, 0);
        o[d0] = __builtin_amdgcn_mfma_f32_32x32x16_bf16(pa2, PK(2), o[d0], 0, 0, 0);
        o[d0] = __builtin_amdgcn_mfma_f32_32x32x16_bf16(pa3, PK(3), o[d0], 0, 0, 0);
#undef PK
    }
}
template <int THRL, bool WMASK> __device__ __forceinline__ void attn_unit(const bf16* Qw0, const bf16* __restrict__ Kc, const bf16* __restrict__ Vc, long dlat, int NT, int kd0,
                                                                         bool has_sink, float sinkl2, bf16* Ow0, char* shm) {
    int tid = threadIdx.x; asm volatile("" : "+v"(tid));
    const int lane = tid & 63, r32 = lane & 31, hi = lane >> 5; const int wid = __builtin_amdgcn_readfirstlane(tid >> 6);
    const bf16* Qw = Qw0 + (long)(wid * QBLK) * ZP;
    const unsigned lds0 = (unsigned)(uintptr_t)shm;
    float* wsf = (float*)(shm + LDS_WS) + wid * 64;
    const bf16* ksrc = Kc + (long)lane * ZP + wid * 8;
    const bf16* vsrc = Vc + (long)(16 * (wid & 3) + (lane >> 2)) * ZP + (wid >> 2) * 32 + (lane & 3) * 8;
    const unsigned kdst = lds0 + LDS_K + wid * 1024, vdst = lds0 + LDS_V + wid * 1024;
#define TOFF(t) (((t) < 4) ? (long)(t) * (KVBLK * ZP) : dlat + (long)((t) - 4) * (KVBLK * ZP))
#define DMA_K(t, slot) glds16(ksrc + TOFF(t), (unsigned)__builtin_amdgcn_readfirstlane(kdst + (slot)))
#define DMA_V(t, slot) glds16(vsrc + TOFF(t), (unsigned)__builtin_amdgcn_readfirstlane(vdst + (slot)))
    const int vb0 = (int)(lds0 + LDS_V) + ((lane >> 4) & 1) * 32 + (lane & 3) * 8 + (4 * hi + ((lane & 15) >> 2)) * 64;
    const char* Kbase = shm + LDS_K; bf16x8 kf[8];
    const lds_cptr shm3 = (lds_cptr)shm; const lds_cptr kp0 = shm3 + LDS_K + hi * 1024 + r32 * 16; const lds_cptr vp0 = shm3 + LDS_V + ((lane >> 4) & 1) * 32 + (lane & 3) * 8 + (4 * hi + ((lane & 15) >> 2)) * 64;
    DMA_K(0, 0); DMA_V(0, 0); DMA_K(1, SLOTB);
    bf16x8 qr[4];
#pragma unroll
    for (int d0 = 0; d0 < 4; ++d0) qr[d0] = *reinterpret_cast<const bf16x8*>(&Qw[(long)r32 * ZP + d0 * 16 + hi * 8]);
    float mhat = 0.f, l_reg = 0.f; f32x16 o[2]; o[0] = f32x16{}; o[1] = f32x16{}; f32x16 negm = f32x16{}; asm volatile("" : "+v"(negm));
    const int qrel = wid * QBLK + r32;
#define CMASK(P0, P1, t) do { if constexpr (WMASK) { if ((t) >= 4) wmask(P0, P1, kd0 + ((t) - 4) * KVBLK - qrel + 4 * hi); } } while (0)
    bool resc = false;
#define START(P0, P1) do { const float rm = rowmax(P0, P1); resc = false; \
    { const float dl = rm; mhat = fadd_s(mhat, dl); \
      _Pragma("unroll") for (int r = 0; r < 16; ++r) { P0[r] = fsub_s(P0[r], dl); P1[r] = fsub_s(P1[r], dl); } \
      _Pragma("unroll") for (int r = 0; r < 16; ++r) negm[r] = -mhat; asm volatile("" : "+v"(negm)); } \
    _Pragma("unroll") for (int r = 0; r < 16; ++r) P0[r] = __builtin_amdgcn_exp2f(P0[r]); } while (0)
#define RESC() do { if (resc) { asm volatile("s_waitcnt lgkmcnt(0)" ::: "memory"); \
      _Pragma("unroll") for (int d_ = 0; d_ < 2; ++d_) _Pragma("unroll") for (int r = 0; r < 16; ++r) o[d_][r] *= wsf[crow(r, hi)]; } } while (0)
    f32x16 pA0, pA1, pB0, pB1;
    int sl_prev = 0, sl_cur = 0, sl_next = SLOTB;
#define ROT() do { sl_prev = sl_cur; sl_cur = sl_next; sl_next = (sl_next == (NSLOT - 1) * SLOTB) ? 0 : sl_next + SLOTB; } while (0)
    DMA_K(2, 2 * SLOTB);
    WAIT_BAR(3);
    qkt(pA0, pA1, Kbase, qr, negm, r32, hi); asm volatile("s_nop 15\n\ts_nop 7" : "+v"(pA0), "+v"(pA1));
    START(pA0, pA1);
    _Pragma("unroll") for (int r = 0; r < 16; ++r) pA1[r] = __builtin_amdgcn_exp2f(pA1[r]);
    WAIT_BAR(0);
    DMA_K(3, 0); DMA_V(1, SLOTB);
    ROT();
    kload8(kf, kp0 + sl_cur);
    WAIT_BAR(2);
    s16x4 vlo[8], vhi[8]; u32x4 pw0, pw1, pw2, pw3;
#define PKW(P, B) cvtpk_s(P[B], P[B + 1])
#define PAF(k) __builtin_bit_cast(bf16x8, pw##k)
#define VFR(i) (bf16x8){vlo[i][0], vlo[i][1], vlo[i][2], vlo[i][3], vhi[i][0], vhi[i][1], vhi[i][2], vhi[i][3]}
#define PIN(x) asm volatile("" : "+v"(x))
#define MX3(a, b, c) __builtin_fmaxf(__builtin_fmaxf((a), (b)), (c))
#define GAPA(MF, A0, A1, A2, A3, W0, W1, PW) do { MF; sacc += A0; sacc += A1; sacc += A2; sacc += A3; PIN(sacc); W0; W1; PIN(PW); SBAR(); } while (0)
#define EX(v) __builtin_amdgcn_exp2f(v)
#define GAPB(MF, X, B) do { MF; X[B] = EX(X[B]); X[B + 1] = EX(X[B + 1]); X[B + 2] = EX(X[B + 2]); X[B + 3] = EX(X[B + 3]); PIN(X); SBAR(); } while (0)
#define VRD(i) do { vlo[i] = vtr(vp_ + (((i) >> 2) * 4096 + ((i) & 3) * 1024)); vhi[i] = vtr(vp_ + (((i) >> 2) * 4096 + ((i) & 3) * 1024 + 512)); } while (0)
#define KRD(G, j) do { if (G) { kload2(kf, kp0 + sl_next, j); SBAR(); } } while (0)
#define STEP(C0, C1, P0, P1, t, GK, GV, GL) do { SBAR(); \
    const lds_cptr vp_ = vp0 + sl_prev; \
    VRD(0); SBAR(); float sacc = (P0[0] + P0[1]); \
    GAPA(C0 = __builtin_amdgcn_mfma_f32_32x32x16_bf16(kf[0], qr[0], negm, 0, 0, 0), P0[2], P0[3], P0[4], P0[5],     pw0[0] = PKW(P0, 0), pw0[1] = PKW(P0, 2), pw0); \
    VRD(4); SBAR(); GAPA(C1 = __builtin_amdgcn_mfma_f32_32x32x16_bf16(kf[1], qr[0], negm, 0, 0, 0), P0[6], P0[7], P0[8], P0[9],     pw0[2] = PKW(P0, 4), pw0[3] = PKW(P0, 6), pw0); \
    VRD(1); SBAR(); GAPA(C0 = __builtin_amdgcn_mfma_f32_32x32x16_bf16(kf[2], qr[1], C0, 0, 0, 0),   P0[10], P0[11], P0[12], P0[13], pw1[0] = PKW(P0, 8), pw1[1] = PKW(P0, 10), pw1); \
    VRD(5); SBAR(); GAPA(C1 = __builtin_amdgcn_mfma_f32_32x32x16_bf16(kf[3], qr[1], C1, 0, 0, 0),   P0[14], P0[15], P1[0], P1[1],   pw1[2] = PKW(P0, 12), pw1[3] = PKW(P0, 14), pw1); \
    VRD(2); SBAR(); GAPA(C0 = __builtin_amdgcn_mfma_f32_32x32x16_bf16(kf[4], qr[2], C0, 0, 0, 0),   P1[2], P1[3], P1[4], P1[5],     pw2[0] = PKW(P1, 0), pw2[1] = PKW(P1, 2), pw2); \
    VRD(6); SBAR(); GAPA(C1 = __builtin_amdgcn_mfma_f32_32x32x16_bf16(kf[5], qr[2], C1, 0, 0, 0),   P1[6], P1[7], P1[8], P1[9],     pw2[2] = PKW(P1, 4), pw2[3] = PKW(P1, 6), pw2); \
    VRD(3); SBAR(); GAPA(C0 = __builtin_amdgcn_mfma_f32_32x32x16_bf16(kf[6], qr[3], C0, 0, 0, 0),   P1[10], P1[11], P1[12], P1[13], pw3[0] = PKW(P1, 8), pw3[1] = PKW(P1, 10), pw3); \
    VRD(7); SBAR(); GAPA(C1 = __builtin_amdgcn_mfma_f32_32x32x16_bf16(kf[7], qr[3], C1, 0, 0, 0),   P1[14], P1[15], 0.f, 0.f,       pw3[2] = PKW(P1, 12), pw3[3] = PKW(P1, 14), pw3); \
    l_reg += sacc; \
    if (GK) { DMA_K((t) + 3, sl_cur); } if (GV) { DMA_V((t) + 1, sl_next); } \
    CMASK(C0, C1, t); \
    { float a = MX3(C0[0], C0[1], C1[0]), b = MX3(C0[2], C0[3], C1[1]); a = MX3(a, C1[2], C1[3]); \
      _Pragma("unroll") for (int r = 4; r < 16; r += 4) { a = MX3(a, C0[r], C0[r + 1]); b = MX3(b, C0[r + 2], C0[r + 3]); a = MX3(a, C1[r], C1[r + 1]); b = MX3(b, C1[r + 2], C1[r + 3]); } \
      float rm = __builtin_fmaxf(a, b); { auto rr = __builtin_amdgcn_permlane32_swap(__float_as_uint(rm), __float_as_uint(rm), false, false); rm = __builtin_fmaxf(__uint_as_float(rr[0]), __uint_as_float(rr[1])); } \
      resc = false; \
      if (__builtin_expect(__any(rm > (float)THRL), 0)) { const float dl = __builtin_fmaxf(rm, 0.f); mhat += dl; \
        _Pragma("unroll") for (int r = 0; r < 16; ++r) { C0[r] -= dl; C1[r] -= dl; } \
        _Pragma("unroll") for (int r = 0; r < 16; ++r) negm[r] = -mhat; asm volatile("" : "+v"(negm)); \
        const float f = __builtin_amdgcn_exp2f(-dl); l_reg *= f; if (hi == 0) wsf[r32] = f; resc = true; } } \
    SBAR(); \
    GAPB(o[0] = __builtin_amdgcn_mfma_f32_32x32x16_bf16(PAF(0), VFR(0), o[0], 0, 0, 0), C0, 0); \
    GAPB(o[1] = __builtin_amdgcn_mfma_f32_32x32x16_bf16(PAF(0), VFR(4), o[1], 0, 0, 0), C0, 4); \
    KRD(GL, 0); GAPB(o[0] = __builtin_amdgcn_mfma_f32_32x32x16_bf16(PAF(1), VFR(1), o[0], 0, 0, 0), C0, 8); \
    KRD(GL, 1); GAPB(o[1] = __builtin_amdgcn_mfma_f32_32x32x16_bf16(PAF(1), VFR(5), o[1], 0, 0, 0), C0, 12); \
    KRD(GL, 2); GAPB(o[0] = __builtin_amdgcn_mfma_f32_32x32x16_bf16(PAF(2), VFR(2), o[0], 0, 0, 0), C1, 0); \
    KRD(GL, 3); GAPB(o[1] = __builtin_amdgcn_mfma_f32_32x32x16_bf16(PAF(2), VFR(6), o[1], 0, 0, 0), C1, 4); \
    GAPB(o[0] = __builtin_amdgcn_mfma_f32_32x32x16_bf16(PAF(3), VFR(3), o[0], 0, 0, 0), C1, 8); \
    GAPB(o[1] = __builtin_amdgcn_mfma_f32_32x32x16_bf16(PAF(3), VFR(7), o[1], 0, 0, 0), C1, 12); \
    } while (0)
    int t = 1;
    for (; t + 5 < NT; t += 2) {
        STEP(pB0, pB1, pA0, pA1, t, true, true, true);     WAIT_BAR(2); RESC(); ROT();
        STEP(pA0, pA1, pB0, pB1, t + 1, true, true, true); WAIT_BAR(2); RESC(); ROT();
    }
#define ENDW(tt) do { if ((tt) + 3 < NT) { WAIT_BAR(2); } else if ((tt) + 2 < NT) { WAIT_BAR(1); } else { WAIT_BAR(0); } } while (0)
    for (; t + 1 < NT; t += 2) {
        STEP(pB0, pB1, pA0, pA1, t, (t + 3 < NT), (t + 1 < NT), (t + 1 < NT));         ENDW(t);     RESC(); ROT();
        STEP(pA0, pA1, pB0, pB1, t + 1, (t + 4 < NT), (t + 2 < NT), (t + 2 < NT));     ENDW(t + 1); RESC(); ROT();
    }
    STEP(pB0, pB1, pA0, pA1, NT - 1, false, false, false); RESC();
    { float sacc = pB0[0] + pB0[1]; _Pragma("unroll") for (int r = 2; r < 16; ++r) sacc += pB0[r]; _Pragma("unroll") for (int r = 0; r < 16; ++r) sacc += pB1[r]; l_reg += sacc;
      pw0 = (u32x4){PKW(pB0, 0), PKW(pB0, 2), PKW(pB0, 4), PKW(pB0, 6)}; pw1 = (u32x4){PKW(pB0, 8), PKW(pB0, 10), PKW(pB0, 12), PKW(pB0, 14)}; pw2 = (u32x4){PKW(pB1, 0), PKW(pB1, 2), PKW(pB1, 4), PKW(pB1, 6)}; pw3 = (u32x4){PKW(pB1, 8), PKW(pB1, 10), PKW(pB1, 12), PKW(pB1, 14)};
      SBAR(); pv(o, vb0 + sl_cur, PAF(0), PAF(1), PAF(2), PAF(3)); }
#undef PKW
#undef PAF
#undef VFR
#undef PIN
#undef MX3
#undef GAPA
#undef GAPB
#undef EX
#undef VRD
#undef KRD
#undef STEP
#undef ENDW
    { auto rr = __builtin_amdgcn_permlane32_swap(__float_as_uint(l_reg), __float_as_uint(l_reg), false, false); l_reg = __uint_as_float(rr[0]) + __uint_as_float(rr[1]); }
    if (has_sink) l_reg += __builtin_amdgcn_exp2f(sinkl2 - mhat);
    if (hi == 0) wsf[32 + r32] = l_reg; asm volatile("s_waitcnt lgkmcnt(0)" ::: "memory");
    float rli[16];
#pragma unroll
    for (int r = 0; r < 16; ++r) rli[r] = __builtin_amdgcn_rcpf(wsf[32 + crow(r, hi)]);
    bf16* Ow = Ow0 + (long)(wid * QBLK) * YP;
    { bf16* stg = (bf16*)(shm + LDS_OST) + wid * 2048;
#pragma unroll
      for (int r = 0; r < 16; ++r) { const int orow = crow(r, hi);
#pragma unroll
        for (int d0 = 0; d0 < 2; ++d0) stg[orow * 64 + d0 * 32 + r32] = __float2bfloat16(o[d0][r] * rli[r]); }
      asm volatile("s_waitcnt lgkmcnt(0)" ::: "memory");
#pragma unroll
      for (int i = 0; i < 4; ++i) { const int row = i * 8 + (lane >> 3), ch = lane & 7; const u32x4 v = *(const u32x4*)(stg + row * 64 + ch * 8); *(u32x4*)(Ow + (long)row * YP + ch * 8) = v; } }
    asm volatile("s_waitcnt lgkmcnt(0)\n\ts_barrier" ::: "memory");
#undef DMA_K
#undef DMA_V
#undef TOFF
#undef CMASK
#undef START
#undef RESC
#undef ROT
}
constexpr int ATTN_LDS_BYTES = LDS_BYTES;
#undef SBAR
#undef WAIT_BAR
}

constexpr int NWAVES = 8, NTHREADS = NWAVES * 64;
constexpr int RING_BYTES = 131072, LDS_BYTES = 147456;
constexpr int LDSCTL_OFF = RING_BYTES, MISC_OFF = LDSCTL_OFF + 320;
#define LAS __attribute__((address_space(3)))
typedef unsigned short bf16;
typedef unsigned v4u __attribute__((ext_vector_type(4)));
typedef unsigned v2u __attribute__((ext_vector_type(2)));
typedef float f32x4 __attribute__((ext_vector_type(4)));
using pg8::cvt_pk_bf16; using pg8::bf_lo; using pg8::bf_hi;

constexpr size_t MiB = 1u << 20;
constexpr size_t WS_MOD = 0;
constexpr size_t WS_CTL = 1 * MiB, CTL_ZERO_BYTES = 16384;
constexpr size_t WS_W = 2 * MiB;
constexpr size_t LW_IN = 0;
constexpr size_t LW_POOL = LW_IN + (size_t)5120 * 1024 * 2;
constexpr size_t LW_BR = LW_POOL + (size_t)512 * 256 * 2;
constexpr size_t LW_OUT = LW_BR + (size_t)3072 * 512 * 2;
constexpr size_t LW_FF = LW_OUT + (size_t)1024 * 1024 * 2;
constexpr size_t LW_DN = LW_FF + (size_t)5632 * 1024 * 2;
constexpr size_t LW_BYTES = LW_DN + (size_t)1024 * 2816 * 2;
constexpr size_t WS_XC = WS_W + ((2 * LW_BYTES + MiB - 1) / MiB) * MiB;
constexpr size_t WS_ARENA = WS_XC + (size_t)NCTX * 1024 * 4;
constexpr size_t AR_Z = 0, AR_G = (size_t)NTOK * ZP * 2, AR_Y = AR_G + (size_t)NTOK * GP * 2, AR_H = AR_Y;
constexpr size_t AR_MRG = AR_Z;
constexpr size_t AR_AV = 0, AR_H2 = (size_t)NTOK * AVP * 2;
constexpr size_t WS_END = WS_ARENA + (size_t)NTOK * 6656 * 2;
static_assert(AR_Y + (size_t)NTOK * YP * 2 == (size_t)NTOK * 6656 * 2 && AR_H2 + (size_t)NTOK * 1024 * 2 == (size_t)NTOK * 6656 * 2, "arena views");


#define XB_TMO      128
#define XB_XCNT(j)  (256  + 64 * (j))
#define XB_XSUB(j)  (1280 + 64 * (j))
#define XB_XGEN(j)  (2304 + 64 * (j))
#define XB_TOP      3328
#define XB_TOPGEN   3392
#define XCD_BAR_WORDS 3456
#define XB_SPIN_CAP (1u << 20)
__device__ __forceinline__ unsigned xb_ld(unsigned* p)              { return __hip_atomic_load(p, __ATOMIC_RELAXED, __HIP_MEMORY_SCOPE_AGENT); }
__device__ __forceinline__ unsigned xb_add(unsigned* p, unsigned v) { return __hip_atomic_fetch_add(p, v, __ATOMIC_RELAXED, __HIP_MEMORY_SCOPE_AGENT); }
__device__ __forceinline__ unsigned xb_xcc_id() { return (unsigned)__builtin_amdgcn_s_getreg((3 << 11) | 20) & 0xFu; }
#define XB_SPIN(cond, bar) do { unsigned _sp = 0; while (cond) { __builtin_amdgcn_s_sleep(1); \
    if ((++_sp & 255u) == 0u) { if (xb_ld(&(bar)[XB_TMO])) break; if (_sp > XB_SPIN_CAP) { atomicAdd(&(bar)[XB_TMO], 1u); break; } } } } while (0)
struct XcdBarrier { unsigned* bar; unsigned x; volatile LAS unsigned* st; };
__device__ __forceinline__ XcdBarrier xcd_barrier_post(unsigned* bar, volatile LAS unsigned* st) {
    XcdBarrier b; b.bar = bar; b.x = xb_xcc_id(); b.st = st;
    if (threadIdx.x == 0) (void)xb_add(&bar[XB_XCNT(b.x)], 1u);
    return b;
}
__device__ __forceinline__ void xcd_barrier_complete(unsigned* bar, unsigned x, unsigned& nloc, unsigned& nx) {
    const unsigned G = gridDim.x * gridDim.y * gridDim.z;
    unsigned sum, cnt, mine, sp = 0u;
    for (;;) {
        sum = 0u; cnt = 0u; mine = 0u;
#pragma unroll
        for (unsigned j = 0; j < 16; ++j) { const unsigned c = xb_ld(&bar[XB_XCNT(j)]); sum += c; cnt += (c > 0u) ? 1u : 0u; mine = (j == x) ? c : mine; }
        if (sum == G) break;
        __builtin_amdgcn_s_sleep(1);
        if ((++sp & 255u) == 0u) { if (xb_ld(&bar[XB_TMO])) break; if (sp > XB_SPIN_CAP) { atomicAdd(&bar[XB_TMO], 1u); break; } }
    }
    nloc = mine > 0u ? mine : 1u; nx = cnt > 0u ? cnt : 1u;
}
__device__ __forceinline__ void xcd_barrier(const XcdBarrier& b) {
    asm volatile("s_waitcnt vmcnt(0)" ::: "memory");
    __syncthreads();
    if (threadIdx.x == 0) {
        unsigned* bar = b.bar;
        __builtin_amdgcn_s_waitcnt(0);
        unsigned nloc = b.st[0], nx = b.st[1];
        if (nloc == 0u) { xcd_barrier_complete(bar, b.x, nloc, nx); b.st[0] = nloc; b.st[1] = nx; }
        const unsigned old = xb_add(&bar[XB_XSUB(b.x)], 1u);
        const unsigned gen = old / nloc;
        if (old + 1u == (gen + 1u) * nloc) {
            __builtin_amdgcn_fence(__ATOMIC_RELEASE, "agent");
            asm volatile("s_waitcnt vmcnt(0)" ::: "memory");
            const unsigned og = xb_add(&bar[XB_TOP], 1u);
            const unsigned tg = og / nx;
            if (og + 1u == (tg + 1u) * nx) xb_add(&bar[XB_TOPGEN], 1u);
            else XB_SPIN(xb_ld(&bar[XB_TOPGEN]) == tg, bar);
            __builtin_amdgcn_fence(__ATOMIC_ACQUIRE, "agent");
            xb_add(&bar[XB_XGEN(b.x)], 1u);
            asm volatile("s_waitcnt vmcnt(0)" ::: "memory");
        } else {
            XB_SPIN(xb_ld(&bar[XB_XGEN(b.x)]) == gen, bar);
            __builtin_amdgcn_fence(__ATOMIC_ACQUIRE, "agent");
            asm volatile("s_waitcnt vmcnt(0)" ::: "memory");
        }
    }
    __syncthreads();
}

struct Args {
    const float *x, *c, *ctx, *c_ctx, *w_mod, *b_mod, *norm1_g, *norm2_g, *w_in, *w_pool_grp, *pool_scale, *win_sink, *q_norm_g, *k_norm_g,
                *w_branch, *w_gate, *b_gate, *w_out, *w_ff_gate, *w_ff_val, *conv_w, *conv_b, *w_ff_down, *final_g;
    float* out; unsigned char* ws; int ph_lo, ph_hi;
};

__device__ __forceinline__ float wave_sum(float v) {
#pragma unroll
    for (int o = 1; o < 64; o <<= 1) v += __shfl_xor(v, o);
    return v;
}
__device__ __forceinline__ void transpose_item(const float* W, int K, int N, bf16* WT, int ldw, int row_off, LAS float* scr, int item, int lane) {
    const int nblk = N / 32, kb = item / nblk, nb = item % nblk, k0 = 64 * kb, n0 = 32 * nb;
#pragma unroll 8
    for (int i = 0; i < 32; ++i) { const int kk = 2 * i + (lane >> 5); scr[kk * 33 + (lane & 31)] = W[(size_t)(k0 + kk) * N + n0 + (lane & 31)]; }
    asm volatile("s_waitcnt lgkmcnt(0)" ::: "memory");
    const int c = lane & 7;
#pragma unroll
    for (int j = 0; j < 4; ++j) { const int n = (lane >> 3) + 8 * j; const LAS float* s = scr + (8 * c) * 33 + n;
        v4u o; o.x = cvt_pk_bf16(s[0 * 33], s[1 * 33]); o.y = cvt_pk_bf16(s[2 * 33], s[3 * 33]); o.z = cvt_pk_bf16(s[4 * 33], s[5 * 33]); o.w = cvt_pk_bf16(s[6 * 33], s[7 * 33]);
        *(v4u*)(WT + (size_t)(row_off + n0 + n) * ldw + k0 + 8 * c) = o; }
    asm volatile("s_waitcnt lgkmcnt(0)" ::: "memory");
}

__device__ __forceinline__ void prologue(const Args& A, LAS unsigned char* lds, int G, int vcu, int tid, int lane, int wave) {
    float* mod = (float*)(A.ws + WS_MOD);
    if ((int)blockIdx.x < 192) {
        LAS float* S = (LAS float*)lds; LAS float* part = (LAS float*)(lds + 17 * 1024 * 4);
        for (int idx = tid; idx < 17 * 1024; idx += NTHREADS) { const int r = idx >> 10, k = idx & 1023; const float v = (r < 16) ? A.c[r * 1024 + k] : A.c_ctx[k];
            S[idx] = v / (1.0f + __builtin_amdgcn_exp2f(-v * LOG2E)); }
        __syncthreads();
        for (int u = blockIdx.x; u < 192; u += G) {
            const int l = u / 96, n0 = (u % 96) * 64;
            float acc[17];
#pragma unroll
            for (int r = 0; r < 17; ++r) acc[r] = 0.f;
            const float* W = A.w_mod + (size_t)l * 1024 * 6144 + n0 + lane;
#pragma unroll 16
            for (int kk = 0; kk < 128; ++kk) { const int k = kk * 8 + wave; const float w = W[(size_t)k * 6144];
#pragma unroll
                for (int r = 0; r < 17; ++r) acc[r] += S[r * 1024 + k] * w; }
#pragma unroll
            for (int r = 0; r < 17; ++r) part[(wave * 17 + r) * 64 + lane] = acc[r];
            __syncthreads();
            for (int idx = tid; idx < 17 * 64; idx += NTHREADS) { const int r = idx >> 6, j = idx & 63; float s = 0.f;
#pragma unroll
                for (int w = 0; w < 8; ++w) s += part[(w * 17 + r) * 64 + j];
                mod[(size_t)(l * 17 + r) * 6144 + n0 + j] = s + A.b_mod[l * 6144 + n0 + j]; }
            __syncthreads();
        }
    }
    __syncthreads();
    LAS float* scr = (LAS float*)(lds + wave * 16384);
    const int gw = vcu * NWAVES + wave, NGW = G * NWAVES;
    constexpr int I_IN = 16 * 64, I_GATE = 16 * 32, I_BR = 8 * 32, I_OUT = 16 * 32, I_FF = 16 * 88, I_DN = 44 * 32;
    constexpr int PER_LAYER = I_IN + 3 * I_GATE + 3 * I_BR + I_OUT + 2 * I_FF + I_DN;
    for (int it = gw; it < 2 * PER_LAYER; it += NGW) {
        const int l = it / PER_LAYER; int r = it % PER_LAYER;
        unsigned char* wl = A.ws + WS_W + (size_t)l * LW_BYTES;
        if (r < I_IN) { transpose_item(A.w_in + (size_t)l * 1024 * 2048, 1024, 2048, (bf16*)(wl + LW_IN), 1024, 0, scr, r, lane); continue; } r -= I_IN;
        if (r < 3 * I_GATE) { const int i = r / I_GATE; transpose_item(A.w_gate + ((size_t)l * 3 + i) * 1024 * 1024, 1024, 1024, (bf16*)(wl + LW_IN), 1024, 2048 + i * 1024, scr, r % I_GATE, lane); continue; } r -= 3 * I_GATE;
        if (r < 3 * I_BR) { const int i = r / I_BR; transpose_item(A.w_branch + ((size_t)l * 3 + i) * 512 * 1024, 512, 1024, (bf16*)(wl + LW_BR), 512, i * 1024, scr, r % I_BR, lane); continue; } r -= 3 * I_BR;
        if (r < I_OUT) { transpose_item(A.w_out + (size_t)l * 1024 * 1024, 1024, 1024, (bf16*)(wl + LW_OUT), 1024, 0, scr, r, lane); continue; } r -= I_OUT;
        if (r < I_FF) { transpose_item(A.w_ff_gate + (size_t)l * 1024 * FF, 1024, FF, (bf16*)(wl + LW_FF), 1024, 0, scr, r, lane); continue; } r -= I_FF;
        if (r < I_FF) { transpose_item(A.w_ff_val + (size_t)l * 1024 * FF, 1024, FF, (bf16*)(wl + LW_FF), 1024, FF, scr, r, lane); continue; } r -= I_FF;
        transpose_item(A.w_ff_down + (size_t)l * FF * 1024, FF, 1024, (bf16*)(wl + LW_DN), FF, 0, scr, r, lane);
    }
    for (int idx = vcu * NTHREADS + tid; idx < 2 * 512 * 256; idx += G * NTHREADS) {
        const int l = idx / (512 * 256), e = idx % (512 * 256), n = e >> 8, k = e & 255, g = n >> 7, gk = 2 * (n >> 8) + (k >> 7);
        const float v = (gk == g) ? A.w_pool_grp[(((size_t)l * 4 + g) * 128 + (k & 127)) * 128 + (n & 127)] : 0.f;
        ((bf16*)(A.ws + WS_W + (size_t)l * LW_BYTES + LW_POOL))[e] = (bf16)(cvt_pk_bf16(v, 0.f) & 0xffffu);
    }
}

__device__ __forceinline__ void norm_rows(const float* xlat, const float* xctx, const float* gvec, const float* modl, int which, int nrows, bf16* H, int gw, int NGW, int lane) {
    asm volatile("" : "+v"(lane));
    for (int row = gw; row < nrows; row += NGW) {
        const bool lat = row < NLAT;
        const float* src = lat ? xlat + (size_t)row * 1024 : xctx + (size_t)(row - NLAT) * 1024;
        const int b = lat ? (row >> 12) : NB;
        const float* shp = modl + (size_t)(b * 6 + which * 3) * 1024; const float* scp = shp + 1024;
        f32x4 v[4]; float ss = 0.f;
#pragma unroll
        for (int j = 0; j < 4; ++j) { v[j] = *(const f32x4*)(src + 4 * lane + 256 * j); ss += (v[j].x * v[j].x + v[j].y * v[j].y) + (v[j].z * v[j].z + v[j].w * v[j].w); }
        const float rstd = __builtin_amdgcn_rsqf(wave_sum(ss) * (1.f / 1024.f) + EPS);
#pragma unroll
        for (int j = 0; j < 4; ++j) { const int c0 = 4 * lane + 256 * j;
            const f32x4 g = *(const f32x4*)(gvec + c0), sh = *(const f32x4*)(shp + c0), sc = *(const f32x4*)(scp + c0);
            const f32x4 y = (v[j] * rstd * g) * (sc + 1.0f) + sh;
            v2u w; w.x = cvt_pk_bf16(y.x, y.y); w.y = cvt_pk_bf16(y.z, y.w);
            *(v2u*)(H + (size_t)row * 1024 + c0) = w; }
    }
}
__device__ __forceinline__ void final_norm_rows(float* x, const float* gvec, int gw, int NGW, int lane) {
    asm volatile("" : "+v"(lane));
    for (int row = gw; row < NLAT; row += NGW) {
        float* src = x + (size_t)row * 1024;
        f32x4 v[4]; float ss = 0.f;
#pragma unroll
        for (int j = 0; j < 4; ++j) { v[j] = *(const f32x4*)(src + 4 * lane + 256 * j); ss += (v[j].x * v[j].x + v[j].y * v[j].y) + (v[j].z * v[j].z + v[j].w * v[j].w); }
        const float rstd = __builtin_amdgcn_rsqf(wave_sum(ss) * (1.f / 1024.f) + EPS);
#pragma unroll
        for (int j = 0; j < 4; ++j) { const int c0 = 4 * lane + 256 * j; const f32x4 g = *(const f32x4*)(gvec + c0); *(f32x4*)(src + c0) = v[j] * rstd * g; }
    }
}

__device__ __forceinline__ void unpack8(const v4u w, float* v) { v[0] = bf_lo(w.x); v[1] = bf_hi(w.x); v[2] = bf_lo(w.y); v[3] = bf_hi(w.y); v[4] = bf_lo(w.z); v[5] = bf_hi(w.z); v[6] = bf_lo(w.w); v[7] = bf_hi(w.w); }
__device__ __forceinline__ v4u pack8(const float* v) { v4u w; w.x = cvt_pk_bf16(v[0], v[1]); w.y = cvt_pk_bf16(v[2], v[3]); w.z = cvt_pk_bf16(v[4], v[5]); w.w = cvt_pk_bf16(v[6], v[7]); return w; }
__device__ __forceinline__ void qk_proc(float* v, bool do_norm, const float* g, bool do_rope, bool hi_half, const float* cs, const float* sn, float scale) {
    float ss = 0.f;
#pragma unroll
    for (int i = 0; i < 8; ++i) ss += v[i] * v[i];
    ss += __shfl_xor(ss, 1); ss += __shfl_xor(ss, 2); ss += __shfl_xor(ss, 4);
    const float rstd = __builtin_amdgcn_rsqf(ss * (1.f / 64.f) + EPS);
#pragma unroll
    for (int i = 0; i < 8; ++i) { const float nv = v[i] * rstd * g[i]; v[i] = do_norm ? nv : v[i]; }
#pragma unroll
    for (int i = 0; i < 8; ++i) { const float pvv = __shfl_xor(v[i], 2);
        const float rv = hi_half ? (v[i] * cs[i] + pvv * sn[i]) : (v[i] * cs[i] - pvv * sn[i]);
        v[i] = (do_rope ? rv : v[i]) * scale; }
}
__device__ __forceinline__ void elem_phase(const Args& A, int layer, int nrows, bf16* Z, bf16* Y, int gw, int NGW, int lane) {
    asm volatile("" : "+v"(lane));
    const int j8 = lane & 7; const bool hi_half = (j8 >> 1) & 1; const int axis = j8 >> 2, fbase = (j8 & 1) * 8;
    float inv[8], qg[8], kg[8];
#pragma unroll
    for (int i = 0; i < 8; ++i) { inv[i] = __builtin_amdgcn_exp2f(-(float)(fbase + i) * (13.287712379549449f / 16.0f)) * 0.15915494309189535f;
        qg[i] = A.q_norm_g[layer * 64 + j8 * 8 + i]; kg[i] = A.k_norm_g[layer * 64 + j8 * 8 + i]; }
    for (int row = gw; row < nrows; row += NGW) {
        const bool lat = row < NLAT;
        const int t = lat ? (row & (SEQ - 1)) : ((row - NLAT) & (CTX - 1));
        const int L = lat ? SEQ : CTX;
        bf16* zrow = Z + (size_t)row * ZP;
        const int g = lane >> 4, w2 = 1 << g; int lo = t - w2; lo = lo < 0 ? 0 : lo; int hi = t + w2; hi = hi > L ? L : hi;
        const bf16* zc = Z + (size_t)(row - t) * ZP + lane * 8;
        const v4u zero = {0u, 0u, 0u, 0u};
        v4u pw[16];
#pragma unroll
        for (int jj = 0; jj < 16; ++jj) { const int r = lo + jj; pw[jj] = (r < hi) ? *(const v4u*)(zc + (size_t)r * ZP) : zero; }
        const v4u own_w = *(const v4u*)(zrow + lane * 8);
        const v4u wq_w = *(const v4u*)(zrow + 512 + lane * 8);
        const v4u gq_w = *(const v4u*)(zrow + 1280 + lane * 8);
        const int l5 = lane & 31; const bool isg = l5 >= 16; const int kcol = isg ? 1792 + (l5 - 16) * 8 : 1024 + l5 * 8;
        const v4u k_w = *(const v4u*)(zrow + kcol);
        float acc[8];
#pragma unroll
        for (int i = 0; i < 8; ++i) acc[i] = 0.f;
#pragma unroll
        for (int jj = 0; jj < 16; ++jj) { float u[8]; unpack8(pw[jj], u);
#pragma unroll
            for (int i = 0; i < 8; ++i) acc[i] += u[i]; }
        { float own[8]; unpack8(own_w, own); const float rc = 1.0f / (float)(hi - lo);
#pragma unroll
          for (int i = 0; i < 8; ++i) acc[i] = acc[i] * rc - own[i]; }
        float cs[8], sn[8];
        { const float pos = (float)(axis ? (t & 63) : (t >> 6));
#pragma unroll
          for (int i = 0; i < 8; ++i) { float r = pos * inv[i]; r = r - __builtin_floorf(r); cs[i] = __builtin_amdgcn_cosf(r); sn[i] = __builtin_amdgcn_sinf(r); } }
        float vq[8], vg[8], vk[8];
        unpack8(wq_w, vq); qk_proc(vq, false, qg, lat, hi_half, cs, sn, C2);
        unpack8(gq_w, vg); qk_proc(vg, true, qg, lat, hi_half, cs, sn, C2);
        unpack8(k_w, vk);  qk_proc(vk, isg, kg, lat, hi_half, cs, sn, 1.0f);
        *(v4u*)(Y + (size_t)row * YP + lane * 8) = pack8(acc);
        *(v4u*)(zrow + 512 + lane * 8) = pack8(vq);
        *(v4u*)(zrow + 1280 + lane * 8) = pack8(vg);
        if (lane < 32) *(v4u*)(zrow + kcol) = pack8(vk);
    }
}

__device__ __forceinline__ void elem2_phase(const Args& A, int layer, int nrows, bf16* AV, int gtid, int NT) {
    asm volatile("" : "+v"(gtid));
    const int items = (nrows / 8) * 352;
    const float* cw = A.conv_w + (size_t)layer * 3 * FF; const float* cb = A.conv_b + (size_t)layer * FF;
    for (int it = gtid; it < items; it += NT) {
        const int c8 = it % 352, ch = it / 352, r0 = ch * 8, col = c8 * 8;
        const bool lat = r0 < NLAT; const int L = lat ? SEQ : CTX; const int t0 = lat ? (r0 & (SEQ - 1)) : ((r0 - NLAT) & (CTX - 1));
        bf16* ap = AV + (size_t)r0 * AVP + col;
        const v4u zero = {0u, 0u, 0u, 0u};
        v4u a[10], vv[8];
        a[0] = (t0 == 0) ? zero : *(const v4u*)(ap - AVP);
#pragma unroll
        for (int i = 0; i < 8; ++i) a[i + 1] = *(const v4u*)(ap + (size_t)i * AVP);
        a[9] = (t0 + 8 == L) ? zero : *(const v4u*)(ap + (size_t)8 * AVP);
#pragma unroll
        for (int i = 0; i < 8; ++i) vv[i] = *(const v4u*)(ap + (size_t)i * AVP + FF);
        float w0[8], w1[8], w2[8], bb[8];
#pragma unroll
        for (int h = 0; h < 2; ++h) { const f32x4 x0 = *(const f32x4*)(cw + col + 4 * h), x1 = *(const f32x4*)(cw + FF + col + 4 * h), x2 = *(const f32x4*)(cw + 2 * FF + col + 4 * h), xb = *(const f32x4*)(cb + col + 4 * h);
#pragma unroll
            for (int e = 0; e < 4; ++e) { w0[4 * h + e] = x0[e]; w1[4 * h + e] = x1[e]; w2[4 * h + e] = x2[e]; bb[4 * h + e] = xb[e]; } }
#pragma unroll
        for (int i = 0; i < 8; ++i) {
            float p[8], c[8], n[8], v[8], o[8]; unpack8(a[i], p); unpack8(a[i + 1], c); unpack8(a[i + 2], n); unpack8(vv[i], v);
#pragma unroll
            for (int e = 0; e < 8; ++e) { const float x = p[e] * w0[e] + c[e] * w1[e] + n[e] * w2[e] + bb[e]; o[e] = x * pg8::sigmoidf_(x) * v[e]; }
            *(v4u*)(ap + (size_t)i * AVP + FF) = pack8(o);
        }
    }
}

__device__ __forceinline__ void attention_phase(const Args& A, int layer, bool last, bf16* Z, bf16* Y, char* shm, int G, int vcu) {
    using abf = attn_body::bf16;
    const float* sink = A.win_sink + layer * 8;
    const int NU = NB * 8 * 16, per = (NU + G - 1) / G;
    int u0 = vcu * per, u1 = u0 + per; if (u1 > NU) u1 = NU;
    for (int u = u0; u < u1; ++u) {
        const int qb = u & 15, h = (u >> 4) & 7, b = u >> 7, kvh = h >> 2;
        const size_t qrow = (size_t)b * SEQ + qb * 256, crow0 = (size_t)NLAT + (size_t)b * CTX;
        const abf* Q = (const abf*)Z + qrow * ZP + 1280 + h * 64;
        const abf* Kc = (const abf*)Z + crow0 * ZP + 1792 + kvh * 64; const abf* Vc = (const abf*)Z + crow0 * ZP + 1920 + kvh * 64;
        const long dlat = ((long)b * SEQ - (long)crow0) * ZP;
        attn_body::attn_unit<8, false>(Q, Kc, Vc, dlat, 68, 0, false, 0.f, (abf*)Y + qrow * YP + 1024 + h * 64, shm);
    }
    for (int u = u0; u < u1; ++u) {
        const int qb = u & 15, h = (u >> 4) & 7, b = u >> 7, kvh = h >> 2;
        const size_t qrow = (size_t)b * SEQ + qb * 256, crow0 = (size_t)NLAT + (size_t)b * CTX;
        int tl0 = 4 * qb - 2; tl0 = tl0 < 0 ? 0 : tl0; int tl1 = 4 * qb + 6; tl1 = tl1 > 64 ? 64 : tl1;
        const abf* Q = (const abf*)Z + qrow * ZP + 512 + h * 64;
        const abf* Kc = (const abf*)Z + crow0 * ZP + 1024 + kvh * 64; const abf* Vc = (const abf*)Z + crow0 * ZP + 1152 + kvh * 64;
        const long dlat = ((long)b * SEQ + tl0 * 64 - (long)crow0) * ZP;
        attn_body::attn_unit<8, true>(Q, Kc, Vc, dlat, 4 + (tl1 - tl0), tl0 * 64 - qb * 256, true, sink[h] * LOG2E, (abf*)Y + qrow * YP + 512 + h * 64, shm);
    }
    if (!last) {
        const int NUC = 2 * NB * 8;
        for (int u = vcu; u < NUC; u += G) {
            const int mixer = u & 1, h = (u >> 1) & 7, b = u >> 4, kvh = h >> 2;
            const size_t crow0 = (size_t)NLAT + (size_t)b * CTX;
            const int qc = mixer ? 1280 : 512, kc = mixer ? 1792 : 1024, vc = mixer ? 1920 : 1152, oc = mixer ? 1024 : 512;
            attn_body::attn_unit<8, false>((const abf*)Z + crow0 * ZP + qc + h * 64, (const abf*)Z + crow0 * ZP + kc + kvh * 64, (const abf*)Z + crow0 * ZP + vc + kvh * 64, 0, 4, 0,
                                           mixer == 0, sink[h] * LOG2E, (abf*)Y + crow0 * YP + oc + h * 64, shm);
        }
    }
}

__global__ void __launch_bounds__(NTHREADS, 2) fwd_megakernel(Args A) {
    extern __shared__ __attribute__((aligned(16))) unsigned char lds_raw[];
    LAS unsigned char* lds = (LAS unsigned char*)lds_raw;
    const int tid = threadIdx.x, lane = tid & 63, wave = __builtin_amdgcn_readfirstlane(tid >> 6);
    const int G = gridDim.x; const int bx = blockIdx.x; const int vcu = (G % 8 == 0) ? (bx % 8) * (G / 8) + bx / 8 : bx;
    const int gw = vcu * NWAVES + wave, NGW = G * NWAVES;
    const int lo = A.ph_lo, hi = A.ph_hi;
    int ph = 0;
#if MK_SPLIT
#define SEAM() do { ++ph; } while (0)
#else
    cg::grid_group grid = cg::this_grid();
    for (int u = tid; u < (LDS_BYTES - LDSCTL_OFF) / 4; u += NTHREADS) ((LAS unsigned*)(lds + LDSCTL_OFF))[u] = 0u;
    __syncthreads();
    XcdBarrier bar = xcd_barrier_post((unsigned*)(A.ws + WS_CTL), (volatile LAS unsigned*)(lds + MISC_OFF) + 8);
#define SEAM() do { if (ph == 0) grid.sync(); else xcd_barrier(bar); ++ph; } while (0)
#endif
#define IN() (lo <= ph && ph < hi)
    unsigned char* ws = A.ws;
    float* mod = (float*)(ws + WS_MOD);
    float* XC = (float*)(ws + WS_XC);
    unsigned char* ar = ws + WS_ARENA;
    bf16* Z = (bf16*)(ar + AR_Z); bf16* Gt = (bf16*)(ar + AR_G); bf16* Y = (bf16*)(ar + AR_Y); bf16* H = (bf16*)(ar + AR_H);
    bf16* Mrg = (bf16*)(ar + AR_MRG); bf16* AV = (bf16*)(ar + AR_AV); bf16* H2 = (bf16*)(ar + AR_H2);

    if (IN()) prologue(A, lds, G, vcu, tid, lane, wave);
    SEAM();
    for (int l = 0; l < 2; ++l) {
        const bool last = (l == 1);
        const int nrows_mix = NTOK, nrows_x = last ? NLAT : NTOK;
        const int nM_mix = nrows_mix / 256, nM_x = nrows_x / 256;
        const float* modl = mod + (size_t)l * 17 * 6144;
        const unsigned char* wl = ws + WS_W + (size_t)l * LW_BYTES;
        const float* xlat_in = (l == 0) ? A.x : A.out; const float* xctx_in = (l == 0) ? A.ctx : XC;
        if (IN()) for (int rep = 0; rep < ((DUP_MASK & 8) ? 2 : 1); ++rep) norm_rows(xlat_in, xctx_in, A.norm1_g + l * 1024, modl, 0, nrows_mix, H, gw, NGW, lane);
        SEAM();
        if (IN()) for (int rep = 0; rep < ((DUP_MASK & 1) ? 2 : 1); ++rep) { pg8::Gemm g{H, (const bf16*)(wl + LW_IN), 1024, 1024, 1024, 0, 0}; pg8::Order S; S.init(nM_mix, 20, G, bx, 1, 0);
            pg8::EpiIn E{Z, Gt, A.b_gate + (size_t)l * 3072};
            pg8::gemm_phase<pg8::EpiIn, true>(lds, g, S, E); }
        SEAM();
        if (IN()) elem_phase(A, l, nrows_mix, Z, Y, gw, NGW, lane);
        SEAM();
        if (IN()) { for (int rep = 0; rep < ((DUP_MASK & 2) ? 2 : 1); ++rep) attention_phase(A, l, last, Z, Y, (char*)lds_raw, G, vcu);
            pg8::Gemm g{Y, (const bf16*)(wl + LW_POOL), YP, 256, 256, 256, 0}; pg8::Order S; S.init(nM_x, 2, G, bx, 1, 1);
            pg8::EpiBf16 E{Y, YP, A.pool_scale + (size_t)l * 512};
            pg8::gemm_phase<pg8::EpiBf16, true>(lds, g, S, E); }
        SEAM();
        if (IN()) for (int rep = 0; rep < ((DUP_MASK & 16) ? 2 : 1); ++rep) { pg8::Gemm g{Y, (const bf16*)(wl + LW_BR), YP, 512, 512, 512, (long)1024 * 512}; pg8::Order S; S.init(nM_x, 4, G, bx, 3, 2);
            pg8::EpiMerge E{Gt, Mrg};
            pg8::gemm_phase<pg8::EpiMerge, true>(lds, g, S, E); }
        SEAM();
        if (IN()) { pg8::Gemm g{Mrg, (const bf16*)(wl + LW_OUT), 1024, 1024, 1024, 0, 0}; pg8::Order S; S.init(nM_x, 4, G, bx, 1, 0);
            pg8::EpiRes E{xlat_in, xctx_in, A.out, XC, modl, 2};
            pg8::gemm_phase<pg8::EpiRes, true>(lds, g, S, E); }
        SEAM();
        if (IN()) for (int rep = 0; rep < ((DUP_MASK & 8) ? 2 : 1); ++rep) norm_rows(A.out, XC, A.norm2_g + l * 1024, modl, 1, nrows_x, H2, gw, NGW, lane);
        SEAM();
        if (IN()) for (int rep = 0; rep < ((DUP_MASK & 4) ? 2 : 1); ++rep) { pg8::Gemm g{H2, (const bf16*)(wl + LW_FF), 1024, 1024, 1024, 0, 0}; pg8::Order S; S.init(nM_x, 22, G, bx, 1, 0);
            pg8::EpiBf16 E{AV, AVP, nullptr};
            pg8::gemm_phase<pg8::EpiBf16, true>(lds, g, S, E); }
        SEAM();
        if (IN()) elem2_phase(A, l, nrows_x, AV, vcu * NTHREADS + tid, G * NTHREADS);
        SEAM();
        if (IN()) { pg8::Gemm g{AV + FF, (const bf16*)(wl + LW_DN), AVP, FF, FF, 0, 0}; pg8::Order S; S.init(nM_x, 4, G, bx, 1, 0);
            pg8::EpiRes E{A.out, XC, A.out, XC, modl, 5};
            pg8::gemm_phase<pg8::EpiRes, true>(lds, g, S, E); }
        SEAM();
    }
    if (IN()) final_norm_rows(A.out, A.final_g, gw, NGW, lane);
#undef IN
#undef SEAM
}
constexpr int N_PHASES = 22;

extern "C" void kernel_launch(void* const* d_in, const int* in_sizes, int n_in, void* d_out, int out_size, void* d_ws, size_t ws_size, hipStream_t stream) {
    static int grid = 0;
    if (grid == 0) {
        if (n_in != 24 || out_size != NLAT * 1024 || ws_size < WS_END) { fprintf(stderr, "kernel_launch: unexpected shapes (n_in %d out %d ws %zu need %zu)\n", n_in, out_size, ws_size, (size_t)WS_END); grid = -1; return; }
        int dev = 0, cus = 0, per_cu = 0;
        hipGetDevice(&dev); hipDeviceGetAttribute(&cus, hipDeviceAttributeMultiprocessorCount, dev);
        if (hipFuncSetAttribute((const void*)fwd_megakernel, hipFuncAttributeMaxDynamicSharedMemorySize, LDS_BYTES) != hipSuccess) { fprintf(stderr, "kernel_launch: hipFuncSetAttribute failed\n"); grid = -1; return; }
        hipOccupancyMaxActiveBlocksPerMultiprocessor(&per_cu, (const void*)fwd_megakernel, NTHREADS, LDS_BYTES);
        (void)hipGetLastError();
        if (per_cu < 1) { fprintf(stderr, "kernel_launch: occupancy query says %d blocks per CU\n", per_cu); per_cu = 1; }
        grid = cus;
    }
    if (grid < 0) return;
    Args a{};
    const float** p = (const float**)&a;
    for (int i = 0; i < 24; ++i) p[i] = (const float*)d_in[i];
    a.out = (float*)d_out; a.ws = (unsigned char*)d_ws;
#if MK_SPLIT
    for (int ph = 0; ph < N_PHASES; ++ph) { a.ph_lo = ph; a.ph_hi = ph + 1; hipLaunchKernelGGL(fwd_megakernel, dim3(grid), dim3(NTHREADS), LDS_BYTES, stream, a); }
#else
    a.ph_lo = 0; a.ph_hi = N_PHASES;
    if (hipMemsetAsync((char*)d_ws + WS_CTL, 0, CTL_ZERO_BYTES, stream) != hipSuccess) { fprintf(stderr, "kernel_launch: memset failed\n"); return; }
    void* args[] = {&a};
    hipError_t e = hipLaunchCooperativeKernel((const void*)fwd_megakernel, dim3(grid), dim3(NTHREADS), args, LDS_BYTES, stream);
    if (e != hipSuccess) fprintf(stderr, "cooperative launch failed: %s (grid %d)\n", hipGetErrorString(e), grid);
#endif
}
```

```cpp
#include <hip/hip_runtime.h>
#include <hip/hip_cooperative_groups.h>
#include <hip/hip_bf16.h>
#include <cstdio>
#include <cstdint>
#include <cmath>
namespace cg = cooperative_groups;

#ifndef DUP_MASK
#define DUP_MASK 0
#endif
#ifndef MK_SPLIT
#define MK_SPLIT 0
#endif

constexpr int DM_ = 1024, NB = 16, SEQ = 4096, CTX = 256, NLAT = NB * SEQ, NCTX = NB * CTX, NTOK = NLAT + NCTX;
constexpr int ZP = 2048, GP = 3072, YP = 1536, FF = 2816, AVP = 2 * FF;
constexpr float EPS = 1e-6f;
constexpr float LOG2E = 1.4426950408889634f;
constexpr float C2 = 0.125f * LOG2E;

__device__ __forceinline__ int lane_fresh() { int l = (int)__builtin_amdgcn_mbcnt_hi(~0u, __builtin_amdgcn_mbcnt_lo(~0u, 0u)); asm volatile("" : "+v"(l)); return l; }

namespace pg8 {
#define PG8_LAS __attribute__((address_space(3)))
typedef unsigned short bf16_t;
typedef short bf16x8 __attribute__((ext_vector_type(8)));
typedef float f32x4 __attribute__((ext_vector_type(4)));
typedef unsigned u32x4 __attribute__((ext_vector_type(4)));
typedef unsigned u32x2 __attribute__((ext_vector_type(2)));
constexpr int BM = 256, BK = 64, HALF = 128, HTB = HALF * BK * 2, STAGE_BYTES = 8 * HTB, NXCD = 8, WGM = 8;

__host__ __device__ __forceinline__ int lds_byte(int r, int c) { const int st = (r >> 4) * 2 + (c >> 5), rr = r & 15, cc = c & 31, ob = rr * 64 + cc * 2; return st * 1024 + (ob ^ (((ob >> 9) & 1) << 5)); }
__host__ __device__ __forceinline__ void stage_rc(int b, int& R, int& C) { const int st = b / 1024, sb = b % 1024, swz = sb ^ (((sb >> 9) & 1) << 5); R = (st >> 1) * 16 + swz / 64; C = (st & 1) * 32 + (swz % 64) / 2; }
__host__ __device__ __forceinline__ int perm32(int rho) { const int n = rho >> 4, i = rho & 15; return 8 * (i >> 2) + 4 * n + (i & 3); }

struct Unit { int pm, pn, g; };
struct Gemm { const bf16_t* A; const bf16_t* Bt; int lda, ldb, K; long a_goff, b_goff; };

struct Order {
    int nM, nN, nwg, G, c, sub, gmode;
    __device__ __forceinline__ void init(int nM_, int nN_, int G_, int c_, int sub_, int gmode_) { nM = nM_; nN = nN_; nwg = nM * nN; G = G_; c = c_; sub = sub_; gmode = gmode_; }
    __device__ __forceinline__ bool next(int i, Unit& u) const {
        const int ti = (sub == 1) ? i : i / sub;
        const long L = (long)ti * G + c; if (L >= nwg) return false;
        int wgid = (int)L; { const int q = nwg / NXCD, r = nwg % NXCD, xcd = wgid % NXCD, off = wgid / NXCD; wgid = (xcd < r ? xcd * (q + 1) : r * (q + 1) + (xcd - r) * q) + off; }
        const int nig = WGM * nN, gid = wgid / nig, fm = gid * WGM, gsz = (nM - fm) < WGM ? (nM - fm) : WGM;
        u.pm = fm + ((wgid % nig) % gsz); u.pn = (wgid % nig) / gsz;
        u.g = (gmode == 0) ? 0 : ((gmode == 1) ? u.pn : (i - ti * sub));
        return true;
    }
};

typedef float f32x2_t __attribute__((ext_vector_type(2))); typedef __bf16 bf16x2_t __attribute__((ext_vector_type(2)));
__device__ __forceinline__ unsigned cvt_pk_bf16(float lo, float hi) { f32x2_t v = {lo, hi}; bf16x2_t b = __builtin_convertvector(v, bf16x2_t); return __builtin_bit_cast(unsigned, b); }
__device__ __forceinline__ float bf_lo(unsigned w) { return __uint_as_float(w << 16); }
__device__ __forceinline__ float bf_hi(unsigned w) { return __uint_as_float(w & 0xffff0000u); }
__device__ __forceinline__ float sigmoidf_(float x) { return __builtin_amdgcn_rcpf(1.0f + __builtin_amdgcn_exp2f(-x * 1.4426950408889634f)); }

struct EpiBf16 {
    static constexpr bool PERM = true;
    bf16_t* O; int ldc; const float* colscale;
    __device__ __forceinline__ void operator()(const f32x4 (&acc)[2][2][4][2], const Unit& u, int wr, int wc, int fr, int fq) const {
        int row0 = u.pm * BM + wr * 64 + fr; asm volatile("" : "+v"(row0)); const int col0 = u.pn * BM + wc * 32 + 8 * fq;
#pragma unroll
        for (int bj = 0; bj < 2; ++bj) {
            f32x4 s0 = (f32x4){1.f, 1.f, 1.f, 1.f}, s1 = s0;
            if (colscale) { s0 = *(const f32x4*)(colscale + col0 + bj * HALF); s1 = *(const f32x4*)(colscale + col0 + bj * HALF + 4); }
#pragma unroll
            for (int ai = 0; ai < 2; ++ai)
#pragma unroll
                for (int m = 0; m < 4; ++m) { bf16_t* rowp = O + (size_t)(row0 + ai * HALF + m * 16) * ldc + col0;
                    const f32x4 v0 = acc[ai][bj][m][0] * s0, v1 = acc[ai][bj][m][1] * s1;
                    u32x4 w; w.x = cvt_pk_bf16(v0[0], v0[1]); w.y = cvt_pk_bf16(v0[2], v0[3]); w.z = cvt_pk_bf16(v1[0], v1[1]); w.w = cvt_pk_bf16(v1[2], v1[3]);
                    *(u32x4*)(rowp + bj * HALF) = w; } }
    }
};
struct EpiIn {
    static constexpr bool PERM = true;
    bf16_t* Z; bf16_t* Gt; const float* bgate;
    __device__ __forceinline__ void operator()(const f32x4 (&acc)[2][2][4][2], const Unit& u, int wr, int wc, int fr, int fq) const {
        int row0 = u.pm * BM + wr * 64 + fr; asm volatile("" : "+v"(row0)); const bool isz = u.pn < 8;
        const int col0 = (isz ? u.pn * BM : (u.pn - 8) * BM) + wc * 32 + 8 * fq;
        bf16_t* base = isz ? Z : Gt; const int ldc = isz ? ZP : GP;
        f32x4 bv[2][2];
#pragma unroll
        for (int bj = 0; bj < 2; ++bj)
#pragma unroll
            for (int n = 0; n < 2; ++n) bv[bj][n] = isz ? (f32x4){0.f, 0.f, 0.f, 0.f} : *(const f32x4*)(bgate + col0 + bj * HALF + 4 * n);
#pragma unroll
        for (int ai = 0; ai < 2; ++ai)
#pragma unroll
            for (int m = 0; m < 4; ++m) { bf16_t* rowp = base + (size_t)(row0 + ai * HALF + m * 16) * ldc + col0;
#pragma unroll
                for (int bj = 0; bj < 2; ++bj) { f32x4 v0 = acc[ai][bj][m][0] + bv[bj][0], v1 = acc[ai][bj][m][1] + bv[bj][1];
                    if (!isz) {
#pragma unroll
                        for (int e = 0; e < 4; ++e) { v0[e] = sigmoidf_(v0[e]); v1[e] = sigmoidf_(v1[e]); } }
                    u32x4 w; w.x = cvt_pk_bf16(v0[0], v0[1]); w.y = cvt_pk_bf16(v0[2], v0[3]); w.z = cvt_pk_bf16(v1[0], v1[1]); w.w = cvt_pk_bf16(v1[2], v1[3]);
                    *(u32x4*)(rowp + bj * HALF) = w; } }
    }
};
struct EpiMerge {
    static constexpr bool PERM = true;
    const bf16_t* Gt; bf16_t* Mrg;
    __device__ __forceinline__ void operator()(const f32x4 (&acc)[2][2][4][2], const Unit& u, int wr, int wc, int fr, int fq) const {
        int row0 = u.pm * BM + wr * 64 + fr; asm volatile("" : "+v"(row0)); const int col0 = u.pn * BM + wc * 32 + 8 * fq;
#pragma unroll
        for (int ai = 0; ai < 2; ++ai)
#pragma unroll
            for (int m = 0; m < 4; ++m) { const size_t row = (size_t)(row0 + ai * HALF + m * 16);
#pragma unroll
                for (int bj = 0; bj < 2; ++bj) {
                    const u32x4 gw = *(const u32x4*)(Gt + row * GP + u.g * 1024 + col0 + bj * HALF);
                    bf16_t* mp = Mrg + row * 1024 + col0 + bj * HALF;
                    const f32x4 a0 = acc[ai][bj][m][0], a1 = acc[ai][bj][m][1];
                    float v[8];
                    v[0] = bf_lo(gw.x) * a0[0]; v[1] = bf_hi(gw.x) * a0[1]; v[2] = bf_lo(gw.y) * a0[2]; v[3] = bf_hi(gw.y) * a0[3];
                    v[4] = bf_lo(gw.z) * a1[0]; v[5] = bf_hi(gw.z) * a1[1]; v[6] = bf_lo(gw.w) * a1[2]; v[7] = bf_hi(gw.w) * a1[3];
                    if (u.g != 0) { const u32x4 ow = *(const u32x4*)mp;
                        v[0] += bf_lo(ow.x); v[1] += bf_hi(ow.x); v[2] += bf_lo(ow.y); v[3] += bf_hi(ow.y); v[4] += bf_lo(ow.z); v[5] += bf_hi(ow.z); v[6] += bf_lo(ow.w); v[7] += bf_hi(ow.w); }
                    u32x4 w; w.x = cvt_pk_bf16(v[0], v[1]); w.y = cvt_pk_bf16(v[2], v[3]); w.z = cvt_pk_bf16(v[4], v[5]); w.w = cvt_pk_bf16(v[6], v[7]);
                    *(u32x4*)mp = w; } }
    }
};
struct EpiRes {
    static constexpr bool PERM = false;
    const float* base_lat; const float* base_ctx; float* out_lat; float* out_ctx; const float* modl; int gate_idx;
    __device__ __forceinline__ void operator()(const f32x4 (&acc)[2][2][4][2], const Unit& u, int wr, int wc, int fr, int fq) const {
        const bool lat = u.pm < (NLAT / BM);
        const int prow = lat ? u.pm * BM : (u.pm * BM - NLAT);
        const float* base = lat ? base_lat : base_ctx; float* out = lat ? out_lat : out_ctx;
        const int b = lat ? (u.pm * BM) / SEQ : NB;
        int col0 = u.pn * BM + wc * 32 + 4 * fq; asm volatile("" : "+v"(col0));
        const float* gp = modl + (size_t)(b * 6 + gate_idx) * 1024 + col0;
        f32x4 gv[2][2];
#pragma unroll
        for (int bj = 0; bj < 2; ++bj)
#pragma unroll
            for (int n = 0; n < 2; ++n) gv[bj][n] = *(const f32x4*)(gp + bj * HALF + n * 16);
#pragma unroll
        for (int ai = 0; ai < 2; ++ai)
#pragma unroll
            for (int m = 0; m < 4; ++m) { const size_t off = (size_t)(prow + ai * HALF + wr * 64 + m * 16 + fr) * 1024 + col0;
#pragma unroll
                for (int bj = 0; bj < 2; ++bj)
#pragma unroll
                    for (int n = 0; n < 2; ++n) { const f32x4 bs = *(const f32x4*)(base + off + bj * HALF + n * 16);
                        *(f32x4*)(out + off + bj * HALF + n * 16) = bs + gv[bj][n] * acc[ai][bj][m][n]; } }
    }
};

struct EpiFF {
    static constexpr bool PERM = true;
    bf16_t* U; const float* cw; const float* cb; float* As; size_t side_elems;
    __device__ __forceinline__ void operator()(const f32x4 (&acc)[2][2][4][2], const Unit& u, int wr, int wc, int fr, int fq) const {
        const int lane = fq * 16 + fr; float* PAs = As + side_elems; float* Vs = PAs + side_elems;
        int ch0 = u.pn * 128 + wc * 32 + 8 * fq; asm volatile("" : "+v"(ch0));
        const int src_up = (lane & 48) | ((fr - 1) & 15), src_dn = (lane & 48) | ((fr + 1) & 15);
#pragma unroll
        for (int h = 0; h < 2; ++h) {
            const f32x4 w0 = *(const f32x4*)(cw + ch0 + 4 * h), w1 = *(const f32x4*)(cw + 2816 + ch0 + 4 * h), w2 = *(const f32x4*)(cw + 2 * 2816 + ch0 + 4 * h), bb = *(const f32x4*)(cb + ch0 + 4 * h);
#pragma unroll
            for (int ai = 0; ai < 2; ++ai) {
                const int rblk = u.pm * 4 + ai * 2 + wr;
                float o[4][4]; f32x4 pre0, pre3;
#pragma unroll
                for (int e = 0; e < 4; ++e) {
                    float a[4], ru[4], rd[4];
#pragma unroll
                    for (int m = 0; m < 4; ++m) { a[m] = acc[ai][0][m][h][e]; ru[m] = __int_as_float(__builtin_amdgcn_ds_bpermute(src_up << 2, __float_as_int(a[m]))); rd[m] = __int_as_float(__builtin_amdgcn_ds_bpermute(src_dn << 2, __float_as_int(a[m]))); }
#pragma unroll
                    for (int m = 0; m < 4; ++m) {
                        const float ap = (fr > 0) ? ru[m] : (m > 0 ? ru[m > 0 ? m - 1 : 0] : 0.f);
                        const float an = (fr < 15) ? rd[m] : (m < 3 ? rd[m < 3 ? m + 1 : 3] : 0.f);
                        const float pre = ap * w0[e] + a[m] * w1[e] + an * w2[e] + bb[e];
                        if (m == 0) pre0[e] = pre; if (m == 3) pre3[e] = pre;
                        o[m][e] = pre * sigmoidf_(pre) * acc[ai][1][m][h][e]; }
                    __builtin_amdgcn_sched_barrier(0); }
#pragma unroll
                for (int m = 0; m < 4; ++m) { u32x2 w; w.x = cvt_pk_bf16(o[m][0], o[m][1]); w.y = cvt_pk_bf16(o[m][2], o[m][3]);
                    *(u32x2*)(U + ((size_t)rblk * 64 + m * 16 + fr) * 2816 + ch0 + 4 * h) = w; }
                if (fr == 0) { const size_t so = (size_t)(2 * rblk) * 2816 + ch0 + 4 * h; *(f32x4*)(As + so) = acc[ai][0][0][h]; *(f32x4*)(Vs + so) = acc[ai][1][0][h]; *(f32x4*)(PAs + so) = pre0; }
                if (fr == 15) { const size_t so = (size_t)(2 * rblk + 1) * 2816 + ch0 + 4 * h; *(f32x4*)(As + so) = acc[ai][0][3][h]; *(f32x4*)(Vs + so) = acc[ai][1][3][h]; *(f32x4*)(PAs + so) = pre3; }
                __builtin_amdgcn_sched_barrier(0);
            }
        }
    }
};

template <class Epi, bool ALIGN_EPI>
__device__ __forceinline__ void gemm_phase(PG8_LAS unsigned char* lds, const Gemm g, const Order& S, const Epi& E, int wid) {
    const int lane = lane_fresh(), tid = wid * 64 + lane;
    const int wr = wid >> 2, wc = wid & 3, fr = lane & 15, fq = lane >> 4;
    const int K = g.K, nt = K / BK;
    unsigned voffA[2], voffB[2];
#pragma unroll
    for (int i = 0; i < 2; ++i) { int R, C; stage_rc(tid * 16 + i * 8192, R, C); const int Rb = Epi::PERM ? ((R & ~31) + perm32(R & 31)) : R;
        voffA[i] = (unsigned)(R * g.lda + C) * 2u; voffB[i] = (unsigned)(Rb * g.ldb + C) * 2u; }
    const size_t kstep = (size_t)(BK * 2);
    const size_t hstepA = (size_t)HALF * g.lda * 2, hstepB = (size_t)HALF * g.ldb * 2;
    const size_t tstepA = 2 * hstepA, tstepB = 2 * hstepB;
    const unsigned ldsw = (unsigned)wid * 1024u;
    const int aoff = lds_byte(wr * 64 + fr, fq * 8), boff = lds_byte(wc * 32 + fr, fq * 8);
#define PG8_UA(u) ((const char*)g.A + (size_t)(u).pm * tstepA + (size_t)((long)(u).g * g.a_goff * 2))
#define PG8_UB(u) ((const char*)g.Bt + (size_t)(u).pn * tstepB + (size_t)((long)(u).g * g.b_goff * 2))
#define PG8_SA(b, h) (((b) * 2 + (h)) * HTB)
#define PG8_SB(b, h) ((4 + (b) * 2 + (h)) * HTB)
#define PG8_STAGE(bufoff, gbase, voff) do { _Pragma("unroll") for (int _i = 0; _i < 2; ++_i) \
        __builtin_amdgcn_global_load_lds((const unsigned*)((const char*)(gbase) + (voff)[_i]), (PG8_LAS unsigned*)(lds + (bufoff) + ldsw + _i * 8192), 16, 0, 0); } while (0)
#define PG8_LDA(dst, b, h) do { _Pragma("unroll") for (int m = 0; m < 4; ++m) _Pragma("unroll") for (int k = 0; k < 2; ++k) dst[m][k] = *(const PG8_LAS bf16x8*)(lds + PG8_SA(b, h) + aoff + m * 2048 + k * 1024); } while (0)
#define PG8_LDB(dst, b, h) do { _Pragma("unroll") for (int n = 0; n < 2; ++n) _Pragma("unroll") for (int k = 0; k < 2; ++k) dst[n][k] = *(const PG8_LAS bf16x8*)(lds + PG8_SB(b, h) + boff + n * 2048 + k * 1024); } while (0)
#define PG8_MMA(ai, bj, At, Bt) do { __builtin_amdgcn_s_setprio(1); _Pragma("unroll") for (int m = 0; m < 4; ++m) _Pragma("unroll") for (int n = 0; n < 2; ++n) _Pragma("unroll") for (int k = 0; k < 2; ++k) \
        acc[ai][bj][m][n] = __builtin_amdgcn_mfma_f32_16x16x32_bf16(Bt[n][k], At[m][k], acc[ai][bj][m][n], 0, 0, 0); __builtin_amdgcn_s_setprio(0); } while (0)
#define PG8_WAIT_V(n) asm volatile("s_waitcnt vmcnt(" #n ")" ::: "memory")
#define PG8_WAIT_L(n) asm volatile("s_waitcnt lgkmcnt(" #n ")" ::: "memory")
#define PG8_BAR __builtin_amdgcn_s_barrier()
#define PG8_SCHED __builtin_amdgcn_sched_barrier(0)
    Unit cur, nxt; int ui = 0;
    if (!S.next(0, cur)) return;
    f32x4 acc[2][2][4][2];
#pragma unroll
    for (int a = 0; a < 2; ++a)
#pragma unroll
        for (int b = 0; b < 2; ++b)
#pragma unroll
            for (int m = 0; m < 4; ++m)
#pragma unroll
                for (int n = 0; n < 2; ++n) acc[a][b][m][n] = (f32x4){0.f, 0.f, 0.f, 0.f};
    bf16x8 At[4][2], B0[2][2], B1[2][2];
    const char* cA = PG8_UA(cur); const char* cB = PG8_UB(cur);
    PG8_STAGE(PG8_SB(0, 0), cB, voffB); PG8_STAGE(PG8_SB(0, 1), cB + hstepB, voffB); PG8_STAGE(PG8_SA(0, 0), cA, voffA); PG8_STAGE(PG8_SA(0, 1), cA + hstepA, voffA);
    if (wr == 1) PG8_BAR;
    PG8_WAIT_V(2); PG8_BAR;
    PG8_STAGE(PG8_SB(1, 0), cB + kstep, voffB); PG8_STAGE(PG8_SA(1, 0), cA + kstep, voffA); PG8_STAGE(PG8_SB(1, 1), cB + hstepB + kstep, voffB);
    PG8_WAIT_V(6); PG8_BAR;
    for (;;) {
        const bool has_next = S.next(ui + 1, nxt);
        const char* nA = has_next ? PG8_UA(nxt) : cA; const char* nB = has_next ? PG8_UB(nxt) : cB;
        for (int t = 0; t < nt; t += 2) {
            const bool last = (t == nt - 2);
            const char* a1 = cA + (size_t)(t + 1) * kstep;
            const char* a2 = last ? nA : cA + (size_t)(t + 2) * kstep; const char* b2 = last ? nB : cB + (size_t)(t + 2) * kstep;
            const char* a3 = a2 + kstep; const char* b3 = b2 + kstep;
            PG8_LDB(B0, 0, 0); PG8_LDB(B1, 0, 1); PG8_SCHED; PG8_LDA(At, 0, 0); PG8_STAGE(PG8_SA(1, 1), a1 + hstepA, voffA);
            PG8_WAIT_V(8); PG8_WAIT_L(0); PG8_BAR; PG8_MMA(0, 0, At, B0); PG8_MMA(0, 1, At, B1); PG8_BAR; PG8_SCHED;
            PG8_LDA(At, 0, 1); PG8_STAGE(PG8_SB(0, 0), b2, voffB); PG8_STAGE(PG8_SB(0, 1), b2 + hstepB, voffB); PG8_STAGE(PG8_SA(0, 0), a2, voffA);
            PG8_WAIT_V(8); PG8_WAIT_L(0); PG8_BAR; PG8_MMA(1, 0, At, B0); PG8_MMA(1, 1, At, B1); PG8_BAR; PG8_SCHED;
            PG8_LDB(B0, 1, 0); PG8_LDB(B1, 1, 1); PG8_SCHED; PG8_LDA(At, 1, 0); PG8_STAGE(PG8_SA(0, 1), a2 + hstepA, voffA);
            PG8_WAIT_V(8); PG8_WAIT_L(0); PG8_BAR; PG8_MMA(0, 0, At, B0); PG8_MMA(0, 1, At, B1); PG8_BAR; PG8_SCHED;
            PG8_LDA(At, 1, 1); PG8_STAGE(PG8_SB(1, 0), b3, voffB); PG8_STAGE(PG8_SB(1, 1), b3 + hstepB, voffB); PG8_STAGE(PG8_SA(1, 0), a3, voffA);
            PG8_WAIT_V(8); PG8_WAIT_L(0); PG8_BAR; PG8_MMA(1, 0, At, B0); PG8_MMA(1, 1, At, B1); PG8_BAR; PG8_SCHED;
        }
        if constexpr (ALIGN_EPI) { if (wr == 0) PG8_BAR; }
        { const int l2 = lane_fresh(); E(acc, cur, wr, wc, l2 & 15, l2 >> 4); }
        if (!has_next) break;
#pragma unroll
        for (int a = 0; a < 2; ++a)
#pragma unroll
            for (int b = 0; b < 2; ++b)
#pragma unroll
                for (int m = 0; m < 4; ++m)
#pragma unroll
                    for (int n = 0; n < 2; ++n) acc[a][b][m][n] = (f32x4){0.f, 0.f, 0.f, 0.f};
        cur = nxt; cA = nA; cB = nB; ++ui;
        if constexpr (ALIGN_EPI) { if (wr == 1) PG8_BAR; }
    }
    PG8_WAIT_V(0);
    if constexpr (!ALIGN_EPI) { if (wr == 0) PG8_BAR; }
    PG8_BAR;
#undef PG8_UA
#undef PG8_UB
#undef PG8_SA
#undef PG8_SB
#undef PG8_STAGE
#undef PG8_LDA
#undef PG8_LDB
#undef PG8_MMA
#undef PG8_WAIT_V
#undef PG8_WAIT_L
#undef PG8_BAR
#undef PG8_SCHED
}
}

namespace attn_body {
using bf16 = __hip_bfloat16;
using bf16x8 = __attribute__((ext_vector_type(8))) short;
using s16x4 = __attribute__((ext_vector_type(4))) short;
using f32x16 = __attribute__((ext_vector_type(16))) float;
using u32x4 = __attribute__((ext_vector_type(4))) unsigned;
constexpr int D = 64, NW = 8, QBLK = 32, QB = QBLK * NW, KVBLK = 64;
__device__ __forceinline__ int crow(int r, int hi) { return (r & 3) + 8 * (r >> 2) + 4 * hi; }
#define SBAR() __builtin_amdgcn_sched_barrier(0)
__device__ __forceinline__ void wmask(f32x16& p0, f32x16& p1, int d0) {
    const float NEG = -INFINITY;
#pragma unroll
    for (int r = 0; r < 16; ++r) { const int d = d0 + (r & 3) + 8 * (r >> 2); if (d > 128 || d < -128) p0[r] = NEG; if (d + 32 > 128 || d + 32 < -128) p1[r] = NEG; }
}
constexpr int NSLOT = 3, SLOTB = 8192;
constexpr int LDS_K = 0, LDS_V = NSLOT * SLOTB, LDS_WS = 2 * NSLOT * SLOTB, LDS_OST = LDS_WS + NW * 64 * 4, LDS_BYTES = LDS_OST + NW * 4096;
__device__ __forceinline__ void glds16(const void* gsrc, unsigned lds_dst) { unsigned keep;
    asm volatile("s_mov_b32 %0, m0\n\ts_mov_b32 m0, %2\n\ts_nop 0\n\tglobal_load_lds_dwordx4 %1, off\n\ts_mov_b32 m0, %0" : "=&s"(keep) : "v"(gsrc), "s"(lds_dst) : "memory"); }
__device__ __forceinline__ float max3f(float a, float b, float c) { float r; asm("v_max3_f32 %0, %1, %2, %3" : "=v"(r) : "v"(a), "v"(b), "v"(c)); return r; }
__device__ __forceinline__ float max2f(float a, float b) { float r; asm("v_max_f32_e32 %0, %1, %2" : "=v"(r) : "v"(a), "v"(b)); return r; }
__device__ __forceinline__ float fadd_s(float a, float b) { float r; asm("v_add_f32_e32 %0, %1, %2" : "=v"(r) : "v"(a), "v"(b)); return r; }
__device__ __forceinline__ float fsub_s(float a, float b) { float r; asm("v_sub_f32_e32 %0, %1, %2" : "=v"(r) : "v"(a), "v"(b)); return r; }
typedef float f32x2_t __attribute__((ext_vector_type(2))); typedef __bf16 bf16x2_t __attribute__((ext_vector_type(2)));
__device__ __forceinline__ unsigned cvtpk_s(float lo, float hi) { f32x2_t v = {lo, hi}; bf16x2_t b = __builtin_convertvector(v, bf16x2_t); return __builtin_bit_cast(unsigned, b); }
#define WAIT_BAR(N) asm volatile("s_waitcnt vmcnt(" #N ") lgkmcnt(0)\n\ts_barrier" ::: "memory")

__device__ __forceinline__ void qkt(f32x16& p0, f32x16& p1, const char* Kslot, const bf16x8* qr, const f32x16& negm, int r32, int hi) {
    const char* kb = Kslot + hi * 1024 + r32 * 16;
#pragma unroll
    for (int d0 = 0; d0 < 4; ++d0) {
        const bf16x8 b0 = *reinterpret_cast<const bf16x8*>(kb + d0 * 2048);
        const bf16x8 b1 = *reinterpret_cast<const bf16x8*>(kb + d0 * 2048 + 512);
        if (d0 == 0) { p0 = __builtin_amdgcn_mfma_f32_32x32x16_bf16(b0, qr[0], negm, 0, 0, 0); p1 = __builtin_amdgcn_mfma_f32_32x32x16_bf16(b1, qr[0], negm, 0, 0, 0); }
        else { p0 = __builtin_amdgcn_mfma_f32_32x32x16_bf16(b0, qr[d0], p0, 0, 0, 0); p1 = __builtin_amdgcn_mfma_f32_32x32x16_bf16(b1, qr[d0], p1, 0, 0, 0); } }
}
typedef __attribute__((address_space(3))) const char* lds_cptr;
typedef short v4i16_t __attribute__((ext_vector_type(4)));
__device__ __forceinline__ void kload8(bf16x8* kf, lds_cptr kp) {
    kf[0] = *(const __attribute__((address_space(3))) bf16x8*)(kp);        kf[1] = *(const __attribute__((address_space(3))) bf16x8*)(kp + 512);
    kf[2] = *(const __attribute__((address_space(3))) bf16x8*)(kp + 2048); kf[3] = *(const __attribute__((address_space(3))) bf16x8*)(kp + 2560);
    kf[4] = *(const __attribute__((address_space(3))) bf16x8*)(kp + 4096); kf[5] = *(const __attribute__((address_space(3))) bf16x8*)(kp + 4608);
    kf[6] = *(const __attribute__((address_space(3))) bf16x8*)(kp + 6144); kf[7] = *(const __attribute__((address_space(3))) bf16x8*)(kp + 6656);
}
__device__ __forceinline__ void kload2(bf16x8* kf, lds_cptr kp, int j) { kf[2 * j] = *(const __attribute__((address_space(3))) bf16x8*)(kp + j * 2048); kf[2 * j + 1] = *(const __attribute__((address_space(3))) bf16x8*)(kp + j * 2048 + 512); }
__device__ __forceinline__ s16x4 vtr(lds_cptr p) { return __builtin_bit_cast(s16x4, __builtin_amdgcn_ds_read_tr16_b64_v4i16((__attribute__((address_space(3))) v4i16_t*)p)); }
__device__ __forceinline__ float rowmax(const f32x16& p0, const f32x16& p1) {
    float a = max3f(p0[0], p0[1], p1[0]), b = max3f(p0[2], p0[3], p1[1]); a = max3f(a, p1[2], p1[3]);
#pragma unroll
    for (int r = 4; r < 16; r += 4) { a = max3f(a, p0[r], p0[r + 1]); b = max3f(b, p0[r + 2], p0[r + 3]); a = max3f(a, p1[r], p1[r + 1]); b = max3f(b, p1[r + 2], p1[r + 3]); }
    const float m = max2f(a, b);
    auto rr = __builtin_amdgcn_permlane32_swap(__float_as_uint(m), __float_as_uint(m), false, false);
    return max2f(__uint_as_float(rr[0]), __uint_as_float(rr[1]));
}
__device__ __forceinline__ void pv(f32x16* o, int vb, bf16x8 pa0, bf16x8 pa1, bf16x8 pa2, bf16x8 pa3) {
#pragma unroll
    for (int d0 = 0; d0 < 2; ++d0) { s16x4 lo[4], hi[4];
#pragma unroll
        for (int ks = 0; ks < 4; ++ks) {
            asm volatile("ds_read_b64_tr_b16 %0,%1 offset:%c2" : "=&v"(lo[ks]) : "v"(vb), "i"(d0 * 4096 + ks * 1024) : "memory");
            asm volatile("ds_read_b64_tr_b16 %0,%1 offset:%c2" : "=&v"(hi[ks]) : "v"(vb), "i"(d0 * 4096 + ks * 1024 + 512) : "memory"); }
        asm volatile("s_waitcnt lgkmcnt(0)" ::: "memory"); SBAR();
#define PK(k) (bf16x8){lo[k][0], lo[k][1], lo[k][2], lo[k][3], hi[k][0], hi[k][1], hi[k][2], hi[k][3]}
        o[d0] = __builtin_amdgcn_mfma_f32_32x32x16_bf16(pa0, PK(0), o[d0], 0, 0, 0);
        o[d0] = __builtin_amdgcn_mfma_f32_32x32x16_bf16(pa1, PK(1), o[d0], 0, 0, 0);
        o[d0] = __builtin_amdgcn_mfma_f32_32x32x16_bf16(pa2, PK(2), o[d0], 0, 0, 0);
        o[d0] = __builtin_amdgcn_mfma_f32_32x32x16_bf16(pa3, PK(3), o[d0], 0, 0, 0);
#undef PK
    }
}
template <int THRL, bool WMASK> __device__ __forceinline__ void attn_unit(const bf16* Qw0, const bf16* __restrict__ Kc, const bf16* __restrict__ Vc, long dlat, int NT, int kd0,
                                                                         bool has_sink, float sinkl2, bf16* Ow0, char* shm, int wid) {
    const int lane = lane_fresh(), r32 = lane & 31, hi = lane >> 5;
    const bf16* Qw = Qw0 + (long)(wid * QBLK) * ZP;
    const unsigned lds0 = (unsigned)(uintptr_t)shm;
    float* wsf = (float*)(shm + LDS_WS) + wid * 64;
    const bf16* ksrc = Kc + (long)lane * ZP + wid * 8;
    const bf16* vsrc = Vc + (long)(16 * (wid & 3) + (lane >> 2)) * ZP + (wid >> 2) * 32 + (lane & 3) * 8;
    const unsigned kdst = lds0 + LDS_K + wid * 1024, vdst = lds0 + LDS_V + wid * 1024;
#define TOFF(t) (((t) < 4) ? (long)(t) * (KVBLK * ZP) : dlat + (long)((t) - 4) * (KVBLK * ZP))
#define DMA_K(t, slot) glds16(ksrc + TOFF(t), (unsigned)__builtin_amdgcn_readfirstlane(kdst + (slot)))
#define DMA_V(t, slot) glds16(vsrc + TOFF(t), (unsigned)__builtin_amdgcn_readfirstlane(vdst + (slot)))
    const int vb0 = (int)(lds0 + LDS_V) + ((lane >> 4) & 1) * 32 + (lane & 3) * 8 + (4 * hi + ((lane & 15) >> 2)) * 64;
    const char* Kbase = shm + LDS_K; bf16x8 kf[8];
    const lds_cptr shm3 = (lds_cptr)shm; const lds_cptr kp0 = shm3 + LDS_K + hi * 1024 + r32 * 16; const lds_cptr vp0 = shm3 + LDS_V + ((lane >> 4) & 1) * 32 + (lane & 3) * 8 + (4 * hi + ((lane & 15) >> 2)) * 64;
    DMA_K(0, 0); DMA_V(0, 0); DMA_K(1, SLOTB);
    bf16x8 qr[4];
#pragma unroll
    for (int d0 = 0; d0 < 4; ++d0) qr[d0] = *reinterpret_cast<const bf16x8*>(&Qw[(long)r32 * ZP + d0 * 16 + hi * 8]);
    float mhat = 0.f, l_reg = 0.f; f32x16 o[2]; f32x16 negm;
    { float zz = 0.f; asm volatile("" : "+v"(zz));
      _Pragma("unroll") for (int r = 0; r < 16; ++r) { o[0][r] = zz; o[1][r] = zz; negm[r] = zz; } }
    asm volatile("" : "+v"(negm));
    const int qrel = wid * QBLK + r32;
#define CMASK(P0, P1, t) do { if constexpr (WMASK) { if ((t) >= 4) wmask(P0, P1, kd0 + ((t) - 4) * KVBLK - qrel + 4 * hi); } } while (0)
    bool resc = false;
#define START(P0, P1) do { const float rm = rowmax(P0, P1); resc = false; \
    { const float dl = rm; mhat = fadd_s(mhat, dl); \
      _Pragma("unroll") for (int r = 0; r < 16; ++r) { P0[r] = fsub_s(P0[r], dl); P1[r] = fsub_s(P1[r], dl); } \
      _Pragma("unroll") for (int r = 0; r < 16; ++r) negm[r] = -mhat; asm volatile("" : "+v"(negm)); } \
    _Pragma("unroll") for (int r = 0; r < 16; ++r) P0[r] = __builtin_amdgcn_exp2f(P0[r]); } while (0)
#define RESC() do { if (resc) { asm volatile("s_waitcnt lgkmcnt(0)" ::: "memory"); \
      _Pragma("unroll") for (int d_ = 0; d_ < 2; ++d_) _Pragma("unroll") for (int r = 0; r < 16; ++r) o[d_][r] *= wsf[crow(r, hi)]; } } while (0)
    f32x16 pA0, pA1, pB0, pB1;
    int sl_prev = 0, sl_cur = 0, sl_next = SLOTB;
#define ROT() do { sl_prev = sl_cur; sl_cur = sl_next; sl_next = (sl_next == (NSLOT - 1) * SLOTB) ? 0 : sl_next + SLOTB; } while (0)
    DMA_K(2, 2 * SLOTB);
    WAIT_BAR(3);
    qkt(pA0, pA1, Kbase, qr, negm, r32, hi); asm volatile("s_nop 15\n\ts_nop 7" : "+v"(pA0), "+v"(pA1));
    START(pA0, pA1);
    _Pragma("unroll") for (int r = 0; r < 16; ++r) pA1[r] = __builtin_amdgcn_exp2f(pA1[r]);
    WAIT_BAR(0);
    DMA_K(3, 0); DMA_V(1, SLOTB);
    ROT();
    kload8(kf, kp0 + sl_cur);
    WAIT_BAR(2);
    s16x4 vlo[8], vhi[8]; u32x4 pw0, pw1, pw2, pw3;
#define PKW(P, B) cvtpk_s(P[B], P[B + 1])
#define PAF(k) __builtin_bit_cast(bf16x8, pw##k)
#define VFR(i) (bf16x8){vlo[i][0], vlo[i][1], vlo[i][2], vlo[i][3], vhi[i][0], vhi[i][1], vhi[i][2], vhi[i][3]}
#define PIN(x) asm volatile("" : "+v"(x))
#define MX3(a, b, c) __builtin_fmaxf(__builtin_fmaxf((a), (b)), (c))
#define GAPA(MF, A0, A1, A2, A3, W0, W1, PW) do { MF; sacc += A0; sacc += A1; sacc += A2; sacc += A3; PIN(sacc); W0; W1; PIN(PW); SBAR(); } while (0)
#define EX(v) __builtin_amdgcn_exp2f(v)
#define GAPB(MF, X, B) do { MF; X[B] = EX(X[B]); X[B + 1] = EX(X[B + 1]); X[B + 2] = EX(X[B + 2]); X[B + 3] = EX(X[B + 3]); PIN(X); SBAR(); } while (0)
#define VRD(i) do { vlo[i] = vtr(vp_ + (((i) >> 2) * 4096 + ((i) & 3) * 1024)); vhi[i] = vtr(vp_ + (((i) >> 2) * 4096 + ((i) & 3) * 1024 + 512)); } while (0)
#define KRD(G, j) do { if (G) { kload2(kf, kp0 + sl_next, j); SBAR(); } } while (0)
#define STEP(C0, C1, P0, P1, t, GK, GV, GL) do { SBAR(); \
    const lds_cptr vp_ = vp0 + sl_prev; \
    VRD(0); SBAR(); float sacc = (P0[0] + P0[1]); \
    GAPA(C0 = __builtin_amdgcn_mfma_f32_32x32x16_bf16(kf[0], qr[0], negm, 0, 0, 0), P0[2], P0[3], P0[4], P0[5],     pw0[0] = PKW(P0, 0), pw0[1] = PKW(P0, 2), pw0); \
    VRD(4); SBAR(); GAPA(C1 = __builtin_amdgcn_mfma_f32_32x32x16_bf16(kf[1], qr[0], negm, 0, 0, 0), P0[6], P0[7], P0[8], P0[9],     pw0[2] = PKW(P0, 4), pw0[3] = PKW(P0, 6), pw0); \
    VRD(1); SBAR(); GAPA(C0 = __builtin_amdgcn_mfma_f32_32x32x16_bf16(kf[2], qr[1], C0, 0, 0, 0),   P0[10], P0[11], P0[12], P0[13], pw1[0] = PKW(P0, 8), pw1[1] = PKW(P0, 10), pw1); \
    VRD(5); SBAR(); GAPA(C1 = __builtin_amdgcn_mfma_f32_32x32x16_bf16(kf[3], qr[1], C1, 0, 0, 0),   P0[14], P0[15], P1[0], P1[1],   pw1[2] = PKW(P0, 12), pw1[3] = PKW(P0, 14), pw1); \
    VRD(2); SBAR(); GAPA(C0 = __builtin_amdgcn_mfma_f32_32x32x16_bf16(kf[4], qr[2], C0, 0, 0, 0),   P1[2], P1[3], P1[4], P1[5],     pw2[0] = PKW(P1, 0), pw2[1] = PKW(P1, 2), pw2); \
    VRD(6); SBAR(); GAPA(C1 = __builtin_amdgcn_mfma_f32_32x32x16_bf16(kf[5], qr[2], C1, 0, 0, 0),   P1[6], P1[7], P1[8], P1[9],     pw2[2] = PKW(P1, 4), pw2[3] = PKW(P1, 6), pw2); \
    VRD(3); SBAR(); GAPA(C0 = __builtin_amdgcn_mfma_f32_32x32x16_bf16(kf[6], qr[3], C0, 0, 0, 0),   P1[10], P1[11], P1[12], P1[13], pw3[0] = PKW(P1, 8), pw3[1] = PKW(P1, 10), pw3); \
    VRD(7); SBAR(); GAPA(C1 = __builtin_amdgcn_mfma_f32_32x32x16_bf16(kf[7], qr[3], C1, 0, 0, 0),   P1[14], P1[15], 0.f, 0.f,       pw3[2] = PKW(P1, 12), pw3[3] = PKW(P1, 14), pw3); \
    l_reg += sacc; \
    if (GK) { DMA_K((t) + 3, sl_cur); } if (GV) { DMA_V((t) + 1, sl_next); } \
    CMASK(C0, C1, t); \
    { float a = MX3(C0[0], C0[1], C1[0]), b = MX3(C0[2], C0[3], C1[1]); a = MX3(a, C1[2], C1[3]); \
      _Pragma("unroll") for (int r = 4; r < 16; r += 4) { a = MX3(a, C0[r], C0[r + 1]); b = MX3(b, C0[r + 2], C0[r + 3]); a = MX3(a, C1[r], C1[r + 1]); b = MX3(b, C1[r + 2], C1[r + 3]); } \
      float rm = __builtin_fmaxf(a, b); { auto rr = __builtin_amdgcn_permlane32_swap(__float_as_uint(rm), __float_as_uint(rm), false, false); rm = __builtin_fmaxf(__uint_as_float(rr[0]), __uint_as_float(rr[1])); } \
      resc = false; \
      if (__builtin_expect(__any(rm > (float)THRL), 0)) { const float dl = __builtin_fmaxf(rm, 0.f); mhat += dl; \
        _Pragma("unroll") for (int r = 0; r < 16; ++r) { C0[r] -= dl; C1[r] -= dl; } \
        _Pragma("unroll") for (int r = 0; r < 16; ++r) negm[r] = -mhat; asm volatile("" : "+v"(negm)); \
        const float f = __builtin_amdgcn_exp2f(-dl); l_reg *= f; if (hi == 0) wsf[r32] = f; resc = true; } } \
    SBAR(); \
    GAPB(o[0] = __builtin_amdgcn_mfma_f32_32x32x16_bf16(PAF(0), VFR(0), o[0], 0, 0, 0), C0, 0); \
    GAPB(o[1] = __builtin_amdgcn_mfma_f32_32x32x16_bf16(PAF(0), VFR(4), o[1], 0, 0, 0), C0, 4); \
    KRD(GL, 0); GAPB(o[0] = __builtin_amdgcn_mfma_f32_32x32x16_bf16(PAF(1), VFR(1), o[0], 0, 0, 0), C0, 8); \
    KRD(GL, 1); GAPB(o[1] = __builtin_amdgcn_mfma_f32_32x32x16_bf16(PAF(1), VFR(5), o[1], 0, 0, 0), C0, 12); \
    KRD(GL, 2); GAPB(o[0] = __builtin_amdgcn_mfma_f32_32x32x16_bf16(PAF(2), VFR(2), o[0], 0, 0, 0), C1, 0); \
    KRD(GL, 3); GAPB(o[1] = __builtin_amdgcn_mfma_f32_32x32x16_bf16(PAF(2), VFR(6), o[1], 0, 0, 0), C1, 4); \
    GAPB(o[0] = __builtin_amdgcn_mfma_f32_32x32x16_bf16(PAF(3), VFR(3), o[0], 0, 0, 0), C1, 8); \
    GAPB(o[1] = __builtin_amdgcn_mfma_f32_32x32x16_bf16(PAF(3), VFR(7), o[1], 0, 0, 0), C1, 12); \
    } while (0)
    int t = 1;
    for (; t + 5 < NT; t += 2) {
        STEP(pB0, pB1, pA0, pA1, t, true, true, true);     WAIT_BAR(2); RESC(); ROT();
        STEP(pA0, pA1, pB0, pB1, t + 1, true, true, true); WAIT_BAR(2); RESC(); ROT();
    }
#define ENDW(tt) do { if ((tt) + 3 < NT) { WAIT_BAR(2); } else if ((tt) + 2 < NT) { WAIT_BAR(1); } else { WAIT_BAR(0); } } while (0)
    for (; t + 1 < NT; t += 2) {
        STEP(pB0, pB1, pA0, pA1, t, (t + 3 < NT), (t + 1 < NT), (t + 1 < NT));         ENDW(t);     RESC(); ROT();
        STEP(pA0, pA1, pB0, pB1, t + 1, (t + 4 < NT), (t + 2 < NT), (t + 2 < NT));     ENDW(t + 1); RESC(); ROT();
    }
    STEP(pB0, pB1, pA0, pA1, NT - 1, false, false, false); RESC();
    { float sacc = pB0[0] + pB0[1]; _Pragma("unroll") for (int r = 2; r < 16; ++r) sacc += pB0[r]; _Pragma("unroll") for (int r = 0; r < 16; ++r) sacc += pB1[r]; l_reg += sacc;
      pw0 = (u32x4){PKW(pB0, 0), PKW(pB0, 2), PKW(pB0, 4), PKW(pB0, 6)}; pw1 = (u32x4){PKW(pB0, 8), PKW(pB0, 10), PKW(pB0, 12), PKW(pB0, 14)}; pw2 = (u32x4){PKW(pB1, 0), PKW(pB1, 2), PKW(pB1, 4), PKW(pB1, 6)}; pw3 = (u32x4){PKW(pB1, 8), PKW(pB1, 10), PKW(pB1, 12), PKW(pB1, 14)};
      SBAR(); pv(o, vb0 + sl_cur, PAF(0), PAF(1), PAF(2), PAF(3)); }
#undef PKW
#undef PAF
#undef VFR
#undef PIN
#undef MX3
#undef GAPA
#undef GAPB
#undef EX
#undef VRD
#undef KRD
#undef STEP
#undef ENDW
    { auto rr = __builtin_amdgcn_permlane32_swap(__float_as_uint(l_reg), __float_as_uint(l_reg), false, false); l_reg = __uint_as_float(rr[0]) + __uint_as_float(rr[1]); }
    if (has_sink) l_reg += __builtin_amdgcn_exp2f(sinkl2 - mhat);
    if (hi == 0) wsf[32 + r32] = l_reg; asm volatile("s_waitcnt lgkmcnt(0)" ::: "memory");
    float rli[16];
#pragma unroll
    for (int r = 0; r < 16; ++r) rli[r] = __builtin_amdgcn_rcpf(wsf[32 + crow(r, hi)]);
    bf16* Ow = Ow0 + (long)(wid * QBLK) * YP;
    { bf16* stg = (bf16*)(shm + LDS_OST) + wid * 2048;
#pragma unroll
      for (int r = 0; r < 16; ++r) { const int orow = crow(r, hi);
#pragma unroll
        for (int d0 = 0; d0 < 2; ++d0) stg[orow * 64 + d0 * 32 + r32] = __float2bfloat16(o[d0][r] * rli[r]); }
      asm volatile("s_waitcnt lgkmcnt(0)" ::: "memory");
#pragma unroll
      for (int i = 0; i < 4; ++i) { const int row = i * 8 + (lane >> 3), ch = lane & 7; const u32x4 v = *(const u32x4*)(stg + row * 64 + ch * 8); *(u32x4*)(Ow + (long)row * YP + ch * 8) = v; } }
    asm volatile("s_waitcnt lgkmcnt(0)\n\ts_barrier" ::: "memory");
#undef DMA_K
#undef DMA_V
#undef TOFF
#undef CMASK
#undef START
#undef RESC
#undef ROT
}
constexpr int ATTN_LDS_BYTES = LDS_BYTES;
#undef SBAR
#undef WAIT_BAR
}

constexpr int NWAVES = 8, NTHREADS = NWAVES * 64;
constexpr int RING_BYTES = 131072, LDS_BYTES = 147456;
constexpr int LDSCTL_OFF = RING_BYTES, MISC_OFF = LDSCTL_OFF + 320;
#define LAS __attribute__((address_space(3)))
typedef unsigned short bf16;
typedef unsigned v4u __attribute__((ext_vector_type(4)));
typedef unsigned v2u __attribute__((ext_vector_type(2)));
typedef float f32x4 __attribute__((ext_vector_type(4)));
using pg8::cvt_pk_bf16; using pg8::bf_lo; using pg8::bf_hi;

constexpr size_t MiB = 1u << 20;
constexpr size_t WS_MOD = 0;
constexpr size_t WS_CTL = 1 * MiB, CTL_ZERO_BYTES = 16384;
constexpr size_t WS_W = 2 * MiB;
constexpr size_t LW_IN = 0;
constexpr size_t LW_POOL = LW_IN + (size_t)5120 * 1024 * 2;
constexpr size_t LW_BR = LW_POOL + (size_t)512 * 256 * 2;
constexpr size_t LW_OUT = LW_BR + (size_t)3072 * 512 * 2;
constexpr size_t LW_FF = LW_OUT + (size_t)1024 * 1024 * 2;
constexpr size_t LW_DN = LW_FF + (size_t)5632 * 1024 * 2;
constexpr size_t LW_BYTES = LW_DN + (size_t)1024 * 2816 * 2;
constexpr size_t WS_XC = WS_W + ((2 * LW_BYTES + MiB - 1) / MiB) * MiB;
constexpr size_t WS_ARENA = WS_XC + (size_t)NCTX * 1024 * 4;
constexpr size_t AR_Z = 0, AR_G = (size_t)NTOK * ZP * 2, AR_Y = AR_G + (size_t)NTOK * GP * 2, AR_H = AR_Y;
constexpr size_t AR_MRG = AR_Z;
constexpr size_t AR_U = 0, AR_SIDE = (size_t)NTOK * FF * 2, SIDE_BYTES = (size_t)(NTOK / 32) * FF * 4, AR_H2 = (size_t)NTOK * AVP * 2;
static_assert(AR_SIDE + 3 * SIDE_BYTES <= AR_H2, "side buffers");
constexpr size_t WS_END = WS_ARENA + (size_t)NTOK * 6656 * 2;
static_assert(AR_Y + (size_t)NTOK * YP * 2 == (size_t)NTOK * 6656 * 2 && AR_H2 + (size_t)NTOK * 1024 * 2 == (size_t)NTOK * 6656 * 2, "arena views");


#define XB_TMO      128
#define XB_XCNT(j)  (256  + 64 * (j))
#define XB_XSUB(j)  (1280 + 64 * (j))
#define XB_XGEN(j)  (2304 + 64 * (j))
#define XB_TOP      3328
#define XB_TOPGEN   3392
#define XCD_BAR_WORDS 3456
#define XB_SPIN_CAP (1u << 20)
__device__ __forceinline__ unsigned xb_ld(unsigned* p)              { return __hip_atomic_load(p, __ATOMIC_RELAXED, __HIP_MEMORY_SCOPE_AGENT); }
__device__ __forceinline__ unsigned xb_add(unsigned* p, unsigned v) { return __hip_atomic_fetch_add(p, v, __ATOMIC_RELAXED, __HIP_MEMORY_SCOPE_AGENT); }
__device__ __forceinline__ unsigned xb_xcc_id() { return (unsigned)__builtin_amdgcn_s_getreg((3 << 11) | 20) & 0xFu; }
#define XB_SPIN(cond, bar) do { unsigned _sp = 0; while (cond) { __builtin_amdgcn_s_sleep(1); \
    if ((++_sp & 255u) == 0u) { if (xb_ld(&(bar)[XB_TMO])) break; if (_sp > XB_SPIN_CAP) { atomicAdd(&(bar)[XB_TMO], 1u); break; } } } } while (0)
struct XcdBarrier { unsigned* bar; unsigned x; volatile LAS unsigned* st; };
__device__ __forceinline__ XcdBarrier xcd_barrier_post(unsigned* bar, volatile LAS unsigned* st) {
    XcdBarrier b; b.bar = bar; b.x = xb_xcc_id(); b.st = st;
    if (threadIdx.x == 0) (void)xb_add(&bar[XB_XCNT(b.x)], 1u);
    return b;
}
__device__ __forceinline__ void xcd_barrier_complete(unsigned* bar, unsigned x, unsigned& nloc, unsigned& nx) {
    const unsigned G = gridDim.x * gridDim.y * gridDim.z;
    unsigned sum, cnt, mine, sp = 0u;
    for (;;) {
        sum = 0u; cnt = 0u; mine = 0u;
#pragma unroll
        for (unsigned j = 0; j < 16; ++j) { const unsigned c = xb_ld(&bar[XB_XCNT(j)]); sum += c; cnt += (c > 0u) ? 1u : 0u; mine = (j == x) ? c : mine; }
        if (sum == G) break;
        __builtin_amdgcn_s_sleep(1);
        if ((++sp & 255u) == 0u) { if (xb_ld(&bar[XB_TMO])) break; if (sp > XB_SPIN_CAP) { atomicAdd(&bar[XB_TMO], 1u); break; } }
    }
    nloc = mine > 0u ? mine : 1u; nx = cnt > 0u ? cnt : 1u;
}
__device__ __forceinline__ void xcd_barrier(const XcdBarrier& b, int wave) {
    asm volatile("s_waitcnt vmcnt(0)" ::: "memory");
    __syncthreads();
    if (wave == 0 && lane_fresh() == 0) {
        unsigned* bar = b.bar;
        __builtin_amdgcn_s_waitcnt(0);
        unsigned nloc = b.st[0], nx = b.st[1];
        if (nloc == 0u) { xcd_barrier_complete(bar, b.x, nloc, nx); b.st[0] = nloc; b.st[1] = nx; }
        const unsigned old = xb_add(&bar[XB_XSUB(b.x)], 1u);
        const unsigned gen = old / nloc;
        if (old + 1u == (gen + 1u) * nloc) {
            __builtin_amdgcn_fence(__ATOMIC_RELEASE, "agent");
            asm volatile("s_waitcnt vmcnt(0)" ::: "memory");
            const unsigned og = xb_add(&bar[XB_TOP], 1u);
            const unsigned tg = og / nx;
            if (og + 1u == (tg + 1u) * nx) xb_add(&bar[XB_TOPGEN], 1u);
            else XB_SPIN(xb_ld(&bar[XB_TOPGEN]) == tg, bar);
            __builtin_amdgcn_fence(__ATOMIC_ACQUIRE, "agent");
            xb_add(&bar[XB_XGEN(b.x)], 1u);
            asm volatile("s_waitcnt vmcnt(0)" ::: "memory");
        } else {
            XB_SPIN(xb_ld(&bar[XB_XGEN(b.x)]) == gen, bar);
            __builtin_amdgcn_fence(__ATOMIC_ACQUIRE, "agent");
            asm volatile("s_waitcnt vmcnt(0)" ::: "memory");
        }
    }
    __syncthreads();
}

struct Args {
    const float *x, *c, *ctx, *c_ctx, *w_mod, *b_mod, *norm1_g, *norm2_g, *w_in, *w_pool_grp, *pool_scale, *win_sink, *q_norm_g, *k_norm_g,
                *w_branch, *w_gate, *b_gate, *w_out, *w_ff_gate, *w_ff_val, *conv_w, *conv_b, *w_ff_down, *final_g;
    float* out; unsigned char* ws; int ph_lo, ph_hi;
};

__device__ __forceinline__ float shx(float v, int lane, int m) { return __int_as_float(__builtin_amdgcn_ds_bpermute((lane ^ m) << 2, __float_as_int(v))); }
__device__ __forceinline__ float wave_sum(float v, int lane) {
#pragma unroll
    for (int o = 1; o < 64; o <<= 1) v += shx(v, lane, o);
    return v;
}
__device__ __forceinline__ void transpose_item(const float* W, int K, int N, bf16* WT, int ldw, int row_off, LAS float* scr, int item, int lane, bool spread = false) {
    const int nblk = N / 32, kb = item / nblk, nb = item % nblk, k0 = 64 * kb, n0 = 32 * nb;
    if (spread) row_off += 128 * (n0 >> 7);
#pragma unroll 8
    for (int i = 0; i < 32; ++i) { const int kk = 2 * i + (lane >> 5); scr[kk * 33 + (lane & 31)] = W[(size_t)(k0 + kk) * N + n0 + (lane & 31)]; }
    asm volatile("s_waitcnt lgkmcnt(0)" ::: "memory");
    const int c = lane & 7;
#pragma unroll
    for (int j = 0; j < 4; ++j) { const int n = (lane >> 3) + 8 * j; const LAS float* s = scr + (8 * c) * 33 + n;
        v4u o; o.x = cvt_pk_bf16(s[0 * 33], s[1 * 33]); o.y = cvt_pk_bf16(s[2 * 33], s[3 * 33]); o.z = cvt_pk_bf16(s[4 * 33], s[5 * 33]); o.w = cvt_pk_bf16(s[6 * 33], s[7 * 33]);
        *(v4u*)(WT + (size_t)(row_off + n0 + n) * ldw + k0 + 8 * c) = o; }
    asm volatile("s_waitcnt lgkmcnt(0)" ::: "memory");
}

__device__ __forceinline__ void prologue(const Args& A, LAS unsigned char* lds, int G, int vcu, int tid, int lane, int wave) {
    float* mod = (float*)(A.ws + WS_MOD);
    if ((int)blockIdx.x < 192) {
        LAS float* S = (LAS float*)lds; LAS float* part = (LAS float*)(lds + 17 * 1024 * 4);
        for (int idx = tid; idx < 17 * 1024; idx += NTHREADS) { const int r = idx >> 10, k = idx & 1023; const float v = (r < 16) ? A.c[r * 1024 + k] : A.c_ctx[k];
            S[idx] = v / (1.0f + __builtin_amdgcn_exp2f(-v * LOG2E)); }
        __syncthreads();
        for (int u = blockIdx.x; u < 192; u += G) {
            const int l = u / 96, n0 = (u % 96) * 64;
            float acc[17];
#pragma unroll
            for (int r = 0; r < 17; ++r) acc[r] = 0.f;
            const float* W = A.w_mod + (size_t)l * 1024 * 6144 + n0 + lane;
#pragma unroll 16
            for (int kk = 0; kk < 128; ++kk) { const int k = kk * 8 + wave; const float w = W[(size_t)k * 6144];
#pragma unroll
                for (int r = 0; r < 17; ++r) acc[r] += S[r * 1024 + k] * w; }
#pragma unroll
            for (int r = 0; r < 17; ++r) part[(wave * 17 + r) * 64 + lane] = acc[r];
            __syncthreads();
            for (int idx = tid; idx < 17 * 64; idx += NTHREADS) { const int r = idx >> 6, j = idx & 63; float s = 0.f;
#pragma unroll
                for (int w = 0; w < 8; ++w) s += part[(w * 17 + r) * 64 + j];
                mod[(size_t)(l * 17 + r) * 6144 + n0 + j] = s + A.b_mod[l * 6144 + n0 + j]; }
            __syncthreads();
        }
    }
    __syncthreads();
    LAS float* scr = (LAS float*)(lds + wave * 16384);
    const int gw = vcu * NWAVES + wave, NGW = G * NWAVES;
    constexpr int I_IN = 16 * 64, I_GATE = 16 * 32, I_BR = 8 * 32, I_OUT = 16 * 32, I_FF = 16 * 88, I_DN = 44 * 32;
    constexpr int PER_LAYER = I_IN + 3 * I_GATE + 3 * I_BR + I_OUT + 2 * I_FF + I_DN;
    for (int it = gw; it < 2 * PER_LAYER; it += NGW) {
        const int l = it / PER_LAYER; int r = it % PER_LAYER;
        unsigned char* wl = A.ws + WS_W + (size_t)l * LW_BYTES;
        if (r < I_IN) { transpose_item(A.w_in + (size_t)l * 1024 * 2048, 1024, 2048, (bf16*)(wl + LW_IN), 1024, 0, scr, r, lane); continue; } r -= I_IN;
        if (r < 3 * I_GATE) { const int i = r / I_GATE; transpose_item(A.w_gate + ((size_t)l * 3 + i) * 1024 * 1024, 1024, 1024, (bf16*)(wl + LW_IN), 1024, 2048 + i * 1024, scr, r % I_GATE, lane); continue; } r -= 3 * I_GATE;
        if (r < 3 * I_BR) { const int i = r / I_BR; transpose_item(A.w_branch + ((size_t)l * 3 + i) * 512 * 1024, 512, 1024, (bf16*)(wl + LW_BR), 512, i * 1024, scr, r % I_BR, lane); continue; } r -= 3 * I_BR;
        if (r < I_OUT) { transpose_item(A.w_out + (size_t)l * 1024 * 1024, 1024, 1024, (bf16*)(wl + LW_OUT), 1024, 0, scr, r, lane); continue; } r -= I_OUT;
        if (r < I_FF) { transpose_item(A.w_ff_gate + (size_t)l * 1024 * FF, 1024, FF, (bf16*)(wl + LW_FF), 1024, 0, scr, r, lane, true); continue; } r -= I_FF;
        if (r < I_FF) { transpose_item(A.w_ff_val + (size_t)l * 1024 * FF, 1024, FF, (bf16*)(wl + LW_FF), 1024, 128, scr, r, lane, true); continue; } r -= I_FF;
        transpose_item(A.w_ff_down + (size_t)l * FF * 1024, FF, 1024, (bf16*)(wl + LW_DN), FF, 0, scr, r, lane);
    }
    for (int idx = vcu * NTHREADS + tid; idx < 2 * 512 * 256; idx += G * NTHREADS) {
        const int l = idx / (512 * 256), e = idx % (512 * 256), n = e >> 8, k = e & 255, g = n >> 7, gk = 2 * (n >> 8) + (k >> 7);
        const float v = (gk == g) ? A.w_pool_grp[(((size_t)l * 4 + g) * 128 + (k & 127)) * 128 + (n & 127)] : 0.f;
        ((bf16*)(A.ws + WS_W + (size_t)l * LW_BYTES + LW_POOL))[e] = (bf16)(cvt_pk_bf16(v, 0.f) & 0xffffu);
    }
}

__device__ __forceinline__ void norm_rows(const float* xlat, const float* xctx, const float* gvec, const float* modl, int which, int nrows, bf16* H, int gw, int NGW) {
    const int lane = lane_fresh(); asm volatile("" : "+s"(gw));
    for (int row = gw; row < nrows; row += NGW) {
        const bool lat = row < NLAT;
        const float* src = lat ? xlat + (size_t)row * 1024 : xctx + (size_t)(row - NLAT) * 1024;
        const int b = lat ? (row >> 12) : NB;
        const float* shp = modl + (size_t)(b * 6 + which * 3) * 1024; const float* scp = shp + 1024;
        f32x4 v[4]; float ss = 0.f;
#pragma unroll
        for (int j = 0; j < 4; ++j) { v[j] = *(const f32x4*)(src + 4 * lane + 256 * j); ss += (v[j].x * v[j].x + v[j].y * v[j].y) + (v[j].z * v[j].z + v[j].w * v[j].w); }
        const float rstd = __builtin_amdgcn_rsqf(wave_sum(ss, lane) * (1.f / 1024.f) + EPS);
#pragma unroll
        for (int j = 0; j < 4; ++j) { const int c0 = 4 * lane + 256 * j;
            const f32x4 g = *(const f32x4*)(gvec + c0), sh = *(const f32x4*)(shp + c0), sc = *(const f32x4*)(scp + c0);
            const f32x4 y = (v[j] * rstd * g) * (sc + 1.0f) + sh;
            v2u w; w.x = cvt_pk_bf16(y.x, y.y); w.y = cvt_pk_bf16(y.z, y.w);
            *(v2u*)(H + (size_t)row * 1024 + c0) = w; }
    }
}
__device__ __forceinline__ void final_norm_rows(float* x, const float* gvec, int gw, int NGW) {
    const int lane = lane_fresh(); asm volatile("" : "+s"(gw));
    for (int row = gw; row < NLAT; row += NGW) {
        float* src = x + (size_t)row * 1024;
        f32x4 v[4]; float ss = 0.f;
#pragma unroll
        for (int j = 0; j < 4; ++j) { v[j] = *(const f32x4*)(src + 4 * lane + 256 * j); ss += (v[j].x * v[j].x + v[j].y * v[j].y) + (v[j].z * v[j].z + v[j].w * v[j].w); }
        const float rstd = __builtin_amdgcn_rsqf(wave_sum(ss, lane) * (1.f / 1024.f) + EPS);
#pragma unroll
        for (int j = 0; j < 4; ++j) { const int c0 = 4 * lane + 256 * j; const f32x4 g = *(const f32x4*)(gvec + c0); *(f32x4*)(src + c0) = v[j] * rstd * g; }
    }
}

__device__ __forceinline__ void unpack8(const v4u w, float* v) { v[0] = bf_lo(w.x); v[1] = bf_hi(w.x); v[2] = bf_lo(w.y); v[3] = bf_hi(w.y); v[4] = bf_lo(w.z); v[5] = bf_hi(w.z); v[6] = bf_lo(w.w); v[7] = bf_hi(w.w); }
__device__ __forceinline__ v4u pack8(const float* v) { v4u w; w.x = cvt_pk_bf16(v[0], v[1]); w.y = cvt_pk_bf16(v[2], v[3]); w.z = cvt_pk_bf16(v[4], v[5]); w.w = cvt_pk_bf16(v[6], v[7]); return w; }
__device__ __forceinline__ void qk_proc(float* v, bool do_norm, const float* g, bool do_rope, bool hi_half, const float* cs, const float* sn, float scale, int lane) {
    float ss = 0.f;
#pragma unroll
    for (int i = 0; i < 8; ++i) ss += v[i] * v[i];
    ss += shx(ss, lane, 1); ss += shx(ss, lane, 2); ss += shx(ss, lane, 4);
    const float rstd = __builtin_amdgcn_rsqf(ss * (1.f / 64.f) + EPS);
#pragma unroll
    for (int i = 0; i < 8; ++i) { const float nv = v[i] * rstd * g[i]; v[i] = do_norm ? nv : v[i]; }
#pragma unroll
    for (int i = 0; i < 8; ++i) { const float pvv = shx(v[i], lane, 2);
        const float rv = hi_half ? (v[i] * cs[i] + pvv * sn[i]) : (v[i] * cs[i] - pvv * sn[i]);
        v[i] = (do_rope ? rv : v[i]) * scale; }
}
__device__ __forceinline__ void elem_phase(const Args& A, int layer, int nrows, bf16* Z, bf16* Y, int gw, int NGW) {
    const int lane = lane_fresh(); asm volatile("" : "+s"(gw));
    const int j8 = lane & 7; const bool hi_half = (j8 >> 1) & 1; const int axis = j8 >> 2, fbase = (j8 & 1) * 8;
    float inv[8], qg[8], kg[8];
#pragma unroll
    for (int i = 0; i < 8; ++i) { inv[i] = __builtin_amdgcn_exp2f(-(float)(fbase + i) * (13.287712379549449f / 16.0f)) * 0.15915494309189535f;
        qg[i] = A.q_norm_g[layer * 64 + j8 * 8 + i]; kg[i] = A.k_norm_g[layer * 64 + j8 * 8 + i]; }
    for (int row = gw; row < nrows; row += NGW) {
        const bool lat = row < NLAT;
        const int t = lat ? (row & (SEQ - 1)) : ((row - NLAT) & (CTX - 1));
        const int L = lat ? SEQ : CTX;
        bf16* zrow = Z + (size_t)row * ZP;
        const int g = lane >> 4, w2 = 1 << g; int lo = t - w2; lo = lo < 0 ? 0 : lo; int hi = t + w2; hi = hi > L ? L : hi;
        const bf16* zc = Z + (size_t)(row - t) * ZP + lane * 8;
        const v4u zero = {0u, 0u, 0u, 0u};
        v4u pw[16];
#pragma unroll
        for (int jj = 0; jj < 16; ++jj) { const int r = lo + jj; pw[jj] = (r < hi) ? *(const v4u*)(zc + (size_t)r * ZP) : zero; }
        const v4u own_w = *(const v4u*)(zrow + lane * 8);
        const v4u wq_w = *(const v4u*)(zrow + 512 + lane * 8);
        const v4u gq_w = *(const v4u*)(zrow + 1280 + lane * 8);
        const int l5 = lane & 31; const bool isg = l5 >= 16; const int kcol = isg ? 1792 + (l5 - 16) * 8 : 1024 + l5 * 8;
        const v4u k_w = *(const v4u*)(zrow + kcol);
        float acc[8];
#pragma unroll
        for (int i = 0; i < 8; ++i) acc[i] = 0.f;
#pragma unroll
        for (int jj = 0; jj < 16; ++jj) { float u[8]; unpack8(pw[jj], u);
#pragma unroll
            for (int i = 0; i < 8; ++i) acc[i] += u[i]; }
        { float own[8]; unpack8(own_w, own); const float rc = 1.0f / (float)(hi - lo);
#pragma unroll
          for (int i = 0; i < 8; ++i) acc[i] = acc[i] * rc - own[i]; }
        float cs[8], sn[8];
        { const float pos = (float)(axis ? (t & 63) : (t >> 6));
#pragma unroll
          for (int i = 0; i < 8; ++i) { float r = pos * inv[i]; r = r - __builtin_floorf(r); cs[i] = __builtin_amdgcn_cosf(r); sn[i] = __builtin_amdgcn_sinf(r); } }
        float vq[8], vg[8], vk[8];
        unpack8(wq_w, vq); qk_proc(vq, false, qg, lat, hi_half, cs, sn, C2, lane);
        unpack8(gq_w, vg); qk_proc(vg, true, qg, lat, hi_half, cs, sn, C2, lane);
        unpack8(k_w, vk);  qk_proc(vk, isg, kg, lat, hi_half, cs, sn, 1.0f, lane);
        *(v4u*)(Y + (size_t)row * YP + lane * 8) = pack8(acc);
        *(v4u*)(zrow + 512 + lane * 8) = pack8(vq);
        *(v4u*)(zrow + 1280 + lane * 8) = pack8(vg);
        if (lane < 32) *(v4u*)(zrow + kcol) = pack8(vk);
    }
}

__device__ __forceinline__ void fixup_phase(const Args& A, int layer, int nrows, bf16* U, const float* As, const float* PAs, const float* Vs, int gbase, int NT) {
    const int gtid = gbase + lane_fresh();
    const int items = (nrows / 32) * 352;
    const float* cw = A.conv_w + (size_t)layer * 3 * FF;
    for (int it = gtid; it < items; it += NT) {
        const int c8 = it % 352, brow = it / 352, side = brow & 1, col = c8 * 8;
        const int r = (brow >> 1) * 64 + (side ? 63 : 0);
        const bool lat = r < NLAT; const int L = lat ? SEQ : CTX; const int t = lat ? (r & (SEQ - 1)) : ((r - NLAT) & (CTX - 1));
        const bool has = side ? (t != L - 1) : (t != 0);
        const int nb = has ? (side ? brow + 1 : brow - 1) : brow;
        const float* wp = cw + (side ? 2 * FF : 0) + col;
        const size_t so = (size_t)brow * FF + col, sn = (size_t)nb * FF + col;
        float o[8];
#pragma unroll
        for (int h = 0; h < 2; ++h) { const f32x4 pa = *(const f32x4*)(PAs + so + 4 * h), vv = *(const f32x4*)(Vs + so + 4 * h), an = *(const f32x4*)(As + sn + 4 * h), w = *(const f32x4*)(wp + 4 * h);
#pragma unroll
            for (int e = 0; e < 4; ++e) { const float pre = pa[e] + (has ? w[e] * an[e] : 0.f); o[4 * h + e] = pre * pg8::sigmoidf_(pre) * vv[e]; } }
        *(v4u*)(U + (size_t)r * FF + col) = pack8(o);
    }
}

__device__ __forceinline__ void attention_phase(const Args& A, int layer, bool last, bf16* Z, bf16* Y, char* shm, int G, int vcu, int wave) {
    using abf = attn_body::bf16;
    asm volatile("" : "+s"(vcu), "+s"(G));
    const float* sink = A.win_sink + layer * 8;
    const int NU = NB * 8 * 16, per = (NU + G - 1) / G;
    int u0 = vcu * per, u1 = u0 + per; if (u1 > NU) u1 = NU;
    for (int u = u0; u < u1; ++u) {
        const int qb = u & 15, h = (u >> 4) & 7, b = u >> 7, kvh = h >> 2;
        const size_t qrow = (size_t)b * SEQ + qb * 256, crow0 = (size_t)NLAT + (size_t)b * CTX;
        const abf* Q = (const abf*)Z + qrow * ZP + 1280 + h * 64;
        const abf* Kc = (const abf*)Z + crow0 * ZP + 1792 + kvh * 64; const abf* Vc = (const abf*)Z + crow0 * ZP + 1920 + kvh * 64;
        const long dlat = ((long)b * SEQ - (long)crow0) * ZP;
        attn_body::attn_unit<8, false>(Q, Kc, Vc, dlat, 68, 0, false, 0.f, (abf*)Y + qrow * YP + 1024 + h * 64, shm, wave);
    }
    for (int u = u0; u < u1; ++u) {
        const int qb = u & 15, h = (u >> 4) & 7, b = u >> 7, kvh = h >> 2;
        const size_t qrow = (size_t)b * SEQ + qb * 256, crow0 = (size_t)NLAT + (size_t)b * CTX;
        int tl0 = 4 * qb - 2; tl0 = tl0 < 0 ? 0 : tl0; int tl1 = 4 * qb + 6; tl1 = tl1 > 64 ? 64 : tl1;
        const abf* Q = (const abf*)Z + qrow * ZP + 512 + h * 64;
        const abf* Kc = (const abf*)Z + crow0 * ZP + 1024 + kvh * 64; const abf* Vc = (const abf*)Z + crow0 * ZP + 1152 + kvh * 64;
        const long dlat = ((long)b * SEQ + tl0 * 64 - (long)crow0) * ZP;
        attn_body::attn_unit<8, true>(Q, Kc, Vc, dlat, 4 + (tl1 - tl0), tl0 * 64 - qb * 256, true, sink[h] * LOG2E, (abf*)Y + qrow * YP + 512 + h * 64, shm, wave);
    }
    if (!last) {
        const int NUC = 2 * NB * 8;
        for (int u = vcu; u < NUC; u += G) {
            const int mixer = u & 1, h = (u >> 1) & 7, b = u >> 4, kvh = h >> 2;
            const size_t crow0 = (size_t)NLAT + (size_t)b * CTX;
            const int qc = mixer ? 1280 : 512, kc = mixer ? 1792 : 1024, vc = mixer ? 1920 : 1152, oc = mixer ? 1024 : 512;
            attn_body::attn_unit<8, false>((const abf*)Z + crow0 * ZP + qc + h * 64, (const abf*)Z + crow0 * ZP + kc + kvh * 64, (const abf*)Z + crow0 * ZP + vc + kvh * 64, 0, 4, 0,
                                           mixer == 0, sink[h] * LOG2E, (abf*)Y + crow0 * YP + oc + h * 64, shm, wave);
        }
    }
}

__global__ void __launch_bounds__(NTHREADS, 2) fwd_megakernel(Args A) {
    extern __shared__ __attribute__((aligned(16))) unsigned char lds_raw[];
    LAS unsigned char* lds = (LAS unsigned char*)lds_raw;
    const int wave = __builtin_amdgcn_readfirstlane(threadIdx.x >> 6);
    const int G = gridDim.x; const int bx = blockIdx.x; const int vcu = (G % 8 == 0) ? (bx % 8) * (G / 8) + bx / 8 : bx;
    const int gw = vcu * NWAVES + wave, NGW = G * NWAVES;
    const int lo = A.ph_lo, hi = A.ph_hi;
    int ph = 0;
#if MK_SPLIT
#define SEAM() do { ++ph; } while (0)
#else
    cg::grid_group grid = cg::this_grid();
    for (int u = threadIdx.x; u < (LDS_BYTES - LDSCTL_OFF) / 4; u += NTHREADS) ((LAS unsigned*)(lds + LDSCTL_OFF))[u] = 0u;
    __syncthreads();
    XcdBarrier bar = xcd_barrier_post((unsigned*)(A.ws + WS_CTL), (volatile LAS unsigned*)(lds + MISC_OFF) + 8);
#define SEAM() do { if (ph == 0) grid.sync(); else xcd_barrier(bar, wave); ++ph; } while (0)
#endif
#define IN() (lo <= ph && ph < hi)
    unsigned char* ws = A.ws;
    float* mod = (float*)(ws + WS_MOD);
    float* XC = (float*)(ws + WS_XC);
    unsigned char* ar = ws + WS_ARENA;
    bf16* Z = (bf16*)(ar + AR_Z); bf16* Gt = (bf16*)(ar + AR_G); bf16* Y = (bf16*)(ar + AR_Y); bf16* H = (bf16*)(ar + AR_H);
    bf16* Mrg = (bf16*)(ar + AR_MRG); bf16* U = (bf16*)(ar + AR_U); bf16* H2 = (bf16*)(ar + AR_H2);
    float* SAs = (float*)(ar + AR_SIDE); float* SPA = (float*)(ar + AR_SIDE + SIDE_BYTES); float* SVs = (float*)(ar + AR_SIDE + 2 * SIDE_BYTES);

    if (IN()) { const int lane = lane_fresh(); prologue(A, lds, G, vcu, wave * 64 + lane, lane, wave); }
    SEAM();
    for (int l = 0; l < 2; ++l) {
        const bool last = (l == 1);
        const int nrows_mix = NTOK, nrows_x = last ? NLAT : NTOK;
        const int nM_mix = nrows_mix / 256, nM_x = nrows_x / 256;
        const float* modl = mod + (size_t)l * 17 * 6144;
        const unsigned char* wl = ws + WS_W + (size_t)l * LW_BYTES;
        const float* xlat_in = (l == 0) ? A.x : A.out; const float* xctx_in = (l == 0) ? A.ctx : XC;
        if (IN()) for (int rep = 0; rep < ((DUP_MASK & 8) ? 2 : 1); ++rep) norm_rows(xlat_in, xctx_in, A.norm1_g + l * 1024, modl, 0, nrows_mix, H, gw, NGW);
        SEAM();
        if (IN()) for (int rep = 0; rep < ((DUP_MASK & 1) ? 2 : 1); ++rep) { pg8::Gemm g{H, (const bf16*)(wl + LW_IN), 1024, 1024, 1024, 0, 0}; pg8::Order S; S.init(nM_mix, 20, G, bx, 1, 0);
            pg8::EpiIn E{Z, Gt, A.b_gate + (size_t)l * 3072};
            pg8::gemm_phase<pg8::EpiIn, true>(lds, g, S, E, wave); }
        SEAM();
        if (IN()) elem_phase(A, l, nrows_mix, Z, Y, gw, NGW);
        SEAM();
        if (IN()) { for (int rep = 0; rep < ((DUP_MASK & 2) ? 2 : 1); ++rep) attention_phase(A, l, last, Z, Y, (char*)lds_raw, G, vcu, wave);
            pg8::Gemm g{Y, (const bf16*)(wl + LW_POOL), YP, 256, 256, 256, 0}; pg8::Order S; S.init(nM_x, 2, G, bx, 1, 1);
            pg8::EpiBf16 E{Y, YP, A.pool_scale + (size_t)l * 512};
            pg8::gemm_phase<pg8::EpiBf16, true>(lds, g, S, E, wave); }
        SEAM();
        if (IN()) for (int rep = 0; rep < ((DUP_MASK & 16) ? 2 : 1); ++rep) { pg8::Gemm g{Y, (const bf16*)(wl + LW_BR), YP, 512, 512, 512, (long)1024 * 512}; pg8::Order S; S.init(nM_x, 4, G, bx, 3, 2);
            pg8::EpiMerge E{Gt, Mrg};
            pg8::gemm_phase<pg8::EpiMerge, true>(lds, g, S, E, wave); }
        SEAM();
        if (IN()) { pg8::Gemm g{Mrg, (const bf16*)(wl + LW_OUT), 1024, 1024, 1024, 0, 0}; pg8::Order S; S.init(nM_x, 4, G, bx, 1, 0);
            pg8::EpiRes E{xlat_in, xctx_in, A.out, XC, modl, 2};
            pg8::gemm_phase<pg8::EpiRes, true>(lds, g, S, E, wave); }
        SEAM();
        if (IN()) for (int rep = 0; rep < ((DUP_MASK & 8) ? 2 : 1); ++rep) norm_rows(A.out, XC, A.norm2_g + l * 1024, modl, 1, nrows_x, H2, gw, NGW);
        SEAM();
        if (IN()) for (int rep = 0; rep < ((DUP_MASK & 4) ? 2 : 1); ++rep) { pg8::Gemm g{H2, (const bf16*)(wl + LW_FF), 1024, 1024, 1024, 0, 0}; pg8::Order S; S.init(nM_x, 22, G, bx, 1, 0);
            pg8::EpiFF E{U, A.conv_w + (size_t)l * 3 * FF, A.conv_b + (size_t)l * FF, SAs, SIDE_BYTES / 4};
            pg8::gemm_phase<pg8::EpiFF, true>(lds, g, S, E, wave); }
        SEAM();
        if (IN()) fixup_phase(A, l, nrows_x, U, SAs, SPA, SVs, vcu * NTHREADS + wave * 64, G * NTHREADS);
        SEAM();
        if (IN()) { pg8::Gemm g{U, (const bf16*)(wl + LW_DN), FF, FF, FF, 0, 0}; pg8::Order S; S.init(nM_x, 4, G, bx, 1, 0);
            pg8::EpiRes E{A.out, XC, A.out, XC, modl, 5};
            pg8::gemm_phase<pg8::EpiRes, true>(lds, g, S, E, wave); }
        SEAM();
    }
    if (IN()) final_norm_rows(A.out, A.final_g, gw, NGW);
#undef IN
#undef SEAM
}
constexpr int N_PHASES = 22;

extern "C" void kernel_launch(void* const* d_in, const int* in_sizes, int n_in, void* d_out, int out_size, void* d_ws, size_t ws_size, hipStream_t stream) {
    static int grid = 0;
    if (grid == 0) {
        if (n_in != 24 || out_size != NLAT * 1024 || ws_size < WS_END) { fprintf(stderr, "kernel_launch: unexpected shapes (n_in %d out %d ws %zu need %zu)\n", n_in, out_size, ws_size, (size_t)WS_END); grid = -1; return; }
        int dev = 0, cus = 0, per_cu = 0;
        hipGetDevice(&dev); hipDeviceGetAttribute(&cus, hipDeviceAttributeMultiprocessorCount, dev);
        if (hipFuncSetAttribute((const void*)fwd_megakernel, hipFuncAttributeMaxDynamicSharedMemorySize, LDS_BYTES) != hipSuccess) { fprintf(stderr, "kernel_launch: hipFuncSetAttribute failed\n"); grid = -1; return; }
        hipOccupancyMaxActiveBlocksPerMultiprocessor(&per_cu, (const void*)fwd_megakernel, NTHREADS, LDS_BYTES);
        (void)hipGetLastError();
        if (per_cu < 1) { fprintf(stderr, "kernel_launch: occupancy query says %d blocks per CU\n", per_cu); per_cu = 1; }
        grid = cus;
    }
    if (grid < 0) return;
    Args a{};
    const float** p = (const float**)&a;
    for (int i = 0; i < 24; ++i) p[i] = (const float*)d_in[i];
    a.out = (float*)d_out; a.ws = (unsigned char*)d_ws;
#if MK_SPLIT
    for (int ph = 0; ph < N_PHASES; ++ph) { a.ph_lo = ph; a.ph_hi = ph + 1; hipLaunchKernelGGL(fwd_megakernel, dim3(grid), dim3(NTHREADS), LDS_BYTES, stream, a); }
#else
    a.ph_lo = 0; a.ph_hi = N_PHASES;
    if (hipMemsetAsync((char*)d_ws + WS_CTL, 0, CTL_ZERO_BYTES, stream) != hipSuccess) { fprintf(stderr, "kernel_launch: memset failed\n"); return; }
    void* args[] = {&a};
    hipError_t e = hipLaunchCooperativeKernel((const void*)fwd_megakernel, dim3(grid), dim3(NTHREADS), args, LDS_BYTES, stream);
    if (e != hipSuccess) fprintf(stderr, "cooperative launch failed: %s (grid %d)\n", hipGetErrorString(e), grid);
#endif
}
```

```cpp
#include <hip/hip_runtime.h>
#include <hip/hip_cooperative_groups.h>
#include <hip/hip_bf16.h>
#include <cstdio>
#include <cstdint>
#include <cmath>
namespace cg = cooperative_groups;

#ifndef DUP_MASK
#define DUP_MASK 0
#endif
#ifndef MK_SPLIT
#define MK_SPLIT 0
#endif

constexpr int DM_ = 1024, NB = 16, SEQ = 4096, CTX = 256, NLAT = NB * SEQ, NCTX = NB * CTX, NTOK = NLAT + NCTX;
constexpr int ZP = 2048, GP = 3072, YP = 1536, FF = 2816, AVP = 2 * FF;
constexpr float EPS = 1e-6f;
constexpr float LOG2E = 1.4426950408889634f;
constexpr float C2 = 0.125f * LOG2E;

__device__ __forceinline__ int lane_fresh() { int l = (int)__builtin_amdgcn_mbcnt_hi(~0u, __builtin_amdgcn_mbcnt_lo(~0u, 0u)); asm volatile("" : "+v"(l)); return l; }

namespace pg8 {
#define PG8_LAS __attribute__((address_space(3)))
typedef unsigned short bf16_t;
typedef short bf16x8 __attribute__((ext_vector_type(8)));
typedef float f32x4 __attribute__((ext_vector_type(4)));
typedef unsigned u32x4 __attribute__((ext_vector_type(4)));
typedef unsigned u32x2 __attribute__((ext_vector_type(2)));
constexpr int BM = 256, BK = 64, HALF = 128, HTB = HALF * BK * 2, STAGE_BYTES = 8 * HTB, NXCD = 8, WGM = 8;

__host__ __device__ __forceinline__ int lds_byte(int r, int c) { const int st = (r >> 4) * 2 + (c >> 5), rr = r & 15, cc = c & 31, ob = rr * 64 + cc * 2; return st * 1024 + (ob ^ (((ob >> 9) & 1) << 5)); }
__host__ __device__ __forceinline__ void stage_rc(int b, int& R, int& C) { const int st = b / 1024, sb = b % 1024, swz = sb ^ (((sb >> 9) & 1) << 5); R = (st >> 1) * 16 + swz / 64; C = (st & 1) * 32 + (swz % 64) / 2; }
__host__ __device__ __forceinline__ int perm32(int rho) { const int n = rho >> 4, i = rho & 15; return 8 * (i >> 2) + 4 * n + (i & 3); }

struct Unit { int pm, pn, g; };
struct Gemm { const bf16_t* A; const bf16_t* Bt; int lda, ldb, K; long a_goff, b_goff; };

struct Order {
    int nM, nN, nwg, G, c, sub, gmode;
    __device__ __forceinline__ void init(int nM_, int nN_, int G_, int c_, int sub_, int gmode_) { nM = nM_; nN = nN_; nwg = nM * nN; G = G_; c = c_; sub = sub_; gmode = gmode_; }
    __device__ __forceinline__ bool next(int i, Unit& u) const {
        const int ti = (sub == 1) ? i : i / sub;
        const long L = (long)ti * G + c; if (L >= nwg) return false;
        int wgid = (int)L; { const int q = nwg / NXCD, r = nwg % NXCD, xcd = wgid % NXCD, off = wgid / NXCD; wgid = (xcd < r ? xcd * (q + 1) : r * (q + 1) + (xcd - r) * q) + off; }
        const int nig = WGM * nN, gid = wgid / nig, fm = gid * WGM, gsz = (nM - fm) < WGM ? (nM - fm) : WGM;
        u.pm = fm + ((wgid % nig) % gsz); u.pn = (wgid % nig) / gsz;
        u.g = (gmode == 0) ? 0 : ((gmode == 1) ? u.pn : (i - ti * sub));
        return true;
    }
};

typedef float f32x2_t __attribute__((ext_vector_type(2))); typedef __bf16 bf16x2_t __attribute__((ext_vector_type(2)));
__device__ __forceinline__ unsigned cvt_pk_bf16(float lo, float hi) { f32x2_t v = {lo, hi}; bf16x2_t b = __builtin_convertvector(v, bf16x2_t); return __builtin_bit_cast(unsigned, b); }
__device__ __forceinline__ float bf_lo(unsigned w) { return __uint_as_float(w << 16); }
__device__ __forceinline__ float bf_hi(unsigned w) { return __uint_as_float(w & 0xffff0000u); }
__device__ __forceinline__ float sigmoidf_(float x) { return __builtin_amdgcn_rcpf(1.0f + __builtin_amdgcn_exp2f(-x * 1.4426950408889634f)); }

struct EpiBf16 {
    static constexpr bool PERM = true;
    bf16_t* O; int ldc; const float* colscale;
    __device__ __forceinline__ void operator()(const f32x4 (&acc)[2][2][4][2], const Unit& u, int wr, int wc, int fr, int fq) const {
        int row0 = u.pm * BM + wr * 64 + fr; asm volatile("" : "+v"(row0)); const int col0 = u.pn * BM + wc * 32 + 8 * fq;
#pragma unroll
        for (int bj = 0; bj < 2; ++bj) {
            f32x4 s0 = (f32x4){1.f, 1.f, 1.f, 1.f}, s1 = s0;
            if (colscale) { s0 = *(const f32x4*)(colscale + col0 + bj * HALF); s1 = *(const f32x4*)(colscale + col0 + bj * HALF + 4); }
#pragma unroll
            for (int ai = 0; ai < 2; ++ai)
#pragma unroll
                for (int m = 0; m < 4; ++m) { bf16_t* rowp = O + (size_t)(row0 + ai * HALF + m * 16) * ldc + col0;
                    const f32x4 v0 = acc[ai][bj][m][0] * s0, v1 = acc[ai][bj][m][1] * s1;
                    u32x4 w; w.x = cvt_pk_bf16(v0[0], v0[1]); w.y = cvt_pk_bf16(v0[2], v0[3]); w.z = cvt_pk_bf16(v1[0], v1[1]); w.w = cvt_pk_bf16(v1[2], v1[3]);
                    *(u32x4*)(rowp + bj * HALF) = w; } }
    }
};
struct EpiIn {
    static constexpr bool PERM = true;
    bf16_t* Z; bf16_t* Gt; const float* bgate;
    __device__ __forceinline__ void operator()(const f32x4 (&acc)[2][2][4][2], const Unit& u, int wr, int wc, int fr, int fq) const {
        int row0 = u.pm * BM + wr * 64 + fr; asm volatile("" : "+v"(row0)); const bool isz = u.pn < 8;
        const int col0 = (isz ? u.pn * BM : (u.pn - 8) * BM) + wc * 32 + 8 * fq;
        bf16_t* base = isz ? Z : Gt; const int ldc = isz ? ZP : GP;
        f32x4 bv[2][2];
#pragma unroll
        for (int bj = 0; bj < 2; ++bj)
#pragma unroll
            for (int n = 0; n < 2; ++n) bv[bj][n] = isz ? (f32x4){0.f, 0.f, 0.f, 0.f} : *(const f32x4*)(bgate + col0 + bj * HALF + 4 * n);
#pragma unroll
        for (int ai = 0; ai < 2; ++ai)
#pragma unroll
            for (int m = 0; m < 4; ++m) { bf16_t* rowp = base + (size_t)(row0 + ai * HALF + m * 16) * ldc + col0;
#pragma unroll
                for (int bj = 0; bj < 2; ++bj) { f32x4 v0 = acc[ai][bj][m][0] + bv[bj][0], v1 = acc[ai][bj][m][1] + bv[bj][1];
                    if (!isz) {
#pragma unroll
                        for (int e = 0; e < 4; ++e) { v0[e] = sigmoidf_(v0[e]); v1[e] = sigmoidf_(v1[e]); } }
                    u32x4 w; w.x = cvt_pk_bf16(v0[0], v0[1]); w.y = cvt_pk_bf16(v0[2], v0[3]); w.z = cvt_pk_bf16(v1[0], v1[1]); w.w = cvt_pk_bf16(v1[2], v1[3]);
                    *(u32x4*)(rowp + bj * HALF) = w; } }
    }
};
struct EpiMerge {
    static constexpr bool PERM = true;
    const bf16_t* Gt; bf16_t* Mrg;
    __device__ __forceinline__ void operator()(const f32x4 (&acc)[2][2][4][2], const Unit& u, int wr, int wc, int fr, int fq) const {
        int row0 = u.pm * BM + wr * 64 + fr; asm volatile("" : "+v"(row0)); const int col0 = u.pn * BM + wc * 32 + 8 * fq;
#pragma unroll
        for (int ai = 0; ai < 2; ++ai)
#pragma unroll
            for (int m = 0; m < 4; ++m) { const size_t row = (size_t)(row0 + ai * HALF + m * 16);
#pragma unroll
                for (int bj = 0; bj < 2; ++bj) {
                    const u32x4 gw = *(const u32x4*)(Gt + row * GP + u.g * 1024 + col0 + bj * HALF);
                    bf16_t* mp = Mrg + row * 1024 + col0 + bj * HALF;
                    const f32x4 a0 = acc[ai][bj][m][0], a1 = acc[ai][bj][m][1];
                    float v[8];
                    v[0] = bf_lo(gw.x) * a0[0]; v[1] = bf_hi(gw.x) * a0[1]; v[2] = bf_lo(gw.y) * a0[2]; v[3] = bf_hi(gw.y) * a0[3];
                    v[4] = bf_lo(gw.z) * a1[0]; v[5] = bf_hi(gw.z) * a1[1]; v[6] = bf_lo(gw.w) * a1[2]; v[7] = bf_hi(gw.w) * a1[3];
                    if (u.g != 0) { const u32x4 ow = *(const u32x4*)mp;
                        v[0] += bf_lo(ow.x); v[1] += bf_hi(ow.x); v[2] += bf_lo(ow.y); v[3] += bf_hi(ow.y); v[4] += bf_lo(ow.z); v[5] += bf_hi(ow.z); v[6] += bf_lo(ow.w); v[7] += bf_hi(ow.w); }
                    u32x4 w; w.x = cvt_pk_bf16(v[0], v[1]); w.y = cvt_pk_bf16(v[2], v[3]); w.z = cvt_pk_bf16(v[4], v[5]); w.w = cvt_pk_bf16(v[6], v[7]);
                    *(u32x4*)mp = w; } }
    }
};
template <bool BASE_BF16, bool OUT_BF16> struct EpiRes {
    static constexpr bool PERM = false;
    const void* base_lat; const void* base_ctx; void* out_lat; void* out_ctx; const float* modl; int gate_idx;
    __device__ __forceinline__ void operator()(const f32x4 (&acc)[2][2][4][2], const Unit& u, int wr, int wc, int fr, int fq) const {
        const bool lat = u.pm < (NLAT / BM);
        const int prow = lat ? u.pm * BM : (u.pm * BM - NLAT);
        const void* base = lat ? base_lat : base_ctx; void* out = lat ? out_lat : out_ctx;
        const int b = lat ? (u.pm * BM) / SEQ : NB;
        int col0 = u.pn * BM + wc * 32 + 4 * fq; asm volatile("" : "+v"(col0));
        const float* gp = modl + (size_t)(b * 6 + gate_idx) * 1024 + col0;
        f32x4 gv[2][2];
#pragma unroll
        for (int bj = 0; bj < 2; ++bj)
#pragma unroll
            for (int n = 0; n < 2; ++n) gv[bj][n] = *(const f32x4*)(gp + bj * HALF + n * 16);
#pragma unroll
        for (int ai = 0; ai < 2; ++ai)
#pragma unroll
            for (int m = 0; m < 4; ++m) { const size_t off = (size_t)(prow + ai * HALF + wr * 64 + m * 16 + fr) * 1024 + col0;
#pragma unroll
                for (int bj = 0; bj < 2; ++bj)
#pragma unroll
                    for (int n = 0; n < 2; ++n) { const size_t o2 = off + bj * HALF + n * 16;
                        f32x4 bs;
                        if constexpr (BASE_BF16) { const u32x2 w = *(const u32x2*)((const bf16_t*)base + o2); bs = (f32x4){bf_lo(w.x), bf_hi(w.x), bf_lo(w.y), bf_hi(w.y)}; }
                        else bs = *(const f32x4*)((const float*)base + o2);
                        const f32x4 r = bs + gv[bj][n] * acc[ai][bj][m][n];
                        if constexpr (OUT_BF16) { u32x2 w; w.x = cvt_pk_bf16(r[0], r[1]); w.y = cvt_pk_bf16(r[2], r[3]); *(u32x2*)((bf16_t*)out + o2) = w; }
                        else *(f32x4*)((float*)out + o2) = r; } }
    }
};
struct EpiFF {
    static constexpr bool PERM = true;
    bf16_t* U; const float* cw; const float* cb; float* As; size_t side_elems;
    __device__ __forceinline__ void operator()(const f32x4 (&acc)[2][2][4][2], const Unit& u, int wr, int wc, int fr, int fq) const {
        const int lane = fq * 16 + fr; float* PAs = As + side_elems; float* Vs = PAs + side_elems;
        int ch0 = u.pn * 128 + wc * 32 + 8 * fq; asm volatile("" : "+v"(ch0));
        const int src_up = (lane & 48) | ((fr - 1) & 15), src_dn = (lane & 48) | ((fr + 1) & 15);
#pragma unroll
        for (int h = 0; h < 2; ++h) {
            const f32x4 w0 = *(const f32x4*)(cw + ch0 + 4 * h), w1 = *(const f32x4*)(cw + 2816 + ch0 + 4 * h), w2 = *(const f32x4*)(cw + 2 * 2816 + ch0 + 4 * h), bb = *(const f32x4*)(cb + ch0 + 4 * h);
#pragma unroll
            for (int ai = 0; ai < 2; ++ai) {
                const int rblk = u.pm * 4 + ai * 2 + wr;
                float o[4][4]; f32x4 pre0, pre3;
#pragma unroll
                for (int e = 0; e < 4; ++e) {
                    float a[4], ru[4], rd[4];
#pragma unroll
                    for (int m = 0; m < 4; ++m) { a[m] = acc[ai][0][m][h][e]; ru[m] = __int_as_float(__builtin_amdgcn_ds_bpermute(src_up << 2, __float_as_int(a[m]))); rd[m] = __int_as_float(__builtin_amdgcn_ds_bpermute(src_dn << 2, __float_as_int(a[m]))); }
#pragma unroll
                    for (int m = 0; m < 4; ++m) {
                        const float ap = (fr > 0) ? ru[m] : (m > 0 ? ru[m > 0 ? m - 1 : 0] : 0.f);
                        const float an = (fr < 15) ? rd[m] : (m < 3 ? rd[m < 3 ? m + 1 : 3] : 0.f);
                        const float pre = ap * w0[e] + a[m] * w1[e] + an * w2[e] + bb[e];
                        if (m == 0) pre0[e] = pre; if (m == 3) pre3[e] = pre;
                        o[m][e] = pre * sigmoidf_(pre) * acc[ai][1][m][h][e]; }
                    __builtin_amdgcn_sched_barrier(0); }
#pragma unroll
                for (int m = 0; m < 4; ++m) { u32x2 w; w.x = cvt_pk_bf16(o[m][0], o[m][1]); w.y = cvt_pk_bf16(o[m][2], o[m][3]);
                    *(u32x2*)(U + ((size_t)rblk * 64 + m * 16 + fr) * 2816 + ch0 + 4 * h) = w; }
                if (fr == 0) { const size_t so = (size_t)(2 * rblk) * 2816 + ch0 + 4 * h; *(f32x4*)(As + so) = acc[ai][0][0][h]; *(f32x4*)(Vs + so) = acc[ai][1][0][h]; *(f32x4*)(PAs + so) = pre0; }
                if (fr == 15) { const size_t so = (size_t)(2 * rblk + 1) * 2816 + ch0 + 4 * h; *(f32x4*)(As + so) = acc[ai][0][3][h]; *(f32x4*)(Vs + so) = acc[ai][1][3][h]; *(f32x4*)(PAs + so) = pre3; }
                __builtin_amdgcn_sched_barrier(0);
            }
        }
    }
};

template <class Epi, bool ALIGN_EPI>
__device__ __forceinline__ void gemm_phase(PG8_LAS unsigned char* lds, const Gemm g, const Order& S, const Epi& E, int wid) {
    const int lane = lane_fresh(), tid = wid * 64 + lane;
    const int wr = wid >> 2, wc = wid & 3, fr = lane & 15, fq = lane >> 4;
    const int K = g.K, nt = K / BK;
    unsigned voffA[2], voffB[2];
#pragma unroll
    for (int i = 0; i < 2; ++i) { int R, C; stage_rc(tid * 16 + i * 8192, R, C); const int Rb = Epi::PERM ? ((R & ~31) + perm32(R & 31)) : R;
        voffA[i] = (unsigned)(R * g.lda + C) * 2u; voffB[i] = (unsigned)(Rb * g.ldb + C) * 2u; }
    const size_t kstep = (size_t)(BK * 2);
    const size_t hstepA = (size_t)HALF * g.lda * 2, hstepB = (size_t)HALF * g.ldb * 2;
    const size_t tstepA = 2 * hstepA, tstepB = 2 * hstepB;
    const unsigned ldsw = (unsigned)wid * 1024u;
    const int aoff = lds_byte(wr * 64 + fr, fq * 8), boff = lds_byte(wc * 32 + fr, fq * 8);
#define PG8_UA(u) ((const char*)g.A + (size_t)(u).pm * tstepA + (size_t)((long)(u).g * g.a_goff * 2))
#define PG8_UB(u) ((const char*)g.Bt + (size_t)(u).pn * tstepB + (size_t)((long)(u).g * g.b_goff * 2))
#define PG8_SA(b, h) (((b) * 2 + (h)) * HTB)
#define PG8_SB(b, h) ((4 + (b) * 2 + (h)) * HTB)
#define PG8_STAGE(bufoff, gbase, voff) do { _Pragma("unroll") for (int _i = 0; _i < 2; ++_i) \
        __builtin_amdgcn_global_load_lds((const unsigned*)((const char*)(gbase) + (voff)[_i]), (PG8_LAS unsigned*)(lds + (bufoff) + ldsw + _i * 8192), 16, 0, 0); } while (0)
#define PG8_LDA(dst, b, h) do { _Pragma("unroll") for (int m = 0; m < 4; ++m) _Pragma("unroll") for (int k = 0; k < 2; ++k) dst[m][k] = *(const PG8_LAS bf16x8*)(lds + PG8_SA(b, h) + aoff + m * 2048 + k * 1024); } while (0)
#define PG8_LDB(dst, b, h) do { _Pragma("unroll") for (int n = 0; n < 2; ++n) _Pragma("unroll") for (int k = 0; k < 2; ++k) dst[n][k] = *(const PG8_LAS bf16x8*)(lds + PG8_SB(b, h) + boff + n * 2048 + k * 1024); } while (0)
#define PG8_MMA(ai, bj, At, Bt) do { __builtin_amdgcn_s_setprio(1); _Pragma("unroll") for (int m = 0; m < 4; ++m) _Pragma("unroll") for (int n = 0; n < 2; ++n) _Pragma("unroll") for (int k = 0; k < 2; ++k) \
        acc[ai][bj][m][n] = __builtin_amdgcn_mfma_f32_16x16x32_bf16(Bt[n][k], At[m][k], acc[ai][bj][m][n], 0, 0, 0); __builtin_amdgcn_s_setprio(0); } while (0)
#define PG8_WAIT_V(n) asm volatile("s_waitcnt vmcnt(" #n ")" ::: "memory")
#define PG8_WAIT_L(n) asm volatile("s_waitcnt lgkmcnt(" #n ")" ::: "memory")
#define PG8_BAR __builtin_amdgcn_s_barrier()
#define PG8_SCHED __builtin_amdgcn_sched_barrier(0)
    Unit cur, nxt; int ui = 0;
    if (!S.next(0, cur)) return;
    f32x4 acc[2][2][4][2];
#pragma unroll
    for (int a = 0; a < 2; ++a)
#pragma unroll
        for (int b = 0; b < 2; ++b)
#pragma unroll
            for (int m = 0; m < 4; ++m)
#pragma unroll
                for (int n = 0; n < 2; ++n) acc[a][b][m][n] = (f32x4){0.f, 0.f, 0.f, 0.f};
    bf16x8 At[4][2], B0[2][2], B1[2][2];
    const char* cA = PG8_UA(cur); const char* cB = PG8_UB(cur);
    PG8_STAGE(PG8_SB(0, 0), cB, voffB); PG8_STAGE(PG8_SB(0, 1), cB + hstepB, voffB); PG8_STAGE(PG8_SA(0, 0), cA, voffA); PG8_STAGE(PG8_SA(0, 1), cA + hstepA, voffA);
    if (wr == 1) PG8_BAR;
    PG8_WAIT_V(2); PG8_BAR;
    PG8_STAGE(PG8_SB(1, 0), cB + kstep, voffB); PG8_STAGE(PG8_SA(1, 0), cA + kstep, voffA); PG8_STAGE(PG8_SB(1, 1), cB + hstepB + kstep, voffB);
    PG8_WAIT_V(6); PG8_BAR;
    for (;;) {
        const bool has_next = S.next(ui + 1, nxt);
        const char* nA = has_next ? PG8_UA(nxt) : cA; const char* nB = has_next ? PG8_UB(nxt) : cB;
        for (int t = 0; t < nt; t += 2) {
            const bool last = (t == nt - 2);
            const char* a1 = cA + (size_t)(t + 1) * kstep;
            const char* a2 = last ? nA : cA + (size_t)(t + 2) * kstep; const char* b2 = last ? nB : cB + (size_t)(t + 2) * kstep;
            const char* a3 = a2 + kstep; const char* b3 = b2 + kstep;
            PG8_LDB(B0, 0, 0); PG8_LDB(B1, 0, 1); PG8_SCHED; PG8_LDA(At, 0, 0); PG8_STAGE(PG8_SA(1, 1), a1 + hstepA, voffA);
            PG8_WAIT_V(8); PG8_WAIT_L(0); PG8_BAR; PG8_MMA(0, 0, At, B0); PG8_MMA(0, 1, At, B1); PG8_BAR; PG8_SCHED;
            PG8_LDA(At, 0, 1); PG8_STAGE(PG8_SB(0, 0), b2, voffB); PG8_STAGE(PG8_SB(0, 1), b2 + hstepB, voffB); PG8_STAGE(PG8_SA(0, 0), a2, voffA);
            PG8_WAIT_V(8); PG8_WAIT_L(0); PG8_BAR; PG8_MMA(1, 0, At, B0); PG8_MMA(1, 1, At, B1); PG8_BAR; PG8_SCHED;
            PG8_LDB(B0, 1, 0); PG8_LDB(B1, 1, 1); PG8_SCHED; PG8_LDA(At, 1, 0); PG8_STAGE(PG8_SA(0, 1), a2 + hstepA, voffA);
            PG8_WAIT_V(8); PG8_WAIT_L(0); PG8_BAR; PG8_MMA(0, 0, At, B0); PG8_MMA(0, 1, At, B1); PG8_BAR; PG8_SCHED;
            PG8_LDA(At, 1, 1); PG8_STAGE(PG8_SB(1, 0), b3, voffB); PG8_STAGE(PG8_SB(1, 1), b3 + hstepB, voffB); PG8_STAGE(PG8_SA(1, 0), a3, voffA);
            PG8_WAIT_V(8); PG8_WAIT_L(0); PG8_BAR; PG8_MMA(1, 0, At, B0); PG8_MMA(1, 1, At, B1); PG8_BAR; PG8_SCHED;
        }
        if constexpr (ALIGN_EPI) { if (wr == 0) PG8_BAR; }
        { const int l2 = lane_fresh(); E(acc, cur, wr, wc, l2 & 15, l2 >> 4); }
        if (!has_next) break;
#pragma unroll
        for (int a = 0; a < 2; ++a)
#pragma unroll
            for (int b = 0; b < 2; ++b)
#pragma unroll
                for (int m = 0; m < 4; ++m)
#pragma unroll
                    for (int n = 0; n < 2; ++n) acc[a][b][m][n] = (f32x4){0.f, 0.f, 0.f, 0.f};
        cur = nxt; cA = nA; cB = nB; ++ui;
        if constexpr (ALIGN_EPI) { if (wr == 1) PG8_BAR; }
    }
    PG8_WAIT_V(0);
    if constexpr (!ALIGN_EPI) { if (wr == 0) PG8_BAR; }
    PG8_BAR;
#undef PG8_UA
#undef PG8_UB
#undef PG8_SA
#undef PG8_SB
#undef PG8_STAGE
#undef PG8_LDA
#undef PG8_LDB
#undef PG8_MMA
#undef PG8_WAIT_V
#undef PG8_WAIT_L
#undef PG8_BAR
#undef PG8_SCHED
}
}

namespace attn_body {
using bf16 = __hip_bfloat16;
using bf16x8 = __attribute__((ext_vector_type(8))) short;
using s16x4 = __attribute__((ext_vector_type(4))) short;
using f32x16 = __attribute__((ext_vector_type(16))) float;
using u32x4 = __attribute__((ext_vector_type(4))) unsigned;
constexpr int D = 64, NW = 8, QBLK = 32, QB = QBLK * NW, KVBLK = 64;
__device__ __forceinline__ int crow(int r, int hi) { return (r & 3) + 8 * (r >> 2) + 4 * hi; }
#define SBAR() __builtin_amdgcn_sched_barrier(0)
__device__ __forceinline__ void wmask(f32x16& p0, f32x16& p1, int d0) {
    const float NEG = -INFINITY;
#pragma unroll
    for (int r = 0; r < 16; ++r) { const int d = d0 + (r & 3) + 8 * (r >> 2); if (d > 128 || d < -128) p0[r] = NEG; if (d + 32 > 128 || d + 32 < -128) p1[r] = NEG; }
}
constexpr int NSLOT = 3, SLOTB = 8192;
constexpr int LDS_K = 0, LDS_V = NSLOT * SLOTB, LDS_WS = 2 * NSLOT * SLOTB, LDS_OST = LDS_WS + NW * 64 * 4, LDS_BYTES = LDS_OST + NW * 4096;
__device__ __forceinline__ void glds16(const void* gsrc, unsigned lds_dst) { unsigned keep;
    asm volatile("s_mov_b32 %0, m0\n\ts_mov_b32 m0, %2\n\ts_nop 0\n\tglobal_load_lds_dwordx4 %1, off\n\ts_mov_b32 m0, %0" : "=&s"(keep) : "v"(gsrc), "s"(lds_dst) : "memory"); }
__device__ __forceinline__ float max3f(float a, float b, float c) { float r; asm("v_max3_f32 %0, %1, %2, %3" : "=v"(r) : "v"(a), "v"(b), "v"(c)); return r; }
__device__ __forceinline__ float max2f(float a, float b) { float r; asm("v_max_f32_e32 %0, %1, %2" : "=v"(r) : "v"(a), "v"(b)); return r; }
__device__ __forceinline__ float fadd_s(float a, float b) { float r; asm("v_add_f32_e32 %0, %1, %2" : "=v"(r) : "v"(a), "v"(b)); return r; }
__device__ __forceinline__ float fsub_s(float a, float b) { float r; asm("v_sub_f32_e32 %0, %1, %2" : "=v"(r) : "v"(a), "v"(b)); return r; }
typedef float f32x2_t __attribute__((ext_vector_type(2))); typedef __bf16 bf16x2_t __attribute__((ext_vector_type(2)));
__device__ __forceinline__ unsigned cvtpk_s(float lo, float hi) { f32x2_t v = {lo, hi}; bf16x2_t b = __builtin_convertvector(v, bf16x2_t); return __builtin_bit_cast(unsigned, b); }
#define WAIT_BAR(N) asm volatile("s_waitcnt vmcnt(" #N ") lgkmcnt(0)\n\ts_barrier" ::: "memory")

__device__ __forceinline__ void qkt(f32x16& p0, f32x16& p1, const char* Kslot, const bf16x8* qr, const f32x16& negm, int r32, int hi) {
    const char* kb = Kslot + hi * 1024 + r32 * 16;
#pragma unroll
    for (int d0 = 0; d0 < 4; ++d0) {
        const bf16x8 b0 = *reinterpret_cast<const bf16x8*>(kb + d0 * 2048);
        const bf16x8 b1 = *reinterpret_cast<const bf16x8*>(kb + d0 * 2048 + 512);
        if (d0 == 0) { p0 = __builtin_amdgcn_mfma_f32_32x32x16_bf16(b0, qr[0], negm, 0, 0, 0); p1 = __builtin_amdgcn_mfma_f32_32x32x16_bf16(b1, qr[0], negm, 0, 0, 0); }
        else { p0 = __builtin_amdgcn_mfma_f32_32x32x16_bf16(b0, qr[d0], p0, 0, 0, 0); p1 = __builtin_amdgcn_mfma_f32_32x32x16_bf16(b1, qr[d0], p1, 0, 0, 0); } }
}
typedef __attribute__((address_space(3))) const char* lds_cptr;
typedef short v4i16_t __attribute__((ext_vector_type(4)));
__device__ __forceinline__ void kload8(bf16x8* kf, lds_cptr kp) {
    kf[0] = *(const __attribute__((address_space(3))) bf16x8*)(kp);        kf[1] = *(const __attribute__((address_space(3))) bf16x8*)(kp + 512);
    kf[2] = *(const __attribute__((address_space(3))) bf16x8*)(kp + 2048); kf[3] = *(const __attribute__((address_space(3))) bf16x8*)(kp + 2560);
    kf[4] = *(const __attribute__((address_space(3))) bf16x8*)(kp + 4096); kf[5] = *(const __attribute__((address_space(3))) bf16x8*)(kp + 4608);
    kf[6] = *(const __attribute__((address_space(3))) bf16x8*)(kp + 6144); kf[7] = *(const __attribute__((address_space(3))) bf16x8*)(kp + 6656);
}
__device__ __forceinline__ void kload2(bf16x8* kf, lds_cptr kp, int j) { kf[2 * j] = *(const __attribute__((address_space(3))) bf16x8*)(kp + j * 2048); kf[2 * j + 1] = *(const __attribute__((address_space(3))) bf16x8*)(kp + j * 2048 + 512); }
__device__ __forceinline__ s16x4 vtr(lds_cptr p) { return __builtin_bit_cast(s16x4, __builtin_amdgcn_ds_read_tr16_b64_v4i16((__attribute__((address_space(3))) v4i16_t*)p)); }
__device__ __forceinline__ float rowmax(const f32x16& p0, const f32x16& p1) {
    float a = max3f(p0[0], p0[1], p1[0]), b = max3f(p0[2], p0[3], p1[1]); a = max3f(a, p1[2], p1[3]);
#pragma unroll
    for (int r = 4; r < 16; r += 4) { a = max3f(a, p0[r], p0[r + 1]); b = max3f(b, p0[r + 2], p0[r + 3]); a = max3f(a, p1[r], p1[r + 1]); b = max3f(b, p1[r + 2], p1[r + 3]); }
    const float m = max2f(a, b);
    auto rr = __builtin_amdgcn_permlane32_swap(__float_as_uint(m), __float_as_uint(m), false, false);
    return max2f(__uint_as_float(rr[0]), __uint_as_float(rr[1]));
}
__device__ __forceinline__ void pv(f32x16* o, int vb, bf16x8 pa0, bf16x8 pa1, bf16x8 pa2, bf16x8 pa3) {
#pragma unroll
    for (int d0 = 0; d0 < 2; ++d0) { s16x4 lo[4], hi[4];
#pragma unroll
        for (int ks = 0; ks < 4; ++ks) {
            asm volatile("ds_read_b64_tr_b16 %0,%1 offset:%c2" : "=&v"(lo[ks]) : "v"(vb), "i"(d0 * 4096 + ks * 1024) : "memory");
            asm volatile("ds_read_b64_tr_b16 %0,%1 offset:%c2" : "=&v"(hi[ks]) : "v"(vb), "i"(d0 * 4096 + ks * 1024 + 512) : "memory"); }
        asm volatile("s_waitcnt lgkmcnt(0)" ::: "memory"); SBAR();
#define PK(k) (bf16x8){lo[k][0], lo[k][1], lo[k][2], lo[k][3], hi[k][0], hi[k][1], hi[k][2], hi[k][3]}
        o[d0] = __builtin_amdgcn_mfma_f32_32x32x16_bf16(pa0, PK(0), o[d0], 0, 0, 0);
        o[d0] = __builtin_amdgcn_mfma_f32_32x32x16_bf16(pa1, PK(1), o[d0], 0, 0, 0);
        o[d0] = __builtin_amdgcn_mfma_f32_32x32x16_bf16(pa2, PK(2), o[d0], 0, 0, 0);
        o[d0] = __builtin_amdgcn_mfma_f32_32x32x16_bf16(pa3, PK(3), o[d0], 0, 0, 0);
#undef PK
    }
}
template <int THRL, bool WMASK> __device__ __forceinline__ void attn_unit(const bf16* Qw0, const bf16* __restrict__ Kc, const bf16* __restrict__ Vc, long dlat, int NT, int kd0,
                                                                         bool has_sink, float sinkl2, bf16* Ow0, char* shm, int wid) {
    const int lane = lane_fresh(), r32 = lane & 31, hi = lane >> 5;
    const bf16* Qw = Qw0 + (long)(wid * QBLK) * ZP;
    const unsigned lds0 = (unsigned)(uintptr_t)shm;
    float* wsf = (float*)(shm + LDS_WS) + wid * 64;
    const bf16* ksrc = Kc + (long)lane * ZP + wid * 8;
    const bf16* vsrc = Vc + (long)(16 * (wid & 3) + (lane >> 2)) * ZP + (wid >> 2) * 32 + (lane & 3) * 8;
    const unsigned kdst = lds0 + LDS_K + wid * 1024, vdst = lds0 + LDS_V + wid * 1024;
#define TOFF(t) (((t) < 4) ? (long)(t) * (KVBLK * ZP) : dlat + (long)((t) - 4) * (KVBLK * ZP))
#define DMA_K(t, slot) glds16(ksrc + TOFF(t), (unsigned)__builtin_amdgcn_readfirstlane(kdst + (slot)))
#define DMA_V(t, slot) glds16(vsrc + TOFF(t), (unsigned)__builtin_amdgcn_readfirstlane(vdst + (slot)))
    const int vb0 = (int)(lds0 + LDS_V) + ((lane >> 4) & 1) * 32 + (lane & 3) * 8 + (4 * hi + ((lane & 15) >> 2)) * 64;
    const char* Kbase = shm + LDS_K; bf16x8 kf[8];
    const lds_cptr shm3 = (lds_cptr)shm; const lds_cptr kp0 = shm3 + LDS_K + hi * 1024 + r32 * 16; const lds_cptr vp0 = shm3 + LDS_V + ((lane >> 4) & 1) * 32 + (lane & 3) * 8 + (4 * hi + ((lane & 15) >> 2)) * 64;
    DMA_K(0, 0); DMA_V(0, 0); DMA_K(1, SLOTB);
    bf16x8 qr[4];
#pragma unroll
    for (int d0 = 0; d0 < 4; ++d0) qr[d0] = *reinterpret_cast<const bf16x8*>(&Qw[(long)r32 * ZP + d0 * 16 + hi * 8]);
    float mhat = 0.f, l_reg = 0.f; f32x16 o[2]; f32x16 negm;
    { float zz = 0.f; asm volatile("" : "+v"(zz));
      _Pragma("unroll") for (int r = 0; r < 16; ++r) { o[0][r] = zz; o[1][r] = zz; negm[r] = zz; } }
    asm volatile("" : "+v"(negm));
    const int qrel = wid * QBLK + r32;
#define CMASK(P0, P1, t) do { if constexpr (WMASK) { if ((t) >= 4) wmask(P0, P1, kd0 + ((t) - 4) * KVBLK - qrel + 4 * hi); } } while (0)
    bool resc = false;
#define START(P0, P1) do { const float rm = rowmax(P0, P1); resc = false; \
    { const float dl = rm; mhat = fadd_s(mhat, dl); \
      _Pragma("unroll") for (int r = 0; r < 16; ++r) { P0[r] = fsub_s(P0[r], dl); P1[r] = fsub_s(P1[r], dl); } \
      _Pragma("unroll") for (int r = 0; r < 16; ++r) negm[r] = -mhat; asm volatile("" : "+v"(negm)); } \
    _Pragma("unroll") for (int r = 0; r < 16; ++r) P0[r] = __builtin_amdgcn_exp2f(P0[r]); } while (0)
#define RESC() do { if (resc) { asm volatile("s_waitcnt lgkmcnt(0)" ::: "memory"); \
      _Pragma("unroll") for (int d_ = 0; d_ < 2; ++d_) _Pragma("unroll") for (int r = 0; r < 16; ++r) o[d_][r] *= wsf[crow(r, hi)]; } } while (0)
    f32x16 pA0, pA1, pB0, pB1;
    int sl_prev = 0, sl_cur = 0, sl_next = SLOTB;
#define ROT() do { sl_prev = sl_cur; sl_cur = sl_next; sl_next = (sl_next == (NSLOT - 1) * SLOTB) ? 0 : sl_next + SLOTB; } while (0)
    DMA_K(2, 2 * SLOTB);
    WAIT_BAR(3);
    qkt(pA0, pA1, Kbase, qr, negm, r32, hi); asm volatile("s_nop 15\n\ts_nop 7" : "+v"(pA0), "+v"(pA1));
    START(pA0, pA1);
    _Pragma("unroll") for (int r = 0; r < 16; ++r) pA1[r] = __builtin_amdgcn_exp2f(pA1[r]);
    WAIT_BAR(0);
    DMA_K(3, 0); DMA_V(1, SLOTB);
    ROT();
    kload8(kf, kp0 + sl_cur);
    WAIT_BAR(2);
    s16x4 vlo[8], vhi[8]; u32x4 pw0, pw1, pw2, pw3;
#define PKW(P, B) cvtpk_s(P[B], P[B + 1])
#define PAF(k) __builtin_bit_cast(bf16x8, pw##k)
#define VFR(i) (bf16x8){vlo[i][0], vlo[i][1], vlo[i][2], vlo[i][3], vhi[i][0], vhi[i][1], vhi[i][2], vhi[i][3]}
#define PIN(x) asm volatile("" : "+v"(x))
#define MX3(a, b, c) __builtin_fmaxf(__builtin_fmaxf((a), (b)), (c))
#define GAPA(MF, A0, A1, A2, A3, W0, W1, PW) do { MF; sacc += A0; sacc += A1; sacc += A2; sacc += A3; PIN(sacc); W0; W1; PIN(PW); SBAR(); } while (0)
#define EX(v) __builtin_amdgcn_exp2f(v)
#define GAPB(MF, X, B) do { MF; X[B] = EX(X[B]); X[B + 1] = EX(X[B + 1]); X[B + 2] = EX(X[B + 2]); X[B + 3] = EX(X[B + 3]); PIN(X); SBAR(); } while (0)
#define VRD(i) do { vlo[i] = vtr(vp_ + (((i) >> 2) * 4096 + ((i) & 3) * 1024)); vhi[i] = vtr(vp_ + (((i) >> 2) * 4096 + ((i) & 3) * 1024 + 512)); } while (0)
#define KRD(G, j) do { if (G) { kload2(kf, kp0 + sl_next, j); SBAR(); } } while (0)
#define STEP(C0, C1, P0, P1, t, GK, GV, GL) do { SBAR(); \
    const lds_cptr vp_ = vp0 + sl_prev; \
    VRD(0); SBAR(); float sacc = (P0[0] + P0[1]); \
    GAPA(C0 = __builtin_amdgcn_mfma_f32_32x32x16_bf16(kf[0], qr[0], negm, 0, 0, 0), P0[2], P0[3], P0[4], P0[5],     pw0[0] = PKW(P0, 0), pw0[1] = PKW(P0, 2), pw0); \
    VRD(4); SBAR(); GAPA(C1 = __builtin_amdgcn_mfma_f32_32x32x16_bf16(kf[1], qr[0], negm, 0, 0, 0), P0[6], P0[7], P0[8], P0[9],     pw0[2] = PKW(P0, 4), pw0[3] = PKW(P0, 6), pw0); \
    VRD(1); SBAR(); GAPA(C0 = __builtin_amdgcn_mfma_f32_32x32x16_bf16(kf[2], qr[1], C0, 0, 0, 0),   P0[10], P0[11], P0[12], P0[13], pw1[0] = PKW(P0, 8), pw1[1] = PKW(P0, 10), pw1); \
    VRD(5); SBAR(); GAPA(C1 = __builtin_amdgcn_mfma_f32_32x32x16_bf16(kf[3], qr[1], C1, 0, 0, 0),   P0[14], P0[15], P1[0], P1[1],   pw1[2] = PKW(P0, 12), pw1[3] = PKW(P0, 14), pw1); \
    VRD(2); SBAR(); GAPA(C0 = __builtin_amdgcn_mfma_f32_32x32x16_bf16(kf[4], qr[2], C0, 0, 0, 0),   P1[2], P1[3], P1[4], P1[5],     pw2[0] = PKW(P1, 0), pw2[1] = PKW(P1, 2), pw2); \
    VRD(6); SBAR(); GAPA(C1 = __builtin_amdgcn_mfma_f32_32x32x16_bf16(kf[5], qr[2], C1, 0, 0, 0),   P1[6], P1[7], P1[8], P1[9],     pw2[2] = PKW(P1, 4), pw2[3] = PKW(P1, 6), pw2); \
    VRD(3); SBAR(); GAPA(C0 = __builtin_amdgcn_mfma_f32_32x32x16_bf16(kf[6], qr[3], C0, 0, 0, 0),   P1[10], P1[11], P1[12], P1[13], pw3[0] = PKW(P1, 8), pw3[1] = PKW(P1, 10), pw3); \
    VRD(7); SBAR(); GAPA(C1 = __builtin_amdgcn_mfma_f32_32x32x16_bf16(kf[7], qr[3], C1, 0, 0, 0),   P1[14], P1[15], 0.f, 0.f,       pw3[2] = PKW(P1, 12), pw3[3] = PKW(P1, 14), pw3); \
    l_reg += sacc; \
    if (GK) { DMA_K((t) + 3, sl_cur); } if (GV) { DMA_V((t) + 1, sl_next); } \
    CMASK(C0, C1, t); \
    { float a = MX3(C0[0], C0[1], C1[0]), b = MX3(C0[2], C0[3], C1[1]); a = MX3(a, C1[2], C1[3]); \
      _Pragma("unroll") for (int r = 4; r < 16; r += 4) { a = MX3(a, C0[r], C0[r + 1]); b = MX3(b, C0[r + 2], C0[r + 3]); a = MX3(a, C1[r], C1[r + 1]); b = MX3(b, C1[r + 2], C1[r + 3]); } \
      float rm = __builtin_fmaxf(a, b); { auto rr = __builtin_amdgcn_permlane32_swap(__float_as_uint(rm), __float_as_uint(rm), false, false); rm = __builtin_fmaxf(__uint_as_float(rr[0]), __uint_as_float(rr[1])); } \
      resc = false; \
      if (__builtin_expect(__any(rm > (float)THRL), 0)) { const float dl = __builtin_fmaxf(rm, 0.f); mhat += dl; \
        _Pragma("unroll") for (int r = 0; r < 16; ++r) { C0[r] -= dl; C1[r] -= dl; } \
        _Pragma("unroll") for (int r = 0; r < 16; ++r) negm[r] = -mhat; asm volatile("" : "+v"(negm)); \
        const float f = __builtin_amdgcn_exp2f(-dl); l_reg *= f; if (hi == 0) wsf[r32] = f; resc = true; } } \
    SBAR(); \
    GAPB(o[0] = __builtin_amdgcn_mfma_f32_32x32x16_bf16(PAF(0), VFR(0), o[0], 0, 0, 0), C0, 0); \
    GAPB(o[1] = __builtin_amdgcn_mfma_f32_32x32x16_bf16(PAF(0), VFR(4), o[1], 0, 0, 0), C0, 4); \
    KRD(GL, 0); GAPB(o[0] = __builtin_amdgcn_mfma_f32_32x32x16_bf16(PAF(1), VFR(1), o[0], 0, 0, 0), C0, 8); \
    KRD(GL, 1); GAPB(o[1] = __builtin_amdgcn_mfma_f32_32x32x16_bf16(PAF(1), VFR(5), o[1], 0, 0, 0), C0, 12); \
    KRD(GL, 2); GAPB(o[0] = __builtin_amdgcn_mfma_f32_32x32x16_bf16(PAF(2), VFR(2), o[0], 0, 0, 0), C1, 0); \
    KRD(GL, 3); GAPB(o[1] = __builtin_amdgcn_mfma_f32_32x32x16_bf16(PAF(2), VFR(6), o[1], 0, 0, 0), C1, 4); \
    GAPB(o[0] = __builtin_amdgcn_mfma_f32_32x32x16_bf16(PAF(3), VFR(3), o[0], 0, 0, 0), C1, 8); \
    GAPB(o[1] = __builtin_amdgcn_mfma_f32_32x32x16_bf16(PAF(3), VFR(7), o[1], 0, 0, 0), C1, 12); \
    } while (0)
    int t = 1;
    for (; t + 5 < NT; t += 2) {
        STEP(pB0, pB1, pA0, pA1, t, true, true, true);     WAIT_BAR(2); RESC(); ROT();
        STEP(pA0, pA1, pB0, pB1, t + 1, true, true, true); WAIT_BAR(2); RESC(); ROT();
    }
#define ENDW(tt) do { if ((tt) + 3 < NT) { WAIT_BAR(2); } else if ((tt) + 2 < NT) { WAIT_BAR(1); } else { WAIT_BAR(0); } } while (0)
    for (; t + 1 < NT; t += 2) {
        STEP(pB0, pB1, pA0, pA1, t, (t + 3 < NT), (t + 1 < NT), (t + 1 < NT));         ENDW(t);     RESC(); ROT();
        STEP(pA0, pA1, pB0, pB1, t + 1, (t + 4 < NT), (t + 2 < NT), (t + 2 < NT));     ENDW(t + 1); RESC(); ROT();
    }
    STEP(pB0, pB1, pA0, pA1, NT - 1, false, false, false); RESC();
    { float sacc = pB0[0] + pB0[1]; _Pragma("unroll") for (int r = 2; r < 16; ++r) sacc += pB0[r]; _Pragma("unroll") for (int r = 0; r < 16; ++r) sacc += pB1[r]; l_reg += sacc;
      pw0 = (u32x4){PKW(pB0, 0), PKW(pB0, 2), PKW(pB0, 4), PKW(pB0, 6)}; pw1 = (u32x4){PKW(pB0, 8), PKW(pB0, 10), PKW(pB0, 12), PKW(pB0, 14)}; pw2 = (u32x4){PKW(pB1, 0), PKW(pB1, 2), PKW(pB1, 4), PKW(pB1, 6)}; pw3 = (u32x4){PKW(pB1, 8), PKW(pB1, 10), PKW(pB1, 12), PKW(pB1, 14)};
      SBAR(); pv(o, vb0 + sl_cur, PAF(0), PAF(1), PAF(2), PAF(3)); }
#undef PKW
#undef PAF
#undef VFR
#undef PIN
#undef MX3
#undef GAPA
#undef GAPB
#undef EX
#undef VRD
#undef KRD
#undef STEP
#undef ENDW
    { auto rr = __builtin_amdgcn_permlane32_swap(__float_as_uint(l_reg), __float_as_uint(l_reg), false, false); l_reg = __uint_as_float(rr[0]) + __uint_as_float(rr[1]); }
    if (has_sink) l_reg += __builtin_amdgcn_exp2f(sinkl2 - mhat);
    if (hi == 0) wsf[32 + r32] = l_reg; asm volatile("s_waitcnt lgkmcnt(0)" ::: "memory");
    float rli[16];
#pragma unroll
    for (int r = 0; r < 16; ++r) rli[r] = __builtin_amdgcn_rcpf(wsf[32 + crow(r, hi)]);
    bf16* Ow = Ow0 + (long)(wid * QBLK) * YP;
    { bf16* stg = (bf16*)(shm + LDS_OST) + wid * 2048;
#pragma unroll
      for (int r = 0; r < 16; ++r) { const int orow = crow(r, hi);
#pragma unroll
        for (int d0 = 0; d0 < 2; ++d0) stg[orow * 64 + d0 * 32 + r32] = __float2bfloat16(o[d0][r] * rli[r]); }
      asm volatile("s_waitcnt lgkmcnt(0)" ::: "memory");
#pragma unroll
      for (int i = 0; i < 4; ++i) { const int row = i * 8 + (lane >> 3), ch = lane & 7; const u32x4 v = *(const u32x4*)(stg + row * 64 + ch * 8); *(u32x4*)(Ow + (long)row * YP + ch * 8) = v; } }
    asm volatile("s_waitcnt lgkmcnt(0)\n\ts_barrier" ::: "memory");
#undef DMA_K
#undef DMA_V
#undef TOFF
#undef CMASK
#undef START
#undef RESC
#undef ROT
}
constexpr int ATTN_LDS_BYTES = LDS_BYTES;
#undef SBAR
#undef WAIT_BAR
}

constexpr int NWAVES = 8, NTHREADS = NWAVES * 64;
constexpr int RING_BYTES = 131072, LDS_BYTES = 147456;
constexpr int LDSCTL_OFF = RING_BYTES, MISC_OFF = LDSCTL_OFF + 320;
#define LAS __attribute__((address_space(3)))
typedef unsigned short bf16;
typedef unsigned v4u __attribute__((ext_vector_type(4)));
typedef unsigned v2u __attribute__((ext_vector_type(2)));
typedef float f32x4 __attribute__((ext_vector_type(4)));
using pg8::cvt_pk_bf16; using pg8::bf_lo; using pg8::bf_hi;

constexpr size_t MiB = 1u << 20;
constexpr size_t WS_MOD = 0;
constexpr size_t WS_CTL = 1 * MiB, CTL_ZERO_BYTES = 16384;
constexpr size_t WS_W = 2 * MiB;
constexpr size_t LW_IN = 0;
constexpr size_t LW_POOL = LW_IN + (size_t)5120 * 1024 * 2;
constexpr size_t LW_BR = LW_POOL + (size_t)512 * 256 * 2;
constexpr size_t LW_OUT = LW_BR + (size_t)3072 * 512 * 2;
constexpr size_t LW_FF = LW_OUT + (size_t)1024 * 1024 * 2;
constexpr size_t LW_DN = LW_FF + (size_t)5632 * 1024 * 2;
constexpr size_t LW_BYTES = LW_DN + (size_t)1024 * 2816 * 2;
constexpr size_t WS_XC = WS_W + ((2 * LW_BYTES + MiB - 1) / MiB) * MiB;
constexpr size_t WS_ARENA = WS_XC + (size_t)NCTX * 1024 * 4;
constexpr size_t AR_Z = 0, AR_G = (size_t)NTOK * ZP * 2, AR_Y = AR_G + (size_t)NTOK * GP * 2, AR_H = AR_Y;
constexpr size_t AR_MRG = AR_Z;
constexpr size_t AR_U = 0, AR_SIDE = (size_t)NTOK * FF * 2, SIDE_BYTES = (size_t)(NTOK / 32) * FF * 4, AR_H2 = (size_t)NTOK * AVP * 2;
constexpr size_t AR_XF = ((AR_SIDE + 3 * SIDE_BYTES + 4095) / 4096) * 4096;
static_assert(AR_XF + (size_t)NLAT * 1024 * 4 <= AR_H2, "side buffers + XF");
constexpr size_t WS_END = WS_ARENA + (size_t)NTOK * 6656 * 2;
static_assert(AR_Y + (size_t)NTOK * YP * 2 == (size_t)NTOK * 6656 * 2 && AR_H2 + (size_t)NTOK * 1024 * 2 == (size_t)NTOK * 6656 * 2, "arena views");


#define XB_TMO      128
#define XB_XCNT(j)  (256  + 64 * (j))
#define XB_XSUB(j)  (1280 + 64 * (j))
#define XB_XGEN(j)  (2304 + 64 * (j))
#define XB_TOP      3328
#define XB_TOPGEN   3392
#define XCD_BAR_WORDS 3456
#define XB_SPIN_CAP (1u << 20)
__device__ __forceinline__ unsigned xb_ld(unsigned* p)              { return __hip_atomic_load(p, __ATOMIC_RELAXED, __HIP_MEMORY_SCOPE_AGENT); }
__device__ __forceinline__ unsigned xb_add(unsigned* p, unsigned v) { return __hip_atomic_fetch_add(p, v, __ATOMIC_RELAXED, __HIP_MEMORY_SCOPE_AGENT); }
__device__ __forceinline__ unsigned xb_xcc_id() { return (unsigned)__builtin_amdgcn_s_getreg((3 << 11) | 20) & 0xFu; }
#define XB_SPIN(cond, bar) do { unsigned _sp = 0; while (cond) { __builtin_amdgcn_s_sleep(1); \
    if ((++_sp & 255u) == 0u) { if (xb_ld(&(bar)[XB_TMO])) break; if (_sp > XB_SPIN_CAP) { atomicAdd(&(bar)[XB_TMO], 1u); break; } } } } while (0)
struct XcdBarrier { unsigned* bar; unsigned x; volatile LAS unsigned* st; };
__device__ __forceinline__ XcdBarrier xcd_barrier_post(unsigned* bar, volatile LAS unsigned* st) {
    XcdBarrier b; b.bar = bar; b.x = xb_xcc_id(); b.st = st;
    if (threadIdx.x == 0) (void)xb_add(&bar[XB_XCNT(b.x)], 1u);
    return b;
}
__device__ __forceinline__ void xcd_barrier_complete(unsigned* bar, unsigned x, unsigned& nloc, unsigned& nx) {
    const unsigned G = gridDim.x * gridDim.y * gridDim.z;
    unsigned sum, cnt, mine, sp = 0u;
    for (;;) {
        sum = 0u; cnt = 0u; mine = 0u;
#pragma unroll
        for (unsigned j = 0; j < 16; ++j) { const unsigned c = xb_ld(&bar[XB_XCNT(j)]); sum += c; cnt += (c > 0u) ? 1u : 0u; mine = (j == x) ? c : mine; }
        if (sum == G) break;
        __builtin_amdgcn_s_sleep(1);
        if ((++sp & 255u) == 0u) { if (xb_ld(&bar[XB_TMO])) break; if (sp > XB_SPIN_CAP) { atomicAdd(&bar[XB_TMO], 1u); break; } }
    }
    nloc = mine > 0u ? mine : 1u; nx = cnt > 0u ? cnt : 1u;
}
__device__ __forceinline__ void xcd_barrier(const XcdBarrier& b, int wave) {
    asm volatile("s_waitcnt vmcnt(0)" ::: "memory");
    __syncthreads();
    if (wave == 0 && lane_fresh() == 0) {
        unsigned* bar = b.bar;
        __builtin_amdgcn_s_waitcnt(0);
        unsigned nloc = b.st[0], nx = b.st[1];
        if (nloc == 0u) { xcd_barrier_complete(bar, b.x, nloc, nx); b.st[0] = nloc; b.st[1] = nx; }
        const unsigned old = xb_add(&bar[XB_XSUB(b.x)], 1u);
        const unsigned gen = old / nloc;
        if (old + 1u == (gen + 1u) * nloc) {
            __builtin_amdgcn_fence(__ATOMIC_RELEASE, "agent");
            asm volatile("s_waitcnt vmcnt(0)" ::: "memory");
            const unsigned og = xb_add(&bar[XB_TOP], 1u);
            const unsigned tg = og / nx;
            if (og + 1u == (tg + 1u) * nx) xb_add(&bar[XB_TOPGEN], 1u);
            else XB_SPIN(xb_ld(&bar[XB_TOPGEN]) == tg, bar);
            __builtin_amdgcn_fence(__ATOMIC_ACQUIRE, "agent");
            xb_add(&bar[XB_XGEN(b.x)], 1u);
            asm volatile("s_waitcnt vmcnt(0)" ::: "memory");
        } else {
            XB_SPIN(xb_ld(&bar[XB_XGEN(b.x)]) == gen, bar);
            __builtin_amdgcn_fence(__ATOMIC_ACQUIRE, "agent");
            asm volatile("s_waitcnt vmcnt(0)" ::: "memory");
        }
    }
    __syncthreads();
}

struct Args {
    const float *x, *c, *ctx, *c_ctx, *w_mod, *b_mod, *norm1_g, *norm2_g, *w_in, *w_pool_grp, *pool_scale, *win_sink, *q_norm_g, *k_norm_g,
                *w_branch, *w_gate, *b_gate, *w_out, *w_ff_gate, *w_ff_val, *conv_w, *conv_b, *w_ff_down, *final_g;
    float* out; unsigned char* ws; int ph_lo, ph_hi;
};

__device__ __forceinline__ float shx(float v, int lane, int m) { return __int_as_float(__builtin_amdgcn_ds_bpermute((lane ^ m) << 2, __float_as_int(v))); }
__device__ __forceinline__ float wave_sum(float v, int lane) {
#pragma unroll
    for (int o = 1; o < 64; o <<= 1) v += shx(v, lane, o);
    return v;
}
__device__ __forceinline__ void transpose_item(const float* W, int K, int N, bf16* WT, int ldw, int row_off, LAS float* scr, int item, int lane, bool spread = false) {
    const int nblk = N / 32, kb = item / nblk, nb = item % nblk, k0 = 64 * kb, n0 = 32 * nb;
    if (spread) row_off += 128 * (n0 >> 7);
#pragma unroll 8
    for (int i = 0; i < 32; ++i) { const int kk = 2 * i + (lane >> 5); scr[kk * 33 + (lane & 31)] = W[(size_t)(k0 + kk) * N + n0 + (lane & 31)]; }
    asm volatile("s_waitcnt lgkmcnt(0)" ::: "memory");
    const int c = lane & 7;
#pragma unroll
    for (int j = 0; j < 4; ++j) { const int n = (lane >> 3) + 8 * j; const LAS float* s = scr + (8 * c) * 33 + n;
        v4u o; o.x = cvt_pk_bf16(s[0 * 33], s[1 * 33]); o.y = cvt_pk_bf16(s[2 * 33], s[3 * 33]); o.z = cvt_pk_bf16(s[4 * 33], s[5 * 33]); o.w = cvt_pk_bf16(s[6 * 33], s[7 * 33]);
        *(v4u*)(WT + (size_t)(row_off + n0 + n) * ldw + k0 + 8 * c) = o; }
    asm volatile("s_waitcnt lgkmcnt(0)" ::: "memory");
}

__device__ __forceinline__ void prologue(const Args& A, LAS unsigned char* lds, int G, int vcu, int tid, int lane, int wave) {
    float* mod = (float*)(A.ws + WS_MOD);
    if ((int)blockIdx.x < 192) {
        LAS float* S = (LAS float*)lds; LAS float* part = (LAS float*)(lds + 17 * 1024 * 4);
        for (int idx = tid; idx < 17 * 1024; idx += NTHREADS) { const int r = idx >> 10, k = idx & 1023; const float v = (r < 16) ? A.c[r * 1024 + k] : A.c_ctx[k];
            S[idx] = v / (1.0f + __builtin_amdgcn_exp2f(-v * LOG2E)); }
        __syncthreads();
        for (int u = blockIdx.x; u < 192; u += G) {
            const int l = u / 96, n0 = (u % 96) * 64;
            float acc[17];
#pragma unroll
            for (int r = 0; r < 17; ++r) acc[r] = 0.f;
            const float* W = A.w_mod + (size_t)l * 1024 * 6144 + n0 + lane;
#pragma unroll 16
            for (int kk = 0; kk < 128; ++kk) { const int k = kk * 8 + wave; const float w = W[(size_t)k * 6144];
#pragma unroll
                for (int r = 0; r < 17; ++r) acc[r] += S[r * 1024 + k] * w; }
#pragma unroll
            for (int r = 0; r < 17; ++r) part[(wave * 17 + r) * 64 + lane] = acc[r];
            __syncthreads();
            for (int idx = tid; idx < 17 * 64; idx += NTHREADS) { const int r = idx >> 6, j = idx & 63; float s = 0.f;
#pragma unroll
                for (int w = 0; w < 8; ++w) s += part[(w * 17 + r) * 64 + j];
                mod[(size_t)(l * 17 + r) * 6144 + n0 + j] = s + A.b_mod[l * 6144 + n0 + j]; }
            __syncthreads();
        }
    }
    __syncthreads();
    LAS float* scr = (LAS float*)(lds + wave * 16384);
    const int gw = vcu * NWAVES + wave, NGW = G * NWAVES;
    constexpr int I_IN = 16 * 64, I_GATE = 16 * 32, I_BR = 8 * 32, I_OUT = 16 * 32, I_FF = 16 * 88, I_DN = 44 * 32;
    constexpr int PER_LAYER = I_IN + 3 * I_GATE + 3 * I_BR + I_OUT + 2 * I_FF + I_DN;
    for (int it = gw; it < 2 * PER_LAYER; it += NGW) {
        const int l = it / PER_LAYER; int r = it % PER_LAYER;
        unsigned char* wl = A.ws + WS_W + (size_t)l * LW_BYTES;
        if (r < I_IN) { transpose_item(A.w_in + (size_t)l * 1024 * 2048, 1024, 2048, (bf16*)(wl + LW_IN), 1024, 0, scr, r, lane); continue; } r -= I_IN;
        if (r < 3 * I_GATE) { const int i = r / I_GATE; transpose_item(A.w_gate + ((size_t)l * 3 + i) * 1024 * 1024, 1024, 1024, (bf16*)(wl + LW_IN), 1024, 2048 + i * 1024, scr, r % I_GATE, lane); continue; } r -= 3 * I_GATE;
        if (r < 3 * I_BR) { const int i = r / I_BR; transpose_item(A.w_branch + ((size_t)l * 3 + i) * 512 * 1024, 512, 1024, (bf16*)(wl + LW_BR), 512, i * 1024, scr, r % I_BR, lane); continue; } r -= 3 * I_BR;
        if (r < I_OUT) { transpose_item(A.w_out + (size_t)l * 1024 * 1024, 1024, 1024, (bf16*)(wl + LW_OUT), 1024, 0, scr, r, lane); continue; } r -= I_OUT;
        if (r < I_FF) { transpose_item(A.w_ff_gate + (size_t)l * 1024 * FF, 1024, FF, (bf16*)(wl + LW_FF), 1024, 0, scr, r, lane, true); continue; } r -= I_FF;
        if (r < I_FF) { transpose_item(A.w_ff_val + (size_t)l * 1024 * FF, 1024, FF, (bf16*)(wl + LW_FF), 1024, 128, scr, r, lane, true); continue; } r -= I_FF;
        transpose_item(A.w_ff_down + (size_t)l * FF * 1024, FF, 1024, (bf16*)(wl + LW_DN), FF, 0, scr, r, lane);
    }
    for (int idx = vcu * NTHREADS + tid; idx < 2 * 512 * 256; idx += G * NTHREADS) {
        const int l = idx / (512 * 256), e = idx % (512 * 256), n = e >> 8, k = e & 255, g = n >> 7, gk = 2 * (n >> 8) + (k >> 7);
        const float v = (gk == g) ? A.w_pool_grp[(((size_t)l * 4 + g) * 128 + (k & 127)) * 128 + (n & 127)] : 0.f;
        ((bf16*)(A.ws + WS_W + (size_t)l * LW_BYTES + LW_POOL))[e] = (bf16)(cvt_pk_bf16(v, 0.f) & 0xffffu);
    }
}

template <bool SRC_BF16>
__device__ __forceinline__ void norm_rows(const void* xlat, const void* xctx, const float* gvec, const float* modl, int which, int nrows, bf16* H, int gw, int NGW) {
    const int lane = lane_fresh(); asm volatile("" : "+s"(gw));
    for (int row = gw; row < nrows; row += NGW) {
        const bool lat = row < NLAT;
        const size_t roff = lat ? (size_t)row * 1024 : (size_t)(row - NLAT) * 1024;
        const void* srcb = lat ? xlat : xctx;
        const int b = lat ? (row >> 12) : NB;
        const float* shp = modl + (size_t)(b * 6 + which * 3) * 1024; const float* scp = shp + 1024;
        float v[2][8]; float ss = 0.f;
#pragma unroll
        for (int j = 0; j < 2; ++j) { const int c0 = 8 * lane + 512 * j;
            if constexpr (SRC_BF16) { const v4u w = *(const v4u*)((const bf16*)srcb + roff + c0);
                v[j][0] = bf_lo(w.x); v[j][1] = bf_hi(w.x); v[j][2] = bf_lo(w.y); v[j][3] = bf_hi(w.y); v[j][4] = bf_lo(w.z); v[j][5] = bf_hi(w.z); v[j][6] = bf_lo(w.w); v[j][7] = bf_hi(w.w); }
            else { const f32x4 a = *(const f32x4*)((const float*)srcb + roff + c0), c = *(const f32x4*)((const float*)srcb + roff + c0 + 4);
                v[j][0] = a.x; v[j][1] = a.y; v[j][2] = a.z; v[j][3] = a.w; v[j][4] = c.x; v[j][5] = c.y; v[j][6] = c.z; v[j][7] = c.w; }
#pragma unroll
            for (int i = 0; i < 8; ++i) ss += v[j][i] * v[j][i]; }
        const float rstd = __builtin_amdgcn_rsqf(wave_sum(ss, lane) * (1.f / 1024.f) + EPS);
#pragma unroll
        for (int j = 0; j < 2; ++j) { const int c0 = 8 * lane + 512 * j; float y[8];
#pragma unroll
            for (int h = 0; h < 2; ++h) { const f32x4 g = *(const f32x4*)(gvec + c0 + 4 * h), sh = *(const f32x4*)(shp + c0 + 4 * h), sc = *(const f32x4*)(scp + c0 + 4 * h);
#pragma unroll
                for (int e = 0; e < 4; ++e) y[4 * h + e] = (v[j][4 * h + e] * rstd * g[e]) * (sc[e] + 1.0f) + sh[e]; }
            v4u w; w.x = cvt_pk_bf16(y[0], y[1]); w.y = cvt_pk_bf16(y[2], y[3]); w.z = cvt_pk_bf16(y[4], y[5]); w.w = cvt_pk_bf16(y[6], y[7]);
            *(v4u*)(H + (size_t)row * 1024 + c0) = w; }
    }
}
__device__ __forceinline__ void final_norm_rows(const float* x, float* out, const float* gvec, int gw, int NGW) {
    const int lane = lane_fresh(); asm volatile("" : "+s"(gw));
    for (int row = gw; row < NLAT; row += NGW) {
        const float* src = x + (size_t)row * 1024; float* dst = out + (size_t)row * 1024;
        f32x4 v[4]; float ss = 0.f;
#pragma unroll
        for (int j = 0; j < 4; ++j) { v[j] = *(const f32x4*)(src + 4 * lane + 256 * j); ss += (v[j].x * v[j].x + v[j].y * v[j].y) + (v[j].z * v[j].z + v[j].w * v[j].w); }
        const float rstd = __builtin_amdgcn_rsqf(wave_sum(ss, lane) * (1.f / 1024.f) + EPS);
#pragma unroll
        for (int j = 0; j < 4; ++j) { const int c0 = 4 * lane + 256 * j; const f32x4 g = *(const f32x4*)(gvec + c0); *(f32x4*)(dst + c0) = v[j] * rstd * g; }
    }
}

__device__ __forceinline__ void unpack8(const v4u w, float* v) { v[0] = bf_lo(w.x); v[1] = bf_hi(w.x); v[2] = bf_lo(w.y); v[3] = bf_hi(w.y); v[4] = bf_lo(w.z); v[5] = bf_hi(w.z); v[6] = bf_lo(w.w); v[7] = bf_hi(w.w); }
__device__ __forceinline__ v4u pack8(const float* v) { v4u w; w.x = cvt_pk_bf16(v[0], v[1]); w.y = cvt_pk_bf16(v[2], v[3]); w.z = cvt_pk_bf16(v[4], v[5]); w.w = cvt_pk_bf16(v[6], v[7]); return w; }
__device__ __forceinline__ void qk_proc(float* v, bool do_norm, const float* g, bool do_rope, bool hi_half, const float* cs, const float* sn, float scale, int lane) {
    float ss = 0.f;
#pragma unroll
    for (int i = 0; i < 8; ++i) ss += v[i] * v[i];
    ss += shx(ss, lane, 1); ss += shx(ss, lane, 2); ss += shx(ss, lane, 4);
    const float rstd = __builtin_amdgcn_rsqf(ss * (1.f / 64.f) + EPS);
#pragma unroll
    for (int i = 0; i < 8; ++i) { const float nv = v[i] * rstd * g[i]; v[i] = do_norm ? nv : v[i]; }
#pragma unroll
    for (int i = 0; i < 8; ++i) { const float pvv = shx(v[i], lane, 2);
        const float rv = hi_half ? (v[i] * cs[i] + pvv * sn[i]) : (v[i] * cs[i] - pvv * sn[i]);
        v[i] = (do_rope ? rv : v[i]) * scale; }
}
__device__ __forceinline__ void elem_phase(const Args& A, int layer, int nrows, bf16* Z, bf16* Y, int gw, int NGW) {
    const int lane = lane_fresh(); asm volatile("" : "+s"(gw));
    const int j8 = lane & 7; const bool hi_half = (j8 >> 1) & 1; const int axis = j8 >> 2, fbase = (j8 & 1) * 8;
    float inv[8], qg[8], kg[8];
#pragma unroll
    for (int i = 0; i < 8; ++i) { inv[i] = __builtin_amdgcn_exp2f(-(float)(fbase + i) * (13.287712379549449f / 16.0f)) * 0.15915494309189535f;
        qg[i] = A.q_norm_g[layer * 64 + j8 * 8 + i]; kg[i] = A.k_norm_g[layer * 64 + j8 * 8 + i]; }
    for (int row = gw; row < nrows; row += NGW) {
        const bool lat = row < NLAT;
        const int t = lat ? (row & (SEQ - 1)) : ((row - NLAT) & (CTX - 1));
        const int L = lat ? SEQ : CTX;
        bf16* zrow = Z + (size_t)row * ZP;
        const int g = lane >> 4, w2 = 1 << g; int lo = t - w2; lo = lo < 0 ? 0 : lo; int hi = t + w2; hi = hi > L ? L : hi;
        const bf16* zc = Z + (size_t)(row - t) * ZP + lane * 8;
        const v4u zero = {0u, 0u, 0u, 0u};
        v4u pw[16];
#pragma unroll
        for (int jj = 0; jj < 16; ++jj) { const int r = lo + jj; pw[jj] = (r < hi) ? *(const v4u*)(zc + (size_t)r * ZP) : zero; }
        const v4u own_w = *(const v4u*)(zrow + lane * 8);
        const v4u wq_w = *(const v4u*)(zrow + 512 + lane * 8);
        const v4u gq_w = *(const v4u*)(zrow + 1280 + lane * 8);
        const int l5 = lane & 31; const bool isg = l5 >= 16; const int kcol = isg ? 1792 + (l5 - 16) * 8 : 1024 + l5 * 8;
        const v4u k_w = *(const v4u*)(zrow + kcol);
        float acc[8];
#pragma unroll
        for (int i = 0; i < 8; ++i) acc[i] = 0.f;
#pragma unroll
        for (int jj = 0; jj < 16; ++jj) { float u[8]; unpack8(pw[jj], u);
#pragma unroll
            for (int i = 0; i < 8; ++i) acc[i] += u[i]; }
        { float own[8]; unpack8(own_w, own); const float rc = 1.0f / (float)(hi - lo);
#pragma unroll
          for (int i = 0; i < 8; ++i) acc[i] = acc[i] * rc - own[i]; }
        float cs[8], sn[8];
        { const float pos = (float)(axis ? (t & 63) : (t >> 6));
#pragma unroll
          for (int i = 0; i < 8; ++i) { float r = pos * inv[i]; r = r - __builtin_floorf(r); cs[i] = __builtin_amdgcn_cosf(r); sn[i] = __builtin_amdgcn_sinf(r); } }
        float vq[8], vg[8], vk[8];
        unpack8(wq_w, vq); qk_proc(vq, false, qg, lat, hi_half, cs, sn, C2, lane);
        unpack8(gq_w, vg); qk_proc(vg, true, qg, lat, hi_half, cs, sn, C2, lane);
        unpack8(k_w, vk);  qk_proc(vk, isg, kg, lat, hi_half, cs, sn, 1.0f, lane);
        *(v4u*)(Y + (size_t)row * YP + lane * 8) = pack8(acc);
        *(v4u*)(zrow + 512 + lane * 8) = pack8(vq);
        *(v4u*)(zrow + 1280 + lane * 8) = pack8(vg);
        if (lane < 32) *(v4u*)(zrow + kcol) = pack8(vk);
    }
}

__device__ __forceinline__ void fixup_phase(const Args& A, int layer, int nrows, bf16* U, const float* As, const float* PAs, const float* Vs, int gbase, int NT) {
    const int gtid = gbase + lane_fresh();
    const int items = (nrows / 32) * 352;
    const float* cw = A.conv_w + (size_t)layer * 3 * FF;
    for (int it = gtid; it < items; it += NT) {
        const int c8 = it % 352, brow = it / 352, side = brow & 1, col = c8 * 8;
        const int r = (brow >> 1) * 64 + (side ? 63 : 0);
        const bool lat = r < NLAT; const int L = lat ? SEQ : CTX; const int t = lat ? (r & (SEQ - 1)) : ((r - NLAT) & (CTX - 1));
        const bool has = side ? (t != L - 1) : (t != 0);
        const int nb = has ? (side ? brow + 1 : brow - 1) : brow;
        const float* wp = cw + (side ? 2 * FF : 0) + col;
        const size_t so = (size_t)brow * FF + col, sn = (size_t)nb * FF + col;
        float o[8];
#pragma unroll
        for (int h = 0; h < 2; ++h) { const f32x4 pa = *(const f32x4*)(PAs + so + 4 * h), vv = *(const f32x4*)(Vs + so + 4 * h), an = *(const f32x4*)(As + sn + 4 * h), w = *(const f32x4*)(wp + 4 * h);
#pragma unroll
            for (int e = 0; e < 4; ++e) { const float pre = pa[e] + (has ? w[e] * an[e] : 0.f); o[4 * h + e] = pre * pg8::sigmoidf_(pre) * vv[e]; } }
        *(v4u*)(U + (size_t)r * FF + col) = pack8(o);
    }
}

__device__ __forceinline__ void attention_phase(const Args& A, int layer, bool last, bf16* Z, bf16* Y, char* shm, int G, int vcu, int wave) {
    using abf = attn_body::bf16;
    asm volatile("" : "+s"(vcu), "+s"(G));
    const float* sink = A.win_sink + layer * 8;
    const int NU = NB * 8 * 16, per = (NU + G - 1) / G;
    int u0 = vcu * per, u1 = u0 + per; if (u1 > NU) u1 = NU;
    for (int u = u0; u < u1; ++u) {
        const int qb = u & 15, h = (u >> 4) & 7, b = u >> 7, kvh = h >> 2;
        const size_t qrow = (size_t)b * SEQ + qb * 256, crow0 = (size_t)NLAT + (size_t)b * CTX;
        const abf* Q = (const abf*)Z + qrow * ZP + 1280 + h * 64;
        const abf* Kc = (const abf*)Z + crow0 * ZP + 1792 + kvh * 64; const abf* Vc = (const abf*)Z + crow0 * ZP + 1920 + kvh * 64;
        const long dlat = ((long)b * SEQ - (long)crow0) * ZP;
        attn_body::attn_unit<8, false>(Q, Kc, Vc, dlat, 68, 0, false, 0.f, (abf*)Y + qrow * YP + 1024 + h * 64, shm, wave);
    }
    for (int u = u0; u < u1; ++u) {
        const int qb = u & 15, h = (u >> 4) & 7, b = u >> 7, kvh = h >> 2;
        const size_t qrow = (size_t)b * SEQ + qb * 256, crow0 = (size_t)NLAT + (size_t)b * CTX;
        int tl0 = 4 * qb - 2; tl0 = tl0 < 0 ? 0 : tl0; int tl1 = 4 * qb + 6; tl1 = tl1 > 64 ? 64 : tl1;
        const abf* Q = (const abf*)Z + qrow * ZP + 512 + h * 64;
        const abf* Kc = (const abf*)Z + crow0 * ZP + 1024 + kvh * 64; const abf* Vc = (const abf*)Z + crow0 * ZP + 1152 + kvh * 64;
        const long dlat = ((long)b * SEQ + tl0 * 64 - (long)crow0) * ZP;
        attn_body::attn_unit<8, true>(Q, Kc, Vc, dlat, 4 + (tl1 - tl0), tl0 * 64 - qb * 256, true, sink[h] * LOG2E, (abf*)Y + qrow * YP + 512 + h * 64, shm, wave);
    }
    if (!last) {
        const int NUC = 2 * NB * 8;
        for (int u = vcu; u < NUC; u += G) {
            const int mixer = u & 1, h = (u >> 1) & 7, b = u >> 4, kvh = h >> 2;
            const size_t crow0 = (size_t)NLAT + (size_t)b * CTX;
            const int qc = mixer ? 1280 : 512, kc = mixer ? 1792 : 1024, vc = mixer ? 1920 : 1152, oc = mixer ? 1024 : 512;
            attn_body::attn_unit<8, false>((const abf*)Z + crow0 * ZP + qc + h * 64, (const abf*)Z + crow0 * ZP + kc + kvh * 64, (const abf*)Z + crow0 * ZP + vc + kvh * 64, 0, 4, 0,
                                           mixer == 0, sink[h] * LOG2E, (abf*)Y + crow0 * YP + oc + h * 64, shm, wave);
        }
    }
}

__global__ void __launch_bounds__(NTHREADS, 2) fwd_megakernel(Args A) {
    extern __shared__ __attribute__((aligned(16))) unsigned char lds_raw[];
    LAS unsigned char* lds = (LAS unsigned char*)lds_raw;
    const int wave = __builtin_amdgcn_readfirstlane(threadIdx.x >> 6);
    const int G = gridDim.x; const int bx = blockIdx.x; const int vcu = (G % 8 == 0) ? (bx % 8) * (G / 8) + bx / 8 : bx;
    const int gw = vcu * NWAVES + wave, NGW = G * NWAVES;
    const int lo = A.ph_lo, hi = A.ph_hi;
    int ph = 0;
#if MK_SPLIT
#define SEAM() do { ++ph; } while (0)
#else
    cg::grid_group grid = cg::this_grid();
    for (int u = threadIdx.x; u < (LDS_BYTES - LDSCTL_OFF) / 4; u += NTHREADS) ((LAS unsigned*)(lds + LDSCTL_OFF))[u] = 0u;
    __syncthreads();
    XcdBarrier bar = xcd_barrier_post((unsigned*)(A.ws + WS_CTL), (volatile LAS unsigned*)(lds + MISC_OFF) + 8);
#define SEAM() do { if (ph == 0) grid.sync(); else xcd_barrier(bar, wave); ++ph; } while (0)
#endif
#define IN() (lo <= ph && ph < hi)
    unsigned char* ws = A.ws;
    float* mod = (float*)(ws + WS_MOD);
    bf16* XB = (bf16*)A.out;
    bf16* XCB = (bf16*)(ws + WS_XC);
    unsigned char* ar = ws + WS_ARENA;
    bf16* Z = (bf16*)(ar + AR_Z); bf16* Gt = (bf16*)(ar + AR_G); bf16* Y = (bf16*)(ar + AR_Y); bf16* H = (bf16*)(ar + AR_H);
    bf16* Mrg = (bf16*)(ar + AR_MRG); bf16* U = (bf16*)(ar + AR_U); bf16* H2 = (bf16*)(ar + AR_H2);
    float* XF = (float*)(ar + AR_XF); float* SAs = (float*)(ar + AR_SIDE); float* SPA = (float*)(ar + AR_SIDE + SIDE_BYTES); float* SVs = (float*)(ar + AR_SIDE + 2 * SIDE_BYTES);

    if (IN()) for (int rep = 0; rep < ((DUP_MASK & 32) ? 2 : 1); ++rep) { const int lane = lane_fresh(); prologue(A, lds, G, vcu, wave * 64 + lane, lane, wave); __syncthreads(); }
    SEAM();
    for (int l = 0; l < 2; ++l) {
        const bool last = (l == 1);
        const int nrows_mix = NTOK, nrows_x = last ? NLAT : NTOK;
        const int nM_mix = nrows_mix / 256, nM_x = nrows_x / 256;
        const float* modl = mod + (size_t)l * 17 * 6144;
        const unsigned char* wl = ws + WS_W + (size_t)l * LW_BYTES;
        if (IN()) { if (l == 0) norm_rows<false>(A.x, A.ctx, A.norm1_g + l * 1024, modl, 0, nrows_mix, H, gw, NGW); else norm_rows<true>(XB, XCB, A.norm1_g + l * 1024, modl, 0, nrows_mix, H, gw, NGW); }
        SEAM();
        if (IN()) for (int rep = 0; rep < ((DUP_MASK & 1) ? 2 : 1); ++rep) { pg8::Gemm g{H, (const bf16*)(wl + LW_IN), 1024, 1024, 1024, 0, 0}; pg8::Order S; S.init(nM_mix, 20, G, bx, 1, 0);
            pg8::EpiIn E{Z, Gt, A.b_gate + (size_t)l * 3072};
            pg8::gemm_phase<pg8::EpiIn, true>(lds, g, S, E, wave); }
        SEAM();
        if (IN()) elem_phase(A, l, nrows_mix, Z, Y, gw, NGW);
        SEAM();
        if (IN()) { for (int rep = 0; rep < ((DUP_MASK & 2) ? 2 : 1); ++rep) attention_phase(A, l, last, Z, Y, (char*)lds_raw, G, vcu, wave);
            pg8::Gemm g{Y, (const bf16*)(wl + LW_POOL), YP, 256, 256, 256, 0}; pg8::Order S; S.init(nM_x, 2, G, bx, 1, 1);
            pg8::EpiBf16 E{Y, YP, A.pool_scale + (size_t)l * 512};
            pg8::gemm_phase<pg8::EpiBf16, true>(lds, g, S, E, wave); }
        SEAM();
        if (IN()) for (int rep = 0; rep < ((DUP_MASK & 16) ? 2 : 1); ++rep) { pg8::Gemm g{Y, (const bf16*)(wl + LW_BR), YP, 512, 512, 512, (long)1024 * 512}; pg8::Order S; S.init(nM_x, 4, G, bx, 3, 2);
            pg8::EpiMerge E{Gt, Mrg};
            pg8::gemm_phase<pg8::EpiMerge, true>(lds, g, S, E, wave); }
        SEAM();
        if (IN()) { pg8::Gemm g{Mrg, (const bf16*)(wl + LW_OUT), 1024, 1024, 1024, 0, 0}; pg8::Order S; S.init(nM_x, 4, G, bx, 1, 0);
            if (l == 0) { pg8::EpiRes<false, true> E{A.x, A.ctx, XB, XCB, modl, 2}; pg8::gemm_phase<pg8::EpiRes<false, true>, true>(lds, g, S, E, wave); }
            else { pg8::EpiRes<true, true> E{XB, XCB, XB, XCB, modl, 2}; pg8::gemm_phase<pg8::EpiRes<true, true>, true>(lds, g, S, E, wave); } }
        SEAM();
        if (IN()) norm_rows<true>(XB, XCB, A.norm2_g + l * 1024, modl, 1, nrows_x, H2, gw, NGW);
        SEAM();
        if (IN()) for (int rep = 0; rep < ((DUP_MASK & 4) ? 2 : 1); ++rep) { pg8::Gemm g{H2, (const bf16*)(wl + LW_FF), 1024, 1024, 1024, 0, 0}; pg8::Order S; S.init(nM_x, 22, G, bx, 1, 0);
            pg8::EpiFF E{U, A.conv_w + (size_t)l * 3 * FF, A.conv_b + (size_t)l * FF, SAs, SIDE_BYTES / 4};
            pg8::gemm_phase<pg8::EpiFF, true>(lds, g, S, E, wave); }
        SEAM();
        if (IN()) fixup_phase(A, l, nrows_x, U, SAs, SPA, SVs, vcu * NTHREADS + wave * 64, G * NTHREADS);
        SEAM();
        if (IN()) { pg8::Gemm g{U, (const bf16*)(wl + LW_DN), FF, FF, FF, 0, 0}; pg8::Order S; S.init(nM_x, 4, G, bx, 1, 0);
            if (!last) { pg8::EpiRes<true, true> E{XB, XCB, XB, XCB, modl, 5}; pg8::gemm_phase<pg8::EpiRes<true, true>, true>(lds, g, S, E, wave); }
            else { pg8::EpiRes<true, false> E{XB, XCB, XF, XF, modl, 5}; pg8::gemm_phase<pg8::EpiRes<true, false>, true>(lds, g, S, E, wave); } }
        SEAM();
    }
    if (IN()) final_norm_rows(XF, A.out, A.final_g, gw, NGW);
#undef IN
#undef SEAM
}
constexpr int N_PHASES = 22;

extern "C" void kernel_launch(void* const* d_in, const int* in_sizes, int n_in, void* d_out, int out_size, void* d_ws, size_t ws_size, hipStream_t stream) {
    static int grid = 0;
    if (grid == 0) {
        if (n_in != 24 || out_size != NLAT * 1024 || ws_size < WS_END) { fprintf(stderr, "kernel_launch: unexpected shapes (n_in %d out %d ws %zu need %zu)\n", n_in, out_size, ws_size, (size_t)WS_END); grid = -1; return; }
        int dev = 0, cus = 0, per_cu = 0;
        hipGetDevice(&dev); hipDeviceGetAttribute(&cus, hipDeviceAttributeMultiprocessorCount, dev);
        if (hipFuncSetAttribute((const void*)fwd_megakernel, hipFuncAttributeMaxDynamicSharedMemorySize, LDS_BYTES) != hipSuccess) { fprintf(stderr, "kernel_launch: hipFuncSetAttribute failed\n"); grid = -1; return; }
        hipOccupancyMaxActiveBlocksPerMultiprocessor(&per_cu, (const void*)fwd_megakernel, NTHREADS, LDS_BYTES);
        (void)hipGetLastError();
        if (per_cu < 1) { fprintf(stderr, "kernel_launch: occupancy query says %d blocks per CU\n", per_cu); per_cu = 1; }
        grid = cus;
    }
    if (grid < 0) return;
    Args a{};
    const float** p = (const float**)&a;
    for (int i = 0; i < 24; ++i) p[i] = (const float*)d_in[i];
    a.out = (float*)d_out; a.ws = (unsigned char*)d_ws;
#if MK_SPLIT
    for (int ph = 0; ph < N_PHASES; ++ph) { a.ph_lo = ph; a.ph_hi = ph + 1; hipLaunchKernelGGL(fwd_megakernel, dim3(grid), dim3(NTHREADS), LDS_BYTES, stream, a); }
#else
    a.ph_lo = 0; a.ph_hi = N_PHASES;
    if (hipMemsetAsync((char*)d_ws + WS_CTL, 0, CTL_ZERO_BYTES, stream) != hipSuccess) { fprintf(stderr, "kernel_launch: memset failed\n"); return; }
    void* args[] = {&a};
    hipError_t e = hipLaunchCooperativeKernel((const void*)fwd_megakernel, dim3(grid), dim3(NTHREADS), args, LDS_BYTES, stream);
    if (e != hipSuccess) fprintf(stderr, "cooperative launch failed: %s (grid %d)\n", hipGetErrorString(e), grid);
#endif
}
```

```cpp
#include <hip/hip_runtime.h>
#include <hip/hip_cooperative_groups.h>
#include <hip/hip_bf16.h>
#include <cstdio>
#include <cstdint>
#include <cmath>
namespace cg = cooperative_groups;

#ifndef DUP_MASK
#define DUP_MASK 0
#endif
#ifndef MK_SPLIT
#define MK_SPLIT 0
#endif

constexpr int DM_ = 1024, NB = 16, SEQ = 4096, CTX = 256, NLAT = NB * SEQ, NCTX = NB * CTX, NTOK = NLAT + NCTX;
constexpr int ZP = 2048, GP = 3072, YP = 1536, FF = 2816, AVP = 2 * FF;
constexpr float EPS = 1e-6f;
constexpr float LOG2E = 1.4426950408889634f;
constexpr float C2 = 0.125f * LOG2E;

__device__ __forceinline__ int lane_fresh() { int l = (int)__builtin_amdgcn_mbcnt_hi(~0u, __builtin_amdgcn_mbcnt_lo(~0u, 0u)); asm volatile("" : "+v"(l)); return l; }

namespace pg8 {
#define PG8_LAS __attribute__((address_space(3)))
typedef unsigned short bf16_t;
typedef short bf16x8 __attribute__((ext_vector_type(8)));
typedef float f32x4 __attribute__((ext_vector_type(4)));
typedef unsigned u32x4 __attribute__((ext_vector_type(4)));
typedef unsigned u32x2 __attribute__((ext_vector_type(2)));
constexpr int BM = 256, BK = 64, HALF = 128, HTB = HALF * BK * 2, STAGE_BYTES = 8 * HTB, NXCD = 8, WGM = 8;

__host__ __device__ __forceinline__ int lds_byte(int r, int c) { const int st = (r >> 4) * 2 + (c >> 5), rr = r & 15, cc = c & 31, ob = rr * 64 + cc * 2; return st * 1024 + (ob ^ (((ob >> 9) & 1) << 5)); }
__host__ __device__ __forceinline__ void stage_rc(int b, int& R, int& C) { const int st = b / 1024, sb = b % 1024, swz = sb ^ (((sb >> 9) & 1) << 5); R = (st >> 1) * 16 + swz / 64; C = (st & 1) * 32 + (swz % 64) / 2; }
__host__ __device__ __forceinline__ int perm32(int rho) { const int n = rho >> 4, i = rho & 15; return 8 * (i >> 2) + 4 * n + (i & 3); }

struct Unit { int pm, pn, g; };
struct Gemm { const bf16_t* A; const bf16_t* Bt; int lda, ldb, K; long a_goff, b_goff; };

struct Order {
    int nM, nN, nwg, G, c, sub, gmode;
    __device__ __forceinline__ void init(int nM_, int nN_, int G_, int c_, int sub_, int gmode_) { nM = nM_; nN = nN_; nwg = nM * nN; G = G_; c = c_; sub = sub_; gmode = gmode_; }
    __device__ __forceinline__ bool next(int i, Unit& u) const {
        const int ti = (sub == 1) ? i : i / sub;
        const long L = (long)ti * G + c; if (L >= nwg) return false;
        int wgid = (int)L; { const int q = nwg / NXCD, r = nwg % NXCD, xcd = wgid % NXCD, off = wgid / NXCD; wgid = (xcd < r ? xcd * (q + 1) : r * (q + 1) + (xcd - r) * q) + off; }
        const int nig = WGM * nN, gid = wgid / nig, fm = gid * WGM, gsz = (nM - fm) < WGM ? (nM - fm) : WGM;
        u.pm = fm + ((wgid % nig) % gsz); u.pn = (wgid % nig) / gsz;
        u.g = (gmode == 0) ? 0 : ((gmode == 1) ? u.pn : (i - ti * sub));
        return true;
    }
};

typedef float f32x2_t __attribute__((ext_vector_type(2))); typedef __bf16 bf16x2_t __attribute__((ext_vector_type(2)));
__device__ __forceinline__ unsigned cvt_pk_bf16(float lo, float hi) { f32x2_t v = {lo, hi}; bf16x2_t b = __builtin_convertvector(v, bf16x2_t); return __builtin_bit_cast(unsigned, b); }
__device__ __forceinline__ float bf_lo(unsigned w) { return __uint_as_float(w << 16); }
__device__ __forceinline__ float bf_hi(unsigned w) { return __uint_as_float(w & 0xffff0000u); }
__device__ __forceinline__ float sigmoidf_(float x) { return __builtin_amdgcn_rcpf(1.0f + __builtin_amdgcn_exp2f(-x * 1.4426950408889634f)); }

struct EpiBf16 {
    static constexpr bool PERM = true;
    bf16_t* O; int ldc; const float* colscale;
    __device__ __forceinline__ void operator()(const f32x4 (&acc)[2][2][4][2], const Unit& u, int wr, int wc, int fr, int fq) const {
        int row0 = u.pm * BM + wr * 64 + fr; asm volatile("" : "+v"(row0)); const int col0 = u.pn * BM + wc * 32 + 8 * fq;
#pragma unroll
        for (int bj = 0; bj < 2; ++bj) {
            f32x4 s0 = (f32x4){1.f, 1.f, 1.f, 1.f}, s1 = s0;
            if (colscale) { s0 = *(const f32x4*)(colscale + col0 + bj * HALF); s1 = *(const f32x4*)(colscale + col0 + bj * HALF + 4); }
#pragma unroll
            for (int ai = 0; ai < 2; ++ai)
#pragma unroll
                for (int m = 0; m < 4; ++m) { bf16_t* rowp = O + (size_t)(row0 + ai * HALF + m * 16) * ldc + col0;
                    const f32x4 v0 = acc[ai][bj][m][0] * s0, v1 = acc[ai][bj][m][1] * s1;
                    u32x4 w; w.x = cvt_pk_bf16(v0[0], v0[1]); w.y = cvt_pk_bf16(v0[2], v0[3]); w.z = cvt_pk_bf16(v1[0], v1[1]); w.w = cvt_pk_bf16(v1[2], v1[3]);
                    *(u32x4*)(rowp + bj * HALF) = w; } }
    }
};
struct EpiIn {
    static constexpr bool PERM = true;
    bf16_t* Z; bf16_t* Gt; const float* bgate;
    __device__ __forceinline__ void operator()(const f32x4 (&acc)[2][2][4][2], const Unit& u, int wr, int wc, int fr, int fq) const {
        int row0 = u.pm * BM + wr * 64 + fr; asm volatile("" : "+v"(row0)); const bool isz = u.pn < 8;
        const int col0 = (isz ? u.pn * BM : (u.pn - 8) * BM) + wc * 32 + 8 * fq;
        bf16_t* base = isz ? Z : Gt; const int ldc = isz ? ZP : GP;
        f32x4 bv[2][2];
#pragma unroll
        for (int bj = 0; bj < 2; ++bj)
#pragma unroll
            for (int n = 0; n < 2; ++n) bv[bj][n] = isz ? (f32x4){0.f, 0.f, 0.f, 0.f} : *(const f32x4*)(bgate + col0 + bj * HALF + 4 * n);
#pragma unroll
        for (int ai = 0; ai < 2; ++ai)
#pragma unroll
            for (int m = 0; m < 4; ++m) { bf16_t* rowp = base + (size_t)(row0 + ai * HALF + m * 16) * ldc + col0;
#pragma unroll
                for (int bj = 0; bj < 2; ++bj) { f32x4 v0 = acc[ai][bj][m][0] + bv[bj][0], v1 = acc[ai][bj][m][1] + bv[bj][1];
                    if (!isz) {
#pragma unroll
                        for (int e = 0; e < 4; ++e) { v0[e] = sigmoidf_(v0[e]); v1[e] = sigmoidf_(v1[e]); } }
                    u32x4 w; w.x = cvt_pk_bf16(v0[0], v0[1]); w.y = cvt_pk_bf16(v0[2], v0[3]); w.z = cvt_pk_bf16(v1[0], v1[1]); w.w = cvt_pk_bf16(v1[2], v1[3]);
                    *(u32x4*)(rowp + bj * HALF) = w; } }
    }
};
struct EpiMerge {
    static constexpr bool PERM = true;
    const bf16_t* Gt; bf16_t* Mrg;
    __device__ __forceinline__ void operator()(const f32x4 (&acc)[2][2][4][2], const Unit& u, int wr, int wc, int fr, int fq) const {
        int row0 = u.pm * BM + wr * 64 + fr; asm volatile("" : "+v"(row0)); const int col0 = u.pn * BM + wc * 32 + 8 * fq;
#pragma unroll
        for (int ai = 0; ai < 2; ++ai) {
            u32x4 gw[4][2], ow[4][2];
#pragma unroll
            for (int m = 0; m < 4; ++m) { const size_t row = (size_t)(row0 + ai * HALF + m * 16);
#pragma unroll
                for (int bj = 0; bj < 2; ++bj) { gw[m][bj] = *(const u32x4*)(Gt + row * GP + u.g * 1024 + col0 + bj * HALF);
                    if (u.g != 0) ow[m][bj] = *(const u32x4*)(Mrg + row * 1024 + col0 + bj * HALF); } }
#pragma unroll
            for (int m = 0; m < 4; ++m) { const size_t row = (size_t)(row0 + ai * HALF + m * 16);
#pragma unroll
                for (int bj = 0; bj < 2; ++bj) {
                    const u32x4 g4 = gw[m][bj];
                    const f32x4 a0 = acc[ai][bj][m][0], a1 = acc[ai][bj][m][1];
                    float v[8];
                    v[0] = bf_lo(g4.x) * a0[0]; v[1] = bf_hi(g4.x) * a0[1]; v[2] = bf_lo(g4.y) * a0[2]; v[3] = bf_hi(g4.y) * a0[3];
                    v[4] = bf_lo(g4.z) * a1[0]; v[5] = bf_hi(g4.z) * a1[1]; v[6] = bf_lo(g4.w) * a1[2]; v[7] = bf_hi(g4.w) * a1[3];
                    if (u.g != 0) { const u32x4 o4 = ow[m][bj];
                        v[0] += bf_lo(o4.x); v[1] += bf_hi(o4.x); v[2] += bf_lo(o4.y); v[3] += bf_hi(o4.y); v[4] += bf_lo(o4.z); v[5] += bf_hi(o4.z); v[6] += bf_lo(o4.w); v[7] += bf_hi(o4.w); }
                    u32x4 w; w.x = cvt_pk_bf16(v[0], v[1]); w.y = cvt_pk_bf16(v[2], v[3]); w.z = cvt_pk_bf16(v[4], v[5]); w.w = cvt_pk_bf16(v[6], v[7]);
                    *(u32x4*)(Mrg + row * 1024 + col0 + bj * HALF) = w; } }
        }
    }
};
template <bool BASE_BF16, bool OUT_BF16> struct EpiRes {
    static constexpr bool PERM = false;
    const void* base_lat; const void* base_ctx; void* out_lat; void* out_ctx; const float* modl; int gate_idx;
    __device__ __forceinline__ void operator()(const f32x4 (&acc)[2][2][4][2], const Unit& u, int wr, int wc, int fr, int fq) const {
        const bool lat = u.pm < (NLAT / BM);
        const int prow = lat ? u.pm * BM : (u.pm * BM - NLAT);
        const void* base = lat ? base_lat : base_ctx; void* out = lat ? out_lat : out_ctx;
        const int b = lat ? (u.pm * BM) / SEQ : NB;
        int col0 = u.pn * BM + wc * 32 + 4 * fq; asm volatile("" : "+v"(col0));
        const float* gp = modl + (size_t)(b * 6 + gate_idx) * 1024 + col0;
        f32x4 gv[2][2];
#pragma unroll
        for (int bj = 0; bj < 2; ++bj)
#pragma unroll
            for (int n = 0; n < 2; ++n) gv[bj][n] = *(const f32x4*)(gp + bj * HALF + n * 16);
#pragma unroll
        for (int ai = 0; ai < 2; ++ai) {
            f32x4 bs[4][2][2];
#pragma unroll
            for (int m = 0; m < 4; ++m) { const size_t off = (size_t)(prow + ai * HALF + wr * 64 + m * 16 + fr) * 1024 + col0;
#pragma unroll
                for (int bj = 0; bj < 2; ++bj)
#pragma unroll
                    for (int n = 0; n < 2; ++n) { const size_t o2 = off + bj * HALF + n * 16;
                        if constexpr (BASE_BF16) { const u32x2 w = *(const u32x2*)((const bf16_t*)base + o2); bs[m][bj][n] = (f32x4){bf_lo(w.x), bf_hi(w.x), bf_lo(w.y), bf_hi(w.y)}; }
                        else bs[m][bj][n] = *(const f32x4*)((const float*)base + o2); } }
#pragma unroll
            for (int m = 0; m < 4; ++m) { const size_t off = (size_t)(prow + ai * HALF + wr * 64 + m * 16 + fr) * 1024 + col0;
#pragma unroll
                for (int bj = 0; bj < 2; ++bj)
#pragma unroll
                    for (int n = 0; n < 2; ++n) { const size_t o2 = off + bj * HALF + n * 16;
                        const f32x4 r = bs[m][bj][n] + gv[bj][n] * acc[ai][bj][m][n];
                        if constexpr (OUT_BF16) { u32x2 w; w.x = cvt_pk_bf16(r[0], r[1]); w.y = cvt_pk_bf16(r[2], r[3]); *(u32x2*)((bf16_t*)out + o2) = w; }
                        else *(f32x4*)((float*)out + o2) = r; } }
        }
    }
};
struct EpiFF {
    static constexpr bool PERM = true;
    bf16_t* U; const float* cw; const float* cb; float* As; size_t side_elems;
    __device__ __forceinline__ void operator()(const f32x4 (&acc)[2][2][4][2], const Unit& u, int wr, int wc, int fr, int fq) const {
        const int lane = fq * 16 + fr; float* PAs = As + side_elems; float* Vs = PAs + side_elems;
        int ch0 = u.pn * 128 + wc * 32 + 8 * fq; asm volatile("" : "+v"(ch0));
        const int src_up = (lane & 48) | ((fr - 1) & 15), src_dn = (lane & 48) | ((fr + 1) & 15);
#pragma unroll
        for (int h = 0; h < 2; ++h) {
            const f32x4 w0 = *(const f32x4*)(cw + ch0 + 4 * h), w1 = *(const f32x4*)(cw + 2816 + ch0 + 4 * h), w2 = *(const f32x4*)(cw + 2 * 2816 + ch0 + 4 * h), bb = *(const f32x4*)(cb + ch0 + 4 * h);
#pragma unroll
            for (int ai = 0; ai < 2; ++ai) {
                const int rblk = u.pm * 4 + ai * 2 + wr;
                float o[4][4]; f32x4 pre0, pre3;
#pragma unroll
                for (int e = 0; e < 4; ++e) {
                    float a[4], ru[4], rd[4];
#pragma unroll
                    for (int m = 0; m < 4; ++m) { a[m] = acc[ai][0][m][h][e]; ru[m] = __int_as_float(__builtin_amdgcn_ds_bpermute(src_up << 2, __float_as_int(a[m]))); rd[m] = __int_as_float(__builtin_amdgcn_ds_bpermute(src_dn << 2, __float_as_int(a[m]))); }
#pragma unroll
                    for (int m = 0; m < 4; ++m) {
                        const float ap = (fr > 0) ? ru[m] : (m > 0 ? ru[m > 0 ? m - 1 : 0] : 0.f);
                        const float an = (fr < 15) ? rd[m] : (m < 3 ? rd[m < 3 ? m + 1 : 3] : 0.f);
                        const float pre = ap * w0[e] + a[m] * w1[e] + an * w2[e] + bb[e];
                        if (m == 0) pre0[e] = pre; if (m == 3) pre3[e] = pre;
                        o[m][e] = pre * sigmoidf_(pre) * acc[ai][1][m][h][e]; }
                    __builtin_amdgcn_sched_barrier(0); }
#pragma unroll
                for (int m = 0; m < 4; ++m) { u32x2 w; w.x = cvt_pk_bf16(o[m][0], o[m][1]); w.y = cvt_pk_bf16(o[m][2], o[m][3]);
                    *(u32x2*)(U + ((size_t)rblk * 64 + m * 16 + fr) * 2816 + ch0 + 4 * h) = w; }
                if (fr == 0) { const size_t so = (size_t)(2 * rblk) * 2816 + ch0 + 4 * h; *(f32x4*)(As + so) = acc[ai][0][0][h]; *(f32x4*)(Vs + so) = acc[ai][1][0][h]; *(f32x4*)(PAs + so) = pre0; }
                if (fr == 15) { const size_t so = (size_t)(2 * rblk + 1) * 2816 + ch0 + 4 * h; *(f32x4*)(As + so) = acc[ai][0][3][h]; *(f32x4*)(Vs + so) = acc[ai][1][3][h]; *(f32x4*)(PAs + so) = pre3; }
                __builtin_amdgcn_sched_barrier(0);
            }
        }
    }
};

template <class Epi, bool ALIGN_EPI>
__device__ __forceinline__ void gemm_phase(PG8_LAS unsigned char* lds, const Gemm g, const Order& S, const Epi& E, int wid) {
    const int lane = lane_fresh(), tid = wid * 64 + lane;
    const int wr = wid >> 2, wc = wid & 3, fr = lane & 15, fq = lane >> 4;
    const int K = g.K, nt = K / BK;
    unsigned voffA[2], voffB[2];
#pragma unroll
    for (int i = 0; i < 2; ++i) { int R, C; stage_rc(tid * 16 + i * 8192, R, C); const int Rb = Epi::PERM ? ((R & ~31) + perm32(R & 31)) : R;
        voffA[i] = (unsigned)(R * g.lda + C) * 2u; voffB[i] = (unsigned)(Rb * g.ldb + C) * 2u; }
    const size_t kstep = (size_t)(BK * 2);
    const size_t hstepA = (size_t)HALF * g.lda * 2, hstepB = (size_t)HALF * g.ldb * 2;
    const size_t tstepA = 2 * hstepA, tstepB = 2 * hstepB;
    const unsigned ldsw = (unsigned)wid * 1024u;
    const int aoff = lds_byte(wr * 64 + fr, fq * 8), boff = lds_byte(wc * 32 + fr, fq * 8);
#define PG8_UA(u) ((const char*)g.A + (size_t)(u).pm * tstepA + (size_t)((long)(u).g * g.a_goff * 2))
#define PG8_UB(u) ((const char*)g.Bt + (size_t)(u).pn * tstepB + (size_t)((long)(u).g * g.b_goff * 2))
#define PG8_SA(b, h) (((b) * 2 + (h)) * HTB)
#define PG8_SB(b, h) ((4 + (b) * 2 + (h)) * HTB)
#define PG8_STAGE(bufoff, gbase, voff) do { _Pragma("unroll") for (int _i = 0; _i < 2; ++_i) \
        __builtin_amdgcn_global_load_lds((const unsigned*)((const char*)(gbase) + (voff)[_i]), (PG8_LAS unsigned*)(lds + (bufoff) + ldsw + _i * 8192), 16, 0, 0); } while (0)
#define PG8_LDA(dst, b, h) do { _Pragma("unroll") for (int m = 0; m < 4; ++m) _Pragma("unroll") for (int k = 0; k < 2; ++k) dst[m][k] = *(const PG8_LAS bf16x8*)(lds + PG8_SA(b, h) + aoff + m * 2048 + k * 1024); } while (0)
#define PG8_LDB(dst, b, h) do { _Pragma("unroll") for (int n = 0; n < 2; ++n) _Pragma("unroll") for (int k = 0; k < 2; ++k) dst[n][k] = *(const PG8_LAS bf16x8*)(lds + PG8_SB(b, h) + boff + n * 2048 + k * 1024); } while (0)
#define PG8_MMA(ai, bj, At, Bt) do { __builtin_amdgcn_s_setprio(1); _Pragma("unroll") for (int m = 0; m < 4; ++m) _Pragma("unroll") for (int n = 0; n < 2; ++n) _Pragma("unroll") for (int k = 0; k < 2; ++k) \
        acc[ai][bj][m][n] = __builtin_amdgcn_mfma_f32_16x16x32_bf16(Bt[n][k], At[m][k], acc[ai][bj][m][n], 0, 0, 0); __builtin_amdgcn_s_setprio(0); } while (0)
#define PG8_WAIT_V(n) asm volatile("s_waitcnt vmcnt(" #n ")" ::: "memory")
#define PG8_WAIT_L(n) asm volatile("s_waitcnt lgkmcnt(" #n ")" ::: "memory")
#define PG8_BAR __builtin_amdgcn_s_barrier()
#define PG8_SCHED __builtin_amdgcn_sched_barrier(0)
    Unit cur, nxt; int ui = 0;
    if (!S.next(0, cur)) return;
    f32x4 acc[2][2][4][2];
#pragma unroll
    for (int a = 0; a < 2; ++a)
#pragma unroll
        for (int b = 0; b < 2; ++b)
#pragma unroll
            for (int m = 0; m < 4; ++m)
#pragma unroll
                for (int n = 0; n < 2; ++n) acc[a][b][m][n] = (f32x4){0.f, 0.f, 0.f, 0.f};
    bf16x8 At[4][2], B0[2][2], B1[2][2];
    const char* cA = PG8_UA(cur); const char* cB = PG8_UB(cur);
    PG8_STAGE(PG8_SB(0, 0), cB, voffB); PG8_STAGE(PG8_SB(0, 1), cB + hstepB, voffB); PG8_STAGE(PG8_SA(0, 0), cA, voffA); PG8_STAGE(PG8_SA(0, 1), cA + hstepA, voffA);
    if (wr == 1) PG8_BAR;
    PG8_WAIT_V(2); PG8_BAR;
    PG8_STAGE(PG8_SB(1, 0), cB + kstep, voffB); PG8_STAGE(PG8_SA(1, 0), cA + kstep, voffA); PG8_STAGE(PG8_SB(1, 1), cB + hstepB + kstep, voffB);
    PG8_WAIT_V(6); PG8_BAR;
    for (;;) {
        const bool has_next = S.next(ui + 1, nxt);
        const char* nA = has_next ? PG8_UA(nxt) : cA; const char* nB = has_next ? PG8_UB(nxt) : cB;
        for (int t = 0; t < nt; t += 2) {
            const bool last = (t == nt - 2);
            const char* a1 = cA + (size_t)(t + 1) * kstep;
            const char* a2 = last ? nA : cA + (size_t)(t + 2) * kstep; const char* b2 = last ? nB : cB + (size_t)(t + 2) * kstep;
            const char* a3 = a2 + kstep; const char* b3 = b2 + kstep;
            PG8_LDB(B0, 0, 0); PG8_LDB(B1, 0, 1); PG8_SCHED; PG8_LDA(At, 0, 0); PG8_STAGE(PG8_SA(1, 1), a1 + hstepA, voffA);
            PG8_WAIT_V(8); PG8_WAIT_L(0); PG8_BAR; PG8_MMA(0, 0, At, B0); PG8_MMA(0, 1, At, B1); PG8_BAR; PG8_SCHED;
            PG8_LDA(At, 0, 1); PG8_STAGE(PG8_SB(0, 0), b2, voffB); PG8_STAGE(PG8_SB(0, 1), b2 + hstepB, voffB); PG8_STAGE(PG8_SA(0, 0), a2, voffA);
            PG8_WAIT_V(8); PG8_WAIT_L(0); PG8_BAR; PG8_MMA(1, 0, At, B0); PG8_MMA(1, 1, At, B1); PG8_BAR; PG8_SCHED;
            PG8_LDB(B0, 1, 0); PG8_LDB(B1, 1, 1); PG8_SCHED; PG8_LDA(At, 1, 0); PG8_STAGE(PG8_SA(0, 1), a2 + hstepA, voffA);
            PG8_WAIT_V(8); PG8_WAIT_L(0); PG8_BAR; PG8_MMA(0, 0, At, B0); PG8_MMA(0, 1, At, B1); PG8_BAR; PG8_SCHED;
            PG8_LDA(At, 1, 1); PG8_STAGE(PG8_SB(1, 0), b3, voffB); PG8_STAGE(PG8_SB(1, 1), b3 + hstepB, voffB); PG8_STAGE(PG8_SA(1, 0), a3, voffA);
            PG8_WAIT_V(8); PG8_WAIT_L(0); PG8_BAR; PG8_MMA(1, 0, At, B0); PG8_MMA(1, 1, At, B1); PG8_BAR; PG8_SCHED;
        }
        if constexpr (ALIGN_EPI) { if (wr == 0) PG8_BAR; }
        { const int l2 = lane_fresh(); E(acc, cur, wr, wc, l2 & 15, l2 >> 4); }
        if (!has_next) break;
#pragma unroll
        for (int a = 0; a < 2; ++a)
#pragma unroll
            for (int b = 0; b < 2; ++b)
#pragma unroll
                for (int m = 0; m < 4; ++m)
#pragma unroll
                    for (int n = 0; n < 2; ++n) acc[a][b][m][n] = (f32x4){0.f, 0.f, 0.f, 0.f};
        cur = nxt; cA = nA; cB = nB; ++ui;
        if constexpr (ALIGN_EPI) { if (wr == 1) PG8_BAR; }
    }
    PG8_WAIT_V(0);
    if constexpr (!ALIGN_EPI) { if (wr == 0) PG8_BAR; }
    PG8_BAR;
#undef PG8_UA
#undef PG8_UB
#undef PG8_SA
#undef PG8_SB
#undef PG8_STAGE
#undef PG8_LDA
#undef PG8_LDB
#undef PG8_MMA
#undef PG8_WAIT_V
#undef PG8_WAIT_L
#undef PG8_BAR
#undef PG8_SCHED
}
}

namespace attn_body {
using bf16 = __hip_bfloat16;
using bf16x8 = __attribute__((ext_vector_type(8))) short;
using s16x4 = __attribute__((ext_vector_type(4))) short;
using f32x16 = __attribute__((ext_vector_type(16))) float;
using u32x4 = __attribute__((ext_vector_type(4))) unsigned;
constexpr int D = 64, NW = 8, QBLK = 32, QB = QBLK * NW, KVBLK = 64;
__device__ __forceinline__ int crow(int r, int hi) { return (r & 3) + 8 * (r >> 2) + 4 * hi; }
#define SBAR() __builtin_amdgcn_sched_barrier(0)
__device__ __forceinline__ void wmask(f32x16& p0, f32x16& p1, int d0) {
    const float NEG = -INFINITY;
#pragma unroll
    for (int r = 0; r < 16; ++r) { const int d = d0 + (r & 3) + 8 * (r >> 2); if (d > 128 || d < -128) p0[r] = NEG; if (d + 32 > 128 || d + 32 < -128) p1[r] = NEG; }
}
constexpr int NSLOT = 3, SLOTB = 8192;
constexpr int LDS_K = 0, LDS_V = NSLOT * SLOTB, LDS_WS = 2 * NSLOT * SLOTB, LDS_OST = LDS_WS + NW * 64 * 4, LDS_BYTES = LDS_OST + NW * 4096;
__device__ __forceinline__ void glds16(const void* gsrc, unsigned lds_dst) { unsigned keep;
    asm volatile("s_mov_b32 %0, m0\n\ts_mov_b32 m0, %2\n\ts_nop 0\n\tglobal_load_lds_dwordx4 %1, off\n\ts_mov_b32 m0, %0" : "=&s"(keep) : "v"(gsrc), "s"(lds_dst) : "memory"); }
__device__ __forceinline__ float max3f(float a, float b, float c) { float r; asm("v_max3_f32 %0, %1, %2, %3" : "=v"(r) : "v"(a), "v"(b), "v"(c)); return r; }
__device__ __forceinline__ float max2f(float a, float b) { float r; asm("v_max_f32_e32 %0, %1, %2" : "=v"(r) : "v"(a), "v"(b)); return r; }
__device__ __forceinline__ float fadd_s(float a, float b) { float r; asm("v_add_f32_e32 %0, %1, %2" : "=v"(r) : "v"(a), "v"(b)); return r; }
__device__ __forceinline__ float fsub_s(float a, float b) { float r; asm("v_sub_f32_e32 %0, %1, %2" : "=v"(r) : "v"(a), "v"(b)); return r; }
typedef float f32x2_t __attribute__((ext_vector_type(2))); typedef __bf16 bf16x2_t __attribute__((ext_vector_type(2)));
__device__ __forceinline__ unsigned cvtpk_s(float lo, float hi) { f32x2_t v = {lo, hi}; bf16x2_t b = __builtin_convertvector(v, bf16x2_t); return __builtin_bit_cast(unsigned, b); }
#define WAIT_BAR(N) asm volatile("s_waitcnt vmcnt(" #N ") lgkmcnt(0)\n\ts_barrier" ::: "memory")

__device__ __forceinline__ void qkt(f32x16& p0, f32x16& p1, const char* Kslot, const bf16x8* qr, const f32x16& negm, int r32, int hi) {
    const char* kb = Kslot + hi * 1024 + r32 * 16;
#pragma unroll
    for (int d0 = 0; d0 < 4; ++d0) {
        const bf16x8 b0 = *reinterpret_cast<const bf16x8*>(kb + d0 * 2048);
        const bf16x8 b1 = *reinterpret_cast<const bf16x8*>(kb + d0 * 2048 + 512);
        if (d0 == 0) { p0 = __builtin_amdgcn_mfma_f32_32x32x16_bf16(b0, qr[0], negm, 0, 0, 0); p1 = __builtin_amdgcn_mfma_f32_32x32x16_bf16(b1, qr[0], negm, 0, 0, 0); }
        else { p0 = __builtin_amdgcn_mfma_f32_32x32x16_bf16(b0, qr[d0], p0, 0, 0, 0); p1 = __builtin_amdgcn_mfma_f32_32x32x16_bf16(b1, qr[d0], p1, 0, 0, 0); } }
}
typedef __attribute__((address_space(3))) const char* lds_cptr;
typedef short v4i16_t __attribute__((ext_vector_type(4)));
__device__ __forceinline__ void kload8(bf16x8* kf, lds_cptr kp) {
    kf[0] = *(const __attribute__((address_space(3))) bf16x8*)(kp);        kf[1] = *(const __attribute__((address_space(3))) bf16x8*)(kp + 512);
    kf[2] = *(const __attribute__((address_space(3))) bf16x8*)(kp + 2048); kf[3] = *(const __attribute__((address_space(3))) bf16x8*)(kp + 2560);
    kf[4] = *(const __attribute__((address_space(3))) bf16x8*)(kp + 4096); kf[5] = *(const __attribute__((address_space(3))) bf16x8*)(kp + 4608);
    kf[6] = *(const __attribute__((address_space(3))) bf16x8*)(kp + 6144); kf[7] = *(const __attribute__((address_space(3))) bf16x8*)(kp + 6656);
}
__device__ __forceinline__ void kload2(bf16x8* kf, lds_cptr kp, int j) { kf[2 * j] = *(const __attribute__((address_space(3))) bf16x8*)(kp + j * 2048); kf[2 * j + 1] = *(const __attribute__((address_space(3))) bf16x8*)(kp + j * 2048 + 512); }
__device__ __forceinline__ s16x4 vtr(lds_cptr p) { return __builtin_bit_cast(s16x4, __builtin_amdgcn_ds_read_tr16_b64_v4i16((__attribute__((address_space(3))) v4i16_t*)p)); }
__device__ __forceinline__ float rowmax(const f32x16& p0, const f32x16& p1) {
    float a = max3f(p0[0], p0[1], p1[0]), b = max3f(p0[2], p0[3], p1[1]); a = max3f(a, p1[2], p1[3]);
#pragma unroll
    for (int r = 4; r < 16; r += 4) { a = max3f(a, p0[r], p0[r + 1]); b = max3f(b, p0[r + 2], p0[r + 3]); a = max3f(a, p1[r], p1[r + 1]); b = max3f(b, p1[r + 2], p1[r + 3]); }
    const float m = max2f(a, b);
    auto rr = __builtin_amdgcn_permlane32_swap(__float_as_uint(m), __float_as_uint(m), false, false);
    return max2f(__uint_as_float(rr[0]), __uint_as_float(rr[1]));
}
__device__ __forceinline__ void pv(f32x16* o, int vb, bf16x8 pa0, bf16x8 pa1, bf16x8 pa2, bf16x8 pa3) {
#pragma unroll
    for (int d0 = 0; d0 < 2; ++d0) { s16x4 lo[4], hi[4];
#pragma unroll
        for (int ks = 0; ks < 4; ++ks) {
            asm volatile("ds_read_b64_tr_b16 %0,%1 offset:%c2" : "=&v"(lo[ks]) : "v"(vb), "i"(d0 * 4096 + ks * 1024) : "memory");
            asm volatile("ds_read_b64_tr_b16 %0,%1 offset:%c2" : "=&v"(hi[ks]) : "v"(vb), "i"(d0 * 4096 + ks * 1024 + 512) : "memory"); }
        asm volatile("s_waitcnt lgkmcnt(0)" ::: "memory"); SBAR();
#define PK(k) (bf16x8){lo[k][0], lo[k][1], lo[k][2], lo[k][3], hi[k][0], hi[k][1], hi[k][2], hi[k][3]}
        o[d0] = __builtin_amdgcn_mfma_f32_32x32x16_bf16(pa0, PK(0), o[d0], 0, 0, 0);
        o[d0] = __builtin_amdgcn_mfma_f32_32x32x16_bf16(pa1, PK(1), o[d0], 0, 0, 0);
        o[d0] = __builtin_amdgcn_mfma_f32_32x32x16_bf16(pa2, PK(2), o[d0], 0, 0, 0);
        o[d0] = __builtin_amdgcn_mfma_f32_32x32x16_bf16(pa3, PK(3), o[d0], 0, 0, 0);
#undef PK
    }
}
template <int THRL, bool WMASK> __device__ __forceinline__ void attn_unit(const bf16* Qw0, const bf16* __restrict__ Kc, const bf16* __restrict__ Vc, long dlat, int NT, int kd0,
                                                                         bool has_sink, float sinkl2, bf16* Ow0, char* shm, int wid) {
    const int lane = lane_fresh(), r32 = lane & 31, hi = lane >> 5;
    const bf16* Qw = Qw0 + (long)(wid * QBLK) * ZP;
    const unsigned lds0 = (unsigned)(uintptr_t)shm;
    float* wsf = (float*)(shm + LDS_WS) + wid * 64;
    const bf16* ksrc = Kc + (long)lane * ZP + wid * 8;
    const bf16* vsrc = Vc + (long)(16 * (wid & 3) + (lane >> 2)) * ZP + (wid >> 2) * 32 + (lane & 3) * 8;
    const unsigned kdst = lds0 + LDS_K + wid * 1024, vdst = lds0 + LDS_V + wid * 1024;
#define TOFF(t) (((t) < 4) ? (long)(t) * (KVBLK * ZP) : dlat + (long)((t) - 4) * (KVBLK * ZP))
#define DMA_K(t, slot) glds16(ksrc + TOFF(t), (unsigned)__builtin_amdgcn_readfirstlane(kdst + (slot)))
#define DMA_V(t, slot) glds16(vsrc + TOFF(t), (unsigned)__builtin_amdgcn_readfirstlane(vdst + (slot)))
    const int vb0 = (int)(lds0 + LDS_V) + ((lane >> 4) & 1) * 32 + (lane & 3) * 8 + (4 * hi + ((lane & 15) >> 2)) * 64;
    const char* Kbase = shm + LDS_K; bf16x8 kf[8];
    const lds_cptr shm3 = (lds_cptr)shm; const lds_cptr kp0 = shm3 + LDS_K + hi * 1024 + r32 * 16; const lds_cptr vp0 = shm3 + LDS_V + ((lane >> 4) & 1) * 32 + (lane & 3) * 8 + (4 * hi + ((lane & 15) >> 2)) * 64;
    DMA_K(0, 0); DMA_V(0, 0); DMA_K(1, SLOTB);
    bf16x8 qr[4];
#pragma unroll
    for (int d0 = 0; d0 < 4; ++d0) qr[d0] = *reinterpret_cast<const bf16x8*>(&Qw[(long)r32 * ZP + d0 * 16 + hi * 8]);
    float mhat = 0.f, l_reg = 0.f; f32x16 o[2]; f32x16 negm;
    { float zz = 0.f; asm volatile("" : "+v"(zz));
      _Pragma("unroll") for (int r = 0; r < 16; ++r) { o[0][r] = zz; o[1][r] = zz; negm[r] = zz; } }
    asm volatile("" : "+v"(negm));
    const int qrel = wid * QBLK + r32;
#define CMASK(P0, P1, t) do { if constexpr (WMASK) { if ((t) >= 4) wmask(P0, P1, kd0 + ((t) - 4) * KVBLK - qrel + 4 * hi); } } while (0)
    bool resc = false;
#define START(P0, P1) do { const float rm = rowmax(P0, P1); resc = false; \
    { const float dl = rm; mhat = fadd_s(mhat, dl); \
      _Pragma("unroll") for (int r = 0; r < 16; ++r) { P0[r] = fsub_s(P0[r], dl); P1[r] = fsub_s(P1[r], dl); } \
      _Pragma("unroll") for (int r = 0; r < 16; ++r) negm[r] = -mhat; asm volatile("" : "+v"(negm)); } \
    _Pragma("unroll") for (int r = 0; r < 16; ++r) P0[r] = __builtin_amdgcn_exp2f(P0[r]); } while (0)
#define RESC() do { if (resc) { asm volatile("s_waitcnt lgkmcnt(0)" ::: "memory"); \
      _Pragma("unroll") for (int d_ = 0; d_ < 2; ++d_) _Pragma("unroll") for (int r = 0; r < 16; ++r) o[d_][r] *= wsf[crow(r, hi)]; } } while (0)
    f32x16 pA0, pA1, pB0, pB1;
    int sl_prev = 0, sl_cur = 0, sl_next = SLOTB;
#define ROT() do { sl_prev = sl_cur; sl_cur = sl_next; sl_next = (sl_next == (NSLOT - 1) * SLOTB) ? 0 : sl_next + SLOTB; } while (0)
    DMA_K(2, 2 * SLOTB);
    WAIT_BAR(3);
    qkt(pA0, pA1, Kbase, qr, negm, r32, hi); asm volatile("s_nop 15\n\ts_nop 7" : "+v"(pA0), "+v"(pA1));
    START(pA0, pA1);
    _Pragma("unroll") for (int r = 0; r < 16; ++r) pA1[r] = __builtin_amdgcn_exp2f(pA1[r]);
    WAIT_BAR(0);
    DMA_K(3, 0); DMA_V(1, SLOTB);
    ROT();
    kload8(kf, kp0 + sl_cur);
    WAIT_BAR(2);
    s16x4 vlo[8], vhi[8]; u32x4 pw0, pw1, pw2, pw3;
#define PKW(P, B) cvtpk_s(P[B], P[B + 1])
#define PAF(k) __builtin_bit_cast(bf16x8, pw##k)
#define VFR(i) (bf16x8){vlo[i][0], vlo[i][1], vlo[i][2], vlo[i][3], vhi[i][0], vhi[i][1], vhi[i][2], vhi[i][3]}
#define PIN(x) asm volatile("" : "+v"(x))
#define MX3(a, b, c) __builtin_fmaxf(__builtin_fmaxf((a), (b)), (c))
#define GAPA(MF, A0, A1, A2, A3, W0, W1, PW) do { MF; sacc += A0; sacc += A1; sacc += A2; sacc += A3; PIN(sacc); W0; W1; PIN(PW); SBAR(); } while (0)
#define EX(v) __builtin_amdgcn_exp2f(v)
#define GAPB(MF, X, B) do { MF; X[B] = EX(X[B]); X[B + 1] = EX(X[B + 1]); X[B + 2] = EX(X[B + 2]); X[B + 3] = EX(X[B + 3]); PIN(X); SBAR(); } while (0)
#define VRD(i) do { vlo[i] = vtr(vp_ + (((i) >> 2) * 4096 + ((i) & 3) * 1024)); vhi[i] = vtr(vp_ + (((i) >> 2) * 4096 + ((i) & 3) * 1024 + 512)); } while (0)
#define KRD(G, j) do { if (G) { kload2(kf, kp0 + sl_next, j); SBAR(); } } while (0)
#define STEP(C0, C1, P0, P1, t, GK, GV, GL) do { SBAR(); \
    const lds_cptr vp_ = vp0 + sl_prev; \
    VRD(0); SBAR(); float sacc = (P0[0] + P0[1]); \
    GAPA(C0 = __builtin_amdgcn_mfma_f32_32x32x16_bf16(kf[0], qr[0], negm, 0, 0, 0), P0[2], P0[3], P0[4], P0[5],     pw0[0] = PKW(P0, 0), pw0[1] = PKW(P0, 2), pw0); \
    VRD(4); SBAR(); GAPA(C1 = __builtin_amdgcn_mfma_f32_32x32x16_bf16(kf[1], qr[0], negm, 0, 0, 0), P0[6], P0[7], P0[8], P0[9],     pw0[2] = PKW(P0, 4), pw0[3] = PKW(P0, 6), pw0); \
    VRD(1); SBAR(); GAPA(C0 = __builtin_amdgcn_mfma_f32_32x32x16_bf16(kf[2], qr[1], C0, 0, 0, 0),   P0[10], P0[11], P0[12], P0[13], pw1[0] = PKW(P0, 8), pw1[1] = PKW(P0, 10), pw1); \
    VRD(5); SBAR(); GAPA(C1 = __builtin_amdgcn_mfma_f32_32x32x16_bf16(kf[3], qr[1], C1, 0, 0, 0),   P0[14], P0[15], P1[0], P1[1],   pw1[2] = PKW(P0, 12), pw1[3] = PKW(P0, 14), pw1); \
    VRD(2); SBAR(); GAPA(C0 = __builtin_amdgcn_mfma_f32_32x32x16_bf16(kf[4], qr[2], C0, 0, 0, 0),   P1[2], P1[3], P1[4], P1[5],     pw2[0] = PKW(P1, 0), pw2[1] = PKW(P1, 2), pw2); \
    VRD(6); SBAR(); GAPA(C1 = __builtin_amdgcn_mfma_f32_32x32x16_bf16(kf[5], qr[2], C1, 0, 0, 0),   P1[6], P1[7], P1[8], P1[9],     pw2[2] = PKW(P1, 4), pw2[3] = PKW(P1, 6), pw2); \
    VRD(3); SBAR(); GAPA(C0 = __builtin_amdgcn_mfma_f32_32x32x16_bf16(kf[6], qr[3], C0, 0, 0, 0),   P1[10], P1[11], P1[12], P1[13], pw3[0] = PKW(P1, 8), pw3[1] = PKW(P1, 10), pw3); \
    VRD(7); SBAR(); GAPA(C1 = __builtin_amdgcn_mfma_f32_32x32x16_bf16(kf[7], qr[3], C1, 0, 0, 0),   P1[14], P1[15], 0.f, 0.f,       pw3[2] = PKW(P1, 12), pw3[3] = PKW(P1, 14), pw3); \
    l_reg += sacc; \
    if (GK) { DMA_K((t) + 3, sl_cur); } if (GV) { DMA_V((t) + 1, sl_next); } \
    CMASK(C0, C1, t); \
    { float a = MX3(C0[0], C0[1], C1[0]), b = MX3(C0[2], C0[3], C1[1]); a = MX3(a, C1[2], C1[3]); \
      _Pragma("unroll") for (int r = 4; r < 16; r += 4) { a = MX3(a, C0[r], C0[r + 1]); b = MX3(b, C0[r + 2], C0[r + 3]); a = MX3(a, C1[r], C1[r + 1]); b = MX3(b, C1[r + 2], C1[r + 3]); } \
      float rm = __builtin_fmaxf(a, b); { auto rr = __builtin_amdgcn_permlane32_swap(__float_as_uint(rm), __float_as_uint(rm), false, false); rm = __builtin_fmaxf(__uint_as_float(rr[0]), __uint_as_float(rr[1])); } \
      resc = false; \
      if (__builtin_expect(__any(rm > (float)THRL), 0)) { const float dl = __builtin_fmaxf(rm, 0.f); mhat += dl; \
        _Pragma("unroll") for (int r = 0; r < 16; ++r) { C0[r] -= dl; C1[r] -= dl; } \
        _Pragma("unroll") for (int r = 0; r < 16; ++r) negm[r] = -mhat; asm volatile("" : "+v"(negm)); \
        const float f = __builtin_amdgcn_exp2f(-dl); l_reg *= f; if (hi == 0) wsf[r32] = f; resc = true; } } \
    SBAR(); \
    GAPB(o[0] = __builtin_amdgcn_mfma_f32_32x32x16_bf16(PAF(0), VFR(0), o[0], 0, 0, 0), C0, 0); \
    GAPB(o[1] = __builtin_amdgcn_mfma_f32_32x32x16_bf16(PAF(0), VFR(4), o[1], 0, 0, 0), C0, 4); \
    KRD(GL, 0); GAPB(o[0] = __builtin_amdgcn_mfma_f32_32x32x16_bf16(PAF(1), VFR(1), o[0], 0, 0, 0), C0, 8); \
    KRD(GL, 1); GAPB(o[1] = __builtin_amdgcn_mfma_f32_32x32x16_bf16(PAF(1), VFR(5), o[1], 0, 0, 0), C0, 12); \
    KRD(GL, 2); GAPB(o[0] = __builtin_amdgcn_mfma_f32_32x32x16_bf16(PAF(2), VFR(2), o[0], 0, 0, 0), C1, 0); \
    KRD(GL, 3); GAPB(o[1] = __builtin_amdgcn_mfma_f32_32x32x16_bf16(PAF(2), VFR(6), o[1], 0, 0, 0), C1, 4); \
    GAPB(o[0] = __builtin_amdgcn_mfma_f32_32x32x16_bf16(PAF(3), VFR(3), o[0], 0, 0, 0), C1, 8); \
    GAPB(o[1] = __builtin_amdgcn_mfma_f32_32x32x16_bf16(PAF(3), VFR(7), o[1], 0, 0, 0), C1, 12); \
    } while (0)
    int t = 1;
    for (; t + 5 < NT; t += 2) {
        STEP(pB0, pB1, pA0, pA1, t, true, true, true);     WAIT_BAR(2); RESC(); ROT();
        STEP(pA0, pA1, pB0, pB1, t + 1, true, true, true); WAIT_BAR(2); RESC(); ROT();
    }
#define ENDW(tt) do { if ((tt) + 3 < NT) { WAIT_BAR(2); } else if ((tt) + 2 < NT) { WAIT_BAR(1); } else { WAIT_BAR(0); } } while (0)
    for (; t + 1 < NT; t += 2) {
        STEP(pB0, pB1, pA0, pA1, t, (t + 3 < NT), (t + 1 < NT), (t + 1 < NT));         ENDW(t);     RESC(); ROT();
        STEP(pA0, pA1, pB0, pB1, t + 1, (t + 4 < NT), (t + 2 < NT), (t + 2 < NT));     ENDW(t + 1); RESC(); ROT();
    }
    STEP(pB0, pB1, pA0, pA1, NT - 1, false, false, false); RESC();
    { float sacc = pB0[0] + pB0[1]; _Pragma("unroll") for (int r = 2; r < 16; ++r) sacc += pB0[r]; _Pragma("unroll") for (int r = 0; r < 16; ++r) sacc += pB1[r]; l_reg += sacc;
      pw0 = (u32x4){PKW(pB0, 0), PKW(pB0, 2), PKW(pB0, 4), PKW(pB0, 6)}; pw1 = (u32x4){PKW(pB0, 8), PKW(pB0, 10), PKW(pB0, 12), PKW(pB0, 14)}; pw2 = (u32x4){PKW(pB1, 0), PKW(pB1, 2), PKW(pB1, 4), PKW(pB1, 6)}; pw3 = (u32x4){PKW(pB1, 8), PKW(pB1, 10), PKW(pB1, 12), PKW(pB1, 14)};
      SBAR(); pv(o, vb0 + sl_cur, PAF(0), PAF(1), PAF(2), PAF(3)); }
#undef PKW
#undef PAF
#undef VFR
#undef PIN
#undef MX3
#undef GAPA
#undef GAPB
#undef EX
#undef VRD
#undef KRD
#undef STEP
#undef ENDW
    { auto rr = __builtin_amdgcn_permlane32_swap(__float_as_uint(l_reg), __float_as_uint(l_reg), false, false); l_reg = __uint_as_float(rr[0]) + __uint_as_float(rr[1]); }
    if (has_sink) l_reg += __builtin_amdgcn_exp2f(sinkl2 - mhat);
    if (hi == 0) wsf[32 + r32] = l_reg; asm volatile("s_waitcnt lgkmcnt(0)" ::: "memory");
    float rli[16];
#pragma unroll
    for (int r = 0; r < 16; ++r) rli[r] = __builtin_amdgcn_rcpf(wsf[32 + crow(r, hi)]);
    bf16* Ow = Ow0 + (long)(wid * QBLK) * YP;
    { bf16* stg = (bf16*)(shm + LDS_OST) + wid * 2048;
#pragma unroll
      for (int r = 0; r < 16; ++r) { const int orow = crow(r, hi);
#pragma unroll
        for (int d0 = 0; d0 < 2; ++d0) stg[orow * 64 + d0 * 32 + r32] = __float2bfloat16(o[d0][r] * rli[r]); }
      asm volatile("s_waitcnt lgkmcnt(0)" ::: "memory");
#pragma unroll
      for (int i = 0; i < 4; ++i) { const int row = i * 8 + (lane >> 3), ch = lane & 7; const u32x4 v = *(const u32x4*)(stg + row * 64 + ch * 8); *(u32x4*)(Ow + (long)row * YP + ch * 8) = v; } }
    asm volatile("s_waitcnt lgkmcnt(0)\n\ts_barrier" ::: "memory");
#undef DMA_K
#undef DMA_V
#undef TOFF
#undef CMASK
#undef START
#undef RESC
#undef ROT
}
constexpr int ATTN_LDS_BYTES = LDS_BYTES;
#undef SBAR
#undef WAIT_BAR
}

constexpr int NWAVES = 8, NTHREADS = NWAVES * 64;
constexpr int RING_BYTES = 131072, LDS_BYTES = 147456;
constexpr int LDSCTL_OFF = RING_BYTES, MISC_OFF = LDSCTL_OFF + 320;
#define LAS __attribute__((address_space(3)))
typedef unsigned short bf16;
typedef unsigned v4u __attribute__((ext_vector_type(4)));
typedef unsigned v2u __attribute__((ext_vector_type(2)));
typedef float f32x4 __attribute__((ext_vector_type(4)));
using pg8::cvt_pk_bf16; using pg8::bf_lo; using pg8::bf_hi;

constexpr size_t MiB = 1u << 20;
constexpr size_t WS_MOD = 0;
constexpr size_t WS_CTL = 1 * MiB, CTL_ZERO_BYTES = 16384;
constexpr size_t WS_W = 2 * MiB;
constexpr size_t LW_IN = 0;
constexpr size_t LW_POOL = LW_IN + (size_t)5120 * 1024 * 2;
constexpr size_t LW_BR = LW_POOL + (size_t)512 * 256 * 2;
constexpr size_t LW_OUT = LW_BR + (size_t)3072 * 512 * 2;
constexpr size_t LW_FF = LW_OUT + (size_t)1024 * 1024 * 2;
constexpr size_t LW_DN = LW_FF + (size_t)5632 * 1024 * 2;
constexpr size_t LW_BYTES = LW_DN + (size_t)1024 * 2816 * 2;
constexpr size_t WS_XC = WS_W + ((2 * LW_BYTES + MiB - 1) / MiB) * MiB;
constexpr size_t WS_ARENA = WS_XC + (size_t)NCTX * 1024 * 4;
constexpr size_t AR_Z = 0, AR_G = (size_t)NTOK * ZP * 2, AR_Y = AR_G + (size_t)NTOK * GP * 2, AR_H = AR_Y;
constexpr size_t AR_MRG = AR_Z;
constexpr size_t AR_U = 0, AR_SIDE = (size_t)NTOK * FF * 2, SIDE_BYTES = (size_t)(NTOK / 32) * FF * 4, AR_H2 = (size_t)NTOK * AVP * 2;
constexpr size_t AR_XF = ((AR_SIDE + 3 * SIDE_BYTES + 4095) / 4096) * 4096;
static_assert(AR_XF + (size_t)NLAT * 1024 * 4 <= AR_H2, "side buffers + XF");
constexpr size_t WS_END = WS_ARENA + (size_t)NTOK * 6656 * 2;
static_assert(AR_Y + (size_t)NTOK * YP * 2 == (size_t)NTOK * 6656 * 2 && AR_H2 + (size_t)NTOK * 1024 * 2 == (size_t)NTOK * 6656 * 2, "arena views");


#define XB_TMO      128
#define XB_XCNT(j)  (256  + 64 * (j))
#define XB_XSUB(j)  (1280 + 64 * (j))
#define XB_XGEN(j)  (2304 + 64 * (j))
#define XB_TOP      3328
#define XB_TOPGEN   3392
#define XCD_BAR_WORDS 3456
#define XB_SPIN_CAP (1u << 20)
__device__ __forceinline__ unsigned xb_ld(unsigned* p)              { return __hip_atomic_load(p, __ATOMIC_RELAXED, __HIP_MEMORY_SCOPE_AGENT); }
__device__ __forceinline__ unsigned xb_add(unsigned* p, unsigned v) { return __hip_atomic_fetch_add(p, v, __ATOMIC_RELAXED, __HIP_MEMORY_SCOPE_AGENT); }
__device__ __forceinline__ unsigned xb_xcc_id() { return (unsigned)__builtin_amdgcn_s_getreg((3 << 11) | 20) & 0xFu; }
#define XB_SPIN(cond, bar) do { unsigned _sp = 0; while (cond) { __builtin_amdgcn_s_sleep(1); \
    if ((++_sp & 255u) == 0u) { if (xb_ld(&(bar)[XB_TMO])) break; if (_sp > XB_SPIN_CAP) { atomicAdd(&(bar)[XB_TMO], 1u); break; } } } } while (0)
struct XcdBarrier { unsigned* bar; unsigned x; volatile LAS unsigned* st; };
__device__ __forceinline__ XcdBarrier xcd_barrier_post(unsigned* bar, volatile LAS unsigned* st) {
    XcdBarrier b; b.bar = bar; b.x = xb_xcc_id(); b.st = st;
    if (threadIdx.x == 0) (void)xb_add(&bar[XB_XCNT(b.x)], 1u);
    return b;
}
__device__ __forceinline__ void xcd_barrier_complete(unsigned* bar, unsigned x, unsigned& nloc, unsigned& nx) {
    const unsigned G = gridDim.x * gridDim.y * gridDim.z;
    unsigned sum, cnt, mine, sp = 0u;
    for (;;) {
        sum = 0u; cnt = 0u; mine = 0u;
#pragma unroll
        for (unsigned j = 0; j < 16; ++j) { const unsigned c = xb_ld(&bar[XB_XCNT(j)]); sum += c; cnt += (c > 0u) ? 1u : 0u; mine = (j == x) ? c : mine; }
        if (sum == G) break;
        __builtin_amdgcn_s_sleep(1);
        if ((++sp & 255u) == 0u) { if (xb_ld(&bar[XB_TMO])) break; if (sp > XB_SPIN_CAP) { atomicAdd(&bar[XB_TMO], 1u); break; } }
    }
    nloc = mine > 0u ? mine : 1u; nx = cnt > 0u ? cnt : 1u;
}
__device__ __forceinline__ void xcd_barrier(const XcdBarrier& b, int wave) {
    asm volatile("s_waitcnt vmcnt(0)" ::: "memory");
    __syncthreads();
    if (wave == 0 && lane_fresh() == 0) {
        unsigned* bar = b.bar;
        __builtin_amdgcn_s_waitcnt(0);
        unsigned nloc = b.st[0], nx = b.st[1];
        if (nloc == 0u) { xcd_barrier_complete(bar, b.x, nloc, nx); b.st[0] = nloc; b.st[1] = nx; }
        const unsigned old = xb_add(&bar[XB_XSUB(b.x)], 1u);
        const unsigned gen = old / nloc;
        if (old + 1u == (gen + 1u) * nloc) {
            __builtin_amdgcn_fence(__ATOMIC_RELEASE, "agent");
            asm volatile("s_waitcnt vmcnt(0)" ::: "memory");
            const unsigned og = xb_add(&bar[XB_TOP], 1u);
            const unsigned tg = og / nx;
            if (og + 1u == (tg + 1u) * nx) xb_add(&bar[XB_TOPGEN], 1u);
            else XB_SPIN(xb_ld(&bar[XB_TOPGEN]) == tg, bar);
            __builtin_amdgcn_fence(__ATOMIC_ACQUIRE, "agent");
            xb_add(&bar[XB_XGEN(b.x)], 1u);
            asm volatile("s_waitcnt vmcnt(0)" ::: "memory");
        } else {
            XB_SPIN(xb_ld(&bar[XB_XGEN(b.x)]) == gen, bar);
            __builtin_amdgcn_fence(__ATOMIC_ACQUIRE, "agent");
            asm volatile("s_waitcnt vmcnt(0)" ::: "memory");
        }
    }
    __syncthreads();
}

struct Args {
    const float *x, *c, *ctx, *c_ctx, *w_mod, *b_mod, *norm1_g, *norm2_g, *w_in, *w_pool_grp, *pool_scale, *win_sink, *q_norm_g, *k_norm_g,
                *w_branch, *w_gate, *b_gate, *w_out, *w_ff_gate, *w_ff_val, *conv_w, *conv_b, *w_ff_down, *final_g;
    float* out; unsigned char* ws; int ph_lo, ph_hi;
};

__device__ __forceinline__ float shx(float v, int lane, int m) { return __int_as_float(__builtin_amdgcn_ds_bpermute((lane ^ m) << 2, __float_as_int(v))); }
__device__ __forceinline__ float wave_sum(float v, int lane) {
#pragma unroll
    for (int o = 1; o < 64; o <<= 1) v += shx(v, lane, o);
    return v;
}
__device__ __forceinline__ void transpose_item(const float* W, int K, int N, bf16* WT, int ldw, int row_off, LAS float* scr, int item, int lane, bool spread = false) {
    const int nblk = N / 32, kb = item / nblk, nb = item % nblk, k0 = 64 * kb, n0 = 32 * nb;
    if (spread) row_off += 128 * (n0 >> 7);
#pragma unroll 8
    for (int i = 0; i < 32; ++i) { const int kk = 2 * i + (lane >> 5); scr[kk * 33 + (lane & 31)] = W[(size_t)(k0 + kk) * N + n0 + (lane & 31)]; }
    asm volatile("s_waitcnt lgkmcnt(0)" ::: "memory");
    const int c = lane & 7;
#pragma unroll
    for (int j = 0; j < 4; ++j) { const int n = (lane >> 3) + 8 * j; const LAS float* s = scr + (8 * c) * 33 + n;
        v4u o; o.x = cvt_pk_bf16(s[0 * 33], s[1 * 33]); o.y = cvt_pk_bf16(s[2 * 33], s[3 * 33]); o.z = cvt_pk_bf16(s[4 * 33], s[5 * 33]); o.w = cvt_pk_bf16(s[6 * 33], s[7 * 33]);
        *(v4u*)(WT + (size_t)(row_off + n0 + n) * ldw + k0 + 8 * c) = o; }
    asm volatile("s_waitcnt lgkmcnt(0)" ::: "memory");
}

__device__ __forceinline__ void prologue(const Args& A, LAS unsigned char* lds, int G, int vcu, int tid, int lane, int wave) {
    float* mod = (float*)(A.ws + WS_MOD);
    if ((int)blockIdx.x < 192) {
        LAS float* S = (LAS float*)lds; LAS float* part = (LAS float*)(lds + 17 * 1024 * 4);
        for (int idx = tid; idx < 17 * 1024; idx += NTHREADS) { const int r = idx >> 10, k = idx & 1023; const float v = (r < 16) ? A.c[r * 1024 + k] : A.c_ctx[k];
            S[idx] = v / (1.0f + __builtin_amdgcn_exp2f(-v * LOG2E)); }
        __syncthreads();
        for (int u = blockIdx.x; u < 192; u += G) {
            const int l = u / 96, n0 = (u % 96) * 64;
            float acc[17];
#pragma unroll
            for (int r = 0; r < 17; ++r) acc[r] = 0.f;
            const float* W = A.w_mod + (size_t)l * 1024 * 6144 + n0 + lane;
#pragma unroll 16
            for (int kk = 0; kk < 128; ++kk) { const int k = kk * 8 + wave; const float w = W[(size_t)k * 6144];
#pragma unroll
                for (int r = 0; r < 17; ++r) acc[r] += S[r * 1024 + k] * w; }
#pragma unroll
            for (int r = 0; r < 17; ++r) part[(wave * 17 + r) * 64 + lane] = acc[r];
            __syncthreads();
            for (int idx = tid; idx < 17 * 64; idx += NTHREADS) { const int r = idx >> 6, j = idx & 63; float s = 0.f;
#pragma unroll
                for (int w = 0; w < 8; ++w) s += part[(w * 17 + r) * 64 + j];
                mod[(size_t)(l * 17 + r) * 6144 + n0 + j] = s + A.b_mod[l * 6144 + n0 + j]; }
            __syncthreads();
        }
    }
    __syncthreads();
    LAS float* scr = (LAS float*)(lds + wave * 16384);
    const int gw = vcu * NWAVES + wave, NGW = G * NWAVES;
    constexpr int I_IN = 16 * 64, I_GATE = 16 * 32, I_BR = 8 * 32, I_OUT = 16 * 32, I_FF = 16 * 88, I_DN = 44 * 32;
    constexpr int PER_LAYER = I_IN + 3 * I_GATE + 3 * I_BR + I_OUT + 2 * I_FF + I_DN;
    for (int it = gw; it < 2 * PER_LAYER; it += NGW) {
        const int l = it / PER_LAYER; int r = it % PER_LAYER;
        unsigned char* wl = A.ws + WS_W + (size_t)l * LW_BYTES;
        if (r < I_IN) { transpose_item(A.w_in + (size_t)l * 1024 * 2048, 1024, 2048, (bf16*)(wl + LW_IN), 1024, 0, scr, r, lane); continue; } r -= I_IN;
        if (r < 3 * I_GATE) { const int i = r / I_GATE; transpose_item(A.w_gate + ((size_t)l * 3 + i) * 1024 * 1024, 1024, 1024, (bf16*)(wl + LW_IN), 1024, 2048 + i * 1024, scr, r % I_GATE, lane); continue; } r -= 3 * I_GATE;
        if (r < 3 * I_BR) { const int i = r / I_BR; transpose_item(A.w_branch + ((size_t)l * 3 + i) * 512 * 1024, 512, 1024, (bf16*)(wl + LW_BR), 512, i * 1024, scr, r % I_BR, lane); continue; } r -= 3 * I_BR;
        if (r < I_OUT) { transpose_item(A.w_out + (size_t)l * 1024 * 1024, 1024, 1024, (bf16*)(wl + LW_OUT), 1024, 0, scr, r, lane); continue; } r -= I_OUT;
        if (r < I_FF) { transpose_item(A.w_ff_gate + (size_t)l * 1024 * FF, 1024, FF, (bf16*)(wl + LW_FF), 1024, 0, scr, r, lane, true); continue; } r -= I_FF;
        if (r < I_FF) { transpose_item(A.w_ff_val + (size_t)l * 1024 * FF, 1024, FF, (bf16*)(wl + LW_FF), 1024, 128, scr, r, lane, true); continue; } r -= I_FF;
        transpose_item(A.w_ff_down + (size_t)l * FF * 1024, FF, 1024, (bf16*)(wl + LW_DN), FF, 0, scr, r, lane);
    }
    for (int idx = vcu * NTHREADS + tid; idx < 2 * 512 * 256; idx += G * NTHREADS) {
        const int l = idx / (512 * 256), e = idx % (512 * 256), n = e >> 8, k = e & 255, g = n >> 7, gk = 2 * (n >> 8) + (k >> 7);
        const float v = (gk == g) ? A.w_pool_grp[(((size_t)l * 4 + g) * 128 + (k & 127)) * 128 + (n & 127)] : 0.f;
        ((bf16*)(A.ws + WS_W + (size_t)l * LW_BYTES + LW_POOL))[e] = (bf16)(cvt_pk_bf16(v, 0.f) & 0xffffu);
    }
}

template <bool SRC_BF16>
__device__ __forceinline__ void norm_rows(const void* xlat, const void* xctx, const float* gvec, const float* modl, int which, int nrows, bf16* H, int gw, int NGW) {
    const int lane = lane_fresh(); asm volatile("" : "+s"(gw));
    constexpr int R = 4;
    for (int row0 = gw * R; row0 < nrows; row0 += NGW * R) {
        const bool lat = row0 < NLAT;
        const size_t roff = lat ? (size_t)row0 * 1024 : (size_t)(row0 - NLAT) * 1024;
        const void* srcb = lat ? xlat : xctx;
        const int b = lat ? (row0 >> 12) : NB;
        const float* shp = modl + (size_t)(b * 6 + which * 3) * 1024; const float* scp = shp + 1024;
        float v[R][2][8]; float ss[R];
#pragma unroll
        for (int r = 0; r < R; ++r)
#pragma unroll
            for (int j = 0; j < 2; ++j) { const size_t o = roff + (size_t)r * 1024 + 8 * lane + 512 * j;
                if constexpr (SRC_BF16) { const v4u w = *(const v4u*)((const bf16*)srcb + o);
                    v[r][j][0] = bf_lo(w.x); v[r][j][1] = bf_hi(w.x); v[r][j][2] = bf_lo(w.y); v[r][j][3] = bf_hi(w.y); v[r][j][4] = bf_lo(w.z); v[r][j][5] = bf_hi(w.z); v[r][j][6] = bf_lo(w.w); v[r][j][7] = bf_hi(w.w); }
                else { const f32x4 a = *(const f32x4*)((const float*)srcb + o), c = *(const f32x4*)((const float*)srcb + o + 4);
                    v[r][j][0] = a.x; v[r][j][1] = a.y; v[r][j][2] = a.z; v[r][j][3] = a.w; v[r][j][4] = c.x; v[r][j][5] = c.y; v[r][j][6] = c.z; v[r][j][7] = c.w; } }
#pragma unroll
        for (int r = 0; r < R; ++r) { float s = 0.f;
#pragma unroll
            for (int j = 0; j < 2; ++j)
#pragma unroll
                for (int i = 0; i < 8; ++i) s += v[r][j][i] * v[r][j][i];
            ss[r] = s; }
#pragma unroll
        for (int o = 1; o < 64; o <<= 1)
#pragma unroll
            for (int r = 0; r < R; ++r) ss[r] += shx(ss[r], lane, o);
#pragma unroll
        for (int j = 0; j < 2; ++j) { const int c0 = 8 * lane + 512 * j; float gm[8], sh[8];
#pragma unroll
            for (int h = 0; h < 2; ++h) { const f32x4 g = *(const f32x4*)(gvec + c0 + 4 * h), s4 = *(const f32x4*)(shp + c0 + 4 * h), sc = *(const f32x4*)(scp + c0 + 4 * h);
#pragma unroll
                for (int e = 0; e < 4; ++e) { gm[4 * h + e] = g[e] * (sc[e] + 1.0f); sh[4 * h + e] = s4[e]; } }
#pragma unroll
            for (int r = 0; r < R; ++r) { const float rstd = __builtin_amdgcn_rsqf(ss[r] * (1.f / 1024.f) + EPS); float y[8];
#pragma unroll
                for (int i = 0; i < 8; ++i) y[i] = (v[r][j][i] * rstd) * gm[i] + sh[i];
                v4u w; w.x = cvt_pk_bf16(y[0], y[1]); w.y = cvt_pk_bf16(y[2], y[3]); w.z = cvt_pk_bf16(y[4], y[5]); w.w = cvt_pk_bf16(y[6], y[7]);
                *(v4u*)(H + (size_t)(row0 + r) * 1024 + c0) = w; } }
    }
}
__device__ __forceinline__ void final_norm_rows(const float* x, float* out, const float* gvec, int gw, int NGW) {
    const int lane = lane_fresh(); asm volatile("" : "+s"(gw));
    constexpr int R = 4;
    for (int row0 = gw * R; row0 < NLAT; row0 += NGW * R) {
        f32x4 v[R][4]; float ss[R];
#pragma unroll
        for (int r = 0; r < R; ++r)
#pragma unroll
            for (int j = 0; j < 4; ++j) v[r][j] = *(const f32x4*)(x + (size_t)(row0 + r) * 1024 + 4 * lane + 256 * j);
#pragma unroll
        for (int r = 0; r < R; ++r) { float s = 0.f;
#pragma unroll
            for (int j = 0; j < 4; ++j) s += (v[r][j].x * v[r][j].x + v[r][j].y * v[r][j].y) + (v[r][j].z * v[r][j].z + v[r][j].w * v[r][j].w);
            ss[r] = s; }
#pragma unroll
        for (int o = 1; o < 64; o <<= 1)
#pragma unroll
            for (int r = 0; r < R; ++r) ss[r] += shx(ss[r], lane, o);
#pragma unroll
        for (int j = 0; j < 4; ++j) { const int c0 = 4 * lane + 256 * j; const f32x4 g = *(const f32x4*)(gvec + c0);
#pragma unroll
            for (int r = 0; r < R; ++r) { const float rstd = __builtin_amdgcn_rsqf(ss[r] * (1.f / 1024.f) + EPS); *(f32x4*)(out + (size_t)(row0 + r) * 1024 + c0) = v[r][j] * rstd * g; } }
    }
}

__device__ __forceinline__ void unpack8(const v4u w, float* v) { v[0] = bf_lo(w.x); v[1] = bf_hi(w.x); v[2] = bf_lo(w.y); v[3] = bf_hi(w.y); v[4] = bf_lo(w.z); v[5] = bf_hi(w.z); v[6] = bf_lo(w.w); v[7] = bf_hi(w.w); }
__device__ __forceinline__ v4u pack8(const float* v) { v4u w; w.x = cvt_pk_bf16(v[0], v[1]); w.y = cvt_pk_bf16(v[2], v[3]); w.z = cvt_pk_bf16(v[4], v[5]); w.w = cvt_pk_bf16(v[6], v[7]); return w; }
__device__ __forceinline__ void qk_proc(float* v, bool do_norm, const float* g, bool do_rope, bool hi_half, const float* cs, const float* sn, float scale, int lane) {
    float ss = 0.f;
#pragma unroll
    for (int i = 0; i < 8; ++i) ss += v[i] * v[i];
    ss += shx(ss, lane, 1); ss += shx(ss, lane, 2); ss += shx(ss, lane, 4);
    const float rstd = __builtin_amdgcn_rsqf(ss * (1.f / 64.f) + EPS);
#pragma unroll
    for (int i = 0; i < 8; ++i) { const float nv = v[i] * rstd * g[i]; v[i] = do_norm ? nv : v[i]; }
#pragma unroll
    for (int i = 0; i < 8; ++i) { const float pvv = shx(v[i], lane, 2);
        const float rv = hi_half ? (v[i] * cs[i] + pvv * sn[i]) : (v[i] * cs[i] - pvv * sn[i]);
        v[i] = (do_rope ? rv : v[i]) * scale; }
}
__device__ __forceinline__ void elem_phase(const Args& A, int layer, int nrows, bf16* Z, bf16* Y, int gw, int NGW) {
    const int lane = lane_fresh(); asm volatile("" : "+s"(gw));
    const int j8 = lane & 7; const bool hi_half = (j8 >> 1) & 1; const int axis = j8 >> 2, fbase = (j8 & 1) * 8;
    float inv[8], qg[8], kg[8];
#pragma unroll
    for (int i = 0; i < 8; ++i) { inv[i] = __builtin_amdgcn_exp2f(-(float)(fbase + i) * (13.287712379549449f / 16.0f)) * 0.15915494309189535f;
        qg[i] = A.q_norm_g[layer * 64 + j8 * 8 + i]; kg[i] = A.k_norm_g[layer * 64 + j8 * 8 + i]; }
    for (int row = gw; row < nrows; row += NGW) {
        const bool lat = row < NLAT;
        const int t = lat ? (row & (SEQ - 1)) : ((row - NLAT) & (CTX - 1));
        const int L = lat ? SEQ : CTX;
        bf16* zrow = Z + (size_t)row * ZP;
        const int g = lane >> 4, w2 = 1 << g; int lo = t - w2; lo = lo < 0 ? 0 : lo; int hi = t + w2; hi = hi > L ? L : hi;
        const bf16* zc = Z + (size_t)(row - t) * ZP + lane * 8;
        const v4u zero = {0u, 0u, 0u, 0u};
        v4u pw[16];
#pragma unroll
        for (int jj = 0; jj < 16; ++jj) { const int r = lo + jj; pw[jj] = (r < hi) ? *(const v4u*)(zc + (size_t)r * ZP) : zero; }
        const v4u own_w = *(const v4u*)(zrow + lane * 8);
        const v4u wq_w = *(const v4u*)(zrow + 512 + lane * 8);
        const v4u gq_w = *(const v4u*)(zrow + 1280 + lane * 8);
        const int l5 = lane & 31; const bool isg = l5 >= 16; const int kcol = isg ? 1792 + (l5 - 16) * 8 : 1024 + l5 * 8;
        const v4u k_w = *(const v4u*)(zrow + kcol);
        float acc[8];
#pragma unroll
        for (int i = 0; i < 8; ++i) acc[i] = 0.f;
#pragma unroll
        for (int jj = 0; jj < 16; ++jj) { float u[8]; unpack8(pw[jj], u);
#pragma unroll
            for (int i = 0; i < 8; ++i) acc[i] += u[i]; }
        { float own[8]; unpack8(own_w, own); const float rc = 1.0f / (float)(hi - lo);
#pragma unroll
          for (int i = 0; i < 8; ++i) acc[i] = acc[i] * rc - own[i]; }
        float cs[8], sn[8];
        { const float pos = (float)(axis ? (t & 63) : (t >> 6));
#pragma unroll
          for (int i = 0; i < 8; ++i) { float r = pos * inv[i]; r = r - __builtin_floorf(r); cs[i] = __builtin_amdgcn_cosf(r); sn[i] = __builtin_amdgcn_sinf(r); } }
        float vq[8], vg[8], vk[8];
        unpack8(wq_w, vq); qk_proc(vq, false, qg, lat, hi_half, cs, sn, C2, lane);
        unpack8(gq_w, vg); qk_proc(vg, true, qg, lat, hi_half, cs, sn, C2, lane);
        unpack8(k_w, vk);  qk_proc(vk, isg, kg, lat, hi_half, cs, sn, 1.0f, lane);
        *(v4u*)(Y + (size_t)row * YP + lane * 8) = pack8(acc);
        *(v4u*)(zrow + 512 + lane * 8) = pack8(vq);
        *(v4u*)(zrow + 1280 + lane * 8) = pack8(vg);
        if (lane < 32) *(v4u*)(zrow + kcol) = pack8(vk);
    }
}

__device__ __forceinline__ void fixup_phase(const Args& A, int layer, int nrows, bf16* U, const float* As, const float* PAs, const float* Vs, int gbase, int NT) {
    const int gtid = gbase + lane_fresh();
    const int items = (nrows / 32) * 352;
    const float* cw = A.conv_w + (size_t)layer * 3 * FF;
    for (int it = gtid; it < items; it += NT) {
        const int c8 = it % 352, brow = it / 352, side = brow & 1, col = c8 * 8;
        const int r = (brow >> 1) * 64 + (side ? 63 : 0);
        const bool lat = r < NLAT; const int L = lat ? SEQ : CTX; const int t = lat ? (r & (SEQ - 1)) : ((r - NLAT) & (CTX - 1));
        const bool has = side ? (t != L - 1) : (t != 0);
        const int nb = has ? (side ? brow + 1 : brow - 1) : brow;
        const float* wp = cw + (side ? 2 * FF : 0) + col;
        const size_t so = (size_t)brow * FF + col, sn = (size_t)nb * FF + col;
        float o[8];
#pragma unroll
        for (int h = 0; h < 2; ++h) { const f32x4 pa = *(const f32x4*)(PAs + so + 4 * h), vv = *(const f32x4*)(Vs + so + 4 * h), an = *(const f32x4*)(As + sn + 4 * h), w = *(const f32x4*)(wp + 4 * h);
#pragma unroll
            for (int e = 0; e < 4; ++e) { const float pre = pa[e] + (has ? w[e] * an[e] : 0.f); o[4 * h + e] = pre * pg8::sigmoidf_(pre) * vv[e]; } }
        *(v4u*)(U + (size_t)r * FF + col) = pack8(o);
    }
}

__device__ __forceinline__ void attention_phase(const Args& A, int layer, bool last, bf16* Z, bf16* Y, char* shm, int G, int vcu, int wave) {
    using abf = attn_body::bf16;
    asm volatile("" : "+s"(vcu), "+s"(G));
    const float* sink = A.win_sink + layer * 8;
    const int NU = NB * 8 * 16, per = (NU + G - 1) / G;
    int u0 = vcu * per, u1 = u0 + per; if (u1 > NU) u1 = NU;
    for (int u = u0; u < u1; ++u) {
        const int qb = u & 15, h = (u >> 4) & 7, b = u >> 7, kvh = h >> 2;
        const size_t qrow = (size_t)b * SEQ + qb * 256, crow0 = (size_t)NLAT + (size_t)b * CTX;
        const abf* Q = (const abf*)Z + qrow * ZP + 1280 + h * 64;
        const abf* Kc = (const abf*)Z + crow0 * ZP + 1792 + kvh * 64; const abf* Vc = (const abf*)Z + crow0 * ZP + 1920 + kvh * 64;
        const long dlat = ((long)b * SEQ - (long)crow0) * ZP;
        attn_body::attn_unit<8, false>(Q, Kc, Vc, dlat, 68, 0, false, 0.f, (abf*)Y + qrow * YP + 1024 + h * 64, shm, wave);
    }
    for (int u = u0; u < u1; ++u) {
        const int qb = u & 15, h = (u >> 4) & 7, b = u >> 7, kvh = h >> 2;
        const size_t qrow = (size_t)b * SEQ + qb * 256, crow0 = (size_t)NLAT + (size_t)b * CTX;
        int tl0 = 4 * qb - 2; tl0 = tl0 < 0 ? 0 : tl0; int tl1 = 4 * qb + 6; tl1 = tl1 > 64 ? 64 : tl1;
        const abf* Q = (const abf*)Z + qrow * ZP + 512 + h * 64;
        const abf* Kc = (const abf*)Z + crow0 * ZP + 1024 + kvh * 64; const abf* Vc = (const abf*)Z + crow0 * ZP + 1152 + kvh * 64;
        const long dlat = ((long)b * SEQ + tl0 * 64 - (long)crow0) * ZP;
        attn_body::attn_unit<8, true>(Q, Kc, Vc, dlat, 4 + (tl1 - tl0), tl0 * 64 - qb * 256, true, sink[h] * LOG2E, (abf*)Y + qrow * YP + 512 + h * 64, shm, wave);
    }
    if (!last) {
        const int NUC = 2 * NB * 8;
        for (int u = vcu; u < NUC; u += G) {
            const int mixer = u & 1, h = (u >> 1) & 7, b = u >> 4, kvh = h >> 2;
            const size_t crow0 = (size_t)NLAT + (size_t)b * CTX;
            const int qc = mixer ? 1280 : 512, kc = mixer ? 1792 : 1024, vc = mixer ? 1920 : 1152, oc = mixer ? 1024 : 512;
            attn_body::attn_unit<8, false>((const abf*)Z + crow0 * ZP + qc + h * 64, (const abf*)Z + crow0 * ZP + kc + kvh * 64, (const abf*)Z + crow0 * ZP + vc + kvh * 64, 0, 4, 0,
                                           mixer == 0, sink[h] * LOG2E, (abf*)Y + crow0 * YP + oc + h * 64, shm, wave);
        }
    }
}

__global__ void __launch_bounds__(NTHREADS, 2) fwd_megakernel(Args A) {
    extern __shared__ __attribute__((aligned(16))) unsigned char lds_raw[];
    LAS unsigned char* lds = (LAS unsigned char*)lds_raw;
    const int wave = __builtin_amdgcn_readfirstlane(threadIdx.x >> 6);
    const int G = gridDim.x; const int bx = blockIdx.x; const int vcu = (G % 8 == 0) ? (bx % 8) * (G / 8) + bx / 8 : bx;
    const int gw = vcu * NWAVES + wave, NGW = G * NWAVES;
    const int lo = A.ph_lo, hi = A.ph_hi;
    int ph = 0;
#if MK_SPLIT
#define SEAM() do { ++ph; } while (0)
#else
    cg::grid_group grid = cg::this_grid();
    for (int u = threadIdx.x; u < (LDS_BYTES - LDSCTL_OFF) / 4; u += NTHREADS) ((LAS unsigned*)(lds + LDSCTL_OFF))[u] = 0u;
    __syncthreads();
    XcdBarrier bar = xcd_barrier_post((unsigned*)(A.ws + WS_CTL), (volatile LAS unsigned*)(lds + MISC_OFF) + 8);
#define SEAM() do { if (ph == 0) grid.sync(); else xcd_barrier(bar, wave); ++ph; } while (0)
#endif
#define IN() (lo <= ph && ph < hi)
    unsigned char* ws = A.ws;
    float* mod = (float*)(ws + WS_MOD);
    bf16* XB = (bf16*)A.out;
    bf16* XCB = (bf16*)(ws + WS_XC);
    unsigned char* ar = ws + WS_ARENA;
    bf16* Z = (bf16*)(ar + AR_Z); bf16* Gt = (bf16*)(ar + AR_G); bf16* Y = (bf16*)(ar + AR_Y); bf16* H = (bf16*)(ar + AR_H);
    bf16* Mrg = (bf16*)(ar + AR_MRG); bf16* U = (bf16*)(ar + AR_U); bf16* H2 = (bf16*)(ar + AR_H2);
    float* XF = (float*)(ar + AR_XF); float* SAs = (float*)(ar + AR_SIDE); float* SPA = (float*)(ar + AR_SIDE + SIDE_BYTES); float* SVs = (float*)(ar + AR_SIDE + 2 * SIDE_BYTES);

    if (IN()) for (int rep = 0; rep < ((DUP_MASK & 32) ? 2 : 1); ++rep) { const int lane = lane_fresh(); prologue(A, lds, G, vcu, wave * 64 + lane, lane, wave); __syncthreads(); }
    SEAM();
    for (int l = 0; l < 2; ++l) {
        const bool last = (l == 1);
        const int nrows_mix = NTOK, nrows_x = last ? NLAT : NTOK;
        const int nM_mix = nrows_mix / 256, nM_x = nrows_x / 256;
        const float* modl = mod + (size_t)l * 17 * 6144;
        const unsigned char* wl = ws + WS_W + (size_t)l * LW_BYTES;
        if (IN()) { if (l == 0) norm_rows<false>(A.x, A.ctx, A.norm1_g + l * 1024, modl, 0, nrows_mix, H, gw, NGW); else norm_rows<true>(XB, XCB, A.norm1_g + l * 1024, modl, 0, nrows_mix, H, gw, NGW); }
        SEAM();
        if (IN()) for (int rep = 0; rep < ((DUP_MASK & 1) ? 2 : 1); ++rep) { pg8::Gemm g{H, (const bf16*)(wl + LW_IN), 1024, 1024, 1024, 0, 0}; pg8::Order S; S.init(nM_mix, 20, G, bx, 1, 0);
            pg8::EpiIn E{Z, Gt, A.b_gate + (size_t)l * 3072};
            pg8::gemm_phase<pg8::EpiIn, true>(lds, g, S, E, wave); }
        SEAM();
        if (IN()) elem_phase(A, l, nrows_mix, Z, Y, gw, NGW);
        SEAM();
        if (IN()) { for (int rep = 0; rep < ((DUP_MASK & 2) ? 2 : 1); ++rep) attention_phase(A, l, last, Z, Y, (char*)lds_raw, G, vcu, wave);
            pg8::Gemm g{Y, (const bf16*)(wl + LW_POOL), YP, 256, 256, 256, 0}; pg8::Order S; S.init(nM_x, 2, G, bx, 1, 1);
            pg8::EpiBf16 E{Y, YP, A.pool_scale + (size_t)l * 512};
            pg8::gemm_phase<pg8::EpiBf16, true>(lds, g, S, E, wave); }
        SEAM();
        if (IN()) for (int rep = 0; rep < ((DUP_MASK & 16) ? 2 : 1); ++rep) { pg8::Gemm g{Y, (const bf16*)(wl + LW_BR), YP, 512, 512, 512, (long)1024 * 512}; pg8::Order S; S.init(nM_x, 4, G, bx, 3, 2);
            pg8::EpiMerge E{Gt, Mrg};
            pg8::gemm_phase<pg8::EpiMerge, true>(lds, g, S, E, wave); }
        SEAM();
        if (IN()) { pg8::Gemm g{Mrg, (const bf16*)(wl + LW_OUT), 1024, 1024, 1024, 0, 0}; pg8::Order S; S.init(nM_x, 4, G, bx, 1, 0);
            if (l == 0) { pg8::EpiRes<false, true> E{A.x, A.ctx, XB, XCB, modl, 2}; pg8::gemm_phase<pg8::EpiRes<false, true>, true>(lds, g, S, E, wave); }
            else { pg8::EpiRes<true, true> E{XB, XCB, XB, XCB, modl, 2}; pg8::gemm_phase<pg8::EpiRes<true, true>, true>(lds, g, S, E, wave); } }
        SEAM();
        if (IN()) norm_rows<true>(XB, XCB, A.norm2_g + l * 1024, modl, 1, nrows_x, H2, gw, NGW);
        SEAM();
        if (IN()) for (int rep = 0; rep < ((DUP_MASK & 4) ? 2 : 1); ++rep) { pg8::Gemm g{H2, (const bf16*)(wl + LW_FF), 1024, 1024, 1024, 0, 0}; pg8::Order S; S.init(nM_x, 22, G, bx, 1, 0);
            pg8::EpiFF E{U, A.conv_w + (size_t)l * 3 * FF, A.conv_b + (size_t)l * FF, SAs, SIDE_BYTES / 4};
            pg8::gemm_phase<pg8::EpiFF, true>(lds, g, S, E, wave); }
        SEAM();
        if (IN()) fixup_phase(A, l, nrows_x, U, SAs, SPA, SVs, vcu * NTHREADS + wave * 64, G * NTHREADS);
        SEAM();
        if (IN()) { pg8::Gemm g{U, (const bf16*)(wl + LW_DN), FF, FF, FF, 0, 0}; pg8::Order S; S.init(nM_x, 4, G, bx, 1, 0);
            if (!last) { pg8::EpiRes<true, true> E{XB, XCB, XB, XCB, modl, 5}; pg8::gemm_phase<pg8::EpiRes<true, true>, true>(lds, g, S, E, wave); }
            else { pg8::EpiRes<true, false> E{XB, XCB, XF, XF, modl, 5}; pg8::gemm_phase<pg8::EpiRes<true, false>, true>(lds, g, S, E, wave); } }
        SEAM();
    }
    if (IN()) final_norm_rows(XF, A.out, A.final_g, gw, NGW);
#undef IN
#undef SEAM
}
constexpr int N_PHASES = 22;

extern "C" void kernel_launch(void* const* d_in, const int* in_sizes, int n_in, void* d_out, int out_size, void* d_ws, size_t ws_size, hipStream_t stream) {
    static int grid = 0;
    if (grid == 0) {
        if (n_in != 24 || out_size != NLAT * 1024 || ws_size < WS_END) { fprintf(stderr, "kernel_launch: unexpected shapes (n_in %d out %d ws %zu need %zu)\n", n_in, out_size, ws_size, (size_t)WS_END); grid = -1; return; }
        int dev = 0, cus = 0, per_cu = 0;
        hipGetDevice(&dev); hipDeviceGetAttribute(&cus, hipDeviceAttributeMultiprocessorCount, dev);
        if (hipFuncSetAttribute((const void*)fwd_megakernel, hipFuncAttributeMaxDynamicSharedMemorySize, LDS_BYTES) != hipSuccess) { fprintf(stderr, "kernel_launch: hipFuncSetAttribute failed\n"); grid = -1; return; }
        hipOccupancyMaxActiveBlocksPerMultiprocessor(&per_cu, (const void*)fwd_megakernel, NTHREADS, LDS_BYTES);
        (void)hipGetLastError();
        if (per_cu < 1) { fprintf(stderr, "kernel_launch: occupancy query says %d blocks per CU\n", per_cu); per_cu = 1; }
        grid = cus;
    }
    if (grid < 0) return;
    Args a{};
    const float** p = (const float**)&a;
    for (int i = 0; i < 24; ++i) p[i] = (const float*)d_in[i];
    a.out = (float*)d_out; a.ws = (unsigned char*)d_ws;
#if MK_SPLIT
    for (int ph = 0; ph < N_PHASES; ++ph) { a.ph_lo = ph; a.ph_hi = ph + 1; hipLaunchKernelGGL(fwd_megakernel, dim3(grid), dim3(NTHREADS), LDS_BYTES, stream, a); }
#else
    a.ph_lo = 0; a.ph_hi = N_PHASES;
    if (hipMemsetAsync((char*)d_ws + WS_CTL, 0, CTL_ZERO_BYTES, stream) != hipSuccess) { fprintf(stderr, "kernel_launch: memset failed\n"); return; }
    void* args[] = {&a};
    hipError_t e = hipLaunchCooperativeKernel((const void*)fwd_megakernel, dim3(grid), dim3(NTHREADS), args, LDS_BYTES, stream);
    if (e != hipSuccess) fprintf(stderr, "cooperative launch failed: %s (grid %d)\n", hipGetErrorString(e), grid);
#endif
}
```

```cpp
#include <hip/hip_runtime.h>
#include <hip/hip_cooperative_groups.h>
#include <hip/hip_bf16.h>
#include <cstdio>
#include <cstdint>
#include <cmath>
namespace cg = cooperative_groups;

#ifndef DUP_MASK
#define DUP_MASK 0
#endif
#ifndef MK_SPLIT
#define MK_SPLIT 0
#endif

constexpr int DM_ = 1024, NB = 16, SEQ = 4096, CTX = 256, NLAT = NB * SEQ, NCTX = NB * CTX, NTOK = NLAT + NCTX;
constexpr int ZP = 2048, GP = 3072, YP = 1536, FF = 2816, AVP = 2 * FF;
constexpr float EPS = 1e-6f;
constexpr float LOG2E = 1.4426950408889634f;
constexpr float C2 = 0.125f * LOG2E;

__device__ __forceinline__ int lane_fresh() { int l = (int)__builtin_amdgcn_mbcnt_hi(~0u, __builtin_amdgcn_mbcnt_lo(~0u, 0u)); asm volatile("" : "+v"(l)); return l; }

namespace pg8 {
#define PG8_LAS __attribute__((address_space(3)))
typedef unsigned short bf16_t;
typedef short bf16x8 __attribute__((ext_vector_type(8)));
typedef float f32x4 __attribute__((ext_vector_type(4)));
typedef unsigned u32x4 __attribute__((ext_vector_type(4)));
typedef unsigned u32x2 __attribute__((ext_vector_type(2)));
constexpr int BM = 256, BK = 64, HALF = 128, HTB = HALF * BK * 2, STAGE_BYTES = 8 * HTB, NXCD = 8, WGM = 8;

__host__ __device__ __forceinline__ int lds_byte(int r, int c) { const int st = (r >> 4) * 2 + (c >> 5), rr = r & 15, cc = c & 31, ob = rr * 64 + cc * 2; return st * 1024 + (ob ^ (((ob >> 9) & 1) << 5)); }
__host__ __device__ __forceinline__ void stage_rc(int b, int& R, int& C) { const int st = b / 1024, sb = b % 1024, swz = sb ^ (((sb >> 9) & 1) << 5); R = (st >> 1) * 16 + swz / 64; C = (st & 1) * 32 + (swz % 64) / 2; }
__host__ __device__ __forceinline__ int perm32(int rho) { const int n = rho >> 4, i = rho & 15; return 8 * (i >> 2) + 4 * n + (i & 3); }

struct Unit { int pm, pn, g; };
struct Gemm { const bf16_t* A; const bf16_t* Bt; int lda, ldb, K; long a_goff, b_goff; };

struct Order {
    int nM, nN, nwg, G, c, sub, gmode;
    __device__ __forceinline__ void init(int nM_, int nN_, int G_, int c_, int sub_, int gmode_) { nM = nM_; nN = nN_; nwg = nM * nN; G = G_; c = c_; sub = sub_; gmode = gmode_; }
    __device__ __forceinline__ bool next(int i, Unit& u) const {
        const int ti = (sub == 1) ? i : i / sub;
        const long L = (long)ti * G + c; if (L >= nwg) return false;
        int wgid = (int)L; { const int q = nwg / NXCD, r = nwg % NXCD, xcd = wgid % NXCD, off = wgid / NXCD; wgid = (xcd < r ? xcd * (q + 1) : r * (q + 1) + (xcd - r) * q) + off; }
        const int nig = WGM * nN, gid = wgid / nig, fm = gid * WGM, gsz = (nM - fm) < WGM ? (nM - fm) : WGM;
        u.pm = fm + ((wgid % nig) % gsz); u.pn = (wgid % nig) / gsz;
        u.g = (gmode == 0) ? 0 : ((gmode == 1) ? u.pn : (i - ti * sub));
        return true;
    }
};

typedef float f32x2_t __attribute__((ext_vector_type(2))); typedef __bf16 bf16x2_t __attribute__((ext_vector_type(2)));
__device__ __forceinline__ unsigned cvt_pk_bf16(float lo, float hi) { f32x2_t v = {lo, hi}; bf16x2_t b = __builtin_convertvector(v, bf16x2_t); return __builtin_bit_cast(unsigned, b); }
__device__ __forceinline__ float bf_lo(unsigned w) { return __uint_as_float(w << 16); }
__device__ __forceinline__ float bf_hi(unsigned w) { return __uint_as_float(w & 0xffff0000u); }
__device__ __forceinline__ float sigmoidf_(float x) { return __builtin_amdgcn_rcpf(1.0f + __builtin_amdgcn_exp2f(-x * 1.4426950408889634f)); }

struct EpiBf16 {
    static constexpr bool PERM = true;
    bf16_t* O; int ldc; const float* colscale;
    __device__ __forceinline__ void operator()(const f32x4 (&acc)[2][2][4][2], const Unit& u, int wr, int wc, int fr, int fq) const {
        int row0 = u.pm * BM + wr * 64 + fr; asm volatile("" : "+v"(row0)); const int col0 = u.pn * BM + wc * 32 + 8 * fq;
#pragma unroll
        for (int bj = 0; bj < 2; ++bj) {
            f32x4 s0 = (f32x4){1.f, 1.f, 1.f, 1.f}, s1 = s0;
            if (colscale) { s0 = *(const f32x4*)(colscale + col0 + bj * HALF); s1 = *(const f32x4*)(colscale + col0 + bj * HALF + 4); }
#pragma unroll
            for (int ai = 0; ai < 2; ++ai)
#pragma unroll
                for (int m = 0; m < 4; ++m) { bf16_t* rowp = O + (size_t)(row0 + ai * HALF + m * 16) * ldc + col0;
                    const f32x4 v0 = acc[ai][bj][m][0] * s0, v1 = acc[ai][bj][m][1] * s1;
                    u32x4 w; w.x = cvt_pk_bf16(v0[0], v0[1]); w.y = cvt_pk_bf16(v0[2], v0[3]); w.z = cvt_pk_bf16(v1[0], v1[1]); w.w = cvt_pk_bf16(v1[2], v1[3]);
                    *(u32x4*)(rowp + bj * HALF) = w; } }
    }
};
struct EpiIn {
    static constexpr bool PERM = true;
    bf16_t* Z; bf16_t* Gt; const float* bgate;
    __device__ __forceinline__ void operator()(const f32x4 (&acc)[2][2][4][2], const Unit& u, int wr, int wc, int fr, int fq) const {
        int row0 = u.pm * BM + wr * 64 + fr; asm volatile("" : "+v"(row0)); const bool isz = u.pn < 8;
        const int col0 = (isz ? u.pn * BM : (u.pn - 8) * BM) + wc * 32 + 8 * fq;
        bf16_t* base = isz ? Z : Gt; const int ldc = isz ? ZP : GP;
        f32x4 bv[2][2];
#pragma unroll
        for (int bj = 0; bj < 2; ++bj)
#pragma unroll
            for (int n = 0; n < 2; ++n) bv[bj][n] = isz ? (f32x4){0.f, 0.f, 0.f, 0.f} : *(const f32x4*)(bgate + col0 + bj * HALF + 4 * n);
#pragma unroll
        for (int ai = 0; ai < 2; ++ai)
#pragma unroll
            for (int m = 0; m < 4; ++m) { bf16_t* rowp = base + (size_t)(row0 + ai * HALF + m * 16) * ldc + col0;
#pragma unroll
                for (int bj = 0; bj < 2; ++bj) { f32x4 v0 = acc[ai][bj][m][0] + bv[bj][0], v1 = acc[ai][bj][m][1] + bv[bj][1];
                    if (!isz) {
#pragma unroll
                        for (int e = 0; e < 4; ++e) { v0[e] = sigmoidf_(v0[e]); v1[e] = sigmoidf_(v1[e]); } }
                    u32x4 w; w.x = cvt_pk_bf16(v0[0], v0[1]); w.y = cvt_pk_bf16(v0[2], v0[3]); w.z = cvt_pk_bf16(v1[0], v1[1]); w.w = cvt_pk_bf16(v1[2], v1[3]);
                    *(u32x4*)(rowp + bj * HALF) = w; } }
    }
};
struct EpiMerge {
    static constexpr bool PERM = true;
    const bf16_t* Gt; bf16_t* Mrg;
    __device__ __forceinline__ void operator()(const f32x4 (&acc)[2][2][4][2], const Unit& u, int wr, int wc, int fr, int fq) const {
        int row0 = u.pm * BM + wr * 64 + fr; asm volatile("" : "+v"(row0)); const int col0 = u.pn * BM + wc * 32 + 8 * fq;
#pragma unroll
        for (int ai = 0; ai < 2; ++ai) {
            u32x4 gw[4][2], ow[4][2];
#pragma unroll
            for (int m = 0; m < 4; ++m) { const size_t row = (size_t)(row0 + ai * HALF + m * 16);
#pragma unroll
                for (int bj = 0; bj < 2; ++bj) { gw[m][bj] = *(const u32x4*)(Gt + row * GP + u.g * 1024 + col0 + bj * HALF);
                    if (u.g != 0) ow[m][bj] = *(const u32x4*)(Mrg + row * 1024 + col0 + bj * HALF); } }
#pragma unroll
            for (int m = 0; m < 4; ++m) { const size_t row = (size_t)(row0 + ai * HALF + m * 16);
#pragma unroll
                for (int bj = 0; bj < 2; ++bj) {
                    const u32x4 g4 = gw[m][bj];
                    const f32x4 a0 = acc[ai][bj][m][0], a1 = acc[ai][bj][m][1];
                    float v[8];
                    v[0] = bf_lo(g4.x) * a0[0]; v[1] = bf_hi(g4.x) * a0[1]; v[2] = bf_lo(g4.y) * a0[2]; v[3] = bf_hi(g4.y) * a0[3];
                    v[4] = bf_lo(g4.z) * a1[0]; v[5] = bf_hi(g4.z) * a1[1]; v[6] = bf_lo(g4.w) * a1[2]; v[7] = bf_hi(g4.w) * a1[3];
                    if (u.g != 0) { const u32x4 o4 = ow[m][bj];
                        v[0] += bf_lo(o4.x); v[1] += bf_hi(o4.x); v[2] += bf_lo(o4.y); v[3] += bf_hi(o4.y); v[4] += bf_lo(o4.z); v[5] += bf_hi(o4.z); v[6] += bf_lo(o4.w); v[7] += bf_hi(o4.w); }
                    u32x4 w; w.x = cvt_pk_bf16(v[0], v[1]); w.y = cvt_pk_bf16(v[2], v[3]); w.z = cvt_pk_bf16(v[4], v[5]); w.w = cvt_pk_bf16(v[6], v[7]);
                    *(u32x4*)(Mrg + row * 1024 + col0 + bj * HALF) = w; } }
        }
    }
};
template <bool BASE_BF16, bool OUT_BF16> struct EpiRes {
    static constexpr bool PERM = false;
    const void* base_lat; const void* base_ctx; void* out_lat; void* out_ctx; const float* modl; int gate_idx;
    __device__ __forceinline__ void operator()(const f32x4 (&acc)[2][2][4][2], const Unit& u, int wr, int wc, int fr, int fq) const {
        const bool lat = u.pm < (NLAT / BM);
        const int prow = lat ? u.pm * BM : (u.pm * BM - NLAT);
        const void* base = lat ? base_lat : base_ctx; void* out = lat ? out_lat : out_ctx;
        const int b = lat ? (u.pm * BM) / SEQ : NB;
        int col0 = u.pn * BM + wc * 32 + 4 * fq; asm volatile("" : "+v"(col0));
        const float* gp = modl + (size_t)(b * 6 + gate_idx) * 1024 + col0;
        f32x4 gv[2][2];
#pragma unroll
        for (int bj = 0; bj < 2; ++bj)
#pragma unroll
            for (int n = 0; n < 2; ++n) gv[bj][n] = *(const f32x4*)(gp + bj * HALF + n * 16);
#pragma unroll
        for (int ai = 0; ai < 2; ++ai) {
            f32x4 bs[4][2][2];
#pragma unroll
            for (int m = 0; m < 4; ++m) { const size_t off = (size_t)(prow + ai * HALF + wr * 64 + m * 16 + fr) * 1024 + col0;
#pragma unroll
                for (int bj = 0; bj < 2; ++bj)
#pragma unroll
                    for (int n = 0; n < 2; ++n) { const size_t o2 = off + bj * HALF + n * 16;
                        if constexpr (BASE_BF16) { const u32x2 w = *(const u32x2*)((const bf16_t*)base + o2); bs[m][bj][n] = (f32x4){bf_lo(w.x), bf_hi(w.x), bf_lo(w.y), bf_hi(w.y)}; }
                        else bs[m][bj][n] = *(const f32x4*)((const float*)base + o2); } }
#pragma unroll
            for (int m = 0; m < 4; ++m) { const size_t off = (size_t)(prow + ai * HALF + wr * 64 + m * 16 + fr) * 1024 + col0;
#pragma unroll
                for (int bj = 0; bj < 2; ++bj)
#pragma unroll
                    for (int n = 0; n < 2; ++n) { const size_t o2 = off + bj * HALF + n * 16;
                        const f32x4 r = bs[m][bj][n] + gv[bj][n] * acc[ai][bj][m][n];
                        if constexpr (OUT_BF16) { u32x2 w; w.x = cvt_pk_bf16(r[0], r[1]); w.y = cvt_pk_bf16(r[2], r[3]); *(u32x2*)((bf16_t*)out + o2) = w; }
                        else *(f32x4*)((float*)out + o2) = r; } }
        }
    }
};
struct EpiFF {
    static constexpr bool PERM = true;
    bf16_t* U; const float* cw; const float* cb; float* As; size_t side_elems;
    __device__ __forceinline__ void operator()(const f32x4 (&acc)[2][2][4][2], const Unit& u, int wr, int wc, int fr, int fq) const {
        const int lane = fq * 16 + fr; float* PAs = As + side_elems; float* Vs = PAs + side_elems;
        int ch0 = u.pn * 128 + wc * 32 + 8 * fq; asm volatile("" : "+v"(ch0));
        const int src_up = (lane & 48) | ((fr - 1) & 15), src_dn = (lane & 48) | ((fr + 1) & 15);
#pragma unroll
        for (int h = 0; h < 2; ++h) {
            const f32x4 w0 = *(const f32x4*)(cw + ch0 + 4 * h), w1 = *(const f32x4*)(cw + 2816 + ch0 + 4 * h), w2 = *(const f32x4*)(cw + 2 * 2816 + ch0 + 4 * h), bb = *(const f32x4*)(cb + ch0 + 4 * h);
#pragma unroll
            for (int ai = 0; ai < 2; ++ai) {
                const int rblk = u.pm * 4 + ai * 2 + wr;
                float o[4][4]; f32x4 pre0, pre3;
#pragma unroll
                for (int e = 0; e < 4; ++e) {
                    float a[4], ru[4], rd[4];
#pragma unroll
                    for (int m = 0; m < 4; ++m) { a[m] = acc[ai][0][m][h][e]; ru[m] = __int_as_float(__builtin_amdgcn_ds_bpermute(src_up << 2, __float_as_int(a[m]))); rd[m] = __int_as_float(__builtin_amdgcn_ds_bpermute(src_dn << 2, __float_as_int(a[m]))); }
#pragma unroll
                    for (int m = 0; m < 4; ++m) {
                        const float ap = (fr > 0) ? ru[m] : (m > 0 ? ru[m > 0 ? m - 1 : 0] : 0.f);
                        const float an = (fr < 15) ? rd[m] : (m < 3 ? rd[m < 3 ? m + 1 : 3] : 0.f);
                        const float pre = ap * w0[e] + a[m] * w1[e] + an * w2[e] + bb[e];
                        if (m == 0) pre0[e] = pre; if (m == 3) pre3[e] = pre;
                        o[m][e] = pre * sigmoidf_(pre) * acc[ai][1][m][h][e]; }
                    __builtin_amdgcn_sched_barrier(0); }
#pragma unroll
                for (int m = 0; m < 4; ++m) { u32x2 w; w.x = cvt_pk_bf16(o[m][0], o[m][1]); w.y = cvt_pk_bf16(o[m][2], o[m][3]);
                    *(u32x2*)(U + ((size_t)rblk * 64 + m * 16 + fr) * 2816 + ch0 + 4 * h) = w; }
                if (fr == 0) { const size_t so = (size_t)(2 * rblk) * 2816 + ch0 + 4 * h; *(f32x4*)(As + so) = acc[ai][0][0][h]; *(f32x4*)(Vs + so) = acc[ai][1][0][h]; *(f32x4*)(PAs + so) = pre0; }
                if (fr == 15) { const size_t so = (size_t)(2 * rblk + 1) * 2816 + ch0 + 4 * h; *(f32x4*)(As + so) = acc[ai][0][3][h]; *(f32x4*)(Vs + so) = acc[ai][1][3][h]; *(f32x4*)(PAs + so) = pre3; }
                __builtin_amdgcn_sched_barrier(0);
            }
        }
    }
};

template <class Epi, bool ALIGN_EPI>
__device__ __forceinline__ void gemm_phase(PG8_LAS unsigned char* lds, const Gemm g, const Order& S, const Epi& E, int wid) {
    const int lane = lane_fresh(), tid = wid * 64 + lane;
    const int wr = wid >> 2, wc = wid & 3, fr = lane & 15, fq = lane >> 4;
    const int K = g.K, nt = K / BK;
    unsigned voffA[2], voffB[2];
#pragma unroll
    for (int i = 0; i < 2; ++i) { int R, C; stage_rc(tid * 16 + i * 8192, R, C); const int Rb = Epi::PERM ? ((R & ~31) + perm32(R & 31)) : R;
        voffA[i] = (unsigned)(R * g.lda + C) * 2u; voffB[i] = (unsigned)(Rb * g.ldb + C) * 2u; }
    const size_t kstep = (size_t)(BK * 2);
    const size_t hstepA = (size_t)HALF * g.lda * 2, hstepB = (size_t)HALF * g.ldb * 2;
    const size_t tstepA = 2 * hstepA, tstepB = 2 * hstepB;
    const unsigned ldsw = (unsigned)wid * 1024u;
    const int aoff = lds_byte(wr * 64 + fr, fq * 8), boff = lds_byte(wc * 32 + fr, fq * 8);
#define PG8_UA(u) ((const char*)g.A + (size_t)(u).pm * tstepA + (size_t)((long)(u).g * g.a_goff * 2))
#define PG8_UB(u) ((const char*)g.Bt + (size_t)(u).pn * tstepB + (size_t)((long)(u).g * g.b_goff * 2))
#define PG8_SA(b, h) (((b) * 2 + (h)) * HTB)
#define PG8_SB(b, h) ((4 + (b) * 2 + (h)) * HTB)
#define PG8_STAGE(bufoff, gbase, voff) do { _Pragma("unroll") for (int _i = 0; _i < 2; ++_i) \
        __builtin_amdgcn_global_load_lds((const unsigned*)((const char*)(gbase) + (voff)[_i]), (PG8_LAS unsigned*)(lds + (bufoff) + ldsw + _i * 8192), 16, 0, 0); } while (0)
#define PG8_LDA(dst, b, h) do { _Pragma("unroll") for (int m = 0; m < 4; ++m) _Pragma("unroll") for (int k = 0; k < 2; ++k) dst[m][k] = *(const PG8_LAS bf16x8*)(lds + PG8_SA(b, h) + aoff + m * 2048 + k * 1024); } while (0)
#define PG8_LDB(dst, b, h) do { _Pragma("unroll") for (int n = 0; n < 2; ++n) _Pragma("unroll") for (int k = 0; k < 2; ++k) dst[n][k] = *(const PG8_LAS bf16x8*)(lds + PG8_SB(b, h) + boff + n * 2048 + k * 1024); } while (0)
#define PG8_MMA(ai, bj, At, Bt) do { __builtin_amdgcn_s_setprio(1); _Pragma("unroll") for (int m = 0; m < 4; ++m) _Pragma("unroll") for (int n = 0; n < 2; ++n) _Pragma("unroll") for (int k = 0; k < 2; ++k) \
        acc[ai][bj][m][n] = __builtin_amdgcn_mfma_f32_16x16x32_bf16(Bt[n][k], At[m][k], acc[ai][bj][m][n], 0, 0, 0); __builtin_amdgcn_s_setprio(0); } while (0)
#define PG8_WAIT_V(n) asm volatile("s_waitcnt vmcnt(" #n ")" ::: "memory")
#define PG8_WAIT_L(n) asm volatile("s_waitcnt lgkmcnt(" #n ")" ::: "memory")
#define PG8_BAR __builtin_amdgcn_s_barrier()
#define PG8_SCHED __builtin_amdgcn_sched_barrier(0)
    Unit cur, nxt; int ui = 0;
    if (!S.next(0, cur)) return;
    f32x4 acc[2][2][4][2];
#pragma unroll
    for (int a = 0; a < 2; ++a)
#pragma unroll
        for (int b = 0; b < 2; ++b)
#pragma unroll
            for (int m = 0; m < 4; ++m)
#pragma unroll
                for (int n = 0; n < 2; ++n) acc[a][b][m][n] = (f32x4){0.f, 0.f, 0.f, 0.f};
    bf16x8 At[4][2], B0[2][2], B1[2][2];
    const char* cA = PG8_UA(cur); const char* cB = PG8_UB(cur);
    PG8_STAGE(PG8_SB(0, 0), cB, voffB); PG8_STAGE(PG8_SB(0, 1), cB + hstepB, voffB); PG8_STAGE(PG8_SA(0, 0), cA, voffA); PG8_STAGE(PG8_SA(0, 1), cA + hstepA, voffA);
    if (wr == 1) PG8_BAR;
    PG8_WAIT_V(2); PG8_BAR;
    PG8_STAGE(PG8_SB(1, 0), cB + kstep, voffB); PG8_STAGE(PG8_SA(1, 0), cA + kstep, voffA); PG8_STAGE(PG8_SB(1, 1), cB + hstepB + kstep, voffB);
    PG8_WAIT_V(6); PG8_BAR;
    for (;;) {
        const bool has_next = S.next(ui + 1, nxt);
        const char* nA = has_next ? PG8_UA(nxt) : cA; const char* nB = has_next ? PG8_UB(nxt) : cB;
        for (int t = 0; t < nt; t += 2) {
            const bool last = (t == nt - 2);
            const char* a1 = cA + (size_t)(t + 1) * kstep;
            const char* a2 = last ? nA : cA + (size_t)(t + 2) * kstep; const char* b2 = last ? nB : cB + (size_t)(t + 2) * kstep;
            const char* a3 = a2 + kstep; const char* b3 = b2 + kstep;
            PG8_LDB(B0, 0, 0); PG8_LDB(B1, 0, 1); PG8_SCHED; PG8_LDA(At, 0, 0); PG8_STAGE(PG8_SA(1, 1), a1 + hstepA, voffA);
            PG8_WAIT_V(8); PG8_WAIT_L(0); PG8_BAR; PG8_MMA(0, 0, At, B0); PG8_MMA(0, 1, At, B1); PG8_BAR; PG8_SCHED;
            PG8_LDA(At, 0, 1); PG8_STAGE(PG8_SB(0, 0), b2, voffB); PG8_STAGE(PG8_SB(0, 1), b2 + hstepB, voffB); PG8_STAGE(PG8_SA(0, 0), a2, voffA);
            PG8_WAIT_V(8); PG8_WAIT_L(0); PG8_BAR; PG8_MMA(1, 0, At, B0); PG8_MMA(1, 1, At, B1); PG8_BAR; PG8_SCHED;
            PG8_LDB(B0, 1, 0); PG8_LDB(B1, 1, 1); PG8_SCHED; PG8_LDA(At, 1, 0); PG8_STAGE(PG8_SA(0, 1), a2 + hstepA, voffA);
            PG8_WAIT_V(8); PG8_WAIT_L(0); PG8_BAR; PG8_MMA(0, 0, At, B0); PG8_MMA(0, 1, At, B1); PG8_BAR; PG8_SCHED;
            PG8_LDA(At, 1, 1); PG8_STAGE(PG8_SB(1, 0), b3, voffB); PG8_STAGE(PG8_SB(1, 1), b3 + hstepB, voffB); PG8_STAGE(PG8_SA(1, 0), a3, voffA);
            PG8_WAIT_V(8); PG8_WAIT_L(0); PG8_BAR; PG8_MMA(1, 0, At, B0); PG8_MMA(1, 1, At, B1); PG8_BAR; PG8_SCHED;
        }
        if constexpr (ALIGN_EPI) { if (wr == 0) PG8_BAR; }
        { const int l2 = lane_fresh(); E(acc, cur, wr, wc, l2 & 15, l2 >> 4); }
        if (!has_next) break;
#pragma unroll
        for (int a = 0; a < 2; ++a)
#pragma unroll
            for (int b = 0; b < 2; ++b)
#pragma unroll
                for (int m = 0; m < 4; ++m)
#pragma unroll
                    for (int n = 0; n < 2; ++n) acc[a][b][m][n] = (f32x4){0.f, 0.f, 0.f, 0.f};
        cur = nxt; cA = nA; cB = nB; ++ui;
        if constexpr (ALIGN_EPI) { if (wr == 1) PG8_BAR; }
    }
    PG8_WAIT_V(0);
    if constexpr (!ALIGN_EPI) { if (wr == 0) PG8_BAR; }
    PG8_BAR;
#undef PG8_UA
#undef PG8_UB
#undef PG8_SA
#undef PG8_SB
#undef PG8_STAGE
#undef PG8_LDA
#undef PG8_LDB
#undef PG8_MMA
#undef PG8_WAIT_V
#undef PG8_WAIT_L
#undef PG8_BAR
#undef PG8_SCHED
}
}

namespace attn_body {
using bf16 = __hip_bfloat16;
using bf16x8 = __attribute__((ext_vector_type(8))) short;
using s16x4 = __attribute__((ext_vector_type(4))) short;
using f32x16 = __attribute__((ext_vector_type(16))) float;
using u32x4 = __attribute__((ext_vector_type(4))) unsigned;
constexpr int D = 64, NW = 8, QBLK = 32, QB = QBLK * NW, KVBLK = 64;
__device__ __forceinline__ int crow(int r, int hi) { return (r & 3) + 8 * (r >> 2) + 4 * hi; }
#define SBAR() __builtin_amdgcn_sched_barrier(0)
__device__ __forceinline__ void wmask(f32x16& p0, f32x16& p1, int d0) {
    const float NEG = -INFINITY;
#pragma unroll
    for (int r = 0; r < 16; ++r) { const int d = d0 + (r & 3) + 8 * (r >> 2); if (d > 128 || d < -128) p0[r] = NEG; if (d + 32 > 128 || d + 32 < -128) p1[r] = NEG; }
}
constexpr int NSLOT = 3, SLOTB = 8192;
constexpr int LDS_K = 0, LDS_V = NSLOT * SLOTB, LDS_WS = 2 * NSLOT * SLOTB, LDS_OST = LDS_WS + NW * 64 * 4, LDS_BYTES = LDS_OST + NW * 4096;
__device__ __forceinline__ void glds16(const void* gsrc, unsigned lds_dst) { unsigned keep;
    asm volatile("s_mov_b32 %0, m0\n\ts_mov_b32 m0, %2\n\ts_nop 0\n\tglobal_load_lds_dwordx4 %1, off\n\ts_mov_b32 m0, %0" : "=&s"(keep) : "v"(gsrc), "s"(lds_dst) : "memory"); }
__device__ __forceinline__ float max3f(float a, float b, float c) { float r; asm("v_max3_f32 %0, %1, %2, %3" : "=v"(r) : "v"(a), "v"(b), "v"(c)); return r; }
__device__ __forceinline__ float max2f(float a, float b) { float r; asm("v_max_f32_e32 %0, %1, %2" : "=v"(r) : "v"(a), "v"(b)); return r; }
__device__ __forceinline__ float fadd_s(float a, float b) { float r; asm("v_add_f32_e32 %0, %1, %2" : "=v"(r) : "v"(a), "v"(b)); return r; }
__device__ __forceinline__ float fsub_s(float a, float b) { float r; asm("v_sub_f32_e32 %0, %1, %2" : "=v"(r) : "v"(a), "v"(b)); return r; }
typedef float f32x2_t __attribute__((ext_vector_type(2))); typedef __bf16 bf16x2_t __attribute__((ext_vector_type(2)));
__device__ __forceinline__ unsigned cvtpk_s(float lo, float hi) { f32x2_t v = {lo, hi}; bf16x2_t b = __builtin_convertvector(v, bf16x2_t); return __builtin_bit_cast(unsigned, b); }
#define WAIT_BAR(N) asm volatile("s_waitcnt vmcnt(" #N ") lgkmcnt(0)\n\ts_barrier" ::: "memory")

__device__ __forceinline__ void qkt(f32x16& p0, f32x16& p1, const char* Kslot, const bf16x8* qr, const f32x16& negm, int r32, int hi) {
    const char* kb = Kslot + hi * 1024 + r32 * 16;
#pragma unroll
    for (int d0 = 0; d0 < 4; ++d0) {
        const bf16x8 b0 = *reinterpret_cast<const bf16x8*>(kb + d0 * 2048);
        const bf16x8 b1 = *reinterpret_cast<const bf16x8*>(kb + d0 * 2048 + 512);
        if (d0 == 0) { p0 = __builtin_amdgcn_mfma_f32_32x32x16_bf16(b0, qr[0], negm, 0, 0, 0); p1 = __builtin_amdgcn_mfma_f32_32x32x16_bf16(b1, qr[0], negm, 0, 0, 0); }
        else { p0 = __builtin_amdgcn_mfma_f32_32x32x16_bf16(b0, qr[d0], p0, 0, 0, 0); p1 = __builtin_amdgcn_mfma_f32_32x32x16_bf16(b1, qr[d0], p1, 0, 0, 0); } }
}
typedef __attribute__((address_space(3))) const char* lds_cptr;
typedef short v4i16_t __attribute__((ext_vector_type(4)));
__device__ __forceinline__ void kload8(bf16x8* kf, lds_cptr kp) {
    kf[0] = *(const __attribute__((address_space(3))) bf16x8*)(kp);        kf[1] = *(const __attribute__((address_space(3))) bf16x8*)(kp + 512);
    kf[2] = *(const __attribute__((address_space(3))) bf16x8*)(kp + 2048); kf[3] = *(const __attribute__((address_space(3))) bf16x8*)(kp + 2560);
    kf[4] = *(const __attribute__((address_space(3))) bf16x8*)(kp + 4096); kf[5] = *(const __attribute__((address_space(3))) bf16x8*)(kp + 4608);
    kf[6] = *(const __attribute__((address_space(3))) bf16x8*)(kp + 6144); kf[7] = *(const __attribute__((address_space(3))) bf16x8*)(kp + 6656);
}
__device__ __forceinline__ void kload2(bf16x8* kf, lds_cptr kp, int j) { kf[2 * j] = *(const __attribute__((address_space(3))) bf16x8*)(kp + j * 2048); kf[2 * j + 1] = *(const __attribute__((address_space(3))) bf16x8*)(kp + j * 2048 + 512); }
__device__ __forceinline__ s16x4 vtr(lds_cptr p) { return __builtin_bit_cast(s16x4, __builtin_amdgcn_ds_read_tr16_b64_v4i16((__attribute__((address_space(3))) v4i16_t*)p)); }
__device__ __forceinline__ float rowmax(const f32x16& p0, const f32x16& p1) {
    float a = max3f(p0[0], p0[1], p1[0]), b = max3f(p0[2], p0[3], p1[1]); a = max3f(a, p1[2], p1[3]);
#pragma unroll
    for (int r = 4; r < 16; r += 4) { a = max3f(a, p0[r], p0[r + 1]); b = max3f(b, p0[r + 2], p0[r + 3]); a = max3f(a, p1[r], p1[r + 1]); b = max3f(b, p1[r + 2], p1[r + 3]); }
    const float m = max2f(a, b);
    auto rr = __builtin_amdgcn_permlane32_swap(__float_as_uint(m), __float_as_uint(m), false, false);
    return max2f(__uint_as_float(rr[0]), __uint_as_float(rr[1]));
}
__device__ __forceinline__ void pv(f32x16* o, int vb, bf16x8 pa0, bf16x8 pa1, bf16x8 pa2, bf16x8 pa3) {
#pragma unroll
    for (int d0 = 0; d0 < 2; ++d0) { s16x4 lo[4], hi[4];
#pragma unroll
        for (int ks = 0; ks < 4; ++ks) {
            asm volatile("ds_read_b64_tr_b16 %0,%1 offset:%c2" : "=&v"(lo[ks]) : "v"(vb), "i"(d0 * 4096 + ks * 1024) : "memory");
            asm volatile("ds_read_b64_tr_b16 %0,%1 offset:%c2" : "=&v"(hi[ks]) : "v"(vb), "i"(d0 * 4096 + ks * 1024 + 512) : "memory"); }
        asm volatile("s_waitcnt lgkmcnt(0)" ::: "memory"); SBAR();
#define PK(k) (bf16x8){lo[k][0], lo[k][1], lo[k][2], lo[k][3], hi[k][0], hi[k][1], hi[k][2], hi[k][3]}
        o[d0] = __builtin_amdgcn_mfma_f32_32x32x16_bf16(pa0, PK(0), o[d0], 0, 0, 0);
        o[d0] = __builtin_amdgcn_mfma_f32_32x32x16_bf16(pa1, PK(1), o[d0], 0, 0, 0);
        o[d0] = __builtin_amdgcn_mfma_f32_32x32x16_bf16(pa2, PK(2), o[d0], 0, 0, 0);
        o[d0] = __builtin_amdgcn_mfma_f32_32x32x16_bf16(pa3, PK(3), o[d0], 0, 0, 0);
#undef PK
    }
}
template <int THRL, bool WMASK> __device__ __forceinline__ void attn_unit(const bf16* Qw0, const bf16* __restrict__ Kc, const bf16* __restrict__ Vc, long dlat, int NT, int kd0,
                                                                         bool has_sink, float sinkl2, bf16* Ow0, char* shm, int wid, bool q_rope, const float* q_normg, int tpos0) {
    const int lane = lane_fresh(), r32 = lane & 31, hi = lane >> 5;
    const bf16* Qw = Qw0 + (long)(wid * QBLK) * ZP;
    const unsigned lds0 = (unsigned)(uintptr_t)shm;
    float* wsf = (float*)(shm + LDS_WS) + wid * 64;
    const bf16* ksrc = Kc + (long)lane * ZP + wid * 8;
    const bf16* vsrc = Vc + (long)(16 * (wid & 3) + (lane >> 2)) * ZP + (wid >> 2) * 32 + (lane & 3) * 8;
    const unsigned kdst = lds0 + LDS_K + wid * 1024, vdst = lds0 + LDS_V + wid * 1024;
#define TOFF(t) (((t) < 4) ? (long)(t) * (KVBLK * ZP) : dlat + (long)((t) - 4) * (KVBLK * ZP))
#define DMA_K(t, slot) glds16(ksrc + TOFF(t), (unsigned)__builtin_amdgcn_readfirstlane(kdst + (slot)))
#define DMA_V(t, slot) glds16(vsrc + TOFF(t), (unsigned)__builtin_amdgcn_readfirstlane(vdst + (slot)))
    const int vb0 = (int)(lds0 + LDS_V) + ((lane >> 4) & 1) * 32 + (lane & 3) * 8 + (4 * hi + ((lane & 15) >> 2)) * 64;
    const char* Kbase = shm + LDS_K; bf16x8 kf[8];
    const lds_cptr shm3 = (lds_cptr)shm; const lds_cptr kp0 = shm3 + LDS_K + hi * 1024 + r32 * 16; const lds_cptr vp0 = shm3 + LDS_V + ((lane >> 4) & 1) * 32 + (lane & 3) * 8 + (4 * hi + ((lane & 15) >> 2)) * 64;
    DMA_K(0, 0); DMA_V(0, 0); DMA_K(1, SLOTB);
    bf16x8 qr[4];
#pragma unroll
    for (int d0 = 0; d0 < 4; ++d0) qr[d0] = *reinterpret_cast<const bf16x8*>(&Qw[(long)r32 * ZP + d0 * 16 + hi * 8]);
    {
        float qf[4][8];
#pragma unroll
        for (int d0 = 0; d0 < 4; ++d0)
#pragma unroll
            for (int i = 0; i < 8; ++i) qf[d0][i] = __uint_as_float(((unsigned)(unsigned short)qr[d0][i]) << 16);
        if (q_normg) {
            float ssq = 0.f;
#pragma unroll
            for (int d0 = 0; d0 < 4; ++d0)
#pragma unroll
                for (int i = 0; i < 8; ++i) ssq += qf[d0][i] * qf[d0][i];
            { auto rr = __builtin_amdgcn_permlane32_swap(__float_as_uint(ssq), __float_as_uint(ssq), false, false); ssq = __uint_as_float(rr[0]) + __uint_as_float(rr[1]); }
            const float rstd = __builtin_amdgcn_rsqf(ssq * (1.f / 64.f) + EPS);
#pragma unroll
            for (int d0 = 0; d0 < 4; ++d0)
#pragma unroll
                for (int i = 0; i < 8; ++i) qf[d0][i] *= rstd * q_normg[d0 * 16 + hi * 8 + i];
        }
        if (q_rope) {
            const int t = tpos0 + wid * QBLK + r32;
#pragma unroll
            for (int a = 0; a < 2; ++a) { const float pos = (float)(a ? (t & 63) : (t >> 6));
#pragma unroll
                for (int i = 0; i < 8; ++i) { float r = pos * (__builtin_amdgcn_exp2f(-(float)(hi * 8 + i) * (13.287712379549449f / 16.0f)) * 0.15915494309189535f); r = r - __builtin_floorf(r);
                    const float c = __builtin_amdgcn_cosf(r), sn = __builtin_amdgcn_sinf(r), x1 = qf[2 * a][i], x2 = qf[2 * a + 1][i];
                    qf[2 * a][i] = x1 * c - x2 * sn; qf[2 * a + 1][i] = x2 * c + x1 * sn; } }
        }
#pragma unroll
        for (int d0 = 0; d0 < 4; ++d0) { u32x4 w; w.x = cvtpk_s(qf[d0][0] * C2, qf[d0][1] * C2); w.y = cvtpk_s(qf[d0][2] * C2, qf[d0][3] * C2); w.z = cvtpk_s(qf[d0][4] * C2, qf[d0][5] * C2); w.w = cvtpk_s(qf[d0][6] * C2, qf[d0][7] * C2);
            qr[d0] = __builtin_bit_cast(bf16x8, w); }
    }
    float mhat = 0.f, l_reg = 0.f; f32x16 o[2]; f32x16 negm;
    { float zz = 0.f; asm volatile("" : "+v"(zz));
      _Pragma("unroll") for (int r = 0; r < 16; ++r) { o[0][r] = zz; o[1][r] = zz; negm[r] = zz; } }
    asm volatile("" : "+v"(negm));
    const int qrel = wid * QBLK + r32;
#define CMASK(P0, P1, t) do { if constexpr (WMASK) { if ((t) >= 4) wmask(P0, P1, kd0 + ((t) - 4) * KVBLK - qrel + 4 * hi); } } while (0)
    bool resc = false;
#define START(P0, P1) do { const float rm = rowmax(P0, P1); resc = false; \
    { const float dl = rm; mhat = fadd_s(mhat, dl); \
      _Pragma("unroll") for (int r = 0; r < 16; ++r) { P0[r] = fsub_s(P0[r], dl); P1[r] = fsub_s(P1[r], dl); } \
      _Pragma("unroll") for (int r = 0; r < 16; ++r) negm[r] = -mhat; asm volatile("" : "+v"(negm)); } \
    _Pragma("unroll") for (int r = 0; r < 16; ++r) P0[r] = __builtin_amdgcn_exp2f(P0[r]); } while (0)
#define RESC() do { if (resc) { asm volatile("s_waitcnt lgkmcnt(0)" ::: "memory"); \
      _Pragma("unroll") for (int d_ = 0; d_ < 2; ++d_) _Pragma("unroll") for (int r = 0; r < 16; ++r) o[d_][r] *= wsf[crow(r, hi)]; } } while (0)
    f32x16 pA0, pA1, pB0, pB1;
    int sl_prev = 0, sl_cur = 0, sl_next = SLOTB;
#define ROT() do { sl_prev = sl_cur; sl_cur = sl_next; sl_next = (sl_next == (NSLOT - 1) * SLOTB) ? 0 : sl_next + SLOTB; } while (0)
    DMA_K(2, 2 * SLOTB);
    WAIT_BAR(3);
    qkt(pA0, pA1, Kbase, qr, negm, r32, hi); asm volatile("s_nop 15\n\ts_nop 7" : "+v"(pA0), "+v"(pA1));
    START(pA0, pA1);
    _Pragma("unroll") for (int r = 0; r < 16; ++r) pA1[r] = __builtin_amdgcn_exp2f(pA1[r]);
    WAIT_BAR(0);
    DMA_K(3, 0); DMA_V(1, SLOTB);
    ROT();
    kload8(kf, kp0 + sl_cur);
    WAIT_BAR(2);
    s16x4 vlo[8], vhi[8]; u32x4 pw0, pw1, pw2, pw3;
#define PKW(P, B) cvtpk_s(P[B], P[B + 1])
#define PAF(k) __builtin_bit_cast(bf16x8, pw##k)
#define VFR(i) (bf16x8){vlo[i][0], vlo[i][1], vlo[i][2], vlo[i][3], vhi[i][0], vhi[i][1], vhi[i][2], vhi[i][3]}
#define PIN(x) asm volatile("" : "+v"(x))
#define MX3(a, b, c) __builtin_fmaxf(__builtin_fmaxf((a), (b)), (c))
#define GAPA(MF, A0, A1, A2, A3, W0, W1, PW) do { MF; sacc += A0; sacc += A1; sacc += A2; sacc += A3; PIN(sacc); W0; W1; PIN(PW); SBAR(); } while (0)
#define EX(v) __builtin_amdgcn_exp2f(v)
#define GAPB(MF, X, B) do { MF; X[B] = EX(X[B]); X[B + 1] = EX(X[B + 1]); X[B + 2] = EX(X[B + 2]); X[B + 3] = EX(X[B + 3]); PIN(X); SBAR(); } while (0)
#define VRD(i) do { vlo[i] = vtr(vp_ + (((i) >> 2) * 4096 + ((i) & 3) * 1024)); vhi[i] = vtr(vp_ + (((i) >> 2) * 4096 + ((i) & 3) * 1024 + 512)); } while (0)
#define KRD(G, j) do { if (G) { kload2(kf, kp0 + sl_next, j); SBAR(); } } while (0)
#define STEP(C0, C1, P0, P1, t, GK, GV, GL) do { SBAR(); \
    const lds_cptr vp_ = vp0 + sl_prev; \
    VRD(0); SBAR(); float sacc = (P0[0] + P0[1]); \
    GAPA(C0 = __builtin_amdgcn_mfma_f32_32x32x16_bf16(kf[0], qr[0], negm, 0, 0, 0), P0[2], P0[3], P0[4], P0[5],     pw0[0] = PKW(P0, 0), pw0[1] = PKW(P0, 2), pw0); \
    VRD(4); SBAR(); GAPA(C1 = __builtin_amdgcn_mfma_f32_32x32x16_bf16(kf[1], qr[0], negm, 0, 0, 0), P0[6], P0[7], P0[8], P0[9],     pw0[2] = PKW(P0, 4), pw0[3] = PKW(P0, 6), pw0); \
    VRD(1); SBAR(); GAPA(C0 = __builtin_amdgcn_mfma_f32_32x32x16_bf16(kf[2], qr[1], C0, 0, 0, 0),   P0[10], P0[11], P0[12], P0[13], pw1[0] = PKW(P0, 8), pw1[1] = PKW(P0, 10), pw1); \
    VRD(5); SBAR(); GAPA(C1 = __builtin_amdgcn_mfma_f32_32x32x16_bf16(kf[3], qr[1], C1, 0, 0, 0),   P0[14], P0[15], P1[0], P1[1],   pw1[2] = PKW(P0, 12), pw1[3] = PKW(P0, 14), pw1); \
    VRD(2); SBAR(); GAPA(C0 = __builtin_amdgcn_mfma_f32_32x32x16_bf16(kf[4], qr[2], C0, 0, 0, 0),   P1[2], P1[3], P1[4], P1[5],     pw2[0] = PKW(P1, 0), pw2[1] = PKW(P1, 2), pw2); \
    VRD(6); SBAR(); GAPA(C1 = __builtin_amdgcn_mfma_f32_32x32x16_bf16(kf[5], qr[2], C1, 0, 0, 0),   P1[6], P1[7], P1[8], P1[9],     pw2[2] = PKW(P1, 4), pw2[3] = PKW(P1, 6), pw2); \
    VRD(3); SBAR(); GAPA(C0 = __builtin_amdgcn_mfma_f32_32x32x16_bf16(kf[6], qr[3], C0, 0, 0, 0),   P1[10], P1[11], P1[12], P1[13], pw3[0] = PKW(P1, 8), pw3[1] = PKW(P1, 10), pw3); \
    VRD(7); SBAR(); GAPA(C1 = __builtin_amdgcn_mfma_f32_32x32x16_bf16(kf[7], qr[3], C1, 0, 0, 0),   P1[14], P1[15], 0.f, 0.f,       pw3[2] = PKW(P1, 12), pw3[3] = PKW(P1, 14), pw3); \
    l_reg += sacc; \
    if (GK) { DMA_K((t) + 3, sl_cur); } if (GV) { DMA_V((t) + 1, sl_next); } \
    CMASK(C0, C1, t); \
    { float a = MX3(C0[0], C0[1], C1[0]), b = MX3(C0[2], C0[3], C1[1]); a = MX3(a, C1[2], C1[3]); \
      _Pragma("unroll") for (int r = 4; r < 16; r += 4) { a = MX3(a, C0[r], C0[r + 1]); b = MX3(b, C0[r + 2], C0[r + 3]); a = MX3(a, C1[r], C1[r + 1]); b = MX3(b, C1[r + 2], C1[r + 3]); } \
      float rm = __builtin_fmaxf(a, b); { auto rr = __builtin_amdgcn_permlane32_swap(__float_as_uint(rm), __float_as_uint(rm), false, false); rm = __builtin_fmaxf(__uint_as_float(rr[0]), __uint_as_float(rr[1])); } \
      resc = false; \
      if (__builtin_expect(__any(rm > (float)THRL), 0)) { const float dl = __builtin_fmaxf(rm, 0.f); mhat += dl; \
        _Pragma("unroll") for (int r = 0; r < 16; ++r) { C0[r] -= dl; C1[r] -= dl; } \
        _Pragma("unroll") for (int r = 0; r < 16; ++r) negm[r] = -mhat; asm volatile("" : "+v"(negm)); \
        const float f = __builtin_amdgcn_exp2f(-dl); l_reg *= f; if (hi == 0) wsf[r32] = f; resc = true; } } \
    SBAR(); \
    GAPB(o[0] = __builtin_amdgcn_mfma_f32_32x32x16_bf16(PAF(0), VFR(0), o[0], 0, 0, 0), C0, 0); \
    GAPB(o[1] = __builtin_amdgcn_mfma_f32_32x32x16_bf16(PAF(0), VFR(4), o[1], 0, 0, 0), C0, 4); \
    KRD(GL, 0); GAPB(o[0] = __builtin_amdgcn_mfma_f32_32x32x16_bf16(PAF(1), VFR(1), o[0], 0, 0, 0), C0, 8); \
    KRD(GL, 1); GAPB(o[1] = __builtin_amdgcn_mfma_f32_32x32x16_bf16(PAF(1), VFR(5), o[1], 0, 0, 0), C0, 12); \
    KRD(GL, 2); GAPB(o[0] = __builtin_amdgcn_mfma_f32_32x32x16_bf16(PAF(2), VFR(2), o[0], 0, 0, 0), C1, 0); \
    KRD(GL, 3); GAPB(o[1] = __builtin_amdgcn_mfma_f32_32x32x16_bf16(PAF(2), VFR(6), o[1], 0, 0, 0), C1, 4); \
    GAPB(o[0] = __builtin_amdgcn_mfma_f32_32x32x16_bf16(PAF(3), VFR(3), o[0], 0, 0, 0), C1, 8); \
    GAPB(o[1] = __builtin_amdgcn_mfma_f32_32x32x16_bf16(PAF(3), VFR(7), o[1], 0, 0, 0), C1, 12); \
    } while (0)
    int t = 1;
    for (; t + 5 < NT; t += 2) {
        STEP(pB0, pB1, pA0, pA1, t, true, true, true);     WAIT_BAR(2); RESC(); ROT();
        STEP(pA0, pA1, pB0, pB1, t + 1, true, true, true); WAIT_BAR(2); RESC(); ROT();
    }
#define ENDW(tt) do { if ((tt) + 3 < NT) { WAIT_BAR(2); } else if ((tt) + 2 < NT) { WAIT_BAR(1); } else { WAIT_BAR(0); } } while (0)
    for (; t + 1 < NT; t += 2) {
        STEP(pB0, pB1, pA0, pA1, t, (t + 3 < NT), (t + 1 < NT), (t + 1 < NT));         ENDW(t);     RESC(); ROT();
        STEP(pA0, pA1, pB0, pB1, t + 1, (t + 4 < NT), (t + 2 < NT), (t + 2 < NT));     ENDW(t + 1); RESC(); ROT();
    }
    STEP(pB0, pB1, pA0, pA1, NT - 1, false, false, false); RESC();
    { float sacc = pB0[0] + pB0[1]; _Pragma("unroll") for (int r = 2; r < 16; ++r) sacc += pB0[r]; _Pragma("unroll") for (int r = 0; r < 16; ++r) sacc += pB1[r]; l_reg += sacc;
      pw0 = (u32x4){PKW(pB0, 0), PKW(pB0, 2), PKW(pB0, 4), PKW(pB0, 6)}; pw1 = (u32x4){PKW(pB0, 8), PKW(pB0, 10), PKW(pB0, 12), PKW(pB0, 14)}; pw2 = (u32x4){PKW(pB1, 0), PKW(pB1, 2), PKW(pB1, 4), PKW(pB1, 6)}; pw3 = (u32x4){PKW(pB1, 8), PKW(pB1, 10), PKW(pB1, 12), PKW(pB1, 14)};
      SBAR(); pv(o, vb0 + sl_cur, PAF(0), PAF(1), PAF(2), PAF(3)); }
#undef PKW
#undef PAF
#undef VFR
#undef PIN
#undef MX3
#undef GAPA
#undef GAPB
#undef EX
#undef VRD
#undef KRD
#undef STEP
#undef ENDW
    { auto rr = __builtin_amdgcn_permlane32_swap(__float_as_uint(l_reg), __float_as_uint(l_reg), false, false); l_reg = __uint_as_float(rr[0]) + __uint_as_float(rr[1]); }
    if (has_sink) l_reg += __builtin_amdgcn_exp2f(sinkl2 - mhat);
    if (hi == 0) wsf[32 + r32] = l_reg; asm volatile("s_waitcnt lgkmcnt(0)" ::: "memory");
    float rli[16];
#pragma unroll
    for (int r = 0; r < 16; ++r) rli[r] = __builtin_amdgcn_rcpf(wsf[32 + crow(r, hi)]);
    bf16* Ow = Ow0 + (long)(wid * QBLK) * YP;
    { bf16* stg = (bf16*)(shm + LDS_OST) + wid * 2048;
#pragma unroll
      for (int r = 0; r < 16; ++r) { const int orow = crow(r, hi);
#pragma unroll
        for (int d0 = 0; d0 < 2; ++d0) stg[orow * 64 + d0 * 32 + r32] = __float2bfloat16(o[d0][r] * rli[r]); }
      asm volatile("s_waitcnt lgkmcnt(0)" ::: "memory");
#pragma unroll
      for (int i = 0; i < 4; ++i) { const int row = i * 8 + (lane >> 3), ch = lane & 7; const u32x4 v = *(const u32x4*)(stg + row * 64 + ch * 8); *(u32x4*)(Ow + (long)row * YP + ch * 8) = v; } }
    asm volatile("s_waitcnt lgkmcnt(0)\n\ts_barrier" ::: "memory");
#undef DMA_K
#undef DMA_V
#undef TOFF
#undef CMASK
#undef START
#undef RESC
#undef ROT
}
constexpr int ATTN_LDS_BYTES = LDS_BYTES;
#undef SBAR
#undef WAIT_BAR
}

constexpr int NWAVES = 8, NTHREADS = NWAVES * 64;
constexpr int RING_BYTES = 131072, LDS_BYTES = 147456;
constexpr int LDSCTL_OFF = RING_BYTES, MISC_OFF = LDSCTL_OFF + 320;
#define LAS __attribute__((address_space(3)))
typedef unsigned short bf16;
typedef unsigned v4u __attribute__((ext_vector_type(4)));
typedef unsigned v2u __attribute__((ext_vector_type(2)));
typedef float f32x4 __attribute__((ext_vector_type(4)));
using pg8::cvt_pk_bf16; using pg8::bf_lo; using pg8::bf_hi;

constexpr size_t MiB = 1u << 20;
constexpr size_t WS_MOD = 0;
constexpr size_t WS_CTL = 1 * MiB, CTL_ZERO_BYTES = 16384;
constexpr size_t WS_W = 2 * MiB;
constexpr size_t LW_IN = 0;
constexpr size_t LW_POOL = LW_IN + (size_t)5120 * 1024 * 2;
constexpr size_t LW_BR = LW_POOL + (size_t)512 * 256 * 2;
constexpr size_t LW_OUT = LW_BR + (size_t)3072 * 512 * 2;
constexpr size_t LW_FF = LW_OUT + (size_t)1024 * 1024 * 2;
constexpr size_t LW_DN = LW_FF + (size_t)5632 * 1024 * 2;
constexpr size_t LW_BYTES = LW_DN + (size_t)1024 * 2816 * 2;
constexpr size_t WS_XC = WS_W + ((2 * LW_BYTES + MiB - 1) / MiB) * MiB;
constexpr size_t WS_ARENA = WS_XC + (size_t)NCTX * 1024 * 4;
constexpr size_t AR_Z = 0, AR_G = (size_t)NTOK * ZP * 2, AR_Y = AR_G + (size_t)NTOK * GP * 2, AR_H = AR_Y;
constexpr size_t AR_MRG = AR_Z;
constexpr size_t AR_U = 0, AR_SIDE = (size_t)NTOK * FF * 2, SIDE_BYTES = (size_t)(NTOK / 32) * FF * 4, AR_H2 = (size_t)NTOK * AVP * 2;
constexpr size_t AR_XF = ((AR_SIDE + 3 * SIDE_BYTES + 4095) / 4096) * 4096;
static_assert(AR_XF + (size_t)NLAT * 1024 * 4 <= AR_H2, "side buffers + XF");
constexpr size_t WS_END = WS_ARENA + (size_t)NTOK * 6656 * 2;
static_assert(AR_Y + (size_t)NTOK * YP * 2 == (size_t)NTOK * 6656 * 2 && AR_H2 + (size_t)NTOK * 1024 * 2 == (size_t)NTOK * 6656 * 2, "arena views");


#define XB_TMO      128
#define XB_XCNT(j)  (256  + 64 * (j))
#define XB_XSUB(j)  (1280 + 64 * (j))
#define XB_XGEN(j)  (2304 + 64 * (j))
#define XB_TOP      3328
#define XB_TOPGEN   3392
#define XCD_BAR_WORDS 3456
#define XB_SPIN_CAP (1u << 20)
__device__ __forceinline__ unsigned xb_ld(unsigned* p)              { return __hip_atomic_load(p, __ATOMIC_RELAXED, __HIP_MEMORY_SCOPE_AGENT); }
__device__ __forceinline__ unsigned xb_add(unsigned* p, unsigned v) { return __hip_atomic_fetch_add(p, v, __ATOMIC_RELAXED, __HIP_MEMORY_SCOPE_AGENT); }
__device__ __forceinline__ unsigned xb_xcc_id() { return (unsigned)__builtin_amdgcn_s_getreg((3 << 11) | 20) & 0xFu; }
#define XB_SPIN(cond, bar) do { unsigned _sp = 0; while (cond) { __builtin_amdgcn_s_sleep(1); \
    if ((++_sp & 255u) == 0u) { if (xb_ld(&(bar)[XB_TMO])) break; if (_sp > XB_SPIN_CAP) { atomicAdd(&(bar)[XB_TMO], 1u); break; } } } } while (0)
struct XcdBarrier { unsigned* bar; unsigned x; volatile LAS unsigned* st; };
__device__ __forceinline__ XcdBarrier xcd_barrier_post(unsigned* bar, volatile LAS unsigned* st) {
    XcdBarrier b; b.bar = bar; b.x = xb_xcc_id(); b.st = st;
    if (threadIdx.x == 0) (void)xb_add(&bar[XB_XCNT(b.x)], 1u);
    return b;
}
__device__ __forceinline__ void xcd_barrier_complete(unsigned* bar, unsigned x, unsigned& nloc, unsigned& nx) {
    const unsigned G = gridDim.x * gridDim.y * gridDim.z;
    unsigned sum, cnt, mine, sp = 0u;
    for (;;) {
        sum = 0u; cnt = 0u; mine = 0u;
#pragma unroll
        for (unsigned j = 0; j < 16; ++j) { const unsigned c = xb_ld(&bar[XB_XCNT(j)]); sum += c; cnt += (c > 0u) ? 1u : 0u; mine = (j == x) ? c : mine; }
        if (sum == G) break;
        __builtin_amdgcn_s_sleep(1);
        if ((++sp & 255u) == 0u) { if (xb_ld(&bar[XB_TMO])) break; if (sp > XB_SPIN_CAP) { atomicAdd(&bar[XB_TMO], 1u); break; } }
    }
    nloc = mine > 0u ? mine : 1u; nx = cnt > 0u ? cnt : 1u;
}
__device__ __forceinline__ void xcd_barrier(const XcdBarrier& b, int wave) {
    asm volatile("s_waitcnt vmcnt(0)" ::: "memory");
    __syncthreads();
    if (wave == 0 && lane_fresh() == 0) {
        unsigned* bar = b.bar;
        __builtin_amdgcn_s_waitcnt(0);
        unsigned nloc = b.st[0], nx = b.st[1];
        if (nloc == 0u) { xcd_barrier_complete(bar, b.x, nloc, nx); b.st[0] = nloc; b.st[1] = nx; }
        const unsigned old = xb_add(&bar[XB_XSUB(b.x)], 1u);
        const unsigned gen = old / nloc;
        if (old + 1u == (gen + 1u) * nloc) {
            __builtin_amdgcn_fence(__ATOMIC_RELEASE, "agent");
            asm volatile("s_waitcnt vmcnt(0)" ::: "memory");
            const unsigned og = xb_add(&bar[XB_TOP], 1u);
            const unsigned tg = og / nx;
            if (og + 1u == (tg + 1u) * nx) xb_add(&bar[XB_TOPGEN], 1u);
            else XB_SPIN(xb_ld(&bar[XB_TOPGEN]) == tg, bar);
            __builtin_amdgcn_fence(__ATOMIC_ACQUIRE, "agent");
            xb_add(&bar[XB_XGEN(b.x)], 1u);
            asm volatile("s_waitcnt vmcnt(0)" ::: "memory");
        } else {
            XB_SPIN(xb_ld(&bar[XB_XGEN(b.x)]) == gen, bar);
            __builtin_amdgcn_fence(__ATOMIC_ACQUIRE, "agent");
            asm volatile("s_waitcnt vmcnt(0)" ::: "memory");
        }
    }
    __syncthreads();
}

struct Args {
    const float *x, *c, *ctx, *c_ctx, *w_mod, *b_mod, *norm1_g, *norm2_g, *w_in, *w_pool_grp, *pool_scale, *win_sink, *q_norm_g, *k_norm_g,
                *w_branch, *w_gate, *b_gate, *w_out, *w_ff_gate, *w_ff_val, *conv_w, *conv_b, *w_ff_down, *final_g;
    float* out; unsigned char* ws; int ph_lo, ph_hi;
};

__device__ __forceinline__ float shx(float v, int lane, int m) { return __int_as_float(__builtin_amdgcn_ds_bpermute((lane ^ m) << 2, __float_as_int(v))); }
__device__ __forceinline__ float wave_sum(float v, int lane) {
#pragma unroll
    for (int o = 1; o < 64; o <<= 1) v += shx(v, lane, o);
    return v;
}
__device__ __forceinline__ void transpose_item(const float* W, int K, int N, bf16* WT, int ldw, int row_off, LAS float* scr, int item, int lane, bool spread = false) {
    const int nblk = N / 32, kb = item / nblk, nb = item % nblk, k0 = 64 * kb, n0 = 32 * nb;
    if (spread) row_off += 128 * (n0 >> 7);
#pragma unroll 8
    for (int i = 0; i < 32; ++i) { const int kk = 2 * i + (lane >> 5); scr[kk * 33 + (lane & 31)] = W[(size_t)(k0 + kk) * N + n0 + (lane & 31)]; }
    asm volatile("s_waitcnt lgkmcnt(0)" ::: "memory");
    const int c = lane & 7;
#pragma unroll
    for (int j = 0; j < 4; ++j) { const int n = (lane >> 3) + 8 * j; const LAS float* s = scr + (8 * c) * 33 + n;
        v4u o; o.x = cvt_pk_bf16(s[0 * 33], s[1 * 33]); o.y = cvt_pk_bf16(s[2 * 33], s[3 * 33]); o.z = cvt_pk_bf16(s[4 * 33], s[5 * 33]); o.w = cvt_pk_bf16(s[6 * 33], s[7 * 33]);
        *(v4u*)(WT + (size_t)(row_off + n0 + n) * ldw + k0 + 8 * c) = o; }
    asm volatile("s_waitcnt lgkmcnt(0)" ::: "memory");
}

__device__ __forceinline__ void prologue(const Args& A, LAS unsigned char* lds, int G, int vcu, int tid, int lane, int wave) {
    float* mod = (float*)(A.ws + WS_MOD);
    if ((int)blockIdx.x < 192) {
        LAS float* S = (LAS float*)lds; LAS float* part = (LAS float*)(lds + 17 * 1024 * 4);
        for (int idx = tid; idx < 17 * 1024; idx += NTHREADS) { const int r = idx >> 10, k = idx & 1023; const float v = (r < 16) ? A.c[r * 1024 + k] : A.c_ctx[k];
            S[idx] = v / (1.0f + __builtin_amdgcn_exp2f(-v * LOG2E)); }
        __syncthreads();
        for (int u = blockIdx.x; u < 192; u += G) {
            const int l = u / 96, n0 = (u % 96) * 64;
            float acc[17];
#pragma unroll
            for (int r = 0; r < 17; ++r) acc[r] = 0.f;
            const float* W = A.w_mod + (size_t)l * 1024 * 6144 + n0 + lane;
#pragma unroll 16
            for (int kk = 0; kk < 128; ++kk) { const int k = kk * 8 + wave; const float w = W[(size_t)k * 6144];
#pragma unroll
                for (int r = 0; r < 17; ++r) acc[r] += S[r * 1024 + k] * w; }
#pragma unroll
            for (int r = 0; r < 17; ++r) part[(wave * 17 + r) * 64 + lane] = acc[r];
            __syncthreads();
            for (int idx = tid; idx < 17 * 64; idx += NTHREADS) { const int r = idx >> 6, j = idx & 63; float s = 0.f;
#pragma unroll
                for (int w = 0; w < 8; ++w) s += part[(w * 17 + r) * 64 + j];
                mod[(size_t)(l * 17 + r) * 6144 + n0 + j] = s + A.b_mod[l * 6144 + n0 + j]; }
            __syncthreads();
        }
    }
    __syncthreads();
    LAS float* scr = (LAS float*)(lds + wave * 16384);
    const int gw = vcu * NWAVES + wave, NGW = G * NWAVES;
    constexpr int I_IN = 16 * 64, I_GATE = 16 * 32, I_BR = 8 * 32, I_OUT = 16 * 32, I_FF = 16 * 88, I_DN = 44 * 32;
    constexpr int PER_LAYER = I_IN + 3 * I_GATE + 3 * I_BR + I_OUT + 2 * I_FF + I_DN;
    for (int it = gw; it < 2 * PER_LAYER; it += NGW) {
        const int l = it / PER_LAYER; int r = it % PER_LAYER;
        unsigned char* wl = A.ws + WS_W + (size_t)l * LW_BYTES;
        if (r < I_IN) { transpose_item(A.w_in + (size_t)l * 1024 * 2048, 1024, 2048, (bf16*)(wl + LW_IN), 1024, 0, scr, r, lane); continue; } r -= I_IN;
        if (r < 3 * I_GATE) { const int i = r / I_GATE; transpose_item(A.w_gate + ((size_t)l * 3 + i) * 1024 * 1024, 1024, 1024, (bf16*)(wl + LW_IN), 1024, 2048 + i * 1024, scr, r % I_GATE, lane); continue; } r -= 3 * I_GATE;
        if (r < 3 * I_BR) { const int i = r / I_BR; transpose_item(A.w_branch + ((size_t)l * 3 + i) * 512 * 1024, 512, 1024, (bf16*)(wl + LW_BR), 512, i * 1024, scr, r % I_BR, lane); continue; } r -= 3 * I_BR;
        if (r < I_OUT) { transpose_item(A.w_out + (size_t)l * 1024 * 1024, 1024, 1024, (bf16*)(wl + LW_OUT), 1024, 0, scr, r, lane); continue; } r -= I_OUT;
        if (r < I_FF) { transpose_item(A.w_ff_gate + (size_t)l * 1024 * FF, 1024, FF, (bf16*)(wl + LW_FF), 1024, 0, scr, r, lane, true); continue; } r -= I_FF;
        if (r < I_FF) { transpose_item(A.w_ff_val + (size_t)l * 1024 * FF, 1024, FF, (bf16*)(wl + LW_FF), 1024, 128, scr, r, lane, true); continue; } r -= I_FF;
        transpose_item(A.w_ff_down + (size_t)l * FF * 1024, FF, 1024, (bf16*)(wl + LW_DN), FF, 0, scr, r, lane);
    }
    for (int idx = vcu * NTHREADS + tid; idx < 2 * 512 * 256; idx += G * NTHREADS) {
        const int l = idx / (512 * 256), e = idx % (512 * 256), n = e >> 8, k = e & 255, g = n >> 7, gk = 2 * (n >> 8) + (k >> 7);
        const float v = (gk == g) ? A.w_pool_grp[(((size_t)l * 4 + g) * 128 + (k & 127)) * 128 + (n & 127)] : 0.f;
        ((bf16*)(A.ws + WS_W + (size_t)l * LW_BYTES + LW_POOL))[e] = (bf16)(cvt_pk_bf16(v, 0.f) & 0xffffu);
    }
}

template <bool SRC_BF16>
__device__ __forceinline__ void norm_rows(const void* xlat, const void* xctx, const float* gvec, const float* modl, int which, int nrows, bf16* H, int gw, int NGW) {
    const int lane = lane_fresh(); asm volatile("" : "+s"(gw));
    constexpr int R = 4;
    for (int row0 = gw * R; row0 < nrows; row0 += NGW * R) {
        const bool lat = row0 < NLAT;
        const size_t roff = lat ? (size_t)row0 * 1024 : (size_t)(row0 - NLAT) * 1024;
        const void* srcb = lat ? xlat : xctx;
        const int b = lat ? (row0 >> 12) : NB;
        const float* shp = modl + (size_t)(b * 6 + which * 3) * 1024; const float* scp = shp + 1024;
        float v[R][2][8]; float ss[R];
#pragma unroll
        for (int r = 0; r < R; ++r)
#pragma unroll
            for (int j = 0; j < 2; ++j) { const size_t o = roff + (size_t)r * 1024 + 8 * lane + 512 * j;
                if constexpr (SRC_BF16) { const v4u w = *(const v4u*)((const bf16*)srcb + o);
                    v[r][j][0] = bf_lo(w.x); v[r][j][1] = bf_hi(w.x); v[r][j][2] = bf_lo(w.y); v[r][j][3] = bf_hi(w.y); v[r][j][4] = bf_lo(w.z); v[r][j][5] = bf_hi(w.z); v[r][j][6] = bf_lo(w.w); v[r][j][7] = bf_hi(w.w); }
                else { const f32x4 a = *(const f32x4*)((const float*)srcb + o), c = *(const f32x4*)((const float*)srcb + o + 4);
                    v[r][j][0] = a.x; v[r][j][1] = a.y; v[r][j][2] = a.z; v[r][j][3] = a.w; v[r][j][4] = c.x; v[r][j][5] = c.y; v[r][j][6] = c.z; v[r][j][7] = c.w; } }
#pragma unroll
        for (int r = 0; r < R; ++r) { float s = 0.f;
#pragma unroll
            for (int j = 0; j < 2; ++j)
#pragma unroll
                for (int i = 0; i < 8; ++i) s += v[r][j][i] * v[r][j][i];
            ss[r] = s; }
#pragma unroll
        for (int o = 1; o < 64; o <<= 1)
#pragma unroll
            for (int r = 0; r < R; ++r) ss[r] += shx(ss[r], lane, o);
#pragma unroll
        for (int j = 0; j < 2; ++j) { const int c0 = 8 * lane + 512 * j; float gm[8], sh[8];
#pragma unroll
            for (int h = 0; h < 2; ++h) { const f32x4 g = *(const f32x4*)(gvec + c0 + 4 * h), s4 = *(const f32x4*)(shp + c0 + 4 * h), sc = *(const f32x4*)(scp + c0 + 4 * h);
#pragma unroll
                for (int e = 0; e < 4; ++e) { gm[4 * h + e] = g[e] * (sc[e] + 1.0f); sh[4 * h + e] = s4[e]; } }
#pragma unroll
            for (int r = 0; r < R; ++r) { const float rstd = __builtin_amdgcn_rsqf(ss[r] * (1.f / 1024.f) + EPS); float y[8];
#pragma unroll
                for (int i = 0; i < 8; ++i) y[i] = (v[r][j][i] * rstd) * gm[i] + sh[i];
                v4u w; w.x = cvt_pk_bf16(y[0], y[1]); w.y = cvt_pk_bf16(y[2], y[3]); w.z = cvt_pk_bf16(y[4], y[5]); w.w = cvt_pk_bf16(y[6], y[7]);
                *(v4u*)(H + (size_t)(row0 + r) * 1024 + c0) = w; } }
    }
}
__device__ __forceinline__ void final_norm_rows(const float* x, float* out, const float* gvec, int gw, int NGW) {
    const int lane = lane_fresh(); asm volatile("" : "+s"(gw));
    constexpr int R = 4;
    for (int row0 = gw * R; row0 < NLAT; row0 += NGW * R) {
        f32x4 v[R][4]; float ss[R];
#pragma unroll
        for (int r = 0; r < R; ++r)
#pragma unroll
            for (int j = 0; j < 4; ++j) v[r][j] = *(const f32x4*)(x + (size_t)(row0 + r) * 1024 + 4 * lane + 256 * j);
#pragma unroll
        for (int r = 0; r < R; ++r) { float s = 0.f;
#pragma unroll
            for (int j = 0; j < 4; ++j) s += (v[r][j].x * v[r][j].x + v[r][j].y * v[r][j].y) + (v[r][j].z * v[r][j].z + v[r][j].w * v[r][j].w);
            ss[r] = s; }
#pragma unroll
        for (int o = 1; o < 64; o <<= 1)
#pragma unroll
            for (int r = 0; r < R; ++r) ss[r] += shx(ss[r], lane, o);
#pragma unroll
        for (int j = 0; j < 4; ++j) { const int c0 = 4 * lane + 256 * j; const f32x4 g = *(const f32x4*)(gvec + c0);
#pragma unroll
            for (int r = 0; r < R; ++r) { const float rstd = __builtin_amdgcn_rsqf(ss[r] * (1.f / 1024.f) + EPS); *(f32x4*)(out + (size_t)(row0 + r) * 1024 + c0) = v[r][j] * rstd * g; } }
    }
}

__device__ __forceinline__ void unpack8(const v4u w, float* v) { v[0] = bf_lo(w.x); v[1] = bf_hi(w.x); v[2] = bf_lo(w.y); v[3] = bf_hi(w.y); v[4] = bf_lo(w.z); v[5] = bf_hi(w.z); v[6] = bf_lo(w.w); v[7] = bf_hi(w.w); }
__device__ __forceinline__ v4u pack8(const float* v) { v4u w; w.x = cvt_pk_bf16(v[0], v[1]); w.y = cvt_pk_bf16(v[2], v[3]); w.z = cvt_pk_bf16(v[4], v[5]); w.w = cvt_pk_bf16(v[6], v[7]); return w; }
__device__ __forceinline__ void qk_proc(float* v, bool do_norm, const float* g, bool do_rope, bool hi_half, const float* cs, const float* sn, float scale, int lane) {
    float ss = 0.f;
#pragma unroll
    for (int i = 0; i < 8; ++i) ss += v[i] * v[i];
    ss += shx(ss, lane, 1); ss += shx(ss, lane, 2); ss += shx(ss, lane, 4);
    const float rstd = __builtin_amdgcn_rsqf(ss * (1.f / 64.f) + EPS);
#pragma unroll
    for (int i = 0; i < 8; ++i) { const float nv = v[i] * rstd * g[i]; v[i] = do_norm ? nv : v[i]; }
#pragma unroll
    for (int i = 0; i < 8; ++i) { const float pvv = shx(v[i], lane, 2);
        const float rv = hi_half ? (v[i] * cs[i] + pvv * sn[i]) : (v[i] * cs[i] - pvv * sn[i]);
        v[i] = (do_rope ? rv : v[i]) * scale; }
}
template <int W2> __device__ __forceinline__ void pool_quad(const bf16* __restrict__ Z, bf16* __restrict__ Y, int row, int t, int L, int ch) {
    int lo = t - W2; lo = lo < 0 ? 0 : lo; int hi = t + W2; hi = hi > L ? L : hi;
    const bf16* zc = Z + (size_t)(row - t) * ZP + ch;
    const v4u zero = {0u, 0u, 0u, 0u};
    v4u pw[2 * W2];
#pragma unroll
    for (int jj = 0; jj < 2 * W2; ++jj) { const int r = lo + jj; pw[jj] = (r < hi) ? *(const v4u*)(zc + (size_t)r * ZP) : zero; }
    const v4u own_w = *(const v4u*)(zc + (size_t)t * ZP);
    float acc[8];
#pragma unroll
    for (int i = 0; i < 8; ++i) acc[i] = 0.f;
#pragma unroll
    for (int jj = 0; jj < 2 * W2; ++jj) { float u[8]; unpack8(pw[jj], u);
#pragma unroll
        for (int i = 0; i < 8; ++i) acc[i] += u[i]; }
    float own[8]; unpack8(own_w, own); const float rc = 1.0f / (float)(hi - lo);
#pragma unroll
    for (int i = 0; i < 8; ++i) acc[i] = acc[i] * rc - own[i];
    *(v4u*)(Y + (size_t)row * YP + ch) = pack8(acc);
}
__device__ __forceinline__ void elem_phase(const Args& A, int layer, int nrows, bf16* Z, bf16* Y, int gw, int NGW) {
    const int lane = lane_fresh(); asm volatile("" : "+s"(gw));
    for (int q = gw; q < nrows / 4; q += NGW) {
        const int row = 4 * q + (lane >> 4), c16 = (lane & 15) * 8;
        const bool lat = row < NLAT;
        const int t = lat ? (row & (SEQ - 1)) : ((row - NLAT) & (CTX - 1));
        const int L = lat ? SEQ : CTX;
        pool_quad<8>(Z, Y, row, t, L, 384 + c16);
        pool_quad<4>(Z, Y, row, t, L, 256 + c16);
        pool_quad<2>(Z, Y, row, t, L, 128 + c16);
        pool_quad<1>(Z, Y, row, t, L, c16);
    }
    const int j8 = lane & 7; const bool hi_half = (j8 >> 1) & 1; const int axis = j8 >> 2, fbase = (j8 & 1) * 8;
    float inv[8], kg[8];
#pragma unroll
    for (int i = 0; i < 8; ++i) { inv[i] = __builtin_amdgcn_exp2f(-(float)(fbase + i) * (13.287712379549449f / 16.0f)) * 0.15915494309189535f;
        kg[i] = A.k_norm_g[layer * 64 + j8 * 8 + i]; }
    for (int p = gw; p < nrows / 2; p += NGW) {
        const int row = 2 * p + (lane >> 5);
        const bool lat = row < NLAT;
        const int t = lat ? (row & (SEQ - 1)) : ((row - NLAT) & (CTX - 1));
        bf16* zrow = Z + (size_t)row * ZP;
        const int l5 = lane & 31; const bool isg = l5 >= 16; const int kcol = isg ? 1792 + (l5 - 16) * 8 : 1024 + l5 * 8;
        const v4u k_w = *(const v4u*)(zrow + kcol);
        float cs[8], sn[8];
        { const float pos = (float)(axis ? (t & 63) : (t >> 6));
#pragma unroll
          for (int i = 0; i < 8; ++i) { float r = pos * inv[i]; r = r - __builtin_floorf(r); cs[i] = __builtin_amdgcn_cosf(r); sn[i] = __builtin_amdgcn_sinf(r); } }
        float vk[8];
        unpack8(k_w, vk); qk_proc(vk, isg, kg, lat, hi_half, cs, sn, 1.0f, lane);
        *(v4u*)(zrow + kcol) = pack8(vk);
    }
}

__device__ __forceinline__ void fixup_phase(const Args& A, int layer, int nrows, bf16* U, const float* As, const float* PAs, const float* Vs, int gbase, int NT) {
    const int gtid = gbase + lane_fresh();
    const int items = (nrows / 32) * 352;
    const float* cw = A.conv_w + (size_t)layer * 3 * FF;
    for (int it = gtid; it < items; it += NT) {
        const int c8 = it % 352, brow = it / 352, side = brow & 1, col = c8 * 8;
        const int r = (brow >> 1) * 64 + (side ? 63 : 0);
        const bool lat = r < NLAT; const int L = lat ? SEQ : CTX; const int t = lat ? (r & (SEQ - 1)) : ((r - NLAT) & (CTX - 1));
        const bool has = side ? (t != L - 1) : (t != 0);
        const int nb = has ? (side ? brow + 1 : brow - 1) : brow;
        const float* wp = cw + (side ? 2 * FF : 0) + col;
        const size_t so = (size_t)brow * FF + col, sn = (size_t)nb * FF + col;
        float o[8];
#pragma unroll
        for (int h = 0; h < 2; ++h) { const f32x4 pa = *(const f32x4*)(PAs + so + 4 * h), vv = *(const f32x4*)(Vs + so + 4 * h), an = *(const f32x4*)(As + sn + 4 * h), w = *(const f32x4*)(wp + 4 * h);
#pragma unroll
            for (int e = 0; e < 4; ++e) { const float pre = pa[e] + (has ? w[e] * an[e] : 0.f); o[4 * h + e] = pre * pg8::sigmoidf_(pre) * vv[e]; } }
        *(v4u*)(U + (size_t)r * FF + col) = pack8(o);
    }
}

__device__ __forceinline__ void attention_phase(const Args& A, int layer, bool last, bf16* Z, bf16* Y, char* shm, int G, int vcu, int wave) {
    using abf = attn_body::bf16;
    asm volatile("" : "+s"(vcu), "+s"(G));
    const float* sink = A.win_sink + layer * 8;
    const int NU = NB * 8 * 16, per = (NU + G - 1) / G;
    int u0 = vcu * per, u1 = u0 + per; if (u1 > NU) u1 = NU;
    for (int u = u0; u < u1; ++u) {
        const int qb = u & 15, h = (u >> 4) & 7, b = u >> 7, kvh = h >> 2;
        const size_t qrow = (size_t)b * SEQ + qb * 256, crow0 = (size_t)NLAT + (size_t)b * CTX;
        const abf* Q = (const abf*)Z + qrow * ZP + 1280 + h * 64;
        const abf* Kc = (const abf*)Z + crow0 * ZP + 1792 + kvh * 64; const abf* Vc = (const abf*)Z + crow0 * ZP + 1920 + kvh * 64;
        const long dlat = ((long)b * SEQ - (long)crow0) * ZP;
        attn_body::attn_unit<8, false>(Q, Kc, Vc, dlat, 68, 0, false, 0.f, (abf*)Y + qrow * YP + 1024 + h * 64, shm, wave, true, A.q_norm_g + layer * 64, qb * 256);
    }
    for (int u = u0; u < u1; ++u) {
        const int qb = u & 15, h = (u >> 4) & 7, b = u >> 7, kvh = h >> 2;
        const size_t qrow = (size_t)b * SEQ + qb * 256, crow0 = (size_t)NLAT + (size_t)b * CTX;
        int tl0 = 4 * qb - 2; tl0 = tl0 < 0 ? 0 : tl0; int tl1 = 4 * qb + 6; tl1 = tl1 > 64 ? 64 : tl1;
        const abf* Q = (const abf*)Z + qrow * ZP + 512 + h * 64;
        const abf* Kc = (const abf*)Z + crow0 * ZP + 1024 + kvh * 64; const abf* Vc = (const abf*)Z + crow0 * ZP + 1152 + kvh * 64;
        const long dlat = ((long)b * SEQ + tl0 * 64 - (long)crow0) * ZP;
        attn_body::attn_unit<8, true>(Q, Kc, Vc, dlat, 4 + (tl1 - tl0), tl0 * 64 - qb * 256, true, sink[h] * LOG2E, (abf*)Y + qrow * YP + 512 + h * 64, shm, wave, true, nullptr, qb * 256);
    }
    if (!last) {
        const int NUC = 2 * NB * 8;
        for (int u = vcu; u < NUC; u += G) {
            const int mixer = u & 1, h = (u >> 1) & 7, b = u >> 4, kvh = h >> 2;
            const size_t crow0 = (size_t)NLAT + (size_t)b * CTX;
            const int qc = mixer ? 1280 : 512, kc = mixer ? 1792 : 1024, vc = mixer ? 1920 : 1152, oc = mixer ? 1024 : 512;
            attn_body::attn_unit<8, false>((const abf*)Z + crow0 * ZP + qc + h * 64, (const abf*)Z + crow0 * ZP + kc + kvh * 64, (const abf*)Z + crow0 * ZP + vc + kvh * 64, 0, 4, 0,
                                           mixer == 0, sink[h] * LOG2E, (abf*)Y + crow0 * YP + oc + h * 64, shm, wave, false, mixer ? A.q_norm_g + layer * 64 : nullptr, 0);
        }
    }
}

__global__ void __launch_bounds__(NTHREADS, 2) fwd_megakernel(Args A) {
    extern __shared__ __attribute__((aligned(16))) unsigned char lds_raw[];
    LAS unsigned char* lds = (LAS unsigned char*)lds_raw;
    const int wave = __builtin_amdgcn_readfirstlane(threadIdx.x >> 6);
    const int G = gridDim.x; const int bx = blockIdx.x; const int vcu = (G % 8 == 0) ? (bx % 8) * (G / 8) + bx / 8 : bx;
    const int gw = vcu * NWAVES + wave, NGW = G * NWAVES;
    const int lo = A.ph_lo, hi = A.ph_hi;
    int ph = 0;
#if MK_SPLIT
#define SEAM() do { ++ph; } while (0)
#else
    cg::grid_group grid = cg::this_grid();
    for (int u = threadIdx.x; u < (LDS_BYTES - LDSCTL_OFF) / 4; u += NTHREADS) ((LAS unsigned*)(lds + LDSCTL_OFF))[u] = 0u;
    __syncthreads();
    XcdBarrier bar = xcd_barrier_post((unsigned*)(A.ws + WS_CTL), (volatile LAS unsigned*)(lds + MISC_OFF) + 8);
#define SEAM() do { if (ph == 0) grid.sync(); else xcd_barrier(bar, wave); ++ph; } while (0)
#endif
#define IN() (lo <= ph && ph < hi)
    unsigned char* ws = A.ws;
    float* mod = (float*)(ws + WS_MOD);
    bf16* XB = (bf16*)A.out;
    bf16* XCB = (bf16*)(ws + WS_XC);
    unsigned char* ar = ws + WS_ARENA;
    bf16* Z = (bf16*)(ar + AR_Z); bf16* Gt = (bf16*)(ar + AR_G); bf16* Y = (bf16*)(ar + AR_Y); bf16* H = (bf16*)(ar + AR_H);
    bf16* Mrg = (bf16*)(ar + AR_MRG); bf16* U = (bf16*)(ar + AR_U); bf16* H2 = (bf16*)(ar + AR_H2);
    float* XF = (float*)(ar + AR_XF); float* SAs = (float*)(ar + AR_SIDE); float* SPA = (float*)(ar + AR_SIDE + SIDE_BYTES); float* SVs = (float*)(ar + AR_SIDE + 2 * SIDE_BYTES);

    if (IN()) for (int rep = 0; rep < ((DUP_MASK & 32) ? 2 : 1); ++rep) { const int lane = lane_fresh(); prologue(A, lds, G, vcu, wave * 64 + lane, lane, wave); __syncthreads(); }
    SEAM();
    for (int l = 0; l < 2; ++l) {
        const bool last = (l == 1);
        const int nrows_mix = NTOK, nrows_x = last ? NLAT : NTOK;
        const int nM_mix = nrows_mix / 256, nM_x = nrows_x / 256;
        const float* modl = mod + (size_t)l * 17 * 6144;
        const unsigned char* wl = ws + WS_W + (size_t)l * LW_BYTES;
        if (IN()) { if (l == 0) norm_rows<false>(A.x, A.ctx, A.norm1_g + l * 1024, modl, 0, nrows_mix, H, gw, NGW); else norm_rows<true>(XB, XCB, A.norm1_g + l * 1024, modl, 0, nrows_mix, H, gw, NGW); }
        SEAM();
        if (IN()) for (int rep = 0; rep < ((DUP_MASK & 1) ? 2 : 1); ++rep) { pg8::Gemm g{H, (const bf16*)(wl + LW_IN), 1024, 1024, 1024, 0, 0}; pg8::Order S; S.init(nM_mix, 20, G, bx, 1, 0);
            pg8::EpiIn E{Z, Gt, A.b_gate + (size_t)l * 3072};
            pg8::gemm_phase<pg8::EpiIn, true>(lds, g, S, E, wave); }
        SEAM();
        if (IN()) elem_phase(A, l, nrows_mix, Z, Y, gw, NGW);
        SEAM();
        if (IN()) { for (int rep = 0; rep < ((DUP_MASK & 2) ? 2 : 1); ++rep) attention_phase(A, l, last, Z, Y, (char*)lds_raw, G, vcu, wave);
            pg8::Gemm g{Y, (const bf16*)(wl + LW_POOL), YP, 256, 256, 256, 0}; pg8::Order S; S.init(nM_x, 2, G, bx, 1, 1);
            pg8::EpiBf16 E{Y, YP, A.pool_scale + (size_t)l * 512};
            pg8::gemm_phase<pg8::EpiBf16, true>(lds, g, S, E, wave); }
        SEAM();
        if (IN()) for (int rep = 0; rep < ((DUP_MASK & 16) ? 2 : 1); ++rep) { pg8::Gemm g{Y, (const bf16*)(wl + LW_BR), YP, 512, 512, 512, (long)1024 * 512}; pg8::Order S; S.init(nM_x, 4, G, bx, 3, 2);
            pg8::EpiMerge E{Gt, Mrg};
            pg8::gemm_phase<pg8::EpiMerge, true>(lds, g, S, E, wave); }
        SEAM();
        if (IN()) { pg8::Gemm g{Mrg, (const bf16*)(wl + LW_OUT), 1024, 1024, 1024, 0, 0}; pg8::Order S; S.init(nM_x, 4, G, bx, 1, 0);
            if (l == 0) { pg8::EpiRes<false, true> E{A.x, A.ctx, XB, XCB, modl, 2}; pg8::gemm_phase<pg8::EpiRes<false, true>, true>(lds, g, S, E, wave); }
            else { pg8::EpiRes<true, true> E{XB, XCB, XB, XCB, modl, 2}; pg8::gemm_phase<pg8::EpiRes<true, true>, true>(lds, g, S, E, wave); } }
        SEAM();
        if (IN()) norm_rows<true>(XB, XCB, A.norm2_g + l * 1024, modl, 1, nrows_x, H2, gw, NGW);
        SEAM();
        if (IN()) for (int rep = 0; rep < ((DUP_MASK & 4) ? 2 : 1); ++rep) { pg8::Gemm g{H2, (const bf16*)(wl + LW_FF), 1024, 1024, 1024, 0, 0}; pg8::Order S; S.init(nM_x, 22, G, bx, 1, 0);
            pg8::EpiFF E{U, A.conv_w + (size_t)l * 3 * FF, A.conv_b + (size_t)l * FF, SAs, SIDE_BYTES / 4};
            pg8::gemm_phase<pg8::EpiFF, true>(lds, g, S, E, wave); }
        SEAM();
        if (IN()) fixup_phase(A, l, nrows_x, U, SAs, SPA, SVs, vcu * NTHREADS + wave * 64, G * NTHREADS);
        SEAM();
        if (IN()) { pg8::Gemm g{U, (const bf16*)(wl + LW_DN), FF, FF, FF, 0, 0}; pg8::Order S; S.init(nM_x, 4, G, bx, 1, 0);
            if (!last) { pg8::EpiRes<true, true> E{XB, XCB, XB, XCB, modl, 5}; pg8::gemm_phase<pg8::EpiRes<true, true>, true>(lds, g, S, E, wave); }
            else { pg8::EpiRes<true, false> E{XB, XCB, XF, XF, modl, 5}; pg8::gemm_phase<pg8::EpiRes<true, false>, true>(lds, g, S, E, wave); } }
        SEAM();
    }
    if (IN()) final_norm_rows(XF, A.out, A.final_g, gw, NGW);
#undef IN
#undef SEAM
}
constexpr int N_PHASES = 22;

extern "C" void kernel_launch(void* const* d_in, const int* in_sizes, int n_in, void* d_out, int out_size, void* d_ws, size_t ws_size, hipStream_t stream) {
    static int grid = 0;
    if (grid == 0) {
        if (n_in != 24 || out_size != NLAT * 1024 || ws_size < WS_END) { fprintf(stderr, "kernel_launch: unexpected shapes (n_in %d out %d ws %zu need %zu)\n", n_in, out_size, ws_size, (size_t)WS_END); grid = -1; return; }
        int dev = 0, cus = 0, per_cu = 0;
        hipGetDevice(&dev); hipDeviceGetAttribute(&cus, hipDeviceAttributeMultiprocessorCount, dev);
        if (hipFuncSetAttribute((const void*)fwd_megakernel, hipFuncAttributeMaxDynamicSharedMemorySize, LDS_BYTES) != hipSuccess) { fprintf(stderr, "kernel_launch: hipFuncSetAttribute failed\n"); grid = -1; return; }
        hipOccupancyMaxActiveBlocksPerMultiprocessor(&per_cu, (const void*)fwd_megakernel, NTHREADS, LDS_BYTES);
        (void)hipGetLastError();
        if (per_cu < 1) { fprintf(stderr, "kernel_launch: occupancy query says %d blocks per CU\n", per_cu); per_cu = 1; }
        grid = cus;
    }
    if (grid < 0) return;
    Args a{};
    const float** p = (const float**)&a;
    for (int i = 0; i < 24; ++i) p[i] = (const float*)d_in[i];
    a.out = (float*)d_out; a.ws = (unsigned char*)d_ws;
#if MK_SPLIT
    for (int ph = 0; ph < N_PHASES; ++ph) { a.ph_lo = ph; a.ph_hi = ph + 1; hipLaunchKernelGGL(fwd_megakernel, dim3(grid), dim3(NTHREADS), LDS_BYTES, stream, a); }
#else
    a.ph_lo = 0; a.ph_hi = N_PHASES;
    if (hipMemsetAsync((char*)d_ws + WS_CTL, 0, CTL_ZERO_BYTES, stream) != hipSuccess) { fprintf(stderr, "kernel_launch: memset failed\n"); return; }
    void* args[] = {&a};
    hipError_t e = hipLaunchCooperativeKernel((const void*)fwd_megakernel, dim3(grid), dim3(NTHREADS), args, LDS_BYTES, stream);
    if (e != hipSuccess) fprintf(stderr, "cooperative launch failed: %s (grid %d)\n", hipGetErrorString(e), grid);
#endif
}
```

```cpp
#include <hip/hip_runtime.h>
#include <hip/hip_cooperative_groups.h>
#include <hip/hip_bf16.h>
#include <cstdio>
#include <cstdint>
#include <cmath>
namespace cg = cooperative_groups;

#ifndef DUP_MASK
#define DUP_MASK 0
#endif
#ifndef MK_SPLIT
#define MK_SPLIT 0
#endif

constexpr int DM_ = 1024, NB = 16, SEQ = 4096, CTX = 256, NLAT = NB * SEQ, NCTX = NB * CTX, NTOK = NLAT + NCTX;
constexpr int ZP = 2048, GP = 3072, YP = 1536, FF = 2816, AVP = 2 * FF;
constexpr float EPS = 1e-6f;
constexpr float LOG2E = 1.4426950408889634f;
constexpr float C2 = 0.125f * LOG2E;

__device__ __forceinline__ int lane_fresh() { int l = (int)__builtin_amdgcn_mbcnt_hi(~0u, __builtin_amdgcn_mbcnt_lo(~0u, 0u)); asm volatile("" : "+v"(l)); return l; }

namespace pg8 {
#define PG8_LAS __attribute__((address_space(3)))
typedef unsigned short bf16_t;
typedef short bf16x8 __attribute__((ext_vector_type(8)));
typedef float f32x4 __attribute__((ext_vector_type(4)));
typedef unsigned u32x4 __attribute__((ext_vector_type(4)));
typedef unsigned u32x2 __attribute__((ext_vector_type(2)));
constexpr int BM = 256, BK = 64, HALF = 128, HTB = HALF * BK * 2, STAGE_BYTES = 8 * HTB, NXCD = 8, WGM = 8;

__host__ __device__ __forceinline__ int lds_byte(int r, int c) { const int st = (r >> 4) * 2 + (c >> 5), rr = r & 15, cc = c & 31, ob = rr * 64 + cc * 2; return st * 1024 + (ob ^ (((ob >> 9) & 1) << 5)); }
__host__ __device__ __forceinline__ void stage_rc(int b, int& R, int& C) { const int st = b / 1024, sb = b % 1024, swz = sb ^ (((sb >> 9) & 1) << 5); R = (st >> 1) * 16 + swz / 64; C = (st & 1) * 32 + (swz % 64) / 2; }
__host__ __device__ __forceinline__ int perm32(int rho) { const int n = rho >> 4, i = rho & 15; return 8 * (i >> 2) + 4 * n + (i & 3); }

struct Unit { int pm, pn, g; };
struct Gemm { const bf16_t* A; const bf16_t* Bt; int lda, ldb, K; long a_goff, b_goff; };

struct Order {
    int nM, nN, nwg, G, c, sub, gmode, nextra;
    __device__ __forceinline__ void init(int nM_, int nN_, int G_, int c_, int sub_, int gmode_, int nextra_ = 0) { nM = nM_; nN = nN_; nwg = nM * nN; G = G_; c = c_; sub = sub_; gmode = gmode_; nextra = nextra_; }
    __device__ __forceinline__ bool next(int i, Unit& u) const {
        const int ti = (sub == 1) ? i : i / sub;
        const long L = (long)ti * G + c;
        if (L >= nwg) { const int j = (int)(L - nwg); if (j >= nextra) return false; u.pm = nM + (j >> 1); u.pn = (j & 1) ? 7 : 4; u.g = 0; return true; }
        int wgid = (int)L; { const int q = nwg / NXCD, r = nwg % NXCD, xcd = wgid % NXCD, off = wgid / NXCD; wgid = (xcd < r ? xcd * (q + 1) : r * (q + 1) + (xcd - r) * q) + off; }
        const int nig = WGM * nN, gid = wgid / nig, fm = gid * WGM, gsz = (nM - fm) < WGM ? (nM - fm) : WGM;
        u.pm = fm + ((wgid % nig) % gsz); u.pn = (wgid % nig) / gsz;
        u.g = (gmode == 0) ? 0 : ((gmode == 1) ? u.pn : (i - ti * sub));
        return true;
    }
};

typedef float f32x2_t __attribute__((ext_vector_type(2))); typedef __bf16 bf16x2_t __attribute__((ext_vector_type(2)));
__device__ __forceinline__ unsigned cvt_pk_bf16(float lo, float hi) { f32x2_t v = {lo, hi}; bf16x2_t b = __builtin_convertvector(v, bf16x2_t); return __builtin_bit_cast(unsigned, b); }
__device__ __forceinline__ float bf_lo(unsigned w) { return __uint_as_float(w << 16); }
__device__ __forceinline__ float bf_hi(unsigned w) { return __uint_as_float(w & 0xffff0000u); }
__device__ __forceinline__ float sigmoidf_(float x) { return __builtin_amdgcn_rcpf(1.0f + __builtin_amdgcn_exp2f(-x * 1.4426950408889634f)); }

struct EpiBf16 {
    static constexpr bool PERM = true;
    bf16_t* O; int ldc; const float* colscale;
    __device__ __forceinline__ void operator()(const f32x4 (&acc)[2][2][4][2], const Unit& u, int wr, int wc, int fr, int fq) const {
        int row0 = u.pm * BM + wr * 64 + fr; asm volatile("" : "+v"(row0)); const int col0 = u.pn * BM + wc * 32 + 8 * fq;
#pragma unroll
        for (int bj = 0; bj < 2; ++bj) {
            f32x4 s0 = (f32x4){1.f, 1.f, 1.f, 1.f}, s1 = s0;
            if (colscale) { s0 = *(const f32x4*)(colscale + col0 + bj * HALF); s1 = *(const f32x4*)(colscale + col0 + bj * HALF + 4); }
#pragma unroll
            for (int ai = 0; ai < 2; ++ai)
#pragma unroll
                for (int m = 0; m < 4; ++m) { bf16_t* rowp = O + (size_t)(row0 + ai * HALF + m * 16) * ldc + col0;
                    const f32x4 v0 = acc[ai][bj][m][0] * s0, v1 = acc[ai][bj][m][1] * s1;
                    u32x4 w; w.x = cvt_pk_bf16(v0[0], v0[1]); w.y = cvt_pk_bf16(v0[2], v0[3]); w.z = cvt_pk_bf16(v1[0], v1[1]); w.w = cvt_pk_bf16(v1[2], v1[3]);
                    *(u32x4*)(rowp + bj * HALF) = w; } }
    }
};
struct EpiIn {
    static constexpr bool PERM = true;
    bf16_t* Z; bf16_t* Gt; const float* bgate;
    __device__ __forceinline__ void operator()(const f32x4 (&acc)[2][2][4][2], const Unit& u, int wr, int wc, int fr, int fq) const {
        int row0 = u.pm * BM + wr * 64 + fr; asm volatile("" : "+v"(row0)); const bool isz = u.pn < 8;
        const int col0 = (isz ? u.pn * BM : (u.pn - 8) * BM) + wc * 32 + 8 * fq;
        bf16_t* base = isz ? Z : Gt; const int ldc = isz ? ZP : GP;
        f32x4 bv[2][2];
#pragma unroll
        for (int bj = 0; bj < 2; ++bj)
#pragma unroll
            for (int n = 0; n < 2; ++n) bv[bj][n] = isz ? (f32x4){0.f, 0.f, 0.f, 0.f} : *(const f32x4*)(bgate + col0 + bj * HALF + 4 * n);
#pragma unroll
        for (int ai = 0; ai < 2; ++ai)
#pragma unroll
            for (int m = 0; m < 4; ++m) { bf16_t* rowp = base + (size_t)(row0 + ai * HALF + m * 16) * ldc + col0;
#pragma unroll
                for (int bj = 0; bj < 2; ++bj) { f32x4 v0 = acc[ai][bj][m][0] + bv[bj][0], v1 = acc[ai][bj][m][1] + bv[bj][1];
                    if (!isz) {
#pragma unroll
                        for (int e = 0; e < 4; ++e) { v0[e] = sigmoidf_(v0[e]); v1[e] = sigmoidf_(v1[e]); } }
                    u32x4 w; w.x = cvt_pk_bf16(v0[0], v0[1]); w.y = cvt_pk_bf16(v0[2], v0[3]); w.z = cvt_pk_bf16(v1[0], v1[1]); w.w = cvt_pk_bf16(v1[2], v1[3]);
                    *(u32x4*)(rowp + bj * HALF) = w; } }
    }
};
struct EpiMerge {
    static constexpr bool PERM = true;
    const bf16_t* Gt; bf16_t* Mrg;
    __device__ __forceinline__ void operator()(const f32x4 (&acc)[2][2][4][2], const Unit& u, int wr, int wc, int fr, int fq) const {
        int row0 = u.pm * BM + wr * 64 + fr; asm volatile("" : "+v"(row0)); const int col0 = u.pn * BM + wc * 32 + 8 * fq;
#pragma unroll
        for (int ai = 0; ai < 2; ++ai) {
            u32x4 gw[4][2], ow[4][2];
#pragma unroll
            for (int m = 0; m < 4; ++m) { const size_t row = (size_t)(row0 + ai * HALF + m * 16);
#pragma unroll
                for (int bj = 0; bj < 2; ++bj) { gw[m][bj] = *(const u32x4*)(Gt + row * GP + u.g * 1024 + col0 + bj * HALF);
                    if (u.g != 0) ow[m][bj] = *(const u32x4*)(Mrg + row * 1024 + col0 + bj * HALF); } }
#pragma unroll
            for (int m = 0; m < 4; ++m) { const size_t row = (size_t)(row0 + ai * HALF + m * 16);
#pragma unroll
                for (int bj = 0; bj < 2; ++bj) {
                    const u32x4 g4 = gw[m][bj];
                    const f32x4 a0 = acc[ai][bj][m][0], a1 = acc[ai][bj][m][1];
                    float v[8];
                    v[0] = bf_lo(g4.x) * a0[0]; v[1] = bf_hi(g4.x) * a0[1]; v[2] = bf_lo(g4.y) * a0[2]; v[3] = bf_hi(g4.y) * a0[3];
                    v[4] = bf_lo(g4.z) * a1[0]; v[5] = bf_hi(g4.z) * a1[1]; v[6] = bf_lo(g4.w) * a1[2]; v[7] = bf_hi(g4.w) * a1[3];
                    if (u.g != 0) { const u32x4 o4 = ow[m][bj];
                        v[0] += bf_lo(o4.x); v[1] += bf_hi(o4.x); v[2] += bf_lo(o4.y); v[3] += bf_hi(o4.y); v[4] += bf_lo(o4.z); v[5] += bf_hi(o4.z); v[6] += bf_lo(o4.w); v[7] += bf_hi(o4.w); }
                    u32x4 w; w.x = cvt_pk_bf16(v[0], v[1]); w.y = cvt_pk_bf16(v[2], v[3]); w.z = cvt_pk_bf16(v[4], v[5]); w.w = cvt_pk_bf16(v[6], v[7]);
                    *(u32x4*)(Mrg + row * 1024 + col0 + bj * HALF) = w; } }
        }
    }
};
template <bool BASE_BF16, bool OUT_BF16> struct EpiRes {
    static constexpr bool PERM = false;
    const void* base_lat; const void* base_ctx; void* out_lat; void* out_ctx; const float* modl; int gate_idx;
    __device__ __forceinline__ void operator()(const f32x4 (&acc)[2][2][4][2], const Unit& u, int wr, int wc, int fr, int fq) const {
        const bool lat = u.pm < (NLAT / BM);
        const int prow = lat ? u.pm * BM : (u.pm * BM - NLAT);
        const void* base = lat ? base_lat : base_ctx; void* out = lat ? out_lat : out_ctx;
        const int b = lat ? (u.pm * BM) / SEQ : NB;
        int col0 = u.pn * BM + wc * 32 + 4 * fq; asm volatile("" : "+v"(col0));
        const float* gp = modl + (size_t)(b * 6 + gate_idx) * 1024 + col0;
        f32x4 gv[2][2];
#pragma unroll
        for (int bj = 0; bj < 2; ++bj)
#pragma unroll
            for (int n = 0; n < 2; ++n) gv[bj][n] = *(const f32x4*)(gp + bj * HALF + n * 16);
#pragma unroll
        for (int ai = 0; ai < 2; ++ai) {
            f32x4 bs[4][2][2];
#pragma unroll
            for (int m = 0; m < 4; ++m) { const size_t off = (size_t)(prow + ai * HALF + wr * 64 + m * 16 + fr) * 1024 + col0;
#pragma unroll
                for (int bj = 0; bj < 2; ++bj)
#pragma unroll
                    for (int n = 0; n < 2; ++n) { const size_t o2 = off + bj * HALF + n * 16;
                        if constexpr (BASE_BF16) { const u32x2 w = *(const u32x2*)((const bf16_t*)base + o2); bs[m][bj][n] = (f32x4){bf_lo(w.x), bf_hi(w.x), bf_lo(w.y), bf_hi(w.y)}; }
                        else bs[m][bj][n] = *(const f32x4*)((const float*)base + o2); } }
#pragma unroll
            for (int m = 0; m < 4; ++m) { const size_t off = (size_t)(prow + ai * HALF + wr * 64 + m * 16 + fr) * 1024 + col0;
#pragma unroll
                for (int bj = 0; bj < 2; ++bj)
#pragma unroll
                    for (int n = 0; n < 2; ++n) { const size_t o2 = off + bj * HALF + n * 16;
                        const f32x4 r = bs[m][bj][n] + gv[bj][n] * acc[ai][bj][m][n];
                        if constexpr (OUT_BF16) { u32x2 w; w.x = cvt_pk_bf16(r[0], r[1]); w.y = cvt_pk_bf16(r[2], r[3]); *(u32x2*)((bf16_t*)out + o2) = w; }
                        else *(f32x4*)((float*)out + o2) = r; } }
        }
    }
};
struct EpiFF {
    static constexpr bool PERM = true;
    bf16_t* U; const float* cw; const float* cb; float* As; size_t side_elems;
    __device__ __forceinline__ void operator()(const f32x4 (&acc)[2][2][4][2], const Unit& u, int wr, int wc, int fr, int fq) const {
        const int lane = fq * 16 + fr; float* PAs = As + side_elems; float* Vs = PAs + side_elems;
        int ch0 = u.pn * 128 + wc * 32 + 8 * fq; asm volatile("" : "+v"(ch0));
        const int src_up = (lane & 48) | ((fr - 1) & 15), src_dn = (lane & 48) | ((fr + 1) & 15);
#pragma unroll
        for (int h = 0; h < 2; ++h) {
            const f32x4 w0 = *(const f32x4*)(cw + ch0 + 4 * h), w1 = *(const f32x4*)(cw + 2816 + ch0 + 4 * h), w2 = *(const f32x4*)(cw + 2 * 2816 + ch0 + 4 * h), bb = *(const f32x4*)(cb + ch0 + 4 * h);
#pragma unroll
            for (int ai = 0; ai < 2; ++ai) {
                const int rblk = u.pm * 4 + ai * 2 + wr;
                float o[4][4]; f32x4 pre0, pre3;
#pragma unroll
                for (int e = 0; e < 4; ++e) {
                    float a[4], ru[4], rd[4];
#pragma unroll
                    for (int m = 0; m < 4; ++m) { a[m] = acc[ai][0][m][h][e]; ru[m] = __int_as_float(__builtin_amdgcn_ds_bpermute(src_up << 2, __float_as_int(a[m]))); rd[m] = __int_as_float(__builtin_amdgcn_ds_bpermute(src_dn << 2, __float_as_int(a[m]))); }
#pragma unroll
                    for (int m = 0; m < 4; ++m) {
                        const float ap = (fr > 0) ? ru[m] : (m > 0 ? ru[m > 0 ? m - 1 : 0] : 0.f);
                        const float an = (fr < 15) ? rd[m] : (m < 3 ? rd[m < 3 ? m + 1 : 3] : 0.f);
                        const float pre = ap * w0[e] + a[m] * w1[e] + an * w2[e] + bb[e];
                        if (m == 0) pre0[e] = pre; if (m == 3) pre3[e] = pre;
                        o[m][e] = pre * sigmoidf_(pre) * acc[ai][1][m][h][e]; }
                    __builtin_amdgcn_sched_barrier(0); }
#pragma unroll
                for (int m = 0; m < 4; ++m) { u32x2 w; w.x = cvt_pk_bf16(o[m][0], o[m][1]); w.y = cvt_pk_bf16(o[m][2], o[m][3]);
                    *(u32x2*)(U + ((size_t)rblk * 64 + m * 16 + fr) * 2816 + ch0 + 4 * h) = w; }
                if (fr == 0) { const size_t so = (size_t)(2 * rblk) * 2816 + ch0 + 4 * h; *(f32x4*)(As + so) = acc[ai][0][0][h]; *(f32x4*)(Vs + so) = acc[ai][1][0][h]; *(f32x4*)(PAs + so) = pre0; }
                if (fr == 15) { const size_t so = (size_t)(2 * rblk + 1) * 2816 + ch0 + 4 * h; *(f32x4*)(As + so) = acc[ai][0][3][h]; *(f32x4*)(Vs + so) = acc[ai][1][3][h]; *(f32x4*)(PAs + so) = pre3; }
                __builtin_amdgcn_sched_barrier(0);
            }
        }
    }
};

template <class Epi, bool ALIGN_EPI>
__device__ __forceinline__ void gemm_phase(PG8_LAS unsigned char* lds, const Gemm g, const Order& S, const Epi& E, int wid) {
    const int lane = lane_fresh(), tid = wid * 64 + lane;
    const int wr = wid >> 2, wc = wid & 3, fr = lane & 15, fq = lane >> 4;
    const int K = g.K, nt = K / BK;
    unsigned voffA[2], voffB[2];
#pragma unroll
    for (int i = 0; i < 2; ++i) { int R, C; stage_rc(tid * 16 + i * 8192, R, C); const int Rb = Epi::PERM ? ((R & ~31) + perm32(R & 31)) : R;
        voffA[i] = (unsigned)(R * g.lda + C) * 2u; voffB[i] = (unsigned)(Rb * g.ldb + C) * 2u; }
    const size_t kstep = (size_t)(BK * 2);
    const size_t hstepA = (size_t)HALF * g.lda * 2, hstepB = (size_t)HALF * g.ldb * 2;
    const size_t tstepA = 2 * hstepA, tstepB = 2 * hstepB;
    const unsigned ldsw = (unsigned)wid * 1024u;
    const int aoff = lds_byte(wr * 64 + fr, fq * 8), boff = lds_byte(wc * 32 + fr, fq * 8);
#define PG8_UA(u) ((const char*)g.A + (size_t)(u).pm * tstepA + (size_t)((long)(u).g * g.a_goff * 2))
#define PG8_UB(u) ((const char*)g.Bt + (size_t)(u).pn * tstepB + (size_t)((long)(u).g * g.b_goff * 2))
#define PG8_SA(b, h) (((b) * 2 + (h)) * HTB)
#define PG8_SB(b, h) ((4 + (b) * 2 + (h)) * HTB)
#define PG8_STAGE(bufoff, gbase, voff) do { _Pragma("unroll") for (int _i = 0; _i < 2; ++_i) \
        __builtin_amdgcn_global_load_lds((const unsigned*)((const char*)(gbase) + (voff)[_i]), (PG8_LAS unsigned*)(lds + (bufoff) + ldsw + _i * 8192), 16, 0, 0); } while (0)
#define PG8_LDA(dst, b, h) do { _Pragma("unroll") for (int m = 0; m < 4; ++m) _Pragma("unroll") for (int k = 0; k < 2; ++k) dst[m][k] = *(const PG8_LAS bf16x8*)(lds + PG8_SA(b, h) + aoff + m * 2048 + k * 1024); } while (0)
#define PG8_LDB(dst, b, h) do { _Pragma("unroll") for (int n = 0; n < 2; ++n) _Pragma("unroll") for (int k = 0; k < 2; ++k) dst[n][k] = *(const PG8_LAS bf16x8*)(lds + PG8_SB(b, h) + boff + n * 2048 + k * 1024); } while (0)
#define PG8_MMA(ai, bj, At, Bt) do { __builtin_amdgcn_s_setprio(1); _Pragma("unroll") for (int m = 0; m < 4; ++m) _Pragma("unroll") for (int n = 0; n < 2; ++n) _Pragma("unroll") for (int k = 0; k < 2; ++k) \
        acc[ai][bj][m][n] = __builtin_amdgcn_mfma_f32_16x16x32_bf16(Bt[n][k], At[m][k], acc[ai][bj][m][n], 0, 0, 0); __builtin_amdgcn_s_setprio(0); } while (0)
#define PG8_WAIT_V(n) asm volatile("s_waitcnt vmcnt(" #n ")" ::: "memory")
#define PG8_WAIT_L(n) asm volatile("s_waitcnt lgkmcnt(" #n ")" ::: "memory")
#define PG8_BAR __builtin_amdgcn_s_barrier()
#define PG8_SCHED __builtin_amdgcn_sched_barrier(0)
    Unit cur, nxt; int ui = 0;
    if (!S.next(0, cur)) return;
    f32x4 acc[2][2][4][2];
#pragma unroll
    for (int a = 0; a < 2; ++a)
#pragma unroll
        for (int b = 0; b < 2; ++b)
#pragma unroll
            for (int m = 0; m < 4; ++m)
#pragma unroll
                for (int n = 0; n < 2; ++n) acc[a][b][m][n] = (f32x4){0.f, 0.f, 0.f, 0.f};
    bf16x8 At[4][2], B0[2][2], B1[2][2];
    const char* cA = PG8_UA(cur); const char* cB = PG8_UB(cur);
    PG8_STAGE(PG8_SB(0, 0), cB, voffB); PG8_STAGE(PG8_SB(0, 1), cB + hstepB, voffB); PG8_STAGE(PG8_SA(0, 0), cA, voffA); PG8_STAGE(PG8_SA(0, 1), cA + hstepA, voffA);
    if (wr == 1) PG8_BAR;
    PG8_WAIT_V(2); PG8_BAR;
    PG8_STAGE(PG8_SB(1, 0), cB + kstep, voffB); PG8_STAGE(PG8_SA(1, 0), cA + kstep, voffA); PG8_STAGE(PG8_SB(1, 1), cB + hstepB + kstep, voffB);
    PG8_WAIT_V(6); PG8_BAR;
    for (;;) {
        const bool has_next = S.next(ui + 1, nxt);
        const char* nA = has_next ? PG8_UA(nxt) : cA; const char* nB = has_next ? PG8_UB(nxt) : cB;
        for (int t = 0; t < nt; t += 2) {
            const bool last = (t == nt - 2);
            const char* a1 = cA + (size_t)(t + 1) * kstep;
            const char* a2 = last ? nA : cA + (size_t)(t + 2) * kstep; const char* b2 = last ? nB : cB + (size_t)(t + 2) * kstep;
            const char* a3 = a2 + kstep; const char* b3 = b2 + kstep;
            PG8_LDB(B0, 0, 0); PG8_LDB(B1, 0, 1); PG8_SCHED; PG8_LDA(At, 0, 0); PG8_STAGE(PG8_SA(1, 1), a1 + hstepA, voffA);
            PG8_WAIT_V(8); PG8_WAIT_L(0); PG8_BAR; PG8_MMA(0, 0, At, B0); PG8_MMA(0, 1, At, B1); PG8_BAR; PG8_SCHED;
            PG8_LDA(At, 0, 1); PG8_STAGE(PG8_SB(0, 0), b2, voffB); PG8_STAGE(PG8_SB(0, 1), b2 + hstepB, voffB); PG8_STAGE(PG8_SA(0, 0), a2, voffA);
            PG8_WAIT_V(8); PG8_WAIT_L(0); PG8_BAR; PG8_MMA(1, 0, At, B0); PG8_MMA(1, 1, At, B1); PG8_BAR; PG8_SCHED;
            PG8_LDB(B0, 1, 0); PG8_LDB(B1, 1, 1); PG8_SCHED; PG8_LDA(At, 1, 0); PG8_STAGE(PG8_SA(0, 1), a2 + hstepA, voffA);
            PG8_WAIT_V(8); PG8_WAIT_L(0); PG8_BAR; PG8_MMA(0, 0, At, B0); PG8_MMA(0, 1, At, B1); PG8_BAR; PG8_SCHED;
            PG8_LDA(At, 1, 1); PG8_STAGE(PG8_SB(1, 0), b3, voffB); PG8_STAGE(PG8_SB(1, 1), b3 + hstepB, voffB); PG8_STAGE(PG8_SA(1, 0), a3, voffA);
            PG8_WAIT_V(8); PG8_WAIT_L(0); PG8_BAR; PG8_MMA(1, 0, At, B0); PG8_MMA(1, 1, At, B1); PG8_BAR; PG8_SCHED;
        }
        if constexpr (ALIGN_EPI) { if (wr == 0) PG8_BAR; }
        { const int l2 = lane_fresh(); E(acc, cur, wr, wc, l2 & 15, l2 >> 4); }
        if (!has_next) break;
#pragma unroll
        for (int a = 0; a < 2; ++a)
#pragma unroll
            for (int b = 0; b < 2; ++b)
#pragma unroll
                for (int m = 0; m < 4; ++m)
#pragma unroll
                    for (int n = 0; n < 2; ++n) acc[a][b][m][n] = (f32x4){0.f, 0.f, 0.f, 0.f};
        cur = nxt; cA = nA; cB = nB; ++ui;
        if constexpr (ALIGN_EPI) { if (wr == 1) PG8_BAR; }
    }
    PG8_WAIT_V(0);
    if constexpr (!ALIGN_EPI) { if (wr == 0) PG8_BAR; }
    PG8_BAR;
#undef PG8_UA
#undef PG8_UB
#undef PG8_SA
#undef PG8_SB
#undef PG8_STAGE
#undef PG8_LDA
#undef PG8_LDB
#undef PG8_MMA
#undef PG8_WAIT_V
#undef PG8_WAIT_L
#undef PG8_BAR
#undef PG8_SCHED
}
}

namespace attn_body {
using bf16 = __hip_bfloat16;
using bf16x8 = __attribute__((ext_vector_type(8))) short;
using s16x4 = __attribute__((ext_vector_type(4))) short;
using f32x16 = __attribute__((ext_vector_type(16))) float;
using u32x4 = __attribute__((ext_vector_type(4))) unsigned;
constexpr int D = 64, NW = 8, QBLK = 32, QB = QBLK * NW, KVBLK = 64;
__device__ __forceinline__ int crow(int r, int hi) { return (r & 3) + 8 * (r >> 2) + 4 * hi; }
#define SBAR() __builtin_amdgcn_sched_barrier(0)
__device__ __forceinline__ void wmask(f32x16& p0, f32x16& p1, int d0) {
    const float NEG = -INFINITY;
#pragma unroll
    for (int r = 0; r < 16; ++r) { const int d = d0 + (r & 3) + 8 * (r >> 2); if (d > 128 || d < -128) p0[r] = NEG; if (d + 32 > 128 || d + 32 < -128) p1[r] = NEG; }
}
constexpr int NSLOT = 3, SLOTB = 8192;
constexpr int LDS_K = 0, LDS_V = NSLOT * SLOTB, LDS_WS = 2 * NSLOT * SLOTB, LDS_OST = LDS_WS + NW * 64 * 4, LDS_BYTES = LDS_OST + NW * 4096;
__device__ __forceinline__ void glds16(const void* gsrc, unsigned lds_dst) { unsigned keep;
    asm volatile("s_mov_b32 %0, m0\n\ts_mov_b32 m0, %2\n\ts_nop 0\n\tglobal_load_lds_dwordx4 %1, off\n\ts_mov_b32 m0, %0" : "=&s"(keep) : "v"(gsrc), "s"(lds_dst) : "memory"); }
__device__ __forceinline__ float max3f(float a, float b, float c) { float r; asm("v_max3_f32 %0, %1, %2, %3" : "=v"(r) : "v"(a), "v"(b), "v"(c)); return r; }
__device__ __forceinline__ float max2f(float a, float b) { float r; asm("v_max_f32_e32 %0, %1, %2" : "=v"(r) : "v"(a), "v"(b)); return r; }
__device__ __forceinline__ float fadd_s(float a, float b) { float r; asm("v_add_f32_e32 %0, %1, %2" : "=v"(r) : "v"(a), "v"(b)); return r; }
__device__ __forceinline__ float fsub_s(float a, float b) { float r; asm("v_sub_f32_e32 %0, %1, %2" : "=v"(r) : "v"(a), "v"(b)); return r; }
typedef float f32x2_t __attribute__((ext_vector_type(2))); typedef __bf16 bf16x2_t __attribute__((ext_vector_type(2)));
__device__ __forceinline__ unsigned cvtpk_s(float lo, float hi) { f32x2_t v = {lo, hi}; bf16x2_t b = __builtin_convertvector(v, bf16x2_t); return __builtin_bit_cast(unsigned, b); }
#define WAIT_BAR(N) asm volatile("s_waitcnt vmcnt(" #N ") lgkmcnt(0)\n\ts_barrier" ::: "memory")

__device__ __forceinline__ void qkt(f32x16& p0, f32x16& p1, const char* Kslot, const bf16x8* qr, const f32x16& negm, int r32, int hi) {
    const char* kb = Kslot + hi * 1024 + r32 * 16;
#pragma unroll
    for (int d0 = 0; d0 < 4; ++d0) {
        const bf16x8 b0 = *reinterpret_cast<const bf16x8*>(kb + d0 * 2048);
        const bf16x8 b1 = *reinterpret_cast<const bf16x8*>(kb + d0 * 2048 + 512);
        if (d0 == 0) { p0 = __builtin_amdgcn_mfma_f32_32x32x16_bf16(b0, qr[0], negm, 0, 0, 0); p1 = __builtin_amdgcn_mfma_f32_32x32x16_bf16(b1, qr[0], negm, 0, 0, 0); }
        else { p0 = __builtin_amdgcn_mfma_f32_32x32x16_bf16(b0, qr[d0], p0, 0, 0, 0); p1 = __builtin_amdgcn_mfma_f32_32x32x16_bf16(b1, qr[d0], p1, 0, 0, 0); } }
}
typedef __attribute__((address_space(3))) const char* lds_cptr;
typedef short v4i16_t __attribute__((ext_vector_type(4)));
__device__ __forceinline__ void kload8(bf16x8* kf, lds_cptr kp) {
    kf[0] = *(const __attribute__((address_space(3))) bf16x8*)(kp);        kf[1] = *(const __attribute__((address_space(3))) bf16x8*)(kp + 512);
    kf[2] = *(const __attribute__((address_space(3))) bf16x8*)(kp + 2048); kf[3] = *(const __attribute__((address_space(3))) bf16x8*)(kp + 2560);
    kf[4] = *(const __attribute__((address_space(3))) bf16x8*)(kp + 4096); kf[5] = *(const __attribute__((address_space(3))) bf16x8*)(kp + 4608);
    kf[6] = *(const __attribute__((address_space(3))) bf16x8*)(kp + 6144); kf[7] = *(const __attribute__((address_space(3))) bf16x8*)(kp + 6656);
}
__device__ __forceinline__ void kload2(bf16x8* kf, lds_cptr kp, int j) { kf[2 * j] = *(const __attribute__((address_space(3))) bf16x8*)(kp + j * 2048); kf[2 * j + 1] = *(const __attribute__((address_space(3))) bf16x8*)(kp + j * 2048 + 512); }
__device__ __forceinline__ s16x4 vtr(lds_cptr p) { return __builtin_bit_cast(s16x4, __builtin_amdgcn_ds_read_tr16_b64_v4i16((__attribute__((address_space(3))) v4i16_t*)p)); }
__device__ __forceinline__ float rowmax(const f32x16& p0, const f32x16& p1) {
    float a = max3f(p0[0], p0[1], p1[0]), b = max3f(p0[2], p0[3], p1[1]); a = max3f(a, p1[2], p1[3]);
#pragma unroll
    for (int r = 4; r < 16; r += 4) { a = max3f(a, p0[r], p0[r + 1]); b = max3f(b, p0[r + 2], p0[r + 3]); a = max3f(a, p1[r], p1[r + 1]); b = max3f(b, p1[r + 2], p1[r + 3]); }
    const float m = max2f(a, b);
    auto rr = __builtin_amdgcn_permlane32_swap(__float_as_uint(m), __float_as_uint(m), false, false);
    return max2f(__uint_as_float(rr[0]), __uint_as_float(rr[1]));
}
__device__ __forceinline__ void pv(f32x16* o, int vb, bf16x8 pa0, bf16x8 pa1, bf16x8 pa2, bf16x8 pa3) {
#pragma unroll
    for (int d0 = 0; d0 < 2; ++d0) { s16x4 lo[4], hi[4];
#pragma unroll
        for (int ks = 0; ks < 4; ++ks) {
            asm volatile("ds_read_b64_tr_b16 %0,%1 offset:%c2" : "=&v"(lo[ks]) : "v"(vb), "i"(d0 * 4096 + ks * 1024) : "memory");
            asm volatile("ds_read_b64_tr_b16 %0,%1 offset:%c2" : "=&v"(hi[ks]) : "v"(vb), "i"(d0 * 4096 + ks * 1024 + 512) : "memory"); }
        asm volatile("s_waitcnt lgkmcnt(0)" ::: "memory"); SBAR();
#define PK(k) (bf16x8){lo[k][0], lo[k][1], lo[k][2], lo[k][3], hi[k][0], hi[k][1], hi[k][2], hi[k][3]}
        o[d0] = __builtin_amdgcn_mfma_f32_32x32x16_bf16(pa0, PK(0), o[d0], 0, 0, 0);
        o[d0] = __builtin_amdgcn_mfma_f32_32x32x16_bf16(pa1, PK(1), o[d0], 0, 0, 0);
        o[d0] = __builtin_amdgcn_mfma_f32_32x32x16_bf16(pa2, PK(2), o[d0], 0, 0, 0);
        o[d0] = __builtin_amdgcn_mfma_f32_32x32x16_bf16(pa3, PK(3), o[d0], 0, 0, 0);
#undef PK
    }
}
template <int THRL, bool WMASK> __device__ __forceinline__ void attn_unit(const bf16* Qw0, const bf16* __restrict__ Kc, const bf16* __restrict__ Vc, long dlat, int NT, int kd0,
                                                                         bool has_sink, float sinkl2, bf16* Ow0, char* shm, int wid, bool q_rope, const float* q_normg, int tpos0) {
    const int lane = lane_fresh(), r32 = lane & 31, hi = lane >> 5;
    const bf16* Qw = Qw0 + (long)(wid * QBLK) * ZP;
    const unsigned lds0 = (unsigned)(uintptr_t)shm;
    float* wsf = (float*)(shm + LDS_WS) + wid * 64;
    const bf16* ksrc = Kc + (long)lane * ZP + wid * 8;
    const bf16* vsrc = Vc + (long)(16 * (wid & 3) + (lane >> 2)) * ZP + (wid >> 2) * 32 + (lane & 3) * 8;
    const unsigned kdst = lds0 + LDS_K + wid * 1024, vdst = lds0 + LDS_V + wid * 1024;
#define TOFF(t) (((t) < 4) ? (long)(t) * (KVBLK * ZP) : dlat + (long)((t) - 4) * (KVBLK * ZP))
#define DMA_K(t, slot) glds16(ksrc + TOFF(t), (unsigned)__builtin_amdgcn_readfirstlane(kdst + (slot)))
#define DMA_V(t, slot) glds16(vsrc + TOFF(t), (unsigned)__builtin_amdgcn_readfirstlane(vdst + (slot)))
    const int vb0 = (int)(lds0 + LDS_V) + ((lane >> 4) & 1) * 32 + (lane & 3) * 8 + (4 * hi + ((lane & 15) >> 2)) * 64;
    const char* Kbase = shm + LDS_K; bf16x8 kf[8];
    const lds_cptr shm3 = (lds_cptr)shm; const lds_cptr kp0 = shm3 + LDS_K + hi * 1024 + r32 * 16; const lds_cptr vp0 = shm3 + LDS_V + ((lane >> 4) & 1) * 32 + (lane & 3) * 8 + (4 * hi + ((lane & 15) >> 2)) * 64;
    DMA_K(0, 0); DMA_V(0, 0); DMA_K(1, SLOTB);
    bf16x8 qr[4];
#pragma unroll
    for (int d0 = 0; d0 < 4; ++d0) qr[d0] = *reinterpret_cast<const bf16x8*>(&Qw[(long)r32 * ZP + d0 * 16 + hi * 8]);
    {
        float qf[4][8];
#pragma unroll
        for (int d0 = 0; d0 < 4; ++d0)
#pragma unroll
            for (int i = 0; i < 8; ++i) qf[d0][i] = __uint_as_float(((unsigned)(unsigned short)qr[d0][i]) << 16);
        if (q_normg) {
            float ssq = 0.f;
#pragma unroll
            for (int d0 = 0; d0 < 4; ++d0)
#pragma unroll
                for (int i = 0; i < 8; ++i) ssq += qf[d0][i] * qf[d0][i];
            { auto rr = __builtin_amdgcn_permlane32_swap(__float_as_uint(ssq), __float_as_uint(ssq), false, false); ssq = __uint_as_float(rr[0]) + __uint_as_float(rr[1]); }
            const float rstd = __builtin_amdgcn_rsqf(ssq * (1.f / 64.f) + EPS);
#pragma unroll
            for (int d0 = 0; d0 < 4; ++d0)
#pragma unroll
                for (int i = 0; i < 8; ++i) qf[d0][i] *= rstd * q_normg[d0 * 16 + hi * 8 + i];
        }
        if (q_rope) {
            const int t = tpos0 + wid * QBLK + r32;
#pragma unroll
            for (int a = 0; a < 2; ++a) { const float pos = (float)(a ? (t & 63) : (t >> 6));
#pragma unroll
                for (int i = 0; i < 8; ++i) { float r = pos * (__builtin_amdgcn_exp2f(-(float)(hi * 8 + i) * (13.287712379549449f / 16.0f)) * 0.15915494309189535f); r = r - __builtin_floorf(r);
                    const float c = __builtin_amdgcn_cosf(r), sn = __builtin_amdgcn_sinf(r), x1 = qf[2 * a][i], x2 = qf[2 * a + 1][i];
                    qf[2 * a][i] = x1 * c - x2 * sn; qf[2 * a + 1][i] = x2 * c + x1 * sn; } }
        }
#pragma unroll
        for (int d0 = 0; d0 < 4; ++d0) { u32x4 w; w.x = cvtpk_s(qf[d0][0] * C2, qf[d0][1] * C2); w.y = cvtpk_s(qf[d0][2] * C2, qf[d0][3] * C2); w.z = cvtpk_s(qf[d0][4] * C2, qf[d0][5] * C2); w.w = cvtpk_s(qf[d0][6] * C2, qf[d0][7] * C2);
            qr[d0] = __builtin_bit_cast(bf16x8, w); }
    }
    float mhat = 0.f, l_reg = 0.f; f32x16 o[2]; f32x16 negm;
    { float zz = 0.f; asm volatile("" : "+v"(zz));
      _Pragma("unroll") for (int r = 0; r < 16; ++r) { o[0][r] = zz; o[1][r] = zz; negm[r] = zz; } }
    asm volatile("" : "+v"(negm));
    const int qrel = wid * QBLK + r32;
#define CMASK(P0, P1, t) do { if constexpr (WMASK) { if ((t) >= 4) wmask(P0, P1, kd0 + ((t) - 4) * KVBLK - qrel + 4 * hi); } } while (0)
    bool resc = false;
#define START(P0, P1) do { const float rm = rowmax(P0, P1); resc = false; \
    { const float dl = rm; mhat = fadd_s(mhat, dl); \
      _Pragma("unroll") for (int r = 0; r < 16; ++r) { P0[r] = fsub_s(P0[r], dl); P1[r] = fsub_s(P1[r], dl); } \
      _Pragma("unroll") for (int r = 0; r < 16; ++r) negm[r] = -mhat; asm volatile("" : "+v"(negm)); } \
    _Pragma("unroll") for (int r = 0; r < 16; ++r) P0[r] = __builtin_amdgcn_exp2f(P0[r]); } while (0)
#define RESC() do { if (resc) { asm volatile("s_waitcnt lgkmcnt(0)" ::: "memory"); \
      _Pragma("unroll") for (int d_ = 0; d_ < 2; ++d_) _Pragma("unroll") for (int r = 0; r < 16; ++r) o[d_][r] *= wsf[crow(r, hi)]; } } while (0)
    f32x16 pA0, pA1, pB0, pB1;
    int sl_prev = 0, sl_cur = 0, sl_next = SLOTB;
#define ROT() do { sl_prev = sl_cur; sl_cur = sl_next; sl_next = (sl_next == (NSLOT - 1) * SLOTB) ? 0 : sl_next + SLOTB; } while (0)
    DMA_K(2, 2 * SLOTB);
    WAIT_BAR(3);
    qkt(pA0, pA1, Kbase, qr, negm, r32, hi); asm volatile("s_nop 15\n\ts_nop 7" : "+v"(pA0), "+v"(pA1));
    START(pA0, pA1);
    _Pragma("unroll") for (int r = 0; r < 16; ++r) pA1[r] = __builtin_amdgcn_exp2f(pA1[r]);
    WAIT_BAR(0);
    DMA_K(3, 0); DMA_V(1, SLOTB);
    ROT();
    kload8(kf, kp0 + sl_cur);
    WAIT_BAR(2);
    s16x4 vlo[8], vhi[8]; u32x4 pw0, pw1, pw2, pw3;
#define PKW(P, B) cvtpk_s(P[B], P[B + 1])
#define PAF(k) __builtin_bit_cast(bf16x8, pw##k)
#define VFR(i) (bf16x8){vlo[i][0], vlo[i][1], vlo[i][2], vlo[i][3], vhi[i][0], vhi[i][1], vhi[i][2], vhi[i][3]}
#define PIN(x) asm volatile("" : "+v"(x))
#define MX3(a, b, c) __builtin_fmaxf(__builtin_fmaxf((a), (b)), (c))
#define GAPA(MF, A0, A1, A2, A3, W0, W1, PW) do { MF; sacc += A0; sacc += A1; sacc += A2; sacc += A3; PIN(sacc); W0; W1; PIN(PW); SBAR(); } while (0)
#define EX(v) __builtin_amdgcn_exp2f(v)
#define GAPB(MF, X, B) do { MF; X[B] = EX(X[B]); X[B + 1] = EX(X[B + 1]); X[B + 2] = EX(X[B + 2]); X[B + 3] = EX(X[B + 3]); PIN(X); SBAR(); } while (0)
#define VRD(i) do { vlo[i] = vtr(vp_ + (((i) >> 2) * 4096 + ((i) & 3) * 1024)); vhi[i] = vtr(vp_ + (((i) >> 2) * 4096 + ((i) & 3) * 1024 + 512)); } while (0)
#define KRD(G, j) do { if (G) { kload2(kf, kp0 + sl_next, j); SBAR(); } } while (0)
#define STEP(C0, C1, P0, P1, t, GK, GV, GL) do { SBAR(); \
    const lds_cptr vp_ = vp0 + sl_prev; \
    VRD(0); SBAR(); float sacc = (P0[0] + P0[1]); \
    GAPA(C0 = __builtin_amdgcn_mfma_f32_32x32x16_bf16(kf[0], qr[0], negm, 0, 0, 0), P0[2], P0[3], P0[4], P0[5],     pw0[0] = PKW(P0, 0), pw0[1] = PKW(P0, 2), pw0); \
    VRD(4); SBAR(); GAPA(C1 = __builtin_amdgcn_mfma_f32_32x32x16_bf16(kf[1], qr[0], negm, 0, 0, 0), P0[6], P0[7], P0[8], P0[9],     pw0[2] = PKW(P0, 4), pw0[3] = PKW(P0, 6), pw0); \
    VRD(1); SBAR(); GAPA(C0 = __builtin_amdgcn_mfma_f32_32x32x16_bf16(kf[2], qr[1], C0, 0, 0, 0),   P0[10], P0[11], P0[12], P0[13], pw1[0] = PKW(P0, 8), pw1[1] = PKW(P0, 10), pw1); \
    VRD(5); SBAR(); GAPA(C1 = __builtin_amdgcn_mfma_f32_32x32x16_bf16(kf[3], qr[1], C1, 0, 0, 0),   P0[14], P0[15], P1[0], P1[1],   pw1[2] = PKW(P0, 12), pw1[3] = PKW(P0, 14), pw1); \
    VRD(2); SBAR(); GAPA(C0 = __builtin_amdgcn_mfma_f32_32x32x16_bf16(kf[4], qr[2], C0, 0, 0, 0),   P1[2], P1[3], P1[4], P1[5],     pw2[0] = PKW(P1, 0), pw2[1] = PKW(P1, 2), pw2); \
    VRD(6); SBAR(); GAPA(C1 = __builtin_amdgcn_mfma_f32_32x32x16_bf16(kf[5], qr[2], C1, 0, 0, 0),   P1[6], P1[7], P1[8], P1[9],     pw2[2] = PKW(P1, 4), pw2[3] = PKW(P1, 6), pw2); \
    VRD(3); SBAR(); GAPA(C0 = __builtin_amdgcn_mfma_f32_32x32x16_bf16(kf[6], qr[3], C0, 0, 0, 0),   P1[10], P1[11], P1[12], P1[13], pw3[0] = PKW(P1, 8), pw3[1] = PKW(P1, 10), pw3); \
    VRD(7); SBAR(); GAPA(C1 = __builtin_amdgcn_mfma_f32_32x32x16_bf16(kf[7], qr[3], C1, 0, 0, 0),   P1[14], P1[15], 0.f, 0.f,       pw3[2] = PKW(P1, 12), pw3[3] = PKW(P1, 14), pw3); \
    l_reg += sacc; \
    if (GK) { DMA_K((t) + 3, sl_cur); } if (GV) { DMA_V((t) + 1, sl_next); } \
    CMASK(C0, C1, t); \
    { float a = MX3(C0[0], C0[1], C1[0]), b = MX3(C0[2], C0[3], C1[1]); a = MX3(a, C1[2], C1[3]); \
      _Pragma("unroll") for (int r = 4; r < 16; r += 4) { a = MX3(a, C0[r], C0[r + 1]); b = MX3(b, C0[r + 2], C0[r + 3]); a = MX3(a, C1[r], C1[r + 1]); b = MX3(b, C1[r + 2], C1[r + 3]); } \
      float rm = __builtin_fmaxf(a, b); { auto rr = __builtin_amdgcn_permlane32_swap(__float_as_uint(rm), __float_as_uint(rm), false, false); rm = __builtin_fmaxf(__uint_as_float(rr[0]), __uint_as_float(rr[1])); } \
      resc = false; \
      if (__builtin_expect(__any(rm > (float)THRL), 0)) { const float dl = __builtin_fmaxf(rm, 0.f); mhat += dl; \
        _Pragma("unroll") for (int r = 0; r < 16; ++r) { C0[r] -= dl; C1[r] -= dl; } \
        _Pragma("unroll") for (int r = 0; r < 16; ++r) negm[r] = -mhat; asm volatile("" : "+v"(negm)); \
        const float f = __builtin_amdgcn_exp2f(-dl); l_reg *= f; if (hi == 0) wsf[r32] = f; resc = true; } } \
    SBAR(); \
    GAPB(o[0] = __builtin_amdgcn_mfma_f32_32x32x16_bf16(PAF(0), VFR(0), o[0], 0, 0, 0), C0, 0); \
    GAPB(o[1] = __builtin_amdgcn_mfma_f32_32x32x16_bf16(PAF(0), VFR(4), o[1], 0, 0, 0), C0, 4); \
    KRD(GL, 0); GAPB(o[0] = __builtin_amdgcn_mfma_f32_32x32x16_bf16(PAF(1), VFR(1), o[0], 0, 0, 0), C0, 8); \
    KRD(GL, 1); GAPB(o[1] = __builtin_amdgcn_mfma_f32_32x32x16_bf16(PAF(1), VFR(5), o[1], 0, 0, 0), C0, 12); \
    KRD(GL, 2); GAPB(o[0] = __builtin_amdgcn_mfma_f32_32x32x16_bf16(PAF(2), VFR(2), o[0], 0, 0, 0), C1, 0); \
    KRD(GL, 3); GAPB(o[1] = __builtin_amdgcn_mfma_f32_32x32x16_bf16(PAF(2), VFR(6), o[1], 0, 0, 0), C1, 4); \
    GAPB(o[0] = __builtin_amdgcn_mfma_f32_32x32x16_bf16(PAF(3), VFR(3), o[0], 0, 0, 0), C1, 8); \
    GAPB(o[1] = __builtin_amdgcn_mfma_f32_32x32x16_bf16(PAF(3), VFR(7), o[1], 0, 0, 0), C1, 12); \
    } while (0)
    int t = 1;
    for (; t + 5 < NT; t += 2) {
        STEP(pB0, pB1, pA0, pA1, t, true, true, true);     WAIT_BAR(2); RESC(); ROT();
        STEP(pA0, pA1, pB0, pB1, t + 1, true, true, true); WAIT_BAR(2); RESC(); ROT();
    }
#define ENDW(tt) do { if ((tt) + 3 < NT) { WAIT_BAR(2); } else if ((tt) + 2 < NT) { WAIT_BAR(1); } else { WAIT_BAR(0); } } while (0)
    for (; t + 1 < NT; t += 2) {
        STEP(pB0, pB1, pA0, pA1, t, (t + 3 < NT), (t + 1 < NT), (t + 1 < NT));         ENDW(t);     RESC(); ROT();
        STEP(pA0, pA1, pB0, pB1, t + 1, (t + 4 < NT), (t + 2 < NT), (t + 2 < NT));     ENDW(t + 1); RESC(); ROT();
    }
    STEP(pB0, pB1, pA0, pA1, NT - 1, false, false, false); RESC();
    { float sacc = pB0[0] + pB0[1]; _Pragma("unroll") for (int r = 2; r < 16; ++r) sacc += pB0[r]; _Pragma("unroll") for (int r = 0; r < 16; ++r) sacc += pB1[r]; l_reg += sacc;
      pw0 = (u32x4){PKW(pB0, 0), PKW(pB0, 2), PKW(pB0, 4), PKW(pB0, 6)}; pw1 = (u32x4){PKW(pB0, 8), PKW(pB0, 10), PKW(pB0, 12), PKW(pB0, 14)}; pw2 = (u32x4){PKW(pB1, 0), PKW(pB1, 2), PKW(pB1, 4), PKW(pB1, 6)}; pw3 = (u32x4){PKW(pB1, 8), PKW(pB1, 10), PKW(pB1, 12), PKW(pB1, 14)};
      SBAR(); pv(o, vb0 + sl_cur, PAF(0), PAF(1), PAF(2), PAF(3)); }
#undef PKW
#undef PAF
#undef VFR
#undef PIN
#undef MX3
#undef GAPA
#undef GAPB
#undef EX
#undef VRD
#undef KRD
#undef STEP
#undef ENDW
    { auto rr = __builtin_amdgcn_permlane32_swap(__float_as_uint(l_reg), __float_as_uint(l_reg), false, false); l_reg = __uint_as_float(rr[0]) + __uint_as_float(rr[1]); }
    if (has_sink) l_reg += __builtin_amdgcn_exp2f(sinkl2 - mhat);
    if (hi == 0) wsf[32 + r32] = l_reg; asm volatile("s_waitcnt lgkmcnt(0)" ::: "memory");
    float rli[16];
#pragma unroll
    for (int r = 0; r < 16; ++r) rli[r] = __builtin_amdgcn_rcpf(wsf[32 + crow(r, hi)]);
    bf16* Ow = Ow0 + (long)(wid * QBLK) * YP;
    { bf16* stg = (bf16*)(shm + LDS_OST) + wid * 2048;
#pragma unroll
      for (int r = 0; r < 16; ++r) { const int orow = crow(r, hi);
#pragma unroll
        for (int d0 = 0; d0 < 2; ++d0) stg[orow * 64 + d0 * 32 + r32] = __float2bfloat16(o[d0][r] * rli[r]); }
      asm volatile("s_waitcnt lgkmcnt(0)" ::: "memory");
#pragma unroll
      for (int i = 0; i < 4; ++i) { const int row = i * 8 + (lane >> 3), ch = lane & 7; const u32x4 v = *(const u32x4*)(stg + row * 64 + ch * 8); *(u32x4*)(Ow + (long)row * YP + ch * 8) = v; } }
    asm volatile("s_waitcnt lgkmcnt(0)\n\ts_barrier" ::: "memory");
#undef DMA_K
#undef DMA_V
#undef TOFF
#undef CMASK
#undef START
#undef RESC
#undef ROT
}
constexpr int ATTN_LDS_BYTES = LDS_BYTES;
#undef SBAR
#undef WAIT_BAR
}

constexpr int NWAVES = 8, NTHREADS = NWAVES * 64;
constexpr int RING_BYTES = 131072, LDS_BYTES = 147456;
constexpr int LDSCTL_OFF = RING_BYTES, MISC_OFF = LDSCTL_OFF + 320;
#define LAS __attribute__((address_space(3)))
typedef unsigned short bf16;
typedef unsigned v4u __attribute__((ext_vector_type(4)));
typedef unsigned v2u __attribute__((ext_vector_type(2)));
typedef float f32x4 __attribute__((ext_vector_type(4)));
using pg8::cvt_pk_bf16; using pg8::bf_lo; using pg8::bf_hi;

constexpr size_t MiB = 1u << 20;
constexpr size_t WS_MOD = 0;
constexpr size_t WS_CTL = 1 * MiB, CTL_ZERO_BYTES = 16384;
constexpr size_t WS_W = 2 * MiB;
constexpr size_t LW_IN = 0;
constexpr size_t LW_POOL = LW_IN + (size_t)5120 * 1024 * 2;
constexpr size_t LW_BR = LW_POOL + (size_t)512 * 256 * 2;
constexpr size_t LW_OUT = LW_BR + (size_t)3072 * 512 * 2;
constexpr size_t LW_FF = LW_OUT + (size_t)1024 * 1024 * 2;
constexpr size_t LW_DN = LW_FF + (size_t)5632 * 1024 * 2;
constexpr size_t LW_BYTES = LW_DN + (size_t)1024 * 2816 * 2;
constexpr size_t WS_XC = WS_W + ((2 * LW_BYTES + MiB - 1) / MiB) * MiB;
constexpr size_t WS_ARENA = WS_XC + (size_t)NCTX * 1024 * 4;
constexpr size_t AR_Z = 0, AR_G = (size_t)NTOK * ZP * 2, AR_Y = AR_G + (size_t)NTOK * GP * 2, AR_H = AR_Y;
constexpr size_t AR_MRG = AR_Z;
constexpr size_t AR_U = 0, AR_SIDE = (size_t)NTOK * FF * 2, SIDE_BYTES = (size_t)(NTOK / 32) * FF * 4, AR_H2 = (size_t)NTOK * AVP * 2;
constexpr size_t AR_XF = ((AR_SIDE + 3 * SIDE_BYTES + 4095) / 4096) * 4096;
static_assert(AR_XF + (size_t)NLAT * 1024 * 4 <= AR_H2, "side buffers + XF");
constexpr size_t WS_END = WS_ARENA + (size_t)NTOK * 6656 * 2;
static_assert(AR_Y + (size_t)NTOK * YP * 2 == (size_t)NTOK * 6656 * 2 && AR_H2 + (size_t)NTOK * 1024 * 2 == (size_t)NTOK * 6656 * 2, "arena views");


#define XB_TMO      128
#define XB_XCNT(j)  (256  + 64 * (j))
#define XB_XSUB(j)  (1280 + 64 * (j))
#define XB_XGEN(j)  (2304 + 64 * (j))
#define XB_TOP      3328
#define XB_TOPGEN   3392
#define XCD_BAR_WORDS 3456
#define XB_SPIN_CAP (1u << 20)
__device__ __forceinline__ unsigned xb_ld(unsigned* p)              { return __hip_atomic_load(p, __ATOMIC_RELAXED, __HIP_MEMORY_SCOPE_AGENT); }
__device__ __forceinline__ unsigned xb_add(unsigned* p, unsigned v) { return __hip_atomic_fetch_add(p, v, __ATOMIC_RELAXED, __HIP_MEMORY_SCOPE_AGENT); }
__device__ __forceinline__ unsigned xb_xcc_id() { return (unsigned)__builtin_amdgcn_s_getreg((3 << 11) | 20) & 0xFu; }
#define XB_SPIN(cond, bar) do { unsigned _sp = 0; while (cond) { __builtin_amdgcn_s_sleep(1); \
    if ((++_sp & 255u) == 0u) { if (xb_ld(&(bar)[XB_TMO])) break; if (_sp > XB_SPIN_CAP) { atomicAdd(&(bar)[XB_TMO], 1u); break; } } } } while (0)
struct XcdBarrier { unsigned* bar; unsigned x; volatile LAS unsigned* st; };
__device__ __forceinline__ XcdBarrier xcd_barrier_post(unsigned* bar, volatile LAS unsigned* st) {
    XcdBarrier b; b.bar = bar; b.x = xb_xcc_id(); b.st = st;
    if (threadIdx.x == 0) (void)xb_add(&bar[XB_XCNT(b.x)], 1u);
    return b;
}
__device__ __forceinline__ void xcd_barrier_complete(unsigned* bar, unsigned x, unsigned& nloc, unsigned& nx) {
    const unsigned G = gridDim.x * gridDim.y * gridDim.z;
    unsigned sum, cnt, mine, sp = 0u;
    for (;;) {
        sum = 0u; cnt = 0u; mine = 0u;
#pragma unroll
        for (unsigned j = 0; j < 16; ++j) { const unsigned c = xb_ld(&bar[XB_XCNT(j)]); sum += c; cnt += (c > 0u) ? 1u : 0u; mine = (j == x) ? c : mine; }
        if (sum == G) break;
        __builtin_amdgcn_s_sleep(1);
        if ((++sp & 255u) == 0u) { if (xb_ld(&bar[XB_TMO])) break; if (sp > XB_SPIN_CAP) { atomicAdd(&bar[XB_TMO], 1u); break; } }
    }
    nloc = mine > 0u ? mine : 1u; nx = cnt > 0u ? cnt : 1u;
}
__device__ __forceinline__ void xcd_barrier(const XcdBarrier& b, int wave) {
    asm volatile("s_waitcnt vmcnt(0)" ::: "memory");
    __syncthreads();
    if (wave == 0 && lane_fresh() == 0) {
        unsigned* bar = b.bar;
        __builtin_amdgcn_s_waitcnt(0);
        unsigned nloc = b.st[0], nx = b.st[1];
        if (nloc == 0u) { xcd_barrier_complete(bar, b.x, nloc, nx); b.st[0] = nloc; b.st[1] = nx; }
        const unsigned old = xb_add(&bar[XB_XSUB(b.x)], 1u);
        const unsigned gen = old / nloc;
        if (old + 1u == (gen + 1u) * nloc) {
            __builtin_amdgcn_fence(__ATOMIC_RELEASE, "agent");
            asm volatile("s_waitcnt vmcnt(0)" ::: "memory");
            const unsigned og = xb_add(&bar[XB_TOP], 1u);
            const unsigned tg = og / nx;
            if (og + 1u == (tg + 1u) * nx) xb_add(&bar[XB_TOPGEN], 1u);
            else XB_SPIN(xb_ld(&bar[XB_TOPGEN]) == tg, bar);
            __builtin_amdgcn_fence(__ATOMIC_ACQUIRE, "agent");
            xb_add(&bar[XB_XGEN(b.x)], 1u);
            asm volatile("s_waitcnt vmcnt(0)" ::: "memory");
        } else {
            XB_SPIN(xb_ld(&bar[XB_XGEN(b.x)]) == gen, bar);
            __builtin_amdgcn_fence(__ATOMIC_ACQUIRE, "agent");
            asm volatile("s_waitcnt vmcnt(0)" ::: "memory");
        }
    }
    __syncthreads();
}

struct Args {
    const float *x, *c, *ctx, *c_ctx, *w_mod, *b_mod, *norm1_g, *norm2_g, *w_in, *w_pool_grp, *pool_scale, *win_sink, *q_norm_g, *k_norm_g,
                *w_branch, *w_gate, *b_gate, *w_out, *w_ff_gate, *w_ff_val, *conv_w, *conv_b, *w_ff_down, *final_g;
    float* out; unsigned char* ws; int ph_lo, ph_hi;
};

__device__ __forceinline__ float shx(float v, int lane, int m) { return __int_as_float(__builtin_amdgcn_ds_bpermute((lane ^ m) << 2, __float_as_int(v))); }
__device__ __forceinline__ float wave_sum(float v, int lane) {
#pragma unroll
    for (int o = 1; o < 64; o <<= 1) v += shx(v, lane, o);
    return v;
}
__device__ __forceinline__ void transpose_item(const float* W, int K, int N, bf16* WT, int ldw, int row_off, LAS float* scr, int item, int lane, bool spread = false) {
    const int nblk = N / 32, kb = item / nblk, nb = item % nblk, k0 = 64 * kb, n0 = 32 * nb;
    if (spread) row_off += 128 * (n0 >> 7);
#pragma unroll 8
    for (int i = 0; i < 32; ++i) { const int kk = 2 * i + (lane >> 5); scr[kk * 33 + (lane & 31)] = W[(size_t)(k0 + kk) * N + n0 + (lane & 31)]; }
    asm volatile("s_waitcnt lgkmcnt(0)" ::: "memory");
    const int c = lane & 7;
#pragma unroll
    for (int j = 0; j < 4; ++j) { const int n = (lane >> 3) + 8 * j; const LAS float* s = scr + (8 * c) * 33 + n;
        v4u o; o.x = cvt_pk_bf16(s[0 * 33], s[1 * 33]); o.y = cvt_pk_bf16(s[2 * 33], s[3 * 33]); o.z = cvt_pk_bf16(s[4 * 33], s[5 * 33]); o.w = cvt_pk_bf16(s[6 * 33], s[7 * 33]);
        *(v4u*)(WT + (size_t)(row_off + n0 + n) * ldw + k0 + 8 * c) = o; }
    asm volatile("s_waitcnt lgkmcnt(0)" ::: "memory");
}

__device__ __forceinline__ void prologue(const Args& A, LAS unsigned char* lds, int G, int vcu, int tid, int lane, int wave) {
    float* mod = (float*)(A.ws + WS_MOD);
    if ((int)blockIdx.x < 192) {
        LAS float* S = (LAS float*)lds; LAS float* part = (LAS float*)(lds + 17 * 1024 * 4);
        for (int idx = tid; idx < 17 * 1024; idx += NTHREADS) { const int r = idx >> 10, k = idx & 1023; const float v = (r < 16) ? A.c[r * 1024 + k] : A.c_ctx[k];
            S[idx] = v / (1.0f + __builtin_amdgcn_exp2f(-v * LOG2E)); }
        __syncthreads();
        for (int u = blockIdx.x; u < 192; u += G) {
            const int l = u / 96, n0 = (u % 96) * 64;
            float acc[17];
#pragma unroll
            for (int r = 0; r < 17; ++r) acc[r] = 0.f;
            const float* W = A.w_mod + (size_t)l * 1024 * 6144 + n0 + lane;
#pragma unroll 16
            for (int kk = 0; kk < 128; ++kk) { const int k = kk * 8 + wave; const float w = W[(size_t)k * 6144];
#pragma unroll
                for (int r = 0; r < 17; ++r) acc[r] += S[r * 1024 + k] * w; }
#pragma unroll
            for (int r = 0; r < 17; ++r) part[(wave * 17 + r) * 64 + lane] = acc[r];
            __syncthreads();
            for (int idx = tid; idx < 17 * 64; idx += NTHREADS) { const int r = idx >> 6, j = idx & 63; float s = 0.f;
#pragma unroll
                for (int w = 0; w < 8; ++w) s += part[(w * 17 + r) * 64 + j];
                mod[(size_t)(l * 17 + r) * 6144 + n0 + j] = s + A.b_mod[l * 6144 + n0 + j]; }
            __syncthreads();
        }
    }
    __syncthreads();
    LAS float* scr = (LAS float*)(lds + wave * 16384);
    const int gw = vcu * NWAVES + wave, NGW = G * NWAVES;
    constexpr int I_IN = 16 * 64, I_GATE = 16 * 32, I_BR = 8 * 32, I_OUT = 16 * 32, I_FF = 16 * 88, I_DN = 44 * 32;
    constexpr int PER_LAYER = I_IN + 3 * I_GATE + 3 * I_BR + I_OUT + 2 * I_FF + I_DN;
    for (int it = gw; it < 2 * PER_LAYER; it += NGW) {
        const int l = it / PER_LAYER; int r = it % PER_LAYER;
        unsigned char* wl = A.ws + WS_W + (size_t)l * LW_BYTES;
        if (r < I_IN) { transpose_item(A.w_in + (size_t)l * 1024 * 2048, 1024, 2048, (bf16*)(wl + LW_IN), 1024, 0, scr, r, lane); continue; } r -= I_IN;
        if (r < 3 * I_GATE) { const int i = r / I_GATE; transpose_item(A.w_gate + ((size_t)l * 3 + i) * 1024 * 1024, 1024, 1024, (bf16*)(wl + LW_IN), 1024, 2048 + i * 1024, scr, r % I_GATE, lane); continue; } r -= 3 * I_GATE;
        if (r < 3 * I_BR) { const int i = r / I_BR; transpose_item(A.w_branch + ((size_t)l * 3 + i) * 512 * 1024, 512, 1024, (bf16*)(wl + LW_BR), 512, i * 1024, scr, r % I_BR, lane); continue; } r -= 3 * I_BR;
        if (r < I_OUT) { transpose_item(A.w_out + (size_t)l * 1024 * 1024, 1024, 1024, (bf16*)(wl + LW_OUT), 1024, 0, scr, r, lane); continue; } r -= I_OUT;
        if (r < I_FF) { transpose_item(A.w_ff_gate + (size_t)l * 1024 * FF, 1024, FF, (bf16*)(wl + LW_FF), 1024, 0, scr, r, lane, true); continue; } r -= I_FF;
        if (r < I_FF) { transpose_item(A.w_ff_val + (size_t)l * 1024 * FF, 1024, FF, (bf16*)(wl + LW_FF), 1024, 128, scr, r, lane, true); continue; } r -= I_FF;
        transpose_item(A.w_ff_down + (size_t)l * FF * 1024, FF, 1024, (bf16*)(wl + LW_DN), FF, 0, scr, r, lane);
    }
    for (int idx = vcu * NTHREADS + tid; idx < 2 * 512 * 256; idx += G * NTHREADS) {
        const int l = idx / (512 * 256), e = idx % (512 * 256), n = e >> 8, k = e & 255, g = n >> 7, gk = 2 * (n >> 8) + (k >> 7);
        const float v = (gk == g) ? A.w_pool_grp[(((size_t)l * 4 + g) * 128 + (k & 127)) * 128 + (n & 127)] : 0.f;
        ((bf16*)(A.ws + WS_W + (size_t)l * LW_BYTES + LW_POOL))[e] = (bf16)(cvt_pk_bf16(v, 0.f) & 0xffffu);
    }
}

template <bool SRC_BF16>
__device__ __forceinline__ void norm_rows(const void* xlat, const void* xctx, const float* gvec, const float* modl, int which, int nrows, bf16* H, int gw, int NGW) {
    const int lane = lane_fresh(); asm volatile("" : "+s"(gw));
    constexpr int R = 4;
    for (int row0 = gw * R; row0 < nrows; row0 += NGW * R) {
        const bool lat = row0 < NLAT;
        const size_t roff = lat ? (size_t)row0 * 1024 : (size_t)(row0 - NLAT) * 1024;
        const void* srcb = lat ? xlat : xctx;
        const int b = lat ? (row0 >> 12) : NB;
        const float* shp = modl + (size_t)(b * 6 + which * 3) * 1024; const float* scp = shp + 1024;
        float v[R][2][8]; float ss[R];
#pragma unroll
        for (int r = 0; r < R; ++r)
#pragma unroll
            for (int j = 0; j < 2; ++j) { const size_t o = roff + (size_t)r * 1024 + 8 * lane + 512 * j;
                if constexpr (SRC_BF16) { const v4u w = *(const v4u*)((const bf16*)srcb + o);
                    v[r][j][0] = bf_lo(w.x); v[r][j][1] = bf_hi(w.x); v[r][j][2] = bf_lo(w.y); v[r][j][3] = bf_hi(w.y); v[r][j][4] = bf_lo(w.z); v[r][j][5] = bf_hi(w.z); v[r][j][6] = bf_lo(w.w); v[r][j][7] = bf_hi(w.w); }
                else { const f32x4 a = *(const f32x4*)((const float*)srcb + o), c = *(const f32x4*)((const float*)srcb + o + 4);
                    v[r][j][0] = a.x; v[r][j][1] = a.y; v[r][j][2] = a.z; v[r][j][3] = a.w; v[r][j][4] = c.x; v[r][j][5] = c.y; v[r][j][6] = c.z; v[r][j][7] = c.w; } }
#pragma unroll
        for (int r = 0; r < R; ++r) { float s = 0.f;
#pragma unroll
            for (int j = 0; j < 2; ++j)
#pragma unroll
                for (int i = 0; i < 8; ++i) s += v[r][j][i] * v[r][j][i];
            ss[r] = s; }
#pragma unroll
        for (int o = 1; o < 64; o <<= 1)
#pragma unroll
            for (int r = 0; r < R; ++r) ss[r] += shx(ss[r], lane, o);
#pragma unroll
        for (int j = 0; j < 2; ++j) { const int c0 = 8 * lane + 512 * j; float gm[8], sh[8];
#pragma unroll
            for (int h = 0; h < 2; ++h) { const f32x4 g = *(const f32x4*)(gvec + c0 + 4 * h), s4 = *(const f32x4*)(shp + c0 + 4 * h), sc = *(const f32x4*)(scp + c0 + 4 * h);
#pragma unroll
                for (int e = 0; e < 4; ++e) { gm[4 * h + e] = g[e] * (sc[e] + 1.0f); sh[4 * h + e] = s4[e]; } }
#pragma unroll
            for (int r = 0; r < R; ++r) { const float rstd = __builtin_amdgcn_rsqf(ss[r] * (1.f / 1024.f) + EPS); float y[8];
#pragma unroll
                for (int i = 0; i < 8; ++i) y[i] = (v[r][j][i] * rstd) * gm[i] + sh[i];
                v4u w; w.x = cvt_pk_bf16(y[0], y[1]); w.y = cvt_pk_bf16(y[2], y[3]); w.z = cvt_pk_bf16(y[4], y[5]); w.w = cvt_pk_bf16(y[6], y[7]);
                *(v4u*)(H + (size_t)(row0 + r) * 1024 + c0) = w; } }
    }
}
__device__ __forceinline__ void final_norm_rows(const float* x, float* out, const float* gvec, int gw, int NGW) {
    const int lane = lane_fresh(); asm volatile("" : "+s"(gw));
    constexpr int R = 4;
    for (int row0 = gw * R; row0 < NLAT; row0 += NGW * R) {
        f32x4 v[R][4]; float ss[R];
#pragma unroll
        for (int r = 0; r < R; ++r)
#pragma unroll
            for (int j = 0; j < 4; ++j) v[r][j] = *(const f32x4*)(x + (size_t)(row0 + r) * 1024 + 4 * lane + 256 * j);
#pragma unroll
        for (int r = 0; r < R; ++r) { float s = 0.f;
#pragma unroll
            for (int j = 0; j < 4; ++j) s += (v[r][j].x * v[r][j].x + v[r][j].y * v[r][j].y) + (v[r][j].z * v[r][j].z + v[r][j].w * v[r][j].w);
            ss[r] = s; }
#pragma unroll
        for (int o = 1; o < 64; o <<= 1)
#pragma unroll
            for (int r = 0; r < R; ++r) ss[r] += shx(ss[r], lane, o);
#pragma unroll
        for (int j = 0; j < 4; ++j) { const int c0 = 4 * lane + 256 * j; const f32x4 g = *(const f32x4*)(gvec + c0);
#pragma unroll
            for (int r = 0; r < R; ++r) { const float rstd = __builtin_amdgcn_rsqf(ss[r] * (1.f / 1024.f) + EPS); *(f32x4*)(out + (size_t)(row0 + r) * 1024 + c0) = v[r][j] * rstd * g; } }
    }
}

__device__ __forceinline__ void unpack8(const v4u w, float* v) { v[0] = bf_lo(w.x); v[1] = bf_hi(w.x); v[2] = bf_lo(w.y); v[3] = bf_hi(w.y); v[4] = bf_lo(w.z); v[5] = bf_hi(w.z); v[6] = bf_lo(w.w); v[7] = bf_hi(w.w); }
__device__ __forceinline__ v4u pack8(const float* v) { v4u w; w.x = cvt_pk_bf16(v[0], v[1]); w.y = cvt_pk_bf16(v[2], v[3]); w.z = cvt_pk_bf16(v[4], v[5]); w.w = cvt_pk_bf16(v[6], v[7]); return w; }
__device__ __forceinline__ void qk_proc(float* v, bool do_norm, const float* g, bool do_rope, bool hi_half, const float* cs, const float* sn, float scale, int lane) {
    float ss = 0.f;
#pragma unroll
    for (int i = 0; i < 8; ++i) ss += v[i] * v[i];
    ss += shx(ss, lane, 1); ss += shx(ss, lane, 2); ss += shx(ss, lane, 4);
    const float rstd = __builtin_amdgcn_rsqf(ss * (1.f / 64.f) + EPS);
#pragma unroll
    for (int i = 0; i < 8; ++i) { const float nv = v[i] * rstd * g[i]; v[i] = do_norm ? nv : v[i]; }
#pragma unroll
    for (int i = 0; i < 8; ++i) { const float pvv = shx(v[i], lane, 2);
        const float rv = hi_half ? (v[i] * cs[i] + pvv * sn[i]) : (v[i] * cs[i] - pvv * sn[i]);
        v[i] = (do_rope ? rv : v[i]) * scale; }
}
template <int W2> __device__ __forceinline__ void pool_quad(const bf16* __restrict__ Z, bf16* __restrict__ Y, int row, int t, int L, int ch) {
    int lo = t - W2; lo = lo < 0 ? 0 : lo; int hi = t + W2; hi = hi > L ? L : hi;
    const bf16* zc = Z + (size_t)(row - t) * ZP + ch;
    const v4u zero = {0u, 0u, 0u, 0u};
    v4u pw[2 * W2];
#pragma unroll
    for (int jj = 0; jj < 2 * W2; ++jj) { const int r = lo + jj; pw[jj] = (r < hi) ? *(const v4u*)(zc + (size_t)r * ZP) : zero; }
    const v4u own_w = *(const v4u*)(zc + (size_t)t * ZP);
    float acc[8];
#pragma unroll
    for (int i = 0; i < 8; ++i) acc[i] = 0.f;
#pragma unroll
    for (int jj = 0; jj < 2 * W2; ++jj) { float u[8]; unpack8(pw[jj], u);
#pragma unroll
        for (int i = 0; i < 8; ++i) acc[i] += u[i]; }
    float own[8]; unpack8(own_w, own); const float rc = 1.0f / (float)(hi - lo);
#pragma unroll
    for (int i = 0; i < 8; ++i) acc[i] = acc[i] * rc - own[i];
    *(v4u*)(Y + (size_t)row * YP + ch) = pack8(acc);
}
__device__ __forceinline__ void elem_phase(const Args& A, int layer, int nrows, int nrows_pool, bf16* Z, bf16* Y, int gw, int NGW) {
    const int lane = lane_fresh(); asm volatile("" : "+s"(gw));
    for (int q = gw; q < nrows_pool / 4; q += NGW) {
        const int row = 4 * q + (lane >> 4), c16 = (lane & 15) * 8;
        const bool lat = row < NLAT;
        const int t = lat ? (row & (SEQ - 1)) : ((row - NLAT) & (CTX - 1));
        const int L = lat ? SEQ : CTX;
        pool_quad<8>(Z, Y, row, t, L, 384 + c16);
        pool_quad<4>(Z, Y, row, t, L, 256 + c16);
        pool_quad<2>(Z, Y, row, t, L, 128 + c16);
        pool_quad<1>(Z, Y, row, t, L, c16);
    }
    const int j8 = lane & 7; const bool hi_half = (j8 >> 1) & 1; const int axis = j8 >> 2, fbase = (j8 & 1) * 8;
    float inv[8], kg[8];
#pragma unroll
    for (int i = 0; i < 8; ++i) { inv[i] = __builtin_amdgcn_exp2f(-(float)(fbase + i) * (13.287712379549449f / 16.0f)) * 0.15915494309189535f;
        kg[i] = A.k_norm_g[layer * 64 + j8 * 8 + i]; }
    for (int p = gw; p < nrows / 2; p += NGW) {
        const int row = 2 * p + (lane >> 5);
        const bool lat = row < NLAT;
        const int t = lat ? (row & (SEQ - 1)) : ((row - NLAT) & (CTX - 1));
        bf16* zrow = Z + (size_t)row * ZP;
        const int l5 = lane & 31; const bool isg = l5 >= 16; const int kcol = isg ? 1792 + (l5 - 16) * 8 : 1024 + l5 * 8;
        const v4u k_w = *(const v4u*)(zrow + kcol);
        float cs[8], sn[8];
        { const float pos = (float)(axis ? (t & 63) : (t >> 6));
#pragma unroll
          for (int i = 0; i < 8; ++i) { float r = pos * inv[i]; r = r - __builtin_floorf(r); cs[i] = __builtin_amdgcn_cosf(r); sn[i] = __builtin_amdgcn_sinf(r); } }
        float vk[8];
        unpack8(k_w, vk); qk_proc(vk, isg, kg, lat, hi_half, cs, sn, 1.0f, lane);
        *(v4u*)(zrow + kcol) = pack8(vk);
    }
}

__device__ __forceinline__ void fixup_phase(const Args& A, int layer, int nrows, bf16* U, const float* As, const float* PAs, const float* Vs, int gbase, int NT) {
    const int gtid = gbase + lane_fresh();
    const int items = (nrows / 32) * 352;
    const float* cw = A.conv_w + (size_t)layer * 3 * FF;
    for (int it = gtid; it < items; it += NT) {
        const int c8 = it % 352, brow = it / 352, side = brow & 1, col = c8 * 8;
        const int r = (brow >> 1) * 64 + (side ? 63 : 0);
        const bool lat = r < NLAT; const int L = lat ? SEQ : CTX; const int t = lat ? (r & (SEQ - 1)) : ((r - NLAT) & (CTX - 1));
        const bool has = side ? (t != L - 1) : (t != 0);
        const int nb = has ? (side ? brow + 1 : brow - 1) : brow;
        const float* wp = cw + (side ? 2 * FF : 0) + col;
        const size_t so = (size_t)brow * FF + col, sn = (size_t)nb * FF + col;
        float o[8];
#pragma unroll
        for (int h = 0; h < 2; ++h) { const f32x4 pa = *(const f32x4*)(PAs + so + 4 * h), vv = *(const f32x4*)(Vs + so + 4 * h), an = *(const f32x4*)(As + sn + 4 * h), w = *(const f32x4*)(wp + 4 * h);
#pragma unroll
            for (int e = 0; e < 4; ++e) { const float pre = pa[e] + (has ? w[e] * an[e] : 0.f); o[4 * h + e] = pre * pg8::sigmoidf_(pre) * vv[e]; } }
        *(v4u*)(U + (size_t)r * FF + col) = pack8(o);
    }
}

__device__ __forceinline__ void attention_phase(const Args& A, int layer, bool last, bf16* Z, bf16* Y, char* shm, int G, int vcu, int wave) {
    using abf = attn_body::bf16;
    asm volatile("" : "+s"(vcu), "+s"(G));
    const float* sink = A.win_sink + layer * 8;
    const int NU = NB * 8 * 16, per = (NU + G - 1) / G;
    int u0 = vcu * per, u1 = u0 + per; if (u1 > NU) u1 = NU;
    for (int u = u0; u < u1; ++u) {
        const int qb = u & 15, h = (u >> 4) & 7, b = u >> 7, kvh = h >> 2;
        const size_t qrow = (size_t)b * SEQ + qb * 256, crow0 = (size_t)NLAT + (size_t)b * CTX;
        const abf* Q = (const abf*)Z + qrow * ZP + 1280 + h * 64;
        const abf* Kc = (const abf*)Z + crow0 * ZP + 1792 + kvh * 64; const abf* Vc = (const abf*)Z + crow0 * ZP + 1920 + kvh * 64;
        const long dlat = ((long)b * SEQ - (long)crow0) * ZP;
        attn_body::attn_unit<8, false>(Q, Kc, Vc, dlat, 68, 0, false, 0.f, (abf*)Y + qrow * YP + 1024 + h * 64, shm, wave, true, A.q_norm_g + layer * 64, qb * 256);
    }
    for (int u = u0; u < u1; ++u) {
        const int qb = u & 15, h = (u >> 4) & 7, b = u >> 7, kvh = h >> 2;
        const size_t qrow = (size_t)b * SEQ + qb * 256, crow0 = (size_t)NLAT + (size_t)b * CTX;
        int tl0 = 4 * qb - 2; tl0 = tl0 < 0 ? 0 : tl0; int tl1 = 4 * qb + 6; tl1 = tl1 > 64 ? 64 : tl1;
        const abf* Q = (const abf*)Z + qrow * ZP + 512 + h * 64;
        const abf* Kc = (const abf*)Z + crow0 * ZP + 1024 + kvh * 64; const abf* Vc = (const abf*)Z + crow0 * ZP + 1152 + kvh * 64;
        const long dlat = ((long)b * SEQ + tl0 * 64 - (long)crow0) * ZP;
        attn_body::attn_unit<8, true>(Q, Kc, Vc, dlat, 4 + (tl1 - tl0), tl0 * 64 - qb * 256, true, sink[h] * LOG2E, (abf*)Y + qrow * YP + 512 + h * 64, shm, wave, true, nullptr, qb * 256);
    }
    if (!last) {
        const int NUC = 2 * NB * 8;
        for (int u = vcu; u < NUC; u += G) {
            const int mixer = u & 1, h = (u >> 1) & 7, b = u >> 4, kvh = h >> 2;
            const size_t crow0 = (size_t)NLAT + (size_t)b * CTX;
            const int qc = mixer ? 1280 : 512, kc = mixer ? 1792 : 1024, vc = mixer ? 1920 : 1152, oc = mixer ? 1024 : 512;
            attn_body::attn_unit<8, false>((const abf*)Z + crow0 * ZP + qc + h * 64, (const abf*)Z + crow0 * ZP + kc + kvh * 64, (const abf*)Z + crow0 * ZP + vc + kvh * 64, 0, 4, 0,
                                           mixer == 0, sink[h] * LOG2E, (abf*)Y + crow0 * YP + oc + h * 64, shm, wave, false, mixer ? A.q_norm_g + layer * 64 : nullptr, 0);
        }
    }
}

__global__ void __launch_bounds__(NTHREADS, 2) fwd_megakernel(Args A) {
    extern __shared__ __attribute__((aligned(16))) unsigned char lds_raw[];
    LAS unsigned char* lds = (LAS unsigned char*)lds_raw;
    const int wave = __builtin_amdgcn_readfirstlane(threadIdx.x >> 6);
    const int G = gridDim.x; const int bx = blockIdx.x; const int vcu = (G % 8 == 0) ? (bx % 8) * (G / 8) + bx / 8 : bx;
    const int gw = vcu * NWAVES + wave, NGW = G * NWAVES;
    const int lo = A.ph_lo, hi = A.ph_hi;
    int ph = 0;
#if MK_SPLIT
#define SEAM() do { ++ph; } while (0)
#else
    cg::grid_group grid = cg::this_grid();
    for (int u = threadIdx.x; u < (LDS_BYTES - LDSCTL_OFF) / 4; u += NTHREADS) ((LAS unsigned*)(lds + LDSCTL_OFF))[u] = 0u;
    __syncthreads();
    XcdBarrier bar = xcd_barrier_post((unsigned*)(A.ws + WS_CTL), (volatile LAS unsigned*)(lds + MISC_OFF) + 8);
#define SEAM() do { if (ph == 0) grid.sync(); else xcd_barrier(bar, wave); ++ph; } while (0)
#endif
#define IN() (lo <= ph && ph < hi)
    unsigned char* ws = A.ws;
    float* mod = (float*)(ws + WS_MOD);
    bf16* XB = (bf16*)A.out;
    bf16* XCB = (bf16*)(ws + WS_XC);
    unsigned char* ar = ws + WS_ARENA;
    bf16* Z = (bf16*)(ar + AR_Z); bf16* Gt = (bf16*)(ar + AR_G); bf16* Y = (bf16*)(ar + AR_Y); bf16* H = (bf16*)(ar + AR_H);
    bf16* Mrg = (bf16*)(ar + AR_MRG); bf16* U = (bf16*)(ar + AR_U); bf16* H2 = (bf16*)(ar + AR_H2);
    float* XF = (float*)(ar + AR_XF); float* SAs = (float*)(ar + AR_SIDE); float* SPA = (float*)(ar + AR_SIDE + SIDE_BYTES); float* SVs = (float*)(ar + AR_SIDE + 2 * SIDE_BYTES);

    if (IN()) for (int rep = 0; rep < ((DUP_MASK & 32) ? 2 : 1); ++rep) { const int lane = lane_fresh(); prologue(A, lds, G, vcu, wave * 64 + lane, lane, wave); __syncthreads(); }
    SEAM();
    for (int l = 0; l < 2; ++l) {
        const bool last = (l == 1);
        const int nrows_mix = NTOK, nrows_x = last ? NLAT : NTOK;
        const int nM_mix = nrows_mix / 256, nM_x = nrows_x / 256;
        const float* modl = mod + (size_t)l * 17 * 6144;
        const unsigned char* wl = ws + WS_W + (size_t)l * LW_BYTES;
        if (IN()) { if (l == 0) norm_rows<false>(A.x, A.ctx, A.norm1_g + l * 1024, modl, 0, nrows_mix, H, gw, NGW); else norm_rows<true>(XB, XCB, A.norm1_g + l * 1024, modl, 0, nrows_mix, H, gw, NGW); }
        SEAM();
        if (IN()) for (int rep = 0; rep < ((DUP_MASK & 1) ? 2 : 1); ++rep) { pg8::Gemm g{H, (const bf16*)(wl + LW_IN), 1024, 1024, 1024, 0, 0}; pg8::Order S; if (!last) S.init(nM_mix, 20, G, bx, 1, 0); else S.init(NLAT / 256, 20, G, bx, 1, 0, 2 * (NCTX / 256));
            pg8::EpiIn E{Z, Gt, A.b_gate + (size_t)l * 3072};
            pg8::gemm_phase<pg8::EpiIn, true>(lds, g, S, E, wave); }
        SEAM();
        if (IN()) elem_phase(A, l, nrows_mix, nrows_x, Z, Y, gw, NGW);
        SEAM();
        if (IN()) { for (int rep = 0; rep < ((DUP_MASK & 2) ? 2 : 1); ++rep) attention_phase(A, l, last, Z, Y, (char*)lds_raw, G, vcu, wave);
            pg8::Gemm g{Y, (const bf16*)(wl + LW_POOL), YP, 256, 256, 256, 0}; pg8::Order S; S.init(nM_x, 2, G, bx, 1, 1);
            pg8::EpiBf16 E{Y, YP, A.pool_scale + (size_t)l * 512};
            pg8::gemm_phase<pg8::EpiBf16, true>(lds, g, S, E, wave); }
        SEAM();
        if (IN()) for (int rep = 0; rep < ((DUP_MASK & 16) ? 2 : 1); ++rep) { pg8::Gemm g{Y, (const bf16*)(wl + LW_BR), YP, 512, 512, 512, (long)1024 * 512}; pg8::Order S; S.init(nM_x, 4, G, bx, 3, 2);
            pg8::EpiMerge E{Gt, Mrg};
            pg8::gemm_phase<pg8::EpiMerge, true>(lds, g, S, E, wave); }
        SEAM();
        if (IN()) { pg8::Gemm g{Mrg, (const bf16*)(wl + LW_OUT), 1024, 1024, 1024, 0, 0}; pg8::Order S; S.init(nM_x, 4, G, bx, 1, 0);
            if (l == 0) { pg8::EpiRes<false, true> E{A.x, A.ctx, XB, XCB, modl, 2}; pg8::gemm_phase<pg8::EpiRes<false, true>, true>(lds, g, S, E, wave); }
            else { pg8::EpiRes<true, true> E{XB, XCB, XB, XCB, modl, 2}; pg8::gemm_phase<pg8::EpiRes<true, true>, true>(lds, g, S, E, wave); } }
        SEAM();
        if (IN()) norm_rows<true>(XB, XCB, A.norm2_g + l * 1024, modl, 1, nrows_x, H2, gw, NGW);
        SEAM();
        if (IN()) for (int rep = 0; rep < ((DUP_MASK & 4) ? 2 : 1); ++rep) { pg8::Gemm g{H2, (const bf16*)(wl + LW_FF), 1024, 1024, 1024, 0, 0}; pg8::Order S; S.init(nM_x, 22, G, bx, 1, 0);
            pg8::EpiFF E{U, A.conv_w + (size_t)l * 3 * FF, A.conv_b + (size_t)l * FF, SAs, SIDE_BYTES / 4};
            pg8::gemm_phase<pg8::EpiFF, true>(lds, g, S, E, wave); }
        SEAM();
        if (IN()) fixup_phase(A, l, nrows_x, U, SAs, SPA, SVs, vcu * NTHREADS + wave * 64, G * NTHREADS);
        SEAM();
        if (IN()) { pg8::Gemm g{U, (const bf16*)(wl + LW_DN), FF, FF, FF, 0, 0}; pg8::Order S; S.init(nM_x, 4, G, bx, 1, 0);
            if (!last) { pg8::EpiRes<true, true> E{XB, XCB, XB, XCB, modl, 5}; pg8::gemm_phase<pg8::EpiRes<true, true>, true>(lds, g, S, E, wave); }
            else { pg8::EpiRes<true, false> E{XB, XCB, XF, XF, modl, 5}; pg8::gemm_phase<pg8::EpiRes<true, false>, true>(lds, g, S, E, wave); } }
        SEAM();
    }
    if (IN()) final_norm_rows(XF, A.out, A.final_g, gw, NGW);
#undef IN
#undef SEAM
}
constexpr int N_PHASES = 22;

extern "C" void kernel_launch(void* const* d_in, const int* in_sizes, int n_in, void* d_out, int out_size, void* d_ws, size_t ws_size, hipStream_t stream) {
    static int grid = 0;
    if (grid == 0) {
        if (n_in != 24 || out_size != NLAT * 1024 || ws_size < WS_END) { fprintf(stderr, "kernel_launch: unexpected shapes (n_in %d out %d ws %zu need %zu)\n", n_in, out_size, ws_size, (size_t)WS_END); grid = -1; return; }
        int dev = 0, cus = 0, per_cu = 0;
        hipGetDevice(&dev); hipDeviceGetAttribute(&cus, hipDeviceAttributeMultiprocessorCount, dev);
        if (hipFuncSetAttribute((const void*)fwd_megakernel, hipFuncAttributeMaxDynamicSharedMemorySize, LDS_BYTES) != hipSuccess) { fprintf(stderr, "kernel_launch: hipFuncSetAttribute failed\n"); grid = -1; return; }
        hipOccupancyMaxActiveBlocksPerMultiprocessor(&per_cu, (const void*)fwd_megakernel, NTHREADS, LDS_BYTES);
        (void)hipGetLastError();
        if (per_cu < 1) { fprintf(stderr, "kernel_launch: occupancy query says %d blocks per CU\n", per_cu); per_cu = 1; }
        grid = cus;
    }
    if (grid < 0) return;
    Args a{};
    const float** p = (const float**)&a;
    for (int i = 0; i < 24; ++i) p[i] = (const float*)d_in[i];
    a.out = (float*)d_out; a.ws = (unsigned char*)d_ws;
#if MK_SPLIT
    for (int ph = 0; ph < N_PHASES; ++ph) { a.ph_lo = ph; a.ph_hi = ph + 1; hipLaunchKernelGGL(fwd_megakernel, dim3(grid), dim3(NTHREADS), LDS_BYTES, stream, a); }
#else
    a.ph_lo = 0; a.ph_hi = N_PHASES;
    if (hipMemsetAsync((char*)d_ws + WS_CTL, 0, CTL_ZERO_BYTES, stream) != hipSuccess) { fprintf(stderr, "kernel_launch: memset failed\n"); return; }
    void* args[] = {&a};
    hipError_t e = hipLaunchCooperativeKernel((const void*)fwd_megakernel, dim3(grid), dim3(NTHREADS), args, LDS_BYTES, stream);
    if (e != hipSuccess) fprintf(stderr, "cooperative launch failed: %s (grid %d)\n", hipGetErrorString(e), grid);
#endif
}
```

```cpp
#include <hip/hip_runtime.h>
#include <hip/hip_cooperative_groups.h>
#include <hip/hip_bf16.h>
#include <cstdio>
#include <cstdint>
#include <cmath>
namespace cg = cooperative_groups;

#ifndef DUP_MASK
#define DUP_MASK 0
#endif
#ifndef MK_SPLIT
#define MK_SPLIT 0
#endif

constexpr int DM_ = 1024, NB = 16, SEQ = 4096, CTX = 256, NLAT = NB * SEQ, NCTX = NB * CTX, NTOK = NLAT + NCTX;
constexpr int ZP = 2048, GP = 3072, YP = 1536, FF = 2816, AVP = 2 * FF;
constexpr float EPS = 1e-6f;
constexpr float LOG2E = 1.4426950408889634f;
constexpr float C2 = 0.125f * LOG2E;

__device__ __forceinline__ int lane_fresh() { int l = (int)__builtin_amdgcn_mbcnt_hi(~0u, __builtin_amdgcn_mbcnt_lo(~0u, 0u)); asm volatile("" : "+v"(l)); return l; }

namespace pg8 {
#define PG8_LAS __attribute__((address_space(3)))
typedef unsigned short bf16_t;
typedef short bf16x8 __attribute__((ext_vector_type(8)));
typedef float f32x4 __attribute__((ext_vector_type(4)));
typedef unsigned u32x4 __attribute__((ext_vector_type(4)));
typedef unsigned u32x2 __attribute__((ext_vector_type(2)));
constexpr int BM = 256, BK = 64, HALF = 128, HTB = HALF * BK * 2, STAGE_BYTES = 8 * HTB, NXCD = 8, WGM = 8;

__host__ __device__ __forceinline__ int lds_byte(int r, int c) { const int st = (r >> 4) * 2 + (c >> 5), rr = r & 15, cc = c & 31, ob = rr * 64 + cc * 2; return st * 1024 + (ob ^ (((ob >> 9) & 1) << 5)); }
__host__ __device__ __forceinline__ void stage_rc(int b, int& R, int& C) { const int st = b / 1024, sb = b % 1024, swz = sb ^ (((sb >> 9) & 1) << 5); R = (st >> 1) * 16 + swz / 64; C = (st & 1) * 32 + (swz % 64) / 2; }
__host__ __device__ __forceinline__ int perm32(int rho) { const int n = rho >> 4, i = rho & 15; return 8 * (i >> 2) + 4 * n + (i & 3); }

struct Unit { int pm, pn, g; };
struct Gemm { const bf16_t* A; const bf16_t* Bt; int lda, ldb, K; long a_goff, b_goff; };

struct Order {
    int nM, nN, nwg, G, c, sub, gmode, nextra;
    __device__ __forceinline__ void init(int nM_, int nN_, int G_, int c_, int sub_, int gmode_, int nextra_ = 0) { nM = nM_; nN = nN_; nwg = nM * nN; G = G_; c = c_; sub = sub_; gmode = gmode_; nextra = nextra_; }
    __device__ __forceinline__ bool next(int i, Unit& u) const {
        const int ti = (sub == 1) ? i : i / sub;
        const long L = (long)ti * G + c;
        if (L >= nwg) { const int j = (int)(L - nwg); if (j >= nextra) return false; u.pm = nM + (j >> 1); u.pn = (j & 1) ? 7 : 4; u.g = 0; return true; }
        int wgid = (int)L; { const int q = nwg / NXCD, r = nwg % NXCD, xcd = wgid % NXCD, off = wgid / NXCD; wgid = (xcd < r ? xcd * (q + 1) : r * (q + 1) + (xcd - r) * q) + off; }
        const int nig = WGM * nN, gid = wgid / nig, fm = gid * WGM, gsz = (nM - fm) < WGM ? (nM - fm) : WGM;
        u.pm = fm + ((wgid % nig) % gsz); u.pn = (wgid % nig) / gsz;
        u.g = (gmode == 0) ? 0 : ((gmode == 1) ? u.pn : (i - ti * sub));
        return true;
    }
};

typedef float f32x2_t __attribute__((ext_vector_type(2))); typedef __bf16 bf16x2_t __attribute__((ext_vector_type(2)));
__device__ __forceinline__ unsigned cvt_pk_bf16(float lo, float hi) { f32x2_t v = {lo, hi}; bf16x2_t b = __builtin_convertvector(v, bf16x2_t); return __builtin_bit_cast(unsigned, b); }
__device__ __forceinline__ float bf_lo(unsigned w) { return __uint_as_float(w << 16); }
__device__ __forceinline__ float bf_hi(unsigned w) { return __uint_as_float(w & 0xffff0000u); }
__device__ __forceinline__ float sigmoidf_(float x) { return __builtin_amdgcn_rcpf(1.0f + __builtin_amdgcn_exp2f(-x * 1.4426950408889634f)); }

struct EpiBf16 {
    static constexpr bool PERM = true;
    bf16_t* O; int ldc; const float* colscale;
    __device__ __forceinline__ void operator()(const f32x4 (&acc)[2][2][4][2], const Unit& u, int wr, int wc, int fr, int fq) const {
        int row0 = u.pm * BM + wr * 64 + fr; asm volatile("" : "+v"(row0)); const int col0 = u.pn * BM + wc * 32 + 8 * fq;
#pragma unroll
        for (int bj = 0; bj < 2; ++bj) {
            f32x4 s0 = (f32x4){1.f, 1.f, 1.f, 1.f}, s1 = s0;
            if (colscale) { s0 = *(const f32x4*)(colscale + col0 + bj * HALF); s1 = *(const f32x4*)(colscale + col0 + bj * HALF + 4); }
#pragma unroll
            for (int ai = 0; ai < 2; ++ai)
#pragma unroll
                for (int m = 0; m < 4; ++m) { bf16_t* rowp = O + (size_t)(row0 + ai * HALF + m * 16) * ldc + col0;
                    const f32x4 v0 = acc[ai][bj][m][0] * s0, v1 = acc[ai][bj][m][1] * s1;
                    u32x4 w; w.x = cvt_pk_bf16(v0[0], v0[1]); w.y = cvt_pk_bf16(v0[2], v0[3]); w.z = cvt_pk_bf16(v1[0], v1[1]); w.w = cvt_pk_bf16(v1[2], v1[3]);
                    *(u32x4*)(rowp + bj * HALF) = w; } }
    }
};
struct EpiIn {
    static constexpr bool PERM = true;
    bf16_t* Z; bf16_t* Gt; const float* bgate;
    __device__ __forceinline__ void operator()(const f32x4 (&acc)[2][2][4][2], const Unit& u, int wr, int wc, int fr, int fq) const {
        int row0 = u.pm * BM + wr * 64 + fr; asm volatile("" : "+v"(row0)); const bool isz = u.pn < 8;
        const int col0 = (isz ? u.pn * BM : (u.pn - 8) * BM) + wc * 32 + 8 * fq;
        bf16_t* base = isz ? Z : Gt; const int ldc = isz ? ZP : GP;
        f32x4 bv[2][2];
#pragma unroll
        for (int bj = 0; bj < 2; ++bj)
#pragma unroll
            for (int n = 0; n < 2; ++n) bv[bj][n] = isz ? (f32x4){0.f, 0.f, 0.f, 0.f} : *(const f32x4*)(bgate + col0 + bj * HALF + 4 * n);
#pragma unroll
        for (int ai = 0; ai < 2; ++ai)
#pragma unroll
            for (int m = 0; m < 4; ++m) { bf16_t* rowp = base + (size_t)(row0 + ai * HALF + m * 16) * ldc + col0;
#pragma unroll
                for (int bj = 0; bj < 2; ++bj) { f32x4 v0 = acc[ai][bj][m][0] + bv[bj][0], v1 = acc[ai][bj][m][1] + bv[bj][1];
                    if (!isz) {
#pragma unroll
                        for (int e = 0; e < 4; ++e) { v0[e] = sigmoidf_(v0[e]); v1[e] = sigmoidf_(v1[e]); } }
                    u32x4 w; w.x = cvt_pk_bf16(v0[0], v0[1]); w.y = cvt_pk_bf16(v0[2], v0[3]); w.z = cvt_pk_bf16(v1[0], v1[1]); w.w = cvt_pk_bf16(v1[2], v1[3]);
                    *(u32x4*)(rowp + bj * HALF) = w; } }
    }
};
struct EpiMerge {
    static constexpr bool PERM = true;
    const bf16_t* Gt; bf16_t* Mrg;
    __device__ __forceinline__ void operator()(const f32x4 (&acc)[2][2][4][2], const Unit& u, int wr, int wc, int fr, int fq) const {
        int row0 = u.pm * BM + wr * 64 + fr; asm volatile("" : "+v"(row0)); const int col0 = u.pn * BM + wc * 32 + 8 * fq;
#pragma unroll
        for (int ai = 0; ai < 2; ++ai) {
            u32x4 gw[4][2], ow[4][2];
#pragma unroll
            for (int m = 0; m < 4; ++m) { const size_t row = (size_t)(row0 + ai * HALF + m * 16);
#pragma unroll
                for (int bj = 0; bj < 2; ++bj) { gw[m][bj] = *(const u32x4*)(Gt + row * GP + u.g * 1024 + col0 + bj * HALF);
                    if (u.g != 0) ow[m][bj] = *(const u32x4*)(Mrg + row * 1024 + col0 + bj * HALF); } }
#pragma unroll
            for (int m = 0; m < 4; ++m) { const size_t row = (size_t)(row0 + ai * HALF + m * 16);
#pragma unroll
                for (int bj = 0; bj < 2; ++bj) {
                    const u32x4 g4 = gw[m][bj];
                    const f32x4 a0 = acc[ai][bj][m][0], a1 = acc[ai][bj][m][1];
                    float v[8];
                    v[0] = bf_lo(g4.x) * a0[0]; v[1] = bf_hi(g4.x) * a0[1]; v[2] = bf_lo(g4.y) * a0[2]; v[3] = bf_hi(g4.y) * a0[3];
                    v[4] = bf_lo(g4.z) * a1[0]; v[5] = bf_hi(g4.z) * a1[1]; v[6] = bf_lo(g4.w) * a1[2]; v[7] = bf_hi(g4.w) * a1[3];
                    if (u.g != 0) { const u32x4 o4 = ow[m][bj];
                        v[0] += bf_lo(o4.x); v[1] += bf_hi(o4.x); v[2] += bf_lo(o4.y); v[3] += bf_hi(o4.y); v[4] += bf_lo(o4.z); v[5] += bf_hi(o4.z); v[6] += bf_lo(o4.w); v[7] += bf_hi(o4.w); }
                    u32x4 w; w.x = cvt_pk_bf16(v[0], v[1]); w.y = cvt_pk_bf16(v[2], v[3]); w.z = cvt_pk_bf16(v[4], v[5]); w.w = cvt_pk_bf16(v[6], v[7]);
                    *(u32x4*)(Mrg + row * 1024 + col0 + bj * HALF) = w; } }
        }
    }
};
template <bool BASE_BF16, bool OUT_BF16> struct EpiRes {
    static constexpr bool PERM = false;
    const void* base_lat; const void* base_ctx; void* out_lat; void* out_ctx; const float* modl; int gate_idx;
    __device__ __forceinline__ void operator()(const f32x4 (&acc)[2][2][4][2], const Unit& u, int wr, int wc, int fr, int fq) const {
        const bool lat = u.pm < (NLAT / BM);
        const int prow = lat ? u.pm * BM : (u.pm * BM - NLAT);
        const void* base = lat ? base_lat : base_ctx; void* out = lat ? out_lat : out_ctx;
        const int b = lat ? (u.pm * BM) / SEQ : NB;
        int col0 = u.pn * BM + wc * 32 + 4 * fq; asm volatile("" : "+v"(col0));
        const float* gp = modl + (size_t)(b * 6 + gate_idx) * 1024 + col0;
        f32x4 gv[2][2];
#pragma unroll
        for (int bj = 0; bj < 2; ++bj)
#pragma unroll
            for (int n = 0; n < 2; ++n) gv[bj][n] = *(const f32x4*)(gp + bj * HALF + n * 16);
#pragma unroll
        for (int ai = 0; ai < 2; ++ai) {
            f32x4 bs[4][2][2];
#pragma unroll
            for (int m = 0; m < 4; ++m) { const size_t off = (size_t)(prow + ai * HALF + wr * 64 + m * 16 + fr) * 1024 + col0;
#pragma unroll
                for (int bj = 0; bj < 2; ++bj)
#pragma unroll
                    for (int n = 0; n < 2; ++n) { const size_t o2 = off + bj * HALF + n * 16;
                        if constexpr (BASE_BF16) { const u32x2 w = *(const u32x2*)((const bf16_t*)base + o2); bs[m][bj][n] = (f32x4){bf_lo(w.x), bf_hi(w.x), bf_lo(w.y), bf_hi(w.y)}; }
                        else bs[m][bj][n] = *(const f32x4*)((const float*)base + o2); } }
#pragma unroll
            for (int m = 0; m < 4; ++m) { const size_t off = (size_t)(prow + ai * HALF + wr * 64 + m * 16 + fr) * 1024 + col0;
#pragma unroll
                for (int bj = 0; bj < 2; ++bj)
#pragma unroll
                    for (int n = 0; n < 2; ++n) { const size_t o2 = off + bj * HALF + n * 16;
                        const f32x4 r = bs[m][bj][n] + gv[bj][n] * acc[ai][bj][m][n];
                        if constexpr (OUT_BF16) { u32x2 w; w.x = cvt_pk_bf16(r[0], r[1]); w.y = cvt_pk_bf16(r[2], r[3]); *(u32x2*)((bf16_t*)out + o2) = w; }
                        else *(f32x4*)((float*)out + o2) = r; } }
        }
    }
};
struct EpiFF {
    static constexpr bool PERM = true;
    bf16_t* U; const float* cw; const float* cb; float* As; size_t side_elems;
    __device__ __forceinline__ void operator()(const f32x4 (&acc)[2][2][4][2], const Unit& u, int wr, int wc, int fr, int fq) const {
        const int lane = fq * 16 + fr; float* PAs = As + side_elems; float* Vs = PAs + side_elems;
        int ch0 = u.pn * 128 + wc * 32 + 8 * fq; asm volatile("" : "+v"(ch0));
        const int src_up = (lane & 48) | ((fr - 1) & 15), src_dn = (lane & 48) | ((fr + 1) & 15);
#pragma unroll
        for (int h = 0; h < 2; ++h) {
            const f32x4 w0 = *(const f32x4*)(cw + ch0 + 4 * h), w1 = *(const f32x4*)(cw + 2816 + ch0 + 4 * h), w2 = *(const f32x4*)(cw + 2 * 2816 + ch0 + 4 * h), bb = *(const f32x4*)(cb + ch0 + 4 * h);
#pragma unroll
            for (int ai = 0; ai < 2; ++ai) {
                const int rblk = u.pm * 4 + ai * 2 + wr;
                float o[4][4]; f32x4 pre0, pre3;
#pragma unroll
                for (int e = 0; e < 4; ++e) {
                    float a[4], ru[4], rd[4];
#pragma unroll
                    for (int m = 0; m < 4; ++m) { a[m] = acc[ai][0][m][h][e]; ru[m] = __int_as_float(__builtin_amdgcn_ds_bpermute(src_up << 2, __float_as_int(a[m]))); rd[m] = __int_as_float(__builtin_amdgcn_ds_bpermute(src_dn << 2, __float_as_int(a[m]))); }
#pragma unroll
                    for (int m = 0; m < 4; ++m) {
                        const float ap = (fr > 0) ? ru[m] : (m > 0 ? ru[m > 0 ? m - 1 : 0] : 0.f);
                        const float an = (fr < 15) ? rd[m] : (m < 3 ? rd[m < 3 ? m + 1 : 3] : 0.f);
                        const float pre = ap * w0[e] + a[m] * w1[e] + an * w2[e] + bb[e];
                        if (m == 0) pre0[e] = pre; if (m == 3) pre3[e] = pre;
                        o[m][e] = pre * sigmoidf_(pre) * acc[ai][1][m][h][e]; }
                    __builtin_amdgcn_sched_barrier(0); }
#pragma unroll
                for (int m = 0; m < 4; ++m) { u32x2 w; w.x = cvt_pk_bf16(o[m][0], o[m][1]); w.y = cvt_pk_bf16(o[m][2], o[m][3]);
                    *(u32x2*)(U + ((size_t)rblk * 64 + m * 16 + fr) * 2816 + ch0 + 4 * h) = w; }
                if (fr == 0) { const size_t so = (size_t)(2 * rblk) * 2816 + ch0 + 4 * h; *(f32x4*)(As + so) = acc[ai][0][0][h]; *(f32x4*)(Vs + so) = acc[ai][1][0][h]; *(f32x4*)(PAs + so) = pre0; }
                if (fr == 15) { const size_t so = (size_t)(2 * rblk + 1) * 2816 + ch0 + 4 * h; *(f32x4*)(As + so) = acc[ai][0][3][h]; *(f32x4*)(Vs + so) = acc[ai][1][3][h]; *(f32x4*)(PAs + so) = pre3; }
                __builtin_amdgcn_sched_barrier(0);
            }
        }
    }
};

template <class Epi, bool ALIGN_EPI>
__device__ __forceinline__ void gemm_phase(PG8_LAS unsigned char* lds, const Gemm g, const Order& S, const Epi& E, int wid) {
    const int lane = lane_fresh(), tid = wid * 64 + lane;
    const int wr = wid >> 2, wc = wid & 3, fr = lane & 15, fq = lane >> 4;
    const int K = g.K, nt = K / BK;
    unsigned voffA[2], voffB[2];
#pragma unroll
    for (int i = 0; i < 2; ++i) { int R, C; stage_rc(tid * 16 + i * 8192, R, C); const int Rb = Epi::PERM ? ((R & ~31) + perm32(R & 31)) : R;
        voffA[i] = (unsigned)(R * g.lda + C) * 2u; voffB[i] = (unsigned)(Rb * g.ldb + C) * 2u; }
    const size_t kstep = (size_t)(BK * 2);
    const size_t hstepA = (size_t)HALF * g.lda * 2, hstepB = (size_t)HALF * g.ldb * 2;
    const size_t tstepA = 2 * hstepA, tstepB = 2 * hstepB;
    const unsigned ldsw = (unsigned)wid * 1024u;
    const int aoff = lds_byte(wr * 64 + fr, fq * 8), boff = lds_byte(wc * 32 + fr, fq * 8);
#define PG8_UA(u) ((const char*)g.A + (size_t)(u).pm * tstepA + (size_t)((long)(u).g * g.a_goff * 2))
#define PG8_UB(u) ((const char*)g.Bt + (size_t)(u).pn * tstepB + (size_t)((long)(u).g * g.b_goff * 2))
#define PG8_SA(b, h) (((b) * 2 + (h)) * HTB)
#define PG8_SB(b, h) ((4 + (b) * 2 + (h)) * HTB)
#define PG8_STAGE(bufoff, gbase, voff) do { _Pragma("unroll") for (int _i = 0; _i < 2; ++_i) \
        __builtin_amdgcn_global_load_lds((const unsigned*)((const char*)(gbase) + (voff)[_i]), (PG8_LAS unsigned*)(lds + (bufoff) + ldsw + _i * 8192), 16, 0, 0); } while (0)
#define PG8_LDA(dst, b, h) do { _Pragma("unroll") for (int m = 0; m < 4; ++m) _Pragma("unroll") for (int k = 0; k < 2; ++k) dst[m][k] = *(const PG8_LAS bf16x8*)(lds + PG8_SA(b, h) + aoff + m * 2048 + k * 1024); } while (0)
#define PG8_LDB(dst, b, h) do { _Pragma("unroll") for (int n = 0; n < 2; ++n) _Pragma("unroll") for (int k = 0; k < 2; ++k) dst[n][k] = *(const PG8_LAS bf16x8*)(lds + PG8_SB(b, h) + boff + n * 2048 + k * 1024); } while (0)
#define PG8_MMA(ai, bj, At, Bt) do { __builtin_amdgcn_s_setprio(1); _Pragma("unroll") for (int m = 0; m < 4; ++m) _Pragma("unroll") for (int n = 0; n < 2; ++n) _Pragma("unroll") for (int k = 0; k < 2; ++k) \
        acc[ai][bj][m][n] = __builtin_amdgcn_mfma_f32_16x16x32_bf16(Bt[n][k], At[m][k], acc[ai][bj][m][n], 0, 0, 0); __builtin_amdgcn_s_setprio(0); } while (0)
#define PG8_WAIT_V(n) asm volatile("s_waitcnt vmcnt(" #n ")" ::: "memory")
#define PG8_WAIT_L(n) asm volatile("s_waitcnt lgkmcnt(" #n ")" ::: "memory")
#define PG8_BAR __builtin_amdgcn_s_barrier()
#define PG8_SCHED __builtin_amdgcn_sched_barrier(0)
    Unit cur, nxt; int ui = 0;
    if (!S.next(0, cur)) return;
    f32x4 acc[2][2][4][2];
#pragma unroll
    for (int a = 0; a < 2; ++a)
#pragma unroll
        for (int b = 0; b < 2; ++b)
#pragma unroll
            for (int m = 0; m < 4; ++m)
#pragma unroll
                for (int n = 0; n < 2; ++n) acc[a][b][m][n] = (f32x4){0.f, 0.f, 0.f, 0.f};
    bf16x8 At[4][2], B0[2][2], B1[2][2];
    const char* cA = PG8_UA(cur); const char* cB = PG8_UB(cur);
    PG8_STAGE(PG8_SB(0, 0), cB, voffB); PG8_STAGE(PG8_SB(0, 1), cB + hstepB, voffB); PG8_STAGE(PG8_SA(0, 0), cA, voffA); PG8_STAGE(PG8_SA(0, 1), cA + hstepA, voffA);
    if (wr == 1) PG8_BAR;
    PG8_WAIT_V(2); PG8_BAR;
    PG8_STAGE(PG8_SB(1, 0), cB + kstep, voffB); PG8_STAGE(PG8_SA(1, 0), cA + kstep, voffA); PG8_STAGE(PG8_SB(1, 1), cB + hstepB + kstep, voffB);
    PG8_WAIT_V(6); PG8_BAR;
    for (;;) {
        const bool has_next = S.next(ui + 1, nxt);
        const char* nA = has_next ? PG8_UA(nxt) : cA; const char* nB = has_next ? PG8_UB(nxt) : cB;
        for (int t = 0; t < nt; t += 2) {
            const bool last = (t == nt - 2);
            const char* a1 = cA + (size_t)(t + 1) * kstep;
            const char* a2 = last ? nA : cA + (size_t)(t + 2) * kstep; const char* b2 = last ? nB : cB + (size_t)(t + 2) * kstep;
            const char* a3 = a2 + kstep; const char* b3 = b2 + kstep;
            PG8_LDB(B0, 0, 0); PG8_LDB(B1, 0, 1); PG8_SCHED; PG8_LDA(At, 0, 0); PG8_STAGE(PG8_SA(1, 1), a1 + hstepA, voffA);
            PG8_WAIT_V(8); PG8_WAIT_L(0); PG8_BAR; PG8_MMA(0, 0, At, B0); PG8_MMA(0, 1, At, B1); PG8_BAR; PG8_SCHED;
            PG8_LDA(At, 0, 1); PG8_STAGE(PG8_SB(0, 0), b2, voffB); PG8_STAGE(PG8_SB(0, 1), b2 + hstepB, voffB); PG8_STAGE(PG8_SA(0, 0), a2, voffA);
            PG8_WAIT_V(8); PG8_WAIT_L(0); PG8_BAR; PG8_MMA(1, 0, At, B0); PG8_MMA(1, 1, At, B1); PG8_BAR; PG8_SCHED;
            PG8_LDB(B0, 1, 0); PG8_LDB(B1, 1, 1); PG8_SCHED; PG8_LDA(At, 1, 0); PG8_STAGE(PG8_SA(0, 1), a2 + hstepA, voffA);
            PG8_WAIT_V(8); PG8_WAIT_L(0); PG8_BAR; PG8_MMA(0, 0, At, B0); PG8_MMA(0, 1, At, B1); PG8_BAR; PG8_SCHED;
            PG8_LDA(At, 1, 1); PG8_STAGE(PG8_SB(1, 0), b3, voffB); PG8_STAGE(PG8_SB(1, 1), b3 + hstepB, voffB); PG8_STAGE(PG8_SA(1, 0), a3, voffA);
            PG8_WAIT_V(8); PG8_WAIT_L(0); PG8_BAR; PG8_MMA(1, 0, At, B0); PG8_MMA(1, 1, At, B1); PG8_BAR; PG8_SCHED;
        }
        if constexpr (ALIGN_EPI) { if (wr == 0) PG8_BAR; }
        { const int l2 = lane_fresh(); E(acc, cur, wr, wc, l2 & 15, l2 >> 4); }
        if (!has_next) break;
#pragma unroll
        for (int a = 0; a < 2; ++a)
#pragma unroll
            for (int b = 0; b < 2; ++b)
#pragma unroll
                for (int m = 0; m < 4; ++m)
#pragma unroll
                    for (int n = 0; n < 2; ++n) acc[a][b][m][n] = (f32x4){0.f, 0.f, 0.f, 0.f};
        cur = nxt; cA = nA; cB = nB; ++ui;
        if constexpr (ALIGN_EPI) { if (wr == 1) PG8_BAR; }
    }
    PG8_WAIT_V(0);
    if constexpr (!ALIGN_EPI) { if (wr == 0) PG8_BAR; }
    PG8_BAR;
#undef PG8_UA
#undef PG8_UB
#undef PG8_SA
#undef PG8_SB
#undef PG8_STAGE
#undef PG8_LDA
#undef PG8_LDB
#undef PG8_MMA
#undef PG8_WAIT_V
#undef PG8_WAIT_L
#undef PG8_BAR
#undef PG8_SCHED
}
}

namespace attn_body {
using bf16 = __hip_bfloat16;
using bf16x8 = __attribute__((ext_vector_type(8))) short;
using s16x4 = __attribute__((ext_vector_type(4))) short;
using f32x16 = __attribute__((ext_vector_type(16))) float;
using u32x4 = __attribute__((ext_vector_type(4))) unsigned;
constexpr int D = 64, NW = 8, QBLK = 32, QB = QBLK * NW, KVBLK = 64;
__device__ __forceinline__ int crow(int r, int hi) { return (r & 3) + 8 * (r >> 2) + 4 * hi; }
#define SBAR() __builtin_amdgcn_sched_barrier(0)
__device__ __forceinline__ void wmask(f32x16& p0, f32x16& p1, int d0) {
    const float NEG = -INFINITY;
#pragma unroll
    for (int r = 0; r < 16; ++r) { const int d = d0 + (r & 3) + 8 * (r >> 2); if (d > 128 || d < -128) p0[r] = NEG; if (d + 32 > 128 || d + 32 < -128) p1[r] = NEG; }
}
constexpr int NSLOT = 3, SLOTB = 8192;
constexpr int LDS_K = 0, LDS_V = NSLOT * SLOTB, LDS_WS = 2 * NSLOT * SLOTB, LDS_OST = LDS_WS + NW * 64 * 4, LDS_BYTES = LDS_OST + NW * 4096;
__device__ __forceinline__ void glds16(const void* gsrc, unsigned lds_dst) { unsigned keep;
    asm volatile("s_mov_b32 %0, m0\n\ts_mov_b32 m0, %2\n\ts_nop 0\n\tglobal_load_lds_dwordx4 %1, off\n\ts_mov_b32 m0, %0" : "=&s"(keep) : "v"(gsrc), "s"(lds_dst) : "memory"); }
__device__ __forceinline__ float max3f(float a, float b, float c) { float r; asm("v_max3_f32 %0, %1, %2, %3" : "=v"(r) : "v"(a), "v"(b), "v"(c)); return r; }
__device__ __forceinline__ float max2f(float a, float b) { float r; asm("v_max_f32_e32 %0, %1, %2" : "=v"(r) : "v"(a), "v"(b)); return r; }
__device__ __forceinline__ float fadd_s(float a, float b) { float r; asm("v_add_f32_e32 %0, %1, %2" : "=v"(r) : "v"(a), "v"(b)); return r; }
__device__ __forceinline__ float fsub_s(float a, float b) { float r; asm("v_sub_f32_e32 %0, %1, %2" : "=v"(r) : "v"(a), "v"(b)); return r; }
typedef float f32x2_t __attribute__((ext_vector_type(2))); typedef __bf16 bf16x2_t __attribute__((ext_vector_type(2)));
__device__ __forceinline__ unsigned cvtpk_s(float lo, float hi) { f32x2_t v = {lo, hi}; bf16x2_t b = __builtin_convertvector(v, bf16x2_t); return __builtin_bit_cast(unsigned, b); }
#define WAIT_BAR(N) asm volatile("s_waitcnt vmcnt(" #N ") lgkmcnt(0)\n\ts_barrier" ::: "memory")

__device__ __forceinline__ void qkt(f32x16& p0, f32x16& p1, const char* Kslot, const bf16x8* qr, const f32x16& negm, int r32, int hi) {
    const char* kb = Kslot + hi * 1024 + r32 * 16;
#pragma unroll
    for (int d0 = 0; d0 < 4; ++d0) {
        const bf16x8 b0 = *reinterpret_cast<const bf16x8*>(kb + d0 * 2048);
        const bf16x8 b1 = *reinterpret_cast<const bf16x8*>(kb + d0 * 2048 + 512);
        if (d0 == 0) { p0 = __builtin_amdgcn_mfma_f32_32x32x16_bf16(b0, qr[0], negm, 0, 0, 0); p1 = __builtin_amdgcn_mfma_f32_32x32x16_bf16(b1, qr[0], negm, 0, 0, 0); }
        else { p0 = __builtin_amdgcn_mfma_f32_32x32x16_bf16(b0, qr[d0], p0, 0, 0, 0); p1 = __builtin_amdgcn_mfma_f32_32x32x16_bf16(b1, qr[d0], p1, 0, 0, 0); } }
}
typedef __attribute__((address_space(3))) const char* lds_cptr;
typedef short v4i16_t __attribute__((ext_vector_type(4)));
__device__ __forceinline__ void kload8(bf16x8* kf, lds_cptr kp) {
    kf[0] = *(const __attribute__((address_space(3))) bf16x8*)(kp);        kf[1] = *(const __attribute__((address_space(3))) bf16x8*)(kp + 512);
    kf[2] = *(const __attribute__((address_space(3))) bf16x8*)(kp + 2048); kf[3] = *(const __attribute__((address_space(3))) bf16x8*)(kp + 2560);
    kf[4] = *(const __attribute__((address_space(3))) bf16x8*)(kp + 4096); kf[5] = *(const __attribute__((address_space(3))) bf16x8*)(kp + 4608);
    kf[6] = *(const __attribute__((address_space(3))) bf16x8*)(kp + 6144); kf[7] = *(const __attribute__((address_space(3))) bf16x8*)(kp + 6656);
}
__device__ __forceinline__ void kload2(bf16x8* kf, lds_cptr kp, int j) { kf[2 * j] = *(const __attribute__((address_space(3))) bf16x8*)(kp + j * 2048); kf[2 * j + 1] = *(const __attribute__((address_space(3))) bf16x8*)(kp + j * 2048 + 512); }
__device__ __forceinline__ s16x4 vtr(lds_cptr p) { return __builtin_bit_cast(s16x4, __builtin_amdgcn_ds_read_tr16_b64_v4i16((__attribute__((address_space(3))) v4i16_t*)p)); }
__device__ __forceinline__ float rowmax(const f32x16& p0, const f32x16& p1) {
    float a = max3f(p0[0], p0[1], p1[0]), b = max3f(p0[2], p0[3], p1[1]); a = max3f(a, p1[2], p1[3]);
#pragma unroll
    for (int r = 4; r < 16; r += 4) { a = max3f(a, p0[r], p0[r + 1]); b = max3f(b, p0[r + 2], p0[r + 3]); a = max3f(a, p1[r], p1[r + 1]); b = max3f(b, p1[r + 2], p1[r + 3]); }
    const float m = max2f(a, b);
    auto rr = __builtin_amdgcn_permlane32_swap(__float_as_uint(m), __float_as_uint(m), false, false);
    return max2f(__uint_as_float(rr[0]), __uint_as_float(rr[1]));
}
__device__ __forceinline__ void pv(f32x16* o, int vb, bf16x8 pa0, bf16x8 pa1, bf16x8 pa2, bf16x8 pa3) {
#pragma unroll
    for (int d0 = 0; d0 < 2; ++d0) { s16x4 lo[4], hi[4];
#pragma unroll
        for (int ks = 0; ks < 4; ++ks) {
            asm volatile("ds_read_b64_tr_b16 %0,%1 offset:%c2" : "=&v"(lo[ks]) : "v"(vb), "i"(d0 * 4096 + ks * 1024) : "memory");
            asm volatile("ds_read_b64_tr_b16 %0,%1 offset:%c2" : "=&v"(hi[ks]) : "v"(vb), "i"(d0 * 4096 + ks * 1024 + 512) : "memory"); }
        asm volatile("s_waitcnt lgkmcnt(0)" ::: "memory"); SBAR();
#define PK(k) (bf16x8){lo[k][0], lo[k][1], lo[k][2], lo[k][3], hi[k][0], hi[k][1], hi[k][2], hi[k][3]}
        o[d0] = __builtin_amdgcn_mfma_f32_32x32x16_bf16(pa0, PK(0), o[d0], 0, 0, 0);
        o[d0] = __builtin_amdgcn_mfma_f32_32x32x16_bf16(pa1, PK(1), o[d0], 0, 0, 0);
        o[d0] = __builtin_amdgcn_mfma_f32_32x32x16_bf16(pa2, PK(2), o[d0], 0, 0, 0);
        o[d0] = __builtin_amdgcn_mfma_f32_32x32x16_bf16(pa3, PK(3), o[d0], 0, 0, 0);
#undef PK
    }
}
template <int THRL, bool WMASK> __device__ __forceinline__ void attn_unit(const bf16* Qw0, const bf16* __restrict__ Kc, const bf16* __restrict__ Vc, long dlat, int NT, int kd0,
                                                                         bool has_sink, float sinkl2, bf16* Ow0, char* shm, int wid, bool q_rope, const float* q_normg, int tpos0) {
    const int lane = lane_fresh(), r32 = lane & 31, hi = lane >> 5;
    const bf16* Qw = Qw0 + (long)(wid * QBLK) * ZP;
    const unsigned lds0 = (unsigned)(uintptr_t)shm;
    float* wsf = (float*)(shm + LDS_WS) + wid * 64;
    const bf16* ksrc = Kc + (long)lane * ZP + wid * 8;
    const bf16* vsrc = Vc + (long)(16 * (wid & 3) + (lane >> 2)) * ZP + (wid >> 2) * 32 + (lane & 3) * 8;
    const unsigned kdst = lds0 + LDS_K + wid * 1024, vdst = lds0 + LDS_V + wid * 1024;
#define TOFF(t) (((t) < 4) ? (long)(t) * (KVBLK * ZP) : dlat + (long)((t) - 4) * (KVBLK * ZP))
#define DMA_K(t, slot) glds16(ksrc + TOFF(t), (unsigned)__builtin_amdgcn_readfirstlane(kdst + (slot)))
#define DMA_V(t, slot) glds16(vsrc + TOFF(t), (unsigned)__builtin_amdgcn_readfirstlane(vdst + (slot)))
    const int vb0 = (int)(lds0 + LDS_V) + ((lane >> 4) & 1) * 32 + (lane & 3) * 8 + (4 * hi + ((lane & 15) >> 2)) * 64;
    const char* Kbase = shm + LDS_K; bf16x8 kf[8];
    const lds_cptr shm3 = (lds_cptr)shm; const lds_cptr kp0 = shm3 + LDS_K + hi * 1024 + r32 * 16; const lds_cptr vp0 = shm3 + LDS_V + ((lane >> 4) & 1) * 32 + (lane & 3) * 8 + (4 * hi + ((lane & 15) >> 2)) * 64;
    DMA_K(0, 0); DMA_V(0, 0); DMA_K(1, SLOTB);
    bf16x8 qr[4];
#pragma unroll
    for (int d0 = 0; d0 < 4; ++d0) qr[d0] = *reinterpret_cast<const bf16x8*>(&Qw[(long)r32 * ZP + d0 * 16 + hi * 8]);
    {
        float qf[4][8];
#pragma unroll
        for (int d0 = 0; d0 < 4; ++d0)
#pragma unroll
            for (int i = 0; i < 8; ++i) qf[d0][i] = __uint_as_float(((unsigned)(unsigned short)qr[d0][i]) << 16);
        if (q_normg) {
            float ssq = 0.f;
#pragma unroll
            for (int d0 = 0; d0 < 4; ++d0)
#pragma unroll
                for (int i = 0; i < 8; ++i) ssq += qf[d0][i] * qf[d0][i];
            { auto rr = __builtin_amdgcn_permlane32_swap(__float_as_uint(ssq), __float_as_uint(ssq), false, false); ssq = __uint_as_float(rr[0]) + __uint_as_float(rr[1]); }
            const float rstd = __builtin_amdgcn_rsqf(ssq * (1.f / 64.f) + EPS);
#pragma unroll
            for (int d0 = 0; d0 < 4; ++d0)
#pragma unroll
                for (int i = 0; i < 8; ++i) qf[d0][i] *= rstd * q_normg[d0 * 16 + hi * 8 + i];
        }
        if (q_rope) {
            const int t = tpos0 + wid * QBLK + r32;
#pragma unroll
            for (int a = 0; a < 2; ++a) { const float pos = (float)(a ? (t & 63) : (t >> 6));
#pragma unroll
                for (int i = 0; i < 8; ++i) { float r = pos * (__builtin_amdgcn_exp2f(-(float)(hi * 8 + i) * (13.287712379549449f / 16.0f)) * 0.15915494309189535f); r = r - __builtin_floorf(r);
                    const float c = __builtin_amdgcn_cosf(r), sn = __builtin_amdgcn_sinf(r), x1 = qf[2 * a][i], x2 = qf[2 * a + 1][i];
                    qf[2 * a][i] = x1 * c - x2 * sn; qf[2 * a + 1][i] = x2 * c + x1 * sn; } }
        }
#pragma unroll
        for (int d0 = 0; d0 < 4; ++d0) { u32x4 w; w.x = cvtpk_s(qf[d0][0] * C2, qf[d0][1] * C2); w.y = cvtpk_s(qf[d0][2] * C2, qf[d0][3] * C2); w.z = cvtpk_s(qf[d0][4] * C2, qf[d0][5] * C2); w.w = cvtpk_s(qf[d0][6] * C2, qf[d0][7] * C2);
            qr[d0] = __builtin_bit_cast(bf16x8, w); }
    }
    float mhat = 0.f, l_reg = 0.f; f32x16 o[2]; f32x16 negm;
    { float zz = 0.f; asm volatile("" : "+v"(zz));
      _Pragma("unroll") for (int r = 0; r < 16; ++r) { o[0][r] = zz; o[1][r] = zz; negm[r] = zz; } }
    asm volatile("" : "+v"(negm));
    const int qrel = wid * QBLK + r32;
#define CMASK(P0, P1, t) do { if constexpr (WMASK) { if ((t) >= 4) wmask(P0, P1, kd0 + ((t) - 4) * KVBLK - qrel + 4 * hi); } } while (0)
    bool resc = false;
#define START(P0, P1) do { const float rm = rowmax(P0, P1); resc = false; \
    { const float dl = rm; mhat = fadd_s(mhat, dl); \
      _Pragma("unroll") for (int r = 0; r < 16; ++r) { P0[r] = fsub_s(P0[r], dl); P1[r] = fsub_s(P1[r], dl); } \
      _Pragma("unroll") for (int r = 0; r < 16; ++r) negm[r] = -mhat; asm volatile("" : "+v"(negm)); } \
    _Pragma("unroll") for (int r = 0; r < 16; ++r) P0[r] = __builtin_amdgcn_exp2f(P0[r]); } while (0)
#define RESC() do { if (resc) { asm volatile("s_waitcnt lgkmcnt(0)" ::: "memory"); \
      _Pragma("unroll") for (int d_ = 0; d_ < 2; ++d_) _Pragma("unroll") for (int r = 0; r < 16; ++r) o[d_][r] *= wsf[crow(r, hi)]; } } while (0)
    f32x16 pA0, pA1, pB0, pB1;
    int sl_prev = 0, sl_cur = 0, sl_next = SLOTB;
#define ROT() do { sl_prev = sl_cur; sl_cur = sl_next; sl_next = (sl_next == (NSLOT - 1) * SLOTB) ? 0 : sl_next + SLOTB; } while (0)
    DMA_K(2, 2 * SLOTB);
    WAIT_BAR(3);
    qkt(pA0, pA1, Kbase, qr, negm, r32, hi); asm volatile("s_nop 15\n\ts_nop 7" : "+v"(pA0), "+v"(pA1));
    START(pA0, pA1);
    _Pragma("unroll") for (int r = 0; r < 16; ++r) pA1[r] = __builtin_amdgcn_exp2f(pA1[r]);
    WAIT_BAR(0);
    DMA_K(3, 0); DMA_V(1, SLOTB);
    ROT();
    kload8(kf, kp0 + sl_cur);
    WAIT_BAR(2);
    s16x4 vlo[8], vhi[8]; u32x4 pw0, pw1, pw2, pw3;
#define PKW(P, B) cvtpk_s(P[B], P[B + 1])
#define PAF(k) __builtin_bit_cast(bf16x8, pw##k)
#define VFR(i) (bf16x8){vlo[i][0], vlo[i][1], vlo[i][2], vlo[i][3], vhi[i][0], vhi[i][1], vhi[i][2], vhi[i][3]}
#define PIN(x) asm volatile("" : "+v"(x))
#define MX3(a, b, c) __builtin_fmaxf(__builtin_fmaxf((a), (b)), (c))
#define GAPA(MF, A0, A1, A2, A3, W0, W1, PW) do { MF; sacc += A0; sacc += A1; sacc += A2; sacc += A3; PIN(sacc); W0; W1; PIN(PW); SBAR(); } while (0)
#define EX(v) __builtin_amdgcn_exp2f(v)
#define GAPB(MF, X, B) do { MF; X[B] = EX(X[B]); X[B + 1] = EX(X[B + 1]); X[B + 2] = EX(X[B + 2]); X[B + 3] = EX(X[B + 3]); PIN(X); SBAR(); } while (0)
#define VRD(i) do { vlo[i] = vtr(vp_ + (((i) >> 2) * 4096 + ((i) & 3) * 1024)); vhi[i] = vtr(vp_ + (((i) >> 2) * 4096 + ((i) & 3) * 1024 + 512)); } while (0)
#define KRD(G, j) do { if (G) { kload2(kf, kp0 + sl_next, j); SBAR(); } } while (0)
#define STEP(C0, C1, P0, P1, t, GK, GV, GL) do { SBAR(); \
    const lds_cptr vp_ = vp0 + sl_prev; \
    VRD(0); SBAR(); float sacc = (P0[0] + P0[1]); \
    GAPA(C0 = __builtin_amdgcn_mfma_f32_32x32x16_bf16(kf[0], qr[0], negm, 0, 0, 0), P0[2], P0[3], P0[4], P0[5],     pw0[0] = PKW(P0, 0), pw0[1] = PKW(P0, 2), pw0); \
    VRD(4); SBAR(); GAPA(C1 = __builtin_amdgcn_mfma_f32_32x32x16_bf16(kf[1], qr[0], negm, 0, 0, 0), P0[6], P0[7], P0[8], P0[9],     pw0[2] = PKW(P0, 4), pw0[3] = PKW(P0, 6), pw0); \
    VRD(1); SBAR(); GAPA(C0 = __builtin_amdgcn_mfma_f32_32x32x16_bf16(kf[2], qr[1], C0, 0, 0, 0),   P0[10], P0[11], P0[12], P0[13], pw1[0] = PKW(P0, 8), pw1[1] = PKW(P0, 10), pw1); \
    VRD(5); SBAR(); GAPA(C1 = __builtin_amdgcn_mfma_f32_32x32x16_bf16(kf[3], qr[1], C1, 0, 0, 0),   P0[14], P0[15], P1[0], P1[1],   pw1[2] = PKW(P0, 12), pw1[3] = PKW(P0, 14), pw1); \
    VRD(2); SBAR(); GAPA(C0 = __builtin_amdgcn_mfma_f32_32x32x16_bf16(kf[4], qr[2], C0, 0, 0, 0),   P1[2], P1[3], P1[4], P1[5],     pw2[0] = PKW(P1, 0), pw2[1] = PKW(P1, 2), pw2); \
    VRD(6); SBAR(); GAPA(C1 = __builtin_amdgcn_mfma_f32_32x32x16_bf16(kf[5], qr[2], C1, 0, 0, 0),   P1[6], P1[7], P1[8], P1[9],     pw2[2] = PKW(P1, 4), pw2[3] = PKW(P1, 6), pw2); \
    VRD(3); SBAR(); GAPA(C0 = __builtin_amdgcn_mfma_f32_32x32x16_bf16(kf[6], qr[3], C0, 0, 0, 0),   P1[10], P1[11], P1[12], P1[13], pw3[0] = PKW(P1, 8), pw3[1] = PKW(P1, 10), pw3); \
    VRD(7); SBAR(); GAPA(C1 = __builtin_amdgcn_mfma_f32_32x32x16_bf16(kf[7], qr[3], C1, 0, 0, 0),   P1[14], P1[15], 0.f, 0.f,       pw3[2] = PKW(P1, 12), pw3[3] = PKW(P1, 14), pw3); \
    l_reg += sacc; \
    if (GK) { DMA_K((t) + 3, sl_cur); } if (GV) { DMA_V((t) + 1, sl_next); } \
    CMASK(C0, C1, t); \
    { float a = MX3(C0[0], C0[1], C1[0]), b = MX3(C0[2], C0[3], C1[1]); a = MX3(a, C1[2], C1[3]); \
      _Pragma("unroll") for (int r = 4; r < 16; r += 4) { a = MX3(a, C0[r], C0[r + 1]); b = MX3(b, C0[r + 2], C0[r + 3]); a = MX3(a, C1[r], C1[r + 1]); b = MX3(b, C1[r + 2], C1[r + 3]); } \
      float rm = __builtin_fmaxf(a, b); { auto rr = __builtin_amdgcn_permlane32_swap(__float_as_uint(rm), __float_as_uint(rm), false, false); rm = __builtin_fmaxf(__uint_as_float(rr[0]), __uint_as_float(rr[1])); } \
      resc = false; \
      if (__builtin_expect(__any(rm > (float)THRL), 0)) { const float dl = __builtin_fmaxf(rm, 0.f); mhat += dl; \
        _Pragma("unroll") for (int r = 0; r < 16; ++r) { C0[r] -= dl; C1[r] -= dl; } \
        _Pragma("unroll") for (int r = 0; r < 16; ++r) negm[r] = -mhat; asm volatile("" : "+v"(negm)); \
        const float f = __builtin_amdgcn_exp2f(-dl); l_reg *= f; if (hi == 0) wsf[r32] = f; resc = true; } } \
    SBAR(); \
    GAPB(o[0] = __builtin_amdgcn_mfma_f32_32x32x16_bf16(PAF(0), VFR(0), o[0], 0, 0, 0), C0, 0); \
    GAPB(o[1] = __builtin_amdgcn_mfma_f32_32x32x16_bf16(PAF(0), VFR(4), o[1], 0, 0, 0), C0, 4); \
    KRD(GL, 0); GAPB(o[0] = __builtin_amdgcn_mfma_f32_32x32x16_bf16(PAF(1), VFR(1), o[0], 0, 0, 0), C0, 8); \
    KRD(GL, 1); GAPB(o[1] = __builtin_amdgcn_mfma_f32_32x32x16_bf16(PAF(1), VFR(5), o[1], 0, 0, 0), C0, 12); \
    KRD(GL, 2); GAPB(o[0] = __builtin_amdgcn_mfma_f32_32x32x16_bf16(PAF(2), VFR(2), o[0], 0, 0, 0), C1, 0); \
    KRD(GL, 3); GAPB(o[1] = __builtin_amdgcn_mfma_f32_32x32x16_bf16(PAF(2), VFR(6), o[1], 0, 0, 0), C1, 4); \
    GAPB(o[0] = __builtin_amdgcn_mfma_f32_32x32x16_bf16(PAF(3), VFR(3), o[0], 0, 0, 0), C1, 8); \
    GAPB(o[1] = __builtin_amdgcn_mfma_f32_32x32x16_bf16(PAF(3), VFR(7), o[1], 0, 0, 0), C1, 12); \
    } while (0)
    int t = 1;
    for (; t + 5 < NT; t += 2) {
        STEP(pB0, pB1, pA0, pA1, t, true, true, true);     WAIT_BAR(2); RESC(); ROT();
        STEP(pA0, pA1, pB0, pB1, t + 1, true, true, true); WAIT_BAR(2); RESC(); ROT();
    }
#define ENDW(tt) do { if ((tt) + 3 < NT) { WAIT_BAR(2); } else if ((tt) + 2 < NT) { WAIT_BAR(1); } else { WAIT_BAR(0); } } while (0)
    for (; t + 1 < NT; t += 2) {
        STEP(pB0, pB1, pA0, pA1, t, (t + 3 < NT), (t + 1 < NT), (t + 1 < NT));         ENDW(t);     RESC(); ROT();
        STEP(pA0, pA1, pB0, pB1, t + 1, (t + 4 < NT), (t + 2 < NT), (t + 2 < NT));     ENDW(t + 1); RESC(); ROT();
    }
    STEP(pB0, pB1, pA0, pA1, NT - 1, false, false, false); RESC();
    { float sacc = pB0[0] + pB0[1]; _Pragma("unroll") for (int r = 2; r < 16; ++r) sacc += pB0[r]; _Pragma("unroll") for (int r = 0; r < 16; ++r) sacc += pB1[r]; l_reg += sacc;
      pw0 = (u32x4){PKW(pB0, 0), PKW(pB0, 2), PKW(pB0, 4), PKW(pB0, 6)}; pw1 = (u32x4){PKW(pB0, 8), PKW(pB0, 10), PKW(pB0, 12), PKW(pB0, 14)}; pw2 = (u32x4){PKW(pB1, 0), PKW(pB1, 2), PKW(pB1, 4), PKW(pB1, 6)}; pw3 = (u32x4){PKW(pB1, 8), PKW(pB1, 10), PKW(pB1, 12), PKW(pB1, 14)};
      SBAR(); pv(o, vb0 + sl_cur, PAF(0), PAF(1), PAF(2), PAF(3)); }
#undef PKW
#undef PAF
#undef VFR
#undef PIN
#undef MX3
#undef GAPA
#undef GAPB
#undef EX
#undef VRD
#undef KRD
#undef STEP
#undef ENDW
    { auto rr = __builtin_amdgcn_permlane32_swap(__float_as_uint(l_reg), __float_as_uint(l_reg), false, false); l_reg = __uint_as_float(rr[0]) + __uint_as_float(rr[1]); }
    if (has_sink) l_reg += __builtin_amdgcn_exp2f(sinkl2 - mhat);
    if (hi == 0) wsf[32 + r32] = l_reg; asm volatile("s_waitcnt lgkmcnt(0)" ::: "memory");
    float rli[16];
#pragma unroll
    for (int r = 0; r < 16; ++r) rli[r] = __builtin_amdgcn_rcpf(wsf[32 + crow(r, hi)]);
    bf16* Ow = Ow0 + (long)(wid * QBLK) * YP;
    { bf16* stg = (bf16*)(shm + LDS_OST) + wid * 2048;
#pragma unroll
      for (int r = 0; r < 16; ++r) { const int orow = crow(r, hi);
#pragma unroll
        for (int d0 = 0; d0 < 2; ++d0) stg[orow * 64 + d0 * 32 + r32] = __float2bfloat16(o[d0][r] * rli[r]); }
      asm volatile("s_waitcnt lgkmcnt(0)" ::: "memory");
#pragma unroll
      for (int i = 0; i < 4; ++i) { const int row = i * 8 + (lane >> 3), ch = lane & 7; const u32x4 v = *(const u32x4*)(stg + row * 64 + ch * 8); *(u32x4*)(Ow + (long)row * YP + ch * 8) = v; } }
    asm volatile("s_waitcnt lgkmcnt(0)\n\ts_barrier" ::: "memory");
#undef DMA_K
#undef DMA_V
#undef TOFF
#undef CMASK
#undef START
#undef RESC
#undef ROT
}
constexpr int ATTN_LDS_BYTES = LDS_BYTES;
#undef SBAR
#undef WAIT_BAR
}

constexpr int NWAVES = 8, NTHREADS = NWAVES * 64;
constexpr int RING_BYTES = 131072, LDS_BYTES = 147456;
constexpr int LDSCTL_OFF = RING_BYTES, MISC_OFF = LDSCTL_OFF + 320;
#define LAS __attribute__((address_space(3)))
typedef unsigned short bf16;
typedef unsigned v4u __attribute__((ext_vector_type(4)));
typedef unsigned v2u __attribute__((ext_vector_type(2)));
typedef float f32x4 __attribute__((ext_vector_type(4)));
using pg8::cvt_pk_bf16; using pg8::bf_lo; using pg8::bf_hi;

constexpr size_t MiB = 1u << 20;
constexpr size_t WS_MOD = 0;
constexpr size_t WS_CTL = 1 * MiB, CTL_ZERO_BYTES = 16384;
constexpr size_t WS_W = 2 * MiB;
constexpr size_t LW_IN = 0;
constexpr size_t LW_POOL = LW_IN + (size_t)5120 * 1024 * 2;
constexpr size_t LW_BR = LW_POOL + (size_t)512 * 256 * 2;
constexpr size_t LW_OUT = LW_BR + (size_t)3072 * 512 * 2;
constexpr size_t LW_FF = LW_OUT + (size_t)1024 * 1024 * 2;
constexpr size_t LW_DN = LW_FF + (size_t)5632 * 1024 * 2;
constexpr size_t LW_BYTES = LW_DN + (size_t)1024 * 2816 * 2;
constexpr size_t WS_XC = WS_W + ((2 * LW_BYTES + MiB - 1) / MiB) * MiB;
constexpr size_t WS_ARENA = WS_XC + (size_t)NCTX * 1024 * 4;
constexpr size_t AR_Z = 0, AR_G = (size_t)NTOK * ZP * 2, AR_Y = AR_G + (size_t)NTOK * GP * 2, AR_H = AR_Y;
constexpr size_t AR_MRG = AR_Z;
constexpr size_t AR_U = 0, AR_SIDE = (size_t)NTOK * FF * 2, SIDE_BYTES = (size_t)(NTOK / 32) * FF * 4, AR_H2 = (size_t)NTOK * AVP * 2;
constexpr size_t AR_XF = ((AR_SIDE + 3 * SIDE_BYTES + 4095) / 4096) * 4096;
static_assert(AR_XF + (size_t)NLAT * 1024 * 4 <= AR_H2, "side buffers + XF");
constexpr size_t WS_END = WS_ARENA + (size_t)NTOK * 6656 * 2;
static_assert(AR_Y + (size_t)NTOK * YP * 2 == (size_t)NTOK * 6656 * 2 && AR_H2 + (size_t)NTOK * 1024 * 2 == (size_t)NTOK * 6656 * 2, "arena views");


#define XB_TMO      128
#define XB_XCNT(j)  (256  + 64 * (j))
#define XB_XSUB(j)  (1280 + 64 * (j))
#define XB_XGEN(j)  (2304 + 64 * (j))
#define XB_TOP      3328
#define XB_TOPGEN   3392
#define XCD_BAR_WORDS 3456
#define XB_SPIN_CAP (1u << 20)
__device__ __forceinline__ unsigned xb_ld(unsigned* p)              { return __hip_atomic_load(p, __ATOMIC_RELAXED, __HIP_MEMORY_SCOPE_AGENT); }
__device__ __forceinline__ unsigned xb_add(unsigned* p, unsigned v) { return __hip_atomic_fetch_add(p, v, __ATOMIC_RELAXED, __HIP_MEMORY_SCOPE_AGENT); }
__device__ __forceinline__ unsigned xb_xcc_id() { return (unsigned)__builtin_amdgcn_s_getreg((3 << 11) | 20) & 0xFu; }
#define XB_SPIN(cond, bar) do { unsigned _sp = 0; while (cond) { __builtin_amdgcn_s_sleep(1); \
    if ((++_sp & 255u) == 0u) { if (xb_ld(&(bar)[XB_TMO])) break; if (_sp > XB_SPIN_CAP) { atomicAdd(&(bar)[XB_TMO], 1u); break; } } } } while (0)
struct XcdBarrier { unsigned* bar; unsigned x; volatile LAS unsigned* st; };
__device__ __forceinline__ XcdBarrier xcd_barrier_post(unsigned* bar, volatile LAS unsigned* st) {
    XcdBarrier b; b.bar = bar; b.x = xb_xcc_id(); b.st = st;
    if (threadIdx.x == 0) (void)xb_add(&bar[XB_XCNT(b.x)], 1u);
    return b;
}
__device__ __forceinline__ void xcd_barrier_complete(unsigned* bar, unsigned x, unsigned& nloc, unsigned& nx) {
    const unsigned G = gridDim.x * gridDim.y * gridDim.z;
    unsigned sum, cnt, mine, sp = 0u;
    for (;;) {
        sum = 0u; cnt = 0u; mine = 0u;
#pragma unroll
        for (unsigned j = 0; j < 16; ++j) { const unsigned c = xb_ld(&bar[XB_XCNT(j)]); sum += c; cnt += (c > 0u) ? 1u : 0u; mine = (j == x) ? c : mine; }
        if (sum == G) break;
        __builtin_amdgcn_s_sleep(1);
        if ((++sp & 255u) == 0u) { if (xb_ld(&bar[XB_TMO])) break; if (sp > XB_SPIN_CAP) { atomicAdd(&bar[XB_TMO], 1u); break; } }
    }
    nloc = mine > 0u ? mine : 1u; nx = cnt > 0u ? cnt : 1u;
}
__device__ __forceinline__ void xcd_barrier(const XcdBarrier& b, int wave) {
    asm volatile("s_waitcnt vmcnt(0)" ::: "memory");
    __syncthreads();
    if (wave == 0 && lane_fresh() == 0) {
        unsigned* bar = b.bar;
        __builtin_amdgcn_s_waitcnt(0);
        unsigned nloc = b.st[0], nx = b.st[1];
        if (nloc == 0u) { xcd_barrier_complete(bar, b.x, nloc, nx); b.st[0] = nloc; b.st[1] = nx; }
        const unsigned old = xb_add(&bar[XB_XSUB(b.x)], 1u);
        const unsigned gen = old / nloc;
        if (old + 1u == (gen + 1u) * nloc) {
            __builtin_amdgcn_fence(__ATOMIC_RELEASE, "agent");
            asm volatile("s_waitcnt vmcnt(0)" ::: "memory");
            const unsigned og = xb_add(&bar[XB_TOP], 1u);
            const unsigned tg = og / nx;
            if (og + 1u == (tg + 1u) * nx) xb_add(&bar[XB_TOPGEN], 1u);
            else XB_SPIN(xb_ld(&bar[XB_TOPGEN]) == tg, bar);
            __builtin_amdgcn_fence(__ATOMIC_ACQUIRE, "agent");
            xb_add(&bar[XB_XGEN(b.x)], 1u);
            asm volatile("s_waitcnt vmcnt(0)" ::: "memory");
        } else {
            XB_SPIN(xb_ld(&bar[XB_XGEN(b.x)]) == gen, bar);
            __builtin_amdgcn_fence(__ATOMIC_ACQUIRE, "agent");
            asm volatile("s_waitcnt vmcnt(0)" ::: "memory");
        }
    }
    __syncthreads();
}

struct Args {
    const float *x, *c, *ctx, *c_ctx, *w_mod, *b_mod, *norm1_g, *norm2_g, *w_in, *w_pool_grp, *pool_scale, *win_sink, *q_norm_g, *k_norm_g,
                *w_branch, *w_gate, *b_gate, *w_out, *w_ff_gate, *w_ff_val, *conv_w, *conv_b, *w_ff_down, *final_g;
    float* out; unsigned char* ws; int ph_lo, ph_hi;
};

__device__ __forceinline__ float shx(float v, int lane, int m) { return __int_as_float(__builtin_amdgcn_ds_bpermute((lane ^ m) << 2, __float_as_int(v))); }
__device__ __forceinline__ float wave_sum(float v, int lane) {
#pragma unroll
    for (int o = 1; o < 64; o <<= 1) v += shx(v, lane, o);
    return v;
}
__device__ __forceinline__ void transpose_item(const float* W, int K, int N, bf16* WT, int ldw, int row_off, LAS float* scr, int item, int lane, bool spread = false) {
    const int nblk = N / 32, kb = item / nblk, nb = item % nblk, k0 = 64 * kb, n0 = 32 * nb;
    if (spread) row_off += 128 * (n0 >> 7);
#pragma unroll 8
    for (int i = 0; i < 32; ++i) { const int kk = 2 * i + (lane >> 5); scr[kk * 33 + (lane & 31)] = W[(size_t)(k0 + kk) * N + n0 + (lane & 31)]; }
    asm volatile("s_waitcnt lgkmcnt(0)" ::: "memory");
    const int c = lane & 7;
#pragma unroll
    for (int j = 0; j < 4; ++j) { const int n = (lane >> 3) + 8 * j; const LAS float* s = scr + (8 * c) * 33 + n;
        v4u o; o.x = cvt_pk_bf16(s[0 * 33], s[1 * 33]); o.y = cvt_pk_bf16(s[2 * 33], s[3 * 33]); o.z = cvt_pk_bf16(s[4 * 33], s[5 * 33]); o.w = cvt_pk_bf16(s[6 * 33], s[7 * 33]);
        *(v4u*)(WT + (size_t)(row_off + n0 + n) * ldw + k0 + 8 * c) = o; }
    asm volatile("s_waitcnt lgkmcnt(0)" ::: "memory");
}

__device__ __forceinline__ void prologue(const Args& A, LAS unsigned char* lds, int G, int vcu, int tid, int lane, int wave) {
    float* mod = (float*)(A.ws + WS_MOD);
    if ((int)blockIdx.x < 192) {
        LAS float* S = (LAS float*)lds; LAS float* part = (LAS float*)(lds + 17 * 1024 * 4);
        for (int idx = tid; idx < 17 * 1024; idx += NTHREADS) { const int r = idx >> 10, k = idx & 1023; const float v = (r < 16) ? A.c[r * 1024 + k] : A.c_ctx[k];
            S[idx] = v / (1.0f + __builtin_amdgcn_exp2f(-v * LOG2E)); }
        __syncthreads();
        for (int u = blockIdx.x; u < 192; u += G) {
            const int l = u / 96, n0 = (u % 96) * 64;
            float acc[17];
#pragma unroll
            for (int r = 0; r < 17; ++r) acc[r] = 0.f;
            const float* W = A.w_mod + (size_t)l * 1024 * 6144 + n0 + lane;
#pragma unroll 16
            for (int kk = 0; kk < 128; ++kk) { const int k = kk * 8 + wave; const float w = W[(size_t)k * 6144];
#pragma unroll
                for (int r = 0; r < 17; ++r) acc[r] += S[r * 1024 + k] * w; }
#pragma unroll
            for (int r = 0; r < 17; ++r) part[(wave * 17 + r) * 64 + lane] = acc[r];
            __syncthreads();
            for (int idx = tid; idx < 17 * 64; idx += NTHREADS) { const int r = idx >> 6, j = idx & 63; float s = 0.f;
#pragma unroll
                for (int w = 0; w < 8; ++w) s += part[(w * 17 + r) * 64 + j];
                mod[(size_t)(l * 17 + r) * 6144 + n0 + j] = s + A.b_mod[l * 6144 + n0 + j]; }
            __syncthreads();
        }
    }
    __syncthreads();
    LAS float* scr = (LAS float*)(lds + wave * 16384);
    const int gw = vcu * NWAVES + wave, NGW = G * NWAVES;
    constexpr int I_IN = 16 * 64, I_GATE = 16 * 32, I_BR = 8 * 32, I_OUT = 16 * 32, I_FF = 16 * 88, I_DN = 44 * 32;
    constexpr int PER_LAYER = I_IN + 3 * I_GATE + 2 * I_BR + I_OUT + 2 * I_FF + I_DN;
    for (int it = gw; it < 2 * PER_LAYER; it += NGW) {
        const int l = it / PER_LAYER; int r = it % PER_LAYER;
        unsigned char* wl = A.ws + WS_W + (size_t)l * LW_BYTES;
        if (r < I_IN) { transpose_item(A.w_in + (size_t)l * 1024 * 2048, 1024, 2048, (bf16*)(wl + LW_IN), 1024, 0, scr, r, lane); continue; } r -= I_IN;
        if (r < 3 * I_GATE) { const int i = r / I_GATE; transpose_item(A.w_gate + ((size_t)l * 3 + i) * 1024 * 1024, 1024, 1024, (bf16*)(wl + LW_IN), 1024, 2048 + i * 1024, scr, r % I_GATE, lane); continue; } r -= 3 * I_GATE;
        if (r < 2 * I_BR) { const int i = 1 + r / I_BR; transpose_item(A.w_branch + ((size_t)l * 3 + i) * 512 * 1024, 512, 1024, (bf16*)(wl + LW_BR), 512, i * 1024, scr, r % I_BR, lane); continue; } r -= 2 * I_BR;
        if (r < I_OUT) { transpose_item(A.w_out + (size_t)l * 1024 * 1024, 1024, 1024, (bf16*)(wl + LW_OUT), 1024, 0, scr, r, lane); continue; } r -= I_OUT;
        if (r < I_FF) { transpose_item(A.w_ff_gate + (size_t)l * 1024 * FF, 1024, FF, (bf16*)(wl + LW_FF), 1024, 0, scr, r, lane, true); continue; } r -= I_FF;
        if (r < I_FF) { transpose_item(A.w_ff_val + (size_t)l * 1024 * FF, 1024, FF, (bf16*)(wl + LW_FF), 1024, 128, scr, r, lane, true); continue; } r -= I_FF;
        transpose_item(A.w_ff_down + (size_t)l * FF * 1024, FF, 1024, (bf16*)(wl + LW_DN), FF, 0, scr, r, lane);
    }
}

__device__ __forceinline__ void weff_phase(const Args& A, int gw, int NGW) {
    const int lane = lane_fresh(); asm volatile("" : "+s"(gw));
    for (int task = gw; task < 2 * 4 * 16 * 8; task += NGW) {
        const int l = task >> 9, r = task & 511, g = r >> 7, nb = (r >> 3) & 15, cb = r & 7, n = nb * 64 + lane, c0 = cb * 16;
        const float* wg = A.w_pool_grp + (((size_t)l * 4 + g) * 128 + c0) * 128;
        const float* wb = A.w_branch + ((size_t)l * 3 * 512 + g * 128) * 1024 + n;
        const float* ps = A.pool_scale + (size_t)l * 512 + g * 128;
        float acc[16];
#pragma unroll
        for (int cc = 0; cc < 16; ++cc) acc[cc] = 0.f;
#pragma unroll 4
        for (int d = 0; d < 128; ++d) { const float x = wb[(size_t)d * 1024] * ps[d];
#pragma unroll
            for (int cc = 0; cc < 16; ++cc) acc[cc] += wg[cc * 128 + d] * x; }
        bf16* dst = (bf16*)(A.ws + WS_W + (size_t)l * LW_BYTES + LW_BR) + (size_t)n * 512 + g * 128 + c0;
        v4u w0, w1; w0.x = cvt_pk_bf16(acc[0], acc[1]); w0.y = cvt_pk_bf16(acc[2], acc[3]); w0.z = cvt_pk_bf16(acc[4], acc[5]); w0.w = cvt_pk_bf16(acc[6], acc[7]);
        w1.x = cvt_pk_bf16(acc[8], acc[9]); w1.y = cvt_pk_bf16(acc[10], acc[11]); w1.z = cvt_pk_bf16(acc[12], acc[13]); w1.w = cvt_pk_bf16(acc[14], acc[15]);
        *(v4u*)dst = w0; *(v4u*)(dst + 8) = w1;
    }
}

template <bool SRC_BF16>
__device__ __forceinline__ void norm_rows(const void* xlat, const void* xctx, const float* gvec, const float* modl, int which, int nrows, bf16* H, int gw, int NGW) {
    const int lane = lane_fresh(); asm volatile("" : "+s"(gw));
    constexpr int R = 4;
    for (int row0 = gw * R; row0 < nrows; row0 += NGW * R) {
        const bool lat = row0 < NLAT;
        const size_t roff = lat ? (size_t)row0 * 1024 : (size_t)(row0 - NLAT) * 1024;
        const void* srcb = lat ? xlat : xctx;
        const int b = lat ? (row0 >> 12) : NB;
        const float* shp = modl + (size_t)(b * 6 + which * 3) * 1024; const float* scp = shp + 1024;
        float v[R][2][8]; float ss[R];
#pragma unroll
        for (int r = 0; r < R; ++r)
#pragma unroll
            for (int j = 0; j < 2; ++j) { const size_t o = roff + (size_t)r * 1024 + 8 * lane + 512 * j;
                if constexpr (SRC_BF16) { const v4u w = *(const v4u*)((const bf16*)srcb + o);
                    v[r][j][0] = bf_lo(w.x); v[r][j][1] = bf_hi(w.x); v[r][j][2] = bf_lo(w.y); v[r][j][3] = bf_hi(w.y); v[r][j][4] = bf_lo(w.z); v[r][j][5] = bf_hi(w.z); v[r][j][6] = bf_lo(w.w); v[r][j][7] = bf_hi(w.w); }
                else { const f32x4 a = *(const f32x4*)((const float*)srcb + o), c = *(const f32x4*)((const float*)srcb + o + 4);
                    v[r][j][0] = a.x; v[r][j][1] = a.y; v[r][j][2] = a.z; v[r][j][3] = a.w; v[r][j][4] = c.x; v[r][j][5] = c.y; v[r][j][6] = c.z; v[r][j][7] = c.w; } }
#pragma unroll
        for (int r = 0; r < R; ++r) { float s = 0.f;
#pragma unroll
            for (int j = 0; j < 2; ++j)
#pragma unroll
                for (int i = 0; i < 8; ++i) s += v[r][j][i] * v[r][j][i];
            ss[r] = s; }
#pragma unroll
        for (int o = 1; o < 64; o <<= 1)
#pragma unroll
            for (int r = 0; r < R; ++r) ss[r] += shx(ss[r], lane, o);
#pragma unroll
        for (int j = 0; j < 2; ++j) { const int c0 = 8 * lane + 512 * j; float gm[8], sh[8];
#pragma unroll
            for (int h = 0; h < 2; ++h) { const f32x4 g = *(const f32x4*)(gvec + c0 + 4 * h), s4 = *(const f32x4*)(shp + c0 + 4 * h), sc = *(const f32x4*)(scp + c0 + 4 * h);
#pragma unroll
                for (int e = 0; e < 4; ++e) { gm[4 * h + e] = g[e] * (sc[e] + 1.0f); sh[4 * h + e] = s4[e]; } }
#pragma unroll
            for (int r = 0; r < R; ++r) { const float rstd = __builtin_amdgcn_rsqf(ss[r] * (1.f / 1024.f) + EPS); float y[8];
#pragma unroll
                for (int i = 0; i < 8; ++i) y[i] = (v[r][j][i] * rstd) * gm[i] + sh[i];
                v4u w; w.x = cvt_pk_bf16(y[0], y[1]); w.y = cvt_pk_bf16(y[2], y[3]); w.z = cvt_pk_bf16(y[4], y[5]); w.w = cvt_pk_bf16(y[6], y[7]);
                *(v4u*)(H + (size_t)(row0 + r) * 1024 + c0) = w; } }
    }
}
__device__ __forceinline__ void final_norm_rows(const float* x, float* out, const float* gvec, int gw, int NGW) {
    const int lane = lane_fresh(); asm volatile("" : "+s"(gw));
    constexpr int R = 4;
    for (int row0 = gw * R; row0 < NLAT; row0 += NGW * R) {
        f32x4 v[R][4]; float ss[R];
#pragma unroll
        for (int r = 0; r < R; ++r)
#pragma unroll
            for (int j = 0; j < 4; ++j) v[r][j] = *(const f32x4*)(x + (size_t)(row0 + r) * 1024 + 4 * lane + 256 * j);
#pragma unroll
        for (int r = 0; r < R; ++r) { float s = 0.f;
#pragma unroll
            for (int j = 0; j < 4; ++j) s += (v[r][j].x * v[r][j].x + v[r][j].y * v[r][j].y) + (v[r][j].z * v[r][j].z + v[r][j].w * v[r][j].w);
            ss[r] = s; }
#pragma unroll
        for (int o = 1; o < 64; o <<= 1)
#pragma unroll
            for (int r = 0; r < R; ++r) ss[r] += shx(ss[r], lane, o);
#pragma unroll
        for (int j = 0; j < 4; ++j) { const int c0 = 4 * lane + 256 * j; const f32x4 g = *(const f32x4*)(gvec + c0);
#pragma unroll
            for (int r = 0; r < R; ++r) { const float rstd = __builtin_amdgcn_rsqf(ss[r] * (1.f / 1024.f) + EPS); *(f32x4*)(out + (size_t)(row0 + r) * 1024 + c0) = v[r][j] * rstd * g; } }
    }
}

__device__ __forceinline__ void unpack8(const v4u w, float* v) { v[0] = bf_lo(w.x); v[1] = bf_hi(w.x); v[2] = bf_lo(w.y); v[3] = bf_hi(w.y); v[4] = bf_lo(w.z); v[5] = bf_hi(w.z); v[6] = bf_lo(w.w); v[7] = bf_hi(w.w); }
__device__ __forceinline__ v4u pack8(const float* v) { v4u w; w.x = cvt_pk_bf16(v[0], v[1]); w.y = cvt_pk_bf16(v[2], v[3]); w.z = cvt_pk_bf16(v[4], v[5]); w.w = cvt_pk_bf16(v[6], v[7]); return w; }
__device__ __forceinline__ void qk_proc(float* v, bool do_norm, const float* g, bool do_rope, bool hi_half, const float* cs, const float* sn, float scale, int lane) {
    float ss = 0.f;
#pragma unroll
    for (int i = 0; i < 8; ++i) ss += v[i] * v[i];
    ss += shx(ss, lane, 1); ss += shx(ss, lane, 2); ss += shx(ss, lane, 4);
    const float rstd = __builtin_amdgcn_rsqf(ss * (1.f / 64.f) + EPS);
#pragma unroll
    for (int i = 0; i < 8; ++i) { const float nv = v[i] * rstd * g[i]; v[i] = do_norm ? nv : v[i]; }
#pragma unroll
    for (int i = 0; i < 8; ++i) { const float pvv = shx(v[i], lane, 2);
        const float rv = hi_half ? (v[i] * cs[i] + pvv * sn[i]) : (v[i] * cs[i] - pvv * sn[i]);
        v[i] = (do_rope ? rv : v[i]) * scale; }
}
template <int W2> __device__ __forceinline__ void pool_quad(const bf16* __restrict__ Z, bf16* __restrict__ Y, int row, int t, int L, int ch) {
    int lo = t - W2; lo = lo < 0 ? 0 : lo; int hi = t + W2; hi = hi > L ? L : hi;
    const bf16* zc = Z + (size_t)(row - t) * ZP + ch;
    const v4u zero = {0u, 0u, 0u, 0u};
    v4u pw[2 * W2];
#pragma unroll
    for (int jj = 0; jj < 2 * W2; ++jj) { const int r = lo + jj; pw[jj] = (r < hi) ? *(const v4u*)(zc + (size_t)r * ZP) : zero; }
    const v4u own_w = *(const v4u*)(zc + (size_t)t * ZP);
    float acc[8];
#pragma unroll
    for (int i = 0; i < 8; ++i) acc[i] = 0.f;
#pragma unroll
    for (int jj = 0; jj < 2 * W2; ++jj) { float u[8]; unpack8(pw[jj], u);
#pragma unroll
        for (int i = 0; i < 8; ++i) acc[i] += u[i]; }
    float own[8]; unpack8(own_w, own); const float rc = 1.0f / (float)(hi - lo);
#pragma unroll
    for (int i = 0; i < 8; ++i) acc[i] = acc[i] * rc - own[i];
    *(v4u*)(Y + (size_t)row * YP + ch) = pack8(acc);
}
__device__ __forceinline__ void elem_phase(const Args& A, int layer, int nrows, int nrows_pool, bf16* Z, bf16* Y, int gw, int NGW) {
    const int lane = lane_fresh(); asm volatile("" : "+s"(gw));
    for (int q = gw; q < nrows_pool / 4; q += NGW) {
        const int row = 4 * q + (lane >> 4), c16 = (lane & 15) * 8;
        const bool lat = row < NLAT;
        const int t = lat ? (row & (SEQ - 1)) : ((row - NLAT) & (CTX - 1));
        const int L = lat ? SEQ : CTX;
        pool_quad<8>(Z, Y, row, t, L, 384 + c16);
        pool_quad<4>(Z, Y, row, t, L, 256 + c16);
        pool_quad<2>(Z, Y, row, t, L, 128 + c16);
        pool_quad<1>(Z, Y, row, t, L, c16);
    }
    const int j8 = lane & 7; const bool hi_half = (j8 >> 1) & 1; const int axis = j8 >> 2, fbase = (j8 & 1) * 8;
    float inv[8], kg[8];
#pragma unroll
    for (int i = 0; i < 8; ++i) { inv[i] = __builtin_amdgcn_exp2f(-(float)(fbase + i) * (13.287712379549449f / 16.0f)) * 0.15915494309189535f;
        kg[i] = A.k_norm_g[layer * 64 + j8 * 8 + i]; }
    for (int p = gw; p < nrows / 2; p += NGW) {
        const int row = 2 * p + (lane >> 5);
        const bool lat = row < NLAT;
        const int t = lat ? (row & (SEQ - 1)) : ((row - NLAT) & (CTX - 1));
        bf16* zrow = Z + (size_t)row * ZP;
        const int l5 = lane & 31; const bool isg = l5 >= 16; const int kcol = isg ? 1792 + (l5 - 16) * 8 : 1024 + l5 * 8;
        const v4u k_w = *(const v4u*)(zrow + kcol);
        float cs[8], sn[8];
        { const float pos = (float)(axis ? (t & 63) : (t >> 6));
#pragma unroll
          for (int i = 0; i < 8; ++i) { float r = pos * inv[i]; r = r - __builtin_floorf(r); cs[i] = __builtin_amdgcn_cosf(r); sn[i] = __builtin_amdgcn_sinf(r); } }
        float vk[8];
        unpack8(k_w, vk); qk_proc(vk, isg, kg, lat, hi_half, cs, sn, 1.0f, lane);
        *(v4u*)(zrow + kcol) = pack8(vk);
    }
}

__device__ __forceinline__ void fixup_phase(const Args& A, int layer, int nrows, bf16* U, const float* As, const float* PAs, const float* Vs, int gbase, int NT) {
    const int gtid = gbase + lane_fresh();
    const int items = (nrows / 32) * 352;
    const float* cw = A.conv_w + (size_t)layer * 3 * FF;
    for (int it = gtid; it < items; it += NT) {
        const int c8 = it % 352, brow = it / 352, side = brow & 1, col = c8 * 8;
        const int r = (brow >> 1) * 64 + (side ? 63 : 0);
        const bool lat = r < NLAT; const int L = lat ? SEQ : CTX; const int t = lat ? (r & (SEQ - 1)) : ((r - NLAT) & (CTX - 1));
        const bool has = side ? (t != L - 1) : (t != 0);
        const int nb = has ? (side ? brow + 1 : brow - 1) : brow;
        const float* wp = cw + (side ? 2 * FF : 0) + col;
        const size_t so = (size_t)brow * FF + col, sn = (size_t)nb * FF + col;
        float o[8];
#pragma unroll
        for (int h = 0; h < 2; ++h) { const f32x4 pa = *(const f32x4*)(PAs + so + 4 * h), vv = *(const f32x4*)(Vs + so + 4 * h), an = *(const f32x4*)(As + sn + 4 * h), w = *(const f32x4*)(wp + 4 * h);
#pragma unroll
            for (int e = 0; e < 4; ++e) { const float pre = pa[e] + (has ? w[e] * an[e] : 0.f); o[4 * h + e] = pre * pg8::sigmoidf_(pre) * vv[e]; } }
        *(v4u*)(U + (size_t)r * FF + col) = pack8(o);
    }
}

__device__ __forceinline__ void attention_phase(const Args& A, int layer, bool last, bf16* Z, bf16* Y, char* shm, int G, int vcu, int wave) {
    using abf = attn_body::bf16;
    asm volatile("" : "+s"(vcu), "+s"(G));
    const float* sink = A.win_sink + layer * 8;
    const int NU = NB * 8 * 16, per = (NU + G - 1) / G;
    int u0 = vcu * per, u1 = u0 + per; if (u1 > NU) u1 = NU;
    for (int u = u0; u < u1; ++u) {
        const int qb = u & 15, h = (u >> 4) & 7, b = u >> 7, kvh = h >> 2;
        const size_t qrow = (size_t)b * SEQ + qb * 256, crow0 = (size_t)NLAT + (size_t)b * CTX;
        const abf* Q = (const abf*)Z + qrow * ZP + 1280 + h * 64;
        const abf* Kc = (const abf*)Z + crow0 * ZP + 1792 + kvh * 64; const abf* Vc = (const abf*)Z + crow0 * ZP + 1920 + kvh * 64;
        const long dlat = ((long)b * SEQ - (long)crow0) * ZP;
        attn_body::attn_unit<8, false>(Q, Kc, Vc, dlat, 68, 0, false, 0.f, (abf*)Y + qrow * YP + 1024 + h * 64, shm, wave, true, A.q_norm_g + layer * 64, qb * 256);
    }
    for (int u = u0; u < u1; ++u) {
        const int qb = u & 15, h = (u >> 4) & 7, b = u >> 7, kvh = h >> 2;
        const size_t qrow = (size_t)b * SEQ + qb * 256, crow0 = (size_t)NLAT + (size_t)b * CTX;
        int tl0 = 4 * qb - 2; tl0 = tl0 < 0 ? 0 : tl0; int tl1 = 4 * qb + 6; tl1 = tl1 > 64 ? 64 : tl1;
        const abf* Q = (const abf*)Z + qrow * ZP + 512 + h * 64;
        const abf* Kc = (const abf*)Z + crow0 * ZP + 1024 + kvh * 64; const abf* Vc = (const abf*)Z + crow0 * ZP + 1152 + kvh * 64;
        const long dlat = ((long)b * SEQ + tl0 * 64 - (long)crow0) * ZP;
        attn_body::attn_unit<8, true>(Q, Kc, Vc, dlat, 4 + (tl1 - tl0), tl0 * 64 - qb * 256, true, sink[h] * LOG2E, (abf*)Y + qrow * YP + 512 + h * 64, shm, wave, true, nullptr, qb * 256);
    }
    if (!last) {
        const int NUC = 2 * NB * 8;
        for (int u = vcu; u < NUC; u += G) {
            const int mixer = u & 1, h = (u >> 1) & 7, b = u >> 4, kvh = h >> 2;
            const size_t crow0 = (size_t)NLAT + (size_t)b * CTX;
            const int qc = mixer ? 1280 : 512, kc = mixer ? 1792 : 1024, vc = mixer ? 1920 : 1152, oc = mixer ? 1024 : 512;
            attn_body::attn_unit<8, false>((const abf*)Z + crow0 * ZP + qc + h * 64, (const abf*)Z + crow0 * ZP + kc + kvh * 64, (const abf*)Z + crow0 * ZP + vc + kvh * 64, 0, 4, 0,
                                           mixer == 0, sink[h] * LOG2E, (abf*)Y + crow0 * YP + oc + h * 64, shm, wave, false, mixer ? A.q_norm_g + layer * 64 : nullptr, 0);
        }
    }
}

__global__ void __launch_bounds__(NTHREADS, 2) fwd_megakernel(Args A) {
    extern __shared__ __attribute__((aligned(16))) unsigned char lds_raw[];
    LAS unsigned char* lds = (LAS unsigned char*)lds_raw;
    const int wave = __builtin_amdgcn_readfirstlane(threadIdx.x >> 6);
    const int G = gridDim.x; const int bx = blockIdx.x; const int vcu = (G % 8 == 0) ? (bx % 8) * (G / 8) + bx / 8 : bx;
    const int gw = vcu * NWAVES + wave, NGW = G * NWAVES;
    const int lo = A.ph_lo, hi = A.ph_hi;
    int ph = 0;
#if MK_SPLIT
#define SEAM() do { ++ph; } while (0)
#else
    cg::grid_group grid = cg::this_grid();
    for (int u = threadIdx.x; u < (LDS_BYTES - LDSCTL_OFF) / 4; u += NTHREADS) ((LAS unsigned*)(lds + LDSCTL_OFF))[u] = 0u;
    __syncthreads();
    XcdBarrier bar = xcd_barrier_post((unsigned*)(A.ws + WS_CTL), (volatile LAS unsigned*)(lds + MISC_OFF) + 8);
#define SEAM() do { if (ph == 0) grid.sync(); else xcd_barrier(bar, wave); ++ph; } while (0)
#endif
#define IN() (lo <= ph && ph < hi)
    unsigned char* ws = A.ws;
    float* mod = (float*)(ws + WS_MOD);
    bf16* XB = (bf16*)A.out;
    bf16* XCB = (bf16*)(ws + WS_XC);
    unsigned char* ar = ws + WS_ARENA;
    bf16* Z = (bf16*)(ar + AR_Z); bf16* Gt = (bf16*)(ar + AR_G); bf16* Y = (bf16*)(ar + AR_Y); bf16* H = (bf16*)(ar + AR_H);
    bf16* Mrg = (bf16*)(ar + AR_MRG); bf16* U = (bf16*)(ar + AR_U); bf16* H2 = (bf16*)(ar + AR_H2);
    float* XF = (float*)(ar + AR_XF); float* SAs = (float*)(ar + AR_SIDE); float* SPA = (float*)(ar + AR_SIDE + SIDE_BYTES); float* SVs = (float*)(ar + AR_SIDE + 2 * SIDE_BYTES);

    if (IN()) for (int rep = 0; rep < ((DUP_MASK & 32) ? 2 : 1); ++rep) { const int lane = lane_fresh(); prologue(A, lds, G, vcu, wave * 64 + lane, lane, wave); __syncthreads(); }
    SEAM();
    for (int l = 0; l < 2; ++l) {
        const bool last = (l == 1);
        const int nrows_mix = NTOK, nrows_x = last ? NLAT : NTOK;
        const int nM_mix = nrows_mix / 256, nM_x = nrows_x / 256;
        const float* modl = mod + (size_t)l * 17 * 6144;
        const unsigned char* wl = ws + WS_W + (size_t)l * LW_BYTES;
        if (IN()) { if (l == 0) { norm_rows<false>(A.x, A.ctx, A.norm1_g + l * 1024, modl, 0, nrows_mix, H, gw, NGW); weff_phase(A, gw, NGW); } else norm_rows<true>(XB, XCB, A.norm1_g + l * 1024, modl, 0, nrows_mix, H, gw, NGW); }
        SEAM();
        if (IN()) for (int rep = 0; rep < ((DUP_MASK & 1) ? 2 : 1); ++rep) { pg8::Gemm g{H, (const bf16*)(wl + LW_IN), 1024, 1024, 1024, 0, 0}; pg8::Order S; if (!last) S.init(nM_mix, 20, G, bx, 1, 0); else S.init(NLAT / 256, 20, G, bx, 1, 0, 2 * (NCTX / 256));
            pg8::EpiIn E{Z, Gt, A.b_gate + (size_t)l * 3072};
            pg8::gemm_phase<pg8::EpiIn, true>(lds, g, S, E, wave); }
        SEAM();
        if (IN()) elem_phase(A, l, nrows_mix, nrows_x, Z, Y, gw, NGW);
        SEAM();
        if (IN()) { for (int rep = 0; rep < ((DUP_MASK & 2) ? 2 : 1); ++rep) attention_phase(A, l, last, Z, Y, (char*)lds_raw, G, vcu, wave);
        }
        SEAM();
        if (IN()) for (int rep = 0; rep < ((DUP_MASK & 16) ? 2 : 1); ++rep) { pg8::Gemm g{Y, (const bf16*)(wl + LW_BR), YP, 512, 512, 512, (long)1024 * 512}; pg8::Order S; S.init(nM_x, 4, G, bx, 3, 2);
            pg8::EpiMerge E{Gt, Mrg};
            pg8::gemm_phase<pg8::EpiMerge, true>(lds, g, S, E, wave); }
        SEAM();
        if (IN()) { pg8::Gemm g{Mrg, (const bf16*)(wl + LW_OUT), 1024, 1024, 1024, 0, 0}; pg8::Order S; S.init(nM_x, 4, G, bx, 1, 0);
            if (l == 0) { pg8::EpiRes<false, true> E{A.x, A.ctx, XB, XCB, modl, 2}; pg8::gemm_phase<pg8::EpiRes<false, true>, true>(lds, g, S, E, wave); }
            else { pg8::EpiRes<true, true> E{XB, XCB, XB, XCB, modl, 2}; pg8::gemm_phase<pg8::EpiRes<true, true>, true>(lds, g, S, E, wave); } }
        SEAM();
        if (IN()) norm_rows<true>(XB, XCB, A.norm2_g + l * 1024, modl, 1, nrows_x, H2, gw, NGW);
        SEAM();
        if (IN()) for (int rep = 0; rep < ((DUP_MASK & 4) ? 2 : 1); ++rep) { pg8::Gemm g{H2, (const bf16*)(wl + LW_FF), 1024, 1024, 1024, 0, 0}; pg8::Order S; S.init(nM_x, 22, G, bx, 1, 0);
            pg8::EpiFF E{U, A.conv_w + (size_t)l * 3 * FF, A.conv_b + (size_t)l * FF, SAs, SIDE_BYTES / 4};
            pg8::gemm_phase<pg8::EpiFF, true>(lds, g, S, E, wave); }
        SEAM();
        if (IN()) fixup_phase(A, l, nrows_x, U, SAs, SPA, SVs, vcu * NTHREADS + wave * 64, G * NTHREADS);
        SEAM();
        if (IN()) { pg8::Gemm g{U, (const bf16*)(wl + LW_DN), FF, FF, FF, 0, 0}; pg8::Order S; S.init(nM_x, 4, G, bx, 1, 0);
            if (!last) { pg8::EpiRes<true, true> E{XB, XCB, XB, XCB, modl, 5}; pg8::gemm_phase<pg8::EpiRes<true, true>, true>(lds, g, S, E, wave); }
            else { pg8::EpiRes<true, false> E{XB, XCB, XF, XF, modl, 5}; pg8::gemm_phase<pg8::EpiRes<true, false>, true>(lds, g, S, E, wave); } }
        SEAM();
    }
    if (IN()) final_norm_rows(XF, A.out, A.final_g, gw, NGW);
#undef IN
#undef SEAM
}
constexpr int N_PHASES = 22;

extern "C" void kernel_launch(void* const* d_in, const int* in_sizes, int n_in, void* d_out, int out_size, void* d_ws, size_t ws_size, hipStream_t stream) {
    static int grid = 0;
    if (grid == 0) {
        if (n_in != 24 || out_size != NLAT * 1024 || ws_size < WS_END) { fprintf(stderr, "kernel_launch: unexpected shapes (n_in %d out %d ws %zu need %zu)\n", n_in, out_size, ws_size, (size_t)WS_END); grid = -1; return; }
        int dev = 0, cus = 0, per_cu = 0;
        hipGetDevice(&dev); hipDeviceGetAttribute(&cus, hipDeviceAttributeMultiprocessorCount, dev);
        if (hipFuncSetAttribute((const void*)fwd_megakernel, hipFuncAttributeMaxDynamicSharedMemorySize, LDS_BYTES) != hipSuccess) { fprintf(stderr, "kernel_launch: hipFuncSetAttribute failed\n"); grid = -1; return; }
        hipOccupancyMaxActiveBlocksPerMultiprocessor(&per_cu, (const void*)fwd_megakernel, NTHREADS, LDS_BYTES);
        (void)hipGetLastError();
        if (per_cu < 1) { fprintf(stderr, "kernel_launch: occupancy query says %d blocks per CU\n", per_cu); per_cu = 1; }
        grid = cus;
    }
    if (grid < 0) return;
    Args a{};
    const float** p = (const float**)&a;
    for (int i = 0; i < 24; ++i) p[i] = (const float*)d_in[i];
    a.out = (float*)d_out; a.ws = (unsigned char*)d_ws;
#if MK_SPLIT
    for (int ph = 0; ph < N_PHASES; ++ph) { a.ph_lo = ph; a.ph_hi = ph + 1; hipLaunchKernelGGL(fwd_megakernel, dim3(grid), dim3(NTHREADS), LDS_BYTES, stream, a); }
#else
    a.ph_lo = 0; a.ph_hi = N_PHASES;
    if (hipMemsetAsync((char*)d_ws + WS_CTL, 0, CTL_ZERO_BYTES, stream) != hipSuccess) { fprintf(stderr, "kernel_launch: memset failed\n"); return; }
    void* args[] = {&a};
    hipError_t e = hipLaunchCooperativeKernel((const void*)fwd_megakernel, dim3(grid), dim3(NTHREADS), args, LDS_BYTES, stream);
    if (e != hipSuccess) fprintf(stderr, "cooperative launch failed: %s (grid %d)\n", hipGetErrorString(e), grid);
#endif
}
```

```cpp
#include <hip/hip_runtime.h>
#include <hip/hip_cooperative_groups.h>
#include <hip/hip_bf16.h>
#include <cstdio>
#include <cstdint>
#include <cmath>
namespace cg = cooperative_groups;

#ifndef DUP_MASK
#define DUP_MASK 0
#endif
#ifndef MK_SPLIT
#define MK_SPLIT 0
#endif

constexpr int DM_ = 1024, NB = 16, SEQ = 4096, CTX = 256, NLAT = NB * SEQ, NCTX = NB * CTX, NTOK = NLAT + NCTX;
constexpr int ZP = 2048, GP = 3072, YP = 1536, FF = 2816, AVP = 2 * FF;
constexpr float EPS = 1e-6f;
constexpr float LOG2E = 1.4426950408889634f;
constexpr float C2 = 0.125f * LOG2E;

__device__ __forceinline__ int lane_fresh() { int l = (int)__builtin_amdgcn_mbcnt_hi(~0u, __builtin_amdgcn_mbcnt_lo(~0u, 0u)); asm volatile("" : "+v"(l)); return l; }

namespace pg8 {
#define PG8_LAS __attribute__((address_space(3)))
typedef unsigned short bf16_t;
typedef short bf16x8 __attribute__((ext_vector_type(8)));
typedef float f32x4 __attribute__((ext_vector_type(4)));
typedef unsigned u32x4 __attribute__((ext_vector_type(4)));
typedef unsigned u32x2 __attribute__((ext_vector_type(2)));
constexpr int BM = 256, BK = 64, HALF = 128, HTB = HALF * BK * 2, STAGE_BYTES = 8 * HTB, NXCD = 8, WGM = 4;

__host__ __device__ __forceinline__ int lds_byte(int r, int c) { const int st = (r >> 4) * 2 + (c >> 5), rr = r & 15, cc = c & 31, ob = rr * 64 + cc * 2; return st * 1024 + (ob ^ (((ob >> 9) & 1) << 5)); }
__host__ __device__ __forceinline__ void stage_rc(int b, int& R, int& C) { const int st = b / 1024, sb = b % 1024, swz = sb ^ (((sb >> 9) & 1) << 5); R = (st >> 1) * 16 + swz / 64; C = (st & 1) * 32 + (swz % 64) / 2; }
__host__ __device__ __forceinline__ int perm32(int rho) { const int n = rho >> 4, i = rho & 15; return 8 * (i >> 2) + 4 * n + (i & 3); }

struct Unit { int pm, pn, g; };
struct Gemm { const bf16_t* A; const bf16_t* Bt; int lda, ldb, K; long a_goff, b_goff; };

struct Order {
    int nM, nN, nwg, G, c, sub, gmode, nextra;
    __device__ __forceinline__ void init(int nM_, int nN_, int G_, int c_, int sub_, int gmode_, int nextra_ = 0) { nM = nM_; nN = nN_; nwg = nM * nN; G = G_; c = c_; sub = sub_; gmode = gmode_; nextra = nextra_; }
    __device__ __forceinline__ bool next(int i, Unit& u) const {
        const int ti = (sub == 1) ? i : i / sub;
        const long L = (long)ti * G + c;
        if (L >= nwg) { const int j = (int)(L - nwg); if (j >= nextra) return false; u.pm = nM + (j >> 1); u.pn = (j & 1) ? 7 : 4; u.g = 0; return true; }
        int wgid = (int)L; { const int q = nwg / NXCD, r = nwg % NXCD, xcd = wgid % NXCD, off = wgid / NXCD; wgid = (xcd < r ? xcd * (q + 1) : r * (q + 1) + (xcd - r) * q) + off; }
        const int nig = WGM * nN, gid = wgid / nig, fm = gid * WGM, gsz = (nM - fm) < WGM ? (nM - fm) : WGM;
        u.pm = fm + ((wgid % nig) % gsz); u.pn = (wgid % nig) / gsz;
        u.g = (gmode == 0) ? 0 : ((gmode == 1) ? u.pn : (i - ti * sub));
        return true;
    }
};

typedef float f32x2_t __attribute__((ext_vector_type(2))); typedef __bf16 bf16x2_t __attribute__((ext_vector_type(2)));
__device__ __forceinline__ unsigned cvt_pk_bf16(float lo, float hi) { f32x2_t v = {lo, hi}; bf16x2_t b = __builtin_convertvector(v, bf16x2_t); return __builtin_bit_cast(unsigned, b); }
__device__ __forceinline__ float bf_lo(unsigned w) { return __uint_as_float(w << 16); }
__device__ __forceinline__ float bf_hi(unsigned w) { return __uint_as_float(w & 0xffff0000u); }
__device__ __forceinline__ float sigmoidf_(float x) { return __builtin_amdgcn_rcpf(1.0f + __builtin_amdgcn_exp2f(-x * 1.4426950408889634f)); }

struct EpiBf16 {
    static constexpr bool PERM = true;
    bf16_t* O; int ldc; const float* colscale;
    __device__ __forceinline__ void operator()(const f32x4 (&acc)[2][2][4][2], const Unit& u, int wr, int wc, int fr, int fq) const {
        int row0 = u.pm * BM + wr * 64 + fr; asm volatile("" : "+v"(row0)); const int col0 = u.pn * BM + wc * 32 + 8 * fq;
#pragma unroll
        for (int bj = 0; bj < 2; ++bj) {
            f32x4 s0 = (f32x4){1.f, 1.f, 1.f, 1.f}, s1 = s0;
            if (colscale) { s0 = *(const f32x4*)(colscale + col0 + bj * HALF); s1 = *(const f32x4*)(colscale + col0 + bj * HALF + 4); }
#pragma unroll
            for (int ai = 0; ai < 2; ++ai)
#pragma unroll
                for (int m = 0; m < 4; ++m) { bf16_t* rowp = O + (size_t)(row0 + ai * HALF + m * 16) * ldc + col0;
                    const f32x4 v0 = acc[ai][bj][m][0] * s0, v1 = acc[ai][bj][m][1] * s1;
                    u32x4 w; w.x = cvt_pk_bf16(v0[0], v0[1]); w.y = cvt_pk_bf16(v0[2], v0[3]); w.z = cvt_pk_bf16(v1[0], v1[1]); w.w = cvt_pk_bf16(v1[2], v1[3]);
                    *(u32x4*)(rowp + bj * HALF) = w; } }
    }
};
struct EpiIn {
    static constexpr bool PERM = true;
    bf16_t* Z; bf16_t* Gt; const float* bgate;
    __device__ __forceinline__ void operator()(const f32x4 (&acc)[2][2][4][2], const Unit& u, int wr, int wc, int fr, int fq) const {
        int row0 = u.pm * BM + wr * 64 + fr; asm volatile("" : "+v"(row0)); const bool isz = u.pn < 8;
        const int col0 = (isz ? u.pn * BM : (u.pn - 8) * BM) + wc * 32 + 8 * fq;
        bf16_t* base = isz ? Z : Gt; const int ldc = isz ? ZP : GP;
        f32x4 bv[2][2];
#pragma unroll
        for (int bj = 0; bj < 2; ++bj)
#pragma unroll
            for (int n = 0; n < 2; ++n) bv[bj][n] = isz ? (f32x4){0.f, 0.f, 0.f, 0.f} : *(const f32x4*)(bgate + col0 + bj * HALF + 4 * n);
#pragma unroll
        for (int ai = 0; ai < 2; ++ai)
#pragma unroll
            for (int m = 0; m < 4; ++m) { bf16_t* rowp = base + (size_t)(row0 + ai * HALF + m * 16) * ldc + col0;
#pragma unroll
                for (int bj = 0; bj < 2; ++bj) { f32x4 v0 = acc[ai][bj][m][0] + bv[bj][0], v1 = acc[ai][bj][m][1] + bv[bj][1];
                    if (!isz) {
#pragma unroll
                        for (int e = 0; e < 4; ++e) { v0[e] = sigmoidf_(v0[e]); v1[e] = sigmoidf_(v1[e]); } }
                    u32x4 w; w.x = cvt_pk_bf16(v0[0], v0[1]); w.y = cvt_pk_bf16(v0[2], v0[3]); w.z = cvt_pk_bf16(v1[0], v1[1]); w.w = cvt_pk_bf16(v1[2], v1[3]);
                    *(u32x4*)(rowp + bj * HALF) = w; } }
    }
};
struct EpiMerge {
    static constexpr bool PERM = true;
    const bf16_t* Gt; bf16_t* Mrg;
    __device__ __forceinline__ void operator()(const f32x4 (&acc)[2][2][4][2], const Unit& u, int wr, int wc, int fr, int fq) const {
        int row0 = u.pm * BM + wr * 64 + fr; asm volatile("" : "+v"(row0)); const int col0 = u.pn * BM + wc * 32 + 8 * fq;
#pragma unroll
        for (int ai = 0; ai < 2; ++ai) {
            u32x4 gw[4][2], ow[4][2];
#pragma unroll
            for (int m = 0; m < 4; ++m) { const size_t row = (size_t)(row0 + ai * HALF + m * 16);
#pragma unroll
                for (int bj = 0; bj < 2; ++bj) { gw[m][bj] = *(const u32x4*)(Gt + row * GP + u.g * 1024 + col0 + bj * HALF);
                    if (u.g != 0) ow[m][bj] = *(const u32x4*)(Mrg + row * 1024 + col0 + bj * HALF); } }
#pragma unroll
            for (int m = 0; m < 4; ++m) { const size_t row = (size_t)(row0 + ai * HALF + m * 16);
#pragma unroll
                for (int bj = 0; bj < 2; ++bj) {
                    const u32x4 g4 = gw[m][bj];
                    const f32x4 a0 = acc[ai][bj][m][0], a1 = acc[ai][bj][m][1];
                    float v[8];
                    v[0] = bf_lo(g4.x) * a0[0]; v[1] = bf_hi(g4.x) * a0[1]; v[2] = bf_lo(g4.y) * a0[2]; v[3] = bf_hi(g4.y) * a0[3];
                    v[4] = bf_lo(g4.z) * a1[0]; v[5] = bf_hi(g4.z) * a1[1]; v[6] = bf_lo(g4.w) * a1[2]; v[7] = bf_hi(g4.w) * a1[3];
                    if (u.g != 0) { const u32x4 o4 = ow[m][bj];
                        v[0] += bf_lo(o4.x); v[1] += bf_hi(o4.x); v[2] += bf_lo(o4.y); v[3] += bf_hi(o4.y); v[4] += bf_lo(o4.z); v[5] += bf_hi(o4.z); v[6] += bf_lo(o4.w); v[7] += bf_hi(o4.w); }
                    u32x4 w; w.x = cvt_pk_bf16(v[0], v[1]); w.y = cvt_pk_bf16(v[2], v[3]); w.z = cvt_pk_bf16(v[4], v[5]); w.w = cvt_pk_bf16(v[6], v[7]);
                    *(u32x4*)(Mrg + row * 1024 + col0 + bj * HALF) = w; } }
        }
    }
};
template <bool BASE_BF16, bool OUT_BF16> struct EpiRes {
    static constexpr bool PERM = false;
    const void* base_lat; const void* base_ctx; void* out_lat; void* out_ctx; const float* modl; int gate_idx;
    __device__ __forceinline__ void operator()(const f32x4 (&acc)[2][2][4][2], const Unit& u, int wr, int wc, int fr, int fq) const {
        const bool lat = u.pm < (NLAT / BM);
        const int prow = lat ? u.pm * BM : (u.pm * BM - NLAT);
        const void* base = lat ? base_lat : base_ctx; void* out = lat ? out_lat : out_ctx;
        const int b = lat ? (u.pm * BM) / SEQ : NB;
        int col0 = u.pn * BM + wc * 32 + 4 * fq; asm volatile("" : "+v"(col0));
        const float* gp = modl + (size_t)(b * 6 + gate_idx) * 1024 + col0;
        f32x4 gv[2][2];
#pragma unroll
        for (int bj = 0; bj < 2; ++bj)
#pragma unroll
            for (int n = 0; n < 2; ++n) gv[bj][n] = *(const f32x4*)(gp + bj * HALF + n * 16);
#pragma unroll
        for (int ai = 0; ai < 2; ++ai) {
            f32x4 bs[4][2][2];
#pragma unroll
            for (int m = 0; m < 4; ++m) { const size_t off = (size_t)(prow + ai * HALF + wr * 64 + m * 16 + fr) * 1024 + col0;
#pragma unroll
                for (int bj = 0; bj < 2; ++bj)
#pragma unroll
                    for (int n = 0; n < 2; ++n) { const size_t o2 = off + bj * HALF + n * 16;
                        if constexpr (BASE_BF16) { const u32x2 w = *(const u32x2*)((const bf16_t*)base + o2); bs[m][bj][n] = (f32x4){bf_lo(w.x), bf_hi(w.x), bf_lo(w.y), bf_hi(w.y)}; }
                        else bs[m][bj][n] = *(const f32x4*)((const float*)base + o2); } }
#pragma unroll
            for (int m = 0; m < 4; ++m) { const size_t off = (size_t)(prow + ai * HALF + wr * 64 + m * 16 + fr) * 1024 + col0;
#pragma unroll
                for (int bj = 0; bj < 2; ++bj)
#pragma unroll
                    for (int n = 0; n < 2; ++n) { const size_t o2 = off + bj * HALF + n * 16;
                        const f32x4 r = bs[m][bj][n] + gv[bj][n] * acc[ai][bj][m][n];
                        if constexpr (OUT_BF16) { u32x2 w; w.x = cvt_pk_bf16(r[0], r[1]); w.y = cvt_pk_bf16(r[2], r[3]); *(u32x2*)((bf16_t*)out + o2) = w; }
                        else *(f32x4*)((float*)out + o2) = r; } }
        }
    }
};
struct EpiFF {
    static constexpr bool PERM = true;
    bf16_t* U; const float* cw; const float* cb; float* As; size_t side_elems;
    __device__ __forceinline__ void operator()(const f32x4 (&acc)[2][2][4][2], const Unit& u, int wr, int wc, int fr, int fq) const {
        const int lane = fq * 16 + fr; float* PAs = As + side_elems; float* Vs = PAs + side_elems;
        int ch0 = u.pn * 128 + wc * 32 + 8 * fq; asm volatile("" : "+v"(ch0));
        const int src_up = (lane & 48) | ((fr - 1) & 15), src_dn = (lane & 48) | ((fr + 1) & 15);
#pragma unroll
        for (int h = 0; h < 2; ++h) {
            const f32x4 w0 = *(const f32x4*)(cw + ch0 + 4 * h), w1 = *(const f32x4*)(cw + 2816 + ch0 + 4 * h), w2 = *(const f32x4*)(cw + 2 * 2816 + ch0 + 4 * h), bb = *(const f32x4*)(cb + ch0 + 4 * h);
#pragma unroll
            for (int ai = 0; ai < 2; ++ai) {
                const int rblk = u.pm * 4 + ai * 2 + wr;
                float o[4][4]; f32x4 pre0, pre3;
#pragma unroll
                for (int e = 0; e < 4; ++e) {
                    float a[4], ru[4], rd[4];
#pragma unroll
                    for (int m = 0; m < 4; ++m) { a[m] = acc[ai][0][m][h][e]; ru[m] = __int_as_float(__builtin_amdgcn_ds_bpermute(src_up << 2, __float_as_int(a[m]))); rd[m] = __int_as_float(__builtin_amdgcn_ds_bpermute(src_dn << 2, __float_as_int(a[m]))); }
#pragma unroll
                    for (int m = 0; m < 4; ++m) {
                        const float ap = (fr > 0) ? ru[m] : (m > 0 ? ru[m > 0 ? m - 1 : 0] : 0.f);
                        const float an = (fr < 15) ? rd[m] : (m < 3 ? rd[m < 3 ? m + 1 : 3] : 0.f);
                        const float pre = ap * w0[e] + a[m] * w1[e] + an * w2[e] + bb[e];
                        if (m == 0) pre0[e] = pre; if (m == 3) pre3[e] = pre;
                        o[m][e] = pre * sigmoidf_(pre) * acc[ai][1][m][h][e]; }
                    __builtin_amdgcn_sched_barrier(0); }
#pragma unroll
                for (int m = 0; m < 4; ++m) { u32x2 w; w.x = cvt_pk_bf16(o[m][0], o[m][1]); w.y = cvt_pk_bf16(o[m][2], o[m][3]);
                    *(u32x2*)(U + ((size_t)rblk * 64 + m * 16 + fr) * 2816 + ch0 + 4 * h) = w; }
                if (fr == 0) { const size_t so = (size_t)(2 * rblk) * 2816 + ch0 + 4 * h; *(f32x4*)(As + so) = acc[ai][0][0][h]; *(f32x4*)(Vs + so) = acc[ai][1][0][h]; *(f32x4*)(PAs + so) = pre0; }
                if (fr == 15) { const size_t so = (size_t)(2 * rblk + 1) * 2816 + ch0 + 4 * h; *(f32x4*)(As + so) = acc[ai][0][3][h]; *(f32x4*)(Vs + so) = acc[ai][1][3][h]; *(f32x4*)(PAs + so) = pre3; }
                __builtin_amdgcn_sched_barrier(0);
            }
        }
    }
};

template <class Epi, bool ALIGN_EPI>
__device__ __forceinline__ void gemm_phase(PG8_LAS unsigned char* lds, const Gemm g, const Order& S, const Epi& E, int wid) {
    const int lane = lane_fresh(), tid = wid * 64 + lane;
    const int wr = wid >> 2, wc = wid & 3, fr = lane & 15, fq = lane >> 4;
    const int K = g.K, nt = K / BK;
    unsigned voffA[2], voffB[2];
#pragma unroll
    for (int i = 0; i < 2; ++i) { int R, C; stage_rc(tid * 16 + i * 8192, R, C); const int Rb = Epi::PERM ? ((R & ~31) + perm32(R & 31)) : R;
        voffA[i] = (unsigned)(R * g.lda + C) * 2u; voffB[i] = (unsigned)(Rb * g.ldb + C) * 2u; }
    const size_t kstep = (size_t)(BK * 2);
    const size_t hstepA = (size_t)HALF * g.lda * 2, hstepB = (size_t)HALF * g.ldb * 2;
    const size_t tstepA = 2 * hstepA, tstepB = 2 * hstepB;
    const unsigned ldsw = (unsigned)wid * 1024u;
    const int aoff = lds_byte(wr * 64 + fr, fq * 8), boff = lds_byte(wc * 32 + fr, fq * 8);
#define PG8_UA(u) ((const char*)g.A + (size_t)(u).pm * tstepA + (size_t)((long)(u).g * g.a_goff * 2))
#define PG8_UB(u) ((const char*)g.Bt + (size_t)(u).pn * tstepB + (size_t)((long)(u).g * g.b_goff * 2))
#define PG8_SA(b, h) (((b) * 2 + (h)) * HTB)
#define PG8_SB(b, h) ((4 + (b) * 2 + (h)) * HTB)
#define PG8_STAGE(bufoff, gbase, voff) do { _Pragma("unroll") for (int _i = 0; _i < 2; ++_i) \
        __builtin_amdgcn_global_load_lds((const unsigned*)((const char*)(gbase) + (voff)[_i]), (PG8_LAS unsigned*)(lds + (bufoff) + ldsw + _i * 8192), 16, 0, 0); } while (0)
#define PG8_LDA(dst, b, h) do { _Pragma("unroll") for (int m = 0; m < 4; ++m) _Pragma("unroll") for (int k = 0; k < 2; ++k) dst[m][k] = *(const PG8_LAS bf16x8*)(lds + PG8_SA(b, h) + aoff + m * 2048 + k * 1024); } while (0)
#define PG8_LDB(dst, b, h) do { _Pragma("unroll") for (int n = 0; n < 2; ++n) _Pragma("unroll") for (int k = 0; k < 2; ++k) dst[n][k] = *(const PG8_LAS bf16x8*)(lds + PG8_SB(b, h) + boff + n * 2048 + k * 1024); } while (0)
#define PG8_MMA(ai, bj, At, Bt) do { __builtin_amdgcn_s_setprio(1); _Pragma("unroll") for (int m = 0; m < 4; ++m) _Pragma("unroll") for (int n = 0; n < 2; ++n) _Pragma("unroll") for (int k = 0; k < 2; ++k) \
        acc[ai][bj][m][n] = __builtin_amdgcn_mfma_f32_16x16x32_bf16(Bt[n][k], At[m][k], acc[ai][bj][m][n], 0, 0, 0); __builtin_amdgcn_s_setprio(0); } while (0)
#define PG8_WAIT_V(n) asm volatile("s_waitcnt vmcnt(" #n ")" ::: "memory")
#define PG8_WAIT_L(n) asm volatile("s_waitcnt lgkmcnt(" #n ")" ::: "memory")
#define PG8_BAR __builtin_amdgcn_s_barrier()
#define PG8_SCHED __builtin_amdgcn_sched_barrier(0)
    Unit cur, nxt; int ui = 0;
    if (!S.next(0, cur)) return;
    f32x4 acc[2][2][4][2];
#pragma unroll
    for (int a = 0; a < 2; ++a)
#pragma unroll
        for (int b = 0; b < 2; ++b)
#pragma unroll
            for (int m = 0; m < 4; ++m)
#pragma unroll
                for (int n = 0; n < 2; ++n) acc[a][b][m][n] = (f32x4){0.f, 0.f, 0.f, 0.f};
    bf16x8 At[4][2], B0[2][2], B1[2][2];
    const char* cA = PG8_UA(cur); const char* cB = PG8_UB(cur);
    PG8_STAGE(PG8_SB(0, 0), cB, voffB); PG8_STAGE(PG8_SB(0, 1), cB + hstepB, voffB); PG8_STAGE(PG8_SA(0, 0), cA, voffA); PG8_STAGE(PG8_SA(0, 1), cA + hstepA, voffA);
    if (wr == 1) PG8_BAR;
    PG8_WAIT_V(2); PG8_BAR;
    PG8_STAGE(PG8_SB(1, 0), cB + kstep, voffB); PG8_STAGE(PG8_SA(1, 0), cA + kstep, voffA); PG8_STAGE(PG8_SB(1, 1), cB + hstepB + kstep, voffB);
    PG8_WAIT_V(6); PG8_BAR;
    for (;;) {
        const bool has_next = S.next(ui + 1, nxt);
        const char* nA = has_next ? PG8_UA(nxt) : cA; const char* nB = has_next ? PG8_UB(nxt) : cB;
        for (int t = 0; t < nt; t += 2) {
            const bool last = (t == nt - 2);
            const char* a1 = cA + (size_t)(t + 1) * kstep;
            const char* a2 = last ? nA : cA + (size_t)(t + 2) * kstep; const char* b2 = last ? nB : cB + (size_t)(t + 2) * kstep;
            const char* a3 = a2 + kstep; const char* b3 = b2 + kstep;
            PG8_LDB(B0, 0, 0); PG8_LDB(B1, 0, 1); PG8_SCHED; PG8_LDA(At, 0, 0); PG8_STAGE(PG8_SA(1, 1), a1 + hstepA, voffA);
            PG8_WAIT_V(8); PG8_WAIT_L(0); PG8_BAR; PG8_MMA(0, 0, At, B0); PG8_MMA(0, 1, At, B1); PG8_BAR; PG8_SCHED;
            PG8_LDA(At, 0, 1); PG8_STAGE(PG8_SB(0, 0), b2, voffB); PG8_STAGE(PG8_SB(0, 1), b2 + hstepB, voffB); PG8_STAGE(PG8_SA(0, 0), a2, voffA);
            PG8_WAIT_V(8); PG8_WAIT_L(0); PG8_BAR; PG8_MMA(1, 0, At, B0); PG8_MMA(1, 1, At, B1); PG8_BAR; PG8_SCHED;
            PG8_LDB(B0, 1, 0); PG8_LDB(B1, 1, 1); PG8_SCHED; PG8_LDA(At, 1, 0); PG8_STAGE(PG8_SA(0, 1), a2 + hstepA, voffA);
            PG8_WAIT_V(8); PG8_WAIT_L(0); PG8_BAR; PG8_MMA(0, 0, At, B0); PG8_MMA(0, 1, At, B1); PG8_BAR; PG8_SCHED;
            PG8_LDA(At, 1, 1); PG8_STAGE(PG8_SB(1, 0), b3, voffB); PG8_STAGE(PG8_SB(1, 1), b3 + hstepB, voffB); PG8_STAGE(PG8_SA(1, 0), a3, voffA);
            PG8_WAIT_V(8); PG8_WAIT_L(0); PG8_BAR; PG8_MMA(1, 0, At, B0); PG8_MMA(1, 1, At, B1); PG8_BAR; PG8_SCHED;
        }
        if constexpr (ALIGN_EPI) { if (wr == 0) PG8_BAR; }
        { const int l2 = lane_fresh(); E(acc, cur, wr, wc, l2 & 15, l2 >> 4); }
        if (!has_next) break;
#pragma unroll
        for (int a = 0; a < 2; ++a)
#pragma unroll
            for (int b = 0; b < 2; ++b)
#pragma unroll
                for (int m = 0; m < 4; ++m)
#pragma unroll
                    for (int n = 0; n < 2; ++n) acc[a][b][m][n] = (f32x4){0.f, 0.f, 0.f, 0.f};
        cur = nxt; cA = nA; cB = nB; ++ui;
        if constexpr (ALIGN_EPI) { if (wr == 1) PG8_BAR; }
    }
    PG8_WAIT_V(0);
    if constexpr (!ALIGN_EPI) { if (wr == 0) PG8_BAR; }
    PG8_BAR;
#undef PG8_UA
#undef PG8_UB
#undef PG8_SA
#undef PG8_SB
#undef PG8_STAGE
#undef PG8_LDA
#undef PG8_LDB
#undef PG8_MMA
#undef PG8_WAIT_V
#undef PG8_WAIT_L
#undef PG8_BAR
#undef PG8_SCHED
}
}

namespace attn_body {
using bf16 = __hip_bfloat16;
using bf16x8 = __attribute__((ext_vector_type(8))) short;
using s16x4 = __attribute__((ext_vector_type(4))) short;
using f32x16 = __attribute__((ext_vector_type(16))) float;
using u32x4 = __attribute__((ext_vector_type(4))) unsigned;
constexpr int D = 64, NW = 8, QBLK = 32, QB = QBLK * NW, KVBLK = 64;
__device__ __forceinline__ int crow(int r, int hi) { return (r & 3) + 8 * (r >> 2) + 4 * hi; }
#define SBAR() __builtin_amdgcn_sched_barrier(0)
__device__ __forceinline__ void wmask(f32x16& p0, f32x16& p1, int d0) {
    const float NEG = -INFINITY;
#pragma unroll
    for (int r = 0; r < 16; ++r) { const int d = d0 + (r & 3) + 8 * (r >> 2); if (d > 128 || d < -128) p0[r] = NEG; if (d + 32 > 128 || d + 32 < -128) p1[r] = NEG; }
}
constexpr int NSLOT = 3, SLOTB = 8192;
constexpr int LDS_K = 0, LDS_V = NSLOT * SLOTB, LDS_WS = 2 * NSLOT * SLOTB, LDS_OST = LDS_WS + NW * 64 * 4, LDS_BYTES = LDS_OST + NW * 4096;
__device__ __forceinline__ void glds16(const void* gsrc, unsigned lds_dst) { unsigned keep;
    asm volatile("s_mov_b32 %0, m0\n\ts_mov_b32 m0, %2\n\ts_nop 0\n\tglobal_load_lds_dwordx4 %1, off\n\ts_mov_b32 m0, %0" : "=&s"(keep) : "v"(gsrc), "s"(lds_dst) : "memory"); }
__device__ __forceinline__ float max3f(float a, float b, float c) { float r; asm("v_max3_f32 %0, %1, %2, %3" : "=v"(r) : "v"(a), "v"(b), "v"(c)); return r; }
__device__ __forceinline__ float max2f(float a, float b) { float r; asm("v_max_f32_e32 %0, %1, %2" : "=v"(r) : "v"(a), "v"(b)); return r; }
__device__ __forceinline__ float fadd_s(float a, float b) { float r; asm("v_add_f32_e32 %0, %1, %2" : "=v"(r) : "v"(a), "v"(b)); return r; }
__device__ __forceinline__ float fsub_s(float a, float b) { float r; asm("v_sub_f32_e32 %0, %1, %2" : "=v"(r) : "v"(a), "v"(b)); return r; }
typedef float f32x2_t __attribute__((ext_vector_type(2))); typedef __bf16 bf16x2_t __attribute__((ext_vector_type(2)));
__device__ __forceinline__ unsigned cvtpk_s(float lo, float hi) { f32x2_t v = {lo, hi}; bf16x2_t b = __builtin_convertvector(v, bf16x2_t); return __builtin_bit_cast(unsigned, b); }
#define WAIT_BAR(N) asm volatile("s_waitcnt vmcnt(" #N ") lgkmcnt(0)\n\ts_barrier" ::: "memory")

__device__ __forceinline__ void qkt(f32x16& p0, f32x16& p1, const char* Kslot, const bf16x8* qr, const f32x16& negm, int r32, int hi) {
    const char* kb = Kslot + hi * 1024 + r32 * 16;
#pragma unroll
    for (int d0 = 0; d0 < 4; ++d0) {
        const bf16x8 b0 = *reinterpret_cast<const bf16x8*>(kb + d0 * 2048);
        const bf16x8 b1 = *reinterpret_cast<const bf16x8*>(kb + d0 * 2048 + 512);
        if (d0 == 0) { p0 = __builtin_amdgcn_mfma_f32_32x32x16_bf16(b0, qr[0], negm, 0, 0, 0); p1 = __builtin_amdgcn_mfma_f32_32x32x16_bf16(b1, qr[0], negm, 0, 0, 0); }
        else { p0 = __builtin_amdgcn_mfma_f32_32x32x16_bf16(b0, qr[d0], p0, 0, 0, 0); p1 = __builtin_amdgcn_mfma_f32_32x32x16_bf16(b1, qr[d0], p1, 0, 0, 0); } }
}
typedef __attribute__((address_space(3))) const char* lds_cptr;
typedef short v4i16_t __attribute__((ext_vector_type(4)));
__device__ __forceinline__ void kload8(bf16x8* kf, lds_cptr kp) {
    kf[0] = *(const __attribute__((address_space(3))) bf16x8*)(kp);        kf[1] = *(const __attribute__((address_space(3))) bf16x8*)(kp + 512);
    kf[2] = *(const __attribute__((address_space(3))) bf16x8*)(kp + 2048); kf[3] = *(const __attribute__((address_space(3))) bf16x8*)(kp + 2560);
    kf[4] = *(const __attribute__((address_space(3))) bf16x8*)(kp + 4096); kf[5] = *(const __attribute__((address_space(3))) bf16x8*)(kp + 4608);
    kf[6] = *(const __attribute__((address_space(3))) bf16x8*)(kp + 6144); kf[7] = *(const __attribute__((address_space(3))) bf16x8*)(kp + 6656);
}
__device__ __forceinline__ void kload2(bf16x8* kf, lds_cptr kp, int j) { kf[2 * j] = *(const __attribute__((address_space(3))) bf16x8*)(kp + j * 2048); kf[2 * j + 1] = *(const __attribute__((address_space(3))) bf16x8*)(kp + j * 2048 + 512); }
__device__ __forceinline__ s16x4 vtr(lds_cptr p) { return __builtin_bit_cast(s16x4, __builtin_amdgcn_ds_read_tr16_b64_v4i16((__attribute__((address_space(3))) v4i16_t*)p)); }
__device__ __forceinline__ float rowmax(const f32x16& p0, const f32x16& p1) {
    float a = max3f(p0[0], p0[1], p1[0]), b = max3f(p0[2], p0[3], p1[1]); a = max3f(a, p1[2], p1[3]);
#pragma unroll
    for (int r = 4; r < 16; r += 4) { a = max3f(a, p0[r], p0[r + 1]); b = max3f(b, p0[r + 2], p0[r + 3]); a = max3f(a, p1[r], p1[r + 1]); b = max3f(b, p1[r + 2], p1[r + 3]); }
    const float m = max2f(a, b);
    auto rr = __builtin_amdgcn_permlane32_swap(__float_as_uint(m), __float_as_uint(m), false, false);
    return max2f(__uint_as_float(rr[0]), __uint_as_float(rr[1]));
}
__device__ __forceinline__ void pv(f32x16* o, int vb, bf16x8 pa0, bf16x8 pa1, bf16x8 pa2, bf16x8 pa3) {
#pragma unroll
    for (int d0 = 0; d0 < 2; ++d0) { s16x4 lo[4], hi[4];
#pragma unroll
        for (int ks = 0; ks < 4; ++ks) {
            asm volatile("ds_read_b64_tr_b16 %0,%1 offset:%c2" : "=&v"(lo[ks]) : "v"(vb), "i"(d0 * 4096 + ks * 1024) : "memory");
            asm volatile("ds_read_b64_tr_b16 %0,%1 offset:%c2" : "=&v"(hi[ks]) : "v"(vb), "i"(d0 * 4096 + ks * 1024 + 512) : "memory"); }
        asm volatile("s_waitcnt lgkmcnt(0)" ::: "memory"); SBAR();
#define PK(k) (bf16x8){lo[k][0], lo[k][1], lo[k][2], lo[k][3], hi[k][0], hi[k][1], hi[k][2], hi[k][3]}
        o[d0] = __builtin_amdgcn_mfma_f32_32x32x16_bf16(pa0, PK(0), o[d0], 0, 0, 0);
        o[d0] = __builtin_amdgcn_mfma_f32_32x32x16_bf16(pa1, PK(1), o[d0], 0, 0, 0);
        o[d0] = __builtin_amdgcn_mfma_f32_32x32x16_bf16(pa2, PK(2), o[d0], 0, 0, 0);
        o[d0] = __builtin_amdgcn_mfma_f32_32x32x16_bf16(pa3, PK(3), o[d0], 0, 0, 0);
#undef PK
    }
}
template <int THRL, bool WMASK> __device__ __forceinline__ void attn_unit(const bf16* Qw0, const bf16* __restrict__ Kc, const bf16* __restrict__ Vc, long dlat, int NT, int kd0,
                                                                         bool has_sink, float sinkl2, bf16* Ow0, char* shm, int wid, bool q_rope, const float* q_normg, int tpos0) {
    const int lane = lane_fresh(), r32 = lane & 31, hi = lane >> 5;
    const bf16* Qw = Qw0 + (long)(wid * QBLK) * ZP;
    const unsigned lds0 = (unsigned)(uintptr_t)shm;
    float* wsf = (float*)(shm + LDS_WS) + wid * 64;
    const bf16* ksrc = Kc + (long)lane * ZP + wid * 8;
    const bf16* vsrc = Vc + (long)(16 * (wid & 3) + (lane >> 2)) * ZP + (wid >> 2) * 32 + (lane & 3) * 8;
    const unsigned kdst = lds0 + LDS_K + wid * 1024, vdst = lds0 + LDS_V + wid * 1024;
#define TOFF(t) (((t) < 4) ? (long)(t) * (KVBLK * ZP) : dlat + (long)((t) - 4) * (KVBLK * ZP))
#define DMA_K(t, slot) glds16(ksrc + TOFF(t), (unsigned)__builtin_amdgcn_readfirstlane(kdst + (slot)))
#define DMA_V(t, slot) glds16(vsrc + TOFF(t), (unsigned)__builtin_amdgcn_readfirstlane(vdst + (slot)))
    const int vb0 = (int)(lds0 + LDS_V) + ((lane >> 4) & 1) * 32 + (lane & 3) * 8 + (4 * hi + ((lane & 15) >> 2)) * 64;
    const char* Kbase = shm + LDS_K; bf16x8 kf[8];
    const lds_cptr shm3 = (lds_cptr)shm; const lds_cptr kp0 = shm3 + LDS_K + hi * 1024 + r32 * 16; const lds_cptr vp0 = shm3 + LDS_V + ((lane >> 4) & 1) * 32 + (lane & 3) * 8 + (4 * hi + ((lane & 15) >> 2)) * 64;
    DMA_K(0, 0); DMA_V(0, 0); DMA_K(1, SLOTB);
    bf16x8 qr[4];
#pragma unroll
    for (int d0 = 0; d0 < 4; ++d0) qr[d0] = *reinterpret_cast<const bf16x8*>(&Qw[(long)r32 * ZP + d0 * 16 + hi * 8]);
    {
        float qf[4][8];
#pragma unroll
        for (int d0 = 0; d0 < 4; ++d0)
#pragma unroll
            for (int i = 0; i < 8; ++i) qf[d0][i] = __uint_as_float(((unsigned)(unsigned short)qr[d0][i]) << 16);
        if (q_normg) {
            float ssq = 0.f;
#pragma unroll
            for (int d0 = 0; d0 < 4; ++d0)
#pragma unroll
                for (int i = 0; i < 8; ++i) ssq += qf[d0][i] * qf[d0][i];
            { auto rr = __builtin_amdgcn_permlane32_swap(__float_as_uint(ssq), __float_as_uint(ssq), false, false); ssq = __uint_as_float(rr[0]) + __uint_as_float(rr[1]); }
            const float rstd = __builtin_amdgcn_rsqf(ssq * (1.f / 64.f) + EPS);
#pragma unroll
            for (int d0 = 0; d0 < 4; ++d0)
#pragma unroll
                for (int i = 0; i < 8; ++i) qf[d0][i] *= rstd * q_normg[d0 * 16 + hi * 8 + i];
        }
        if (q_rope) {
            const int t = tpos0 + wid * QBLK + r32;
#pragma unroll
            for (int a = 0; a < 2; ++a) { const float pos = (float)(a ? (t & 63) : (t >> 6));
#pragma unroll
                for (int i = 0; i < 8; ++i) { float r = pos * (__builtin_amdgcn_exp2f(-(float)(hi * 8 + i) * (13.287712379549449f / 16.0f)) * 0.15915494309189535f); r = r - __builtin_floorf(r);
                    const float c = __builtin_amdgcn_cosf(r), sn = __builtin_amdgcn_sinf(r), x1 = qf[2 * a][i], x2 = qf[2 * a + 1][i];
                    qf[2 * a][i] = x1 * c - x2 * sn; qf[2 * a + 1][i] = x2 * c + x1 * sn; } }
        }
#pragma unroll
        for (int d0 = 0; d0 < 4; ++d0) { u32x4 w; w.x = cvtpk_s(qf[d0][0] * C2, qf[d0][1] * C2); w.y = cvtpk_s(qf[d0][2] * C2, qf[d0][3] * C2); w.z = cvtpk_s(qf[d0][4] * C2, qf[d0][5] * C2); w.w = cvtpk_s(qf[d0][6] * C2, qf[d0][7] * C2);
            qr[d0] = __builtin_bit_cast(bf16x8, w); }
    }
    float mhat = 0.f, l_reg = 0.f; f32x16 o[2]; f32x16 negm;
    { float zz = 0.f; asm volatile("" : "+v"(zz));
      _Pragma("unroll") for (int r = 0; r < 16; ++r) { o[0][r] = zz; o[1][r] = zz; negm[r] = zz; } }
    asm volatile("" : "+v"(negm));
    const int qrel = wid * QBLK + r32;
#define CMASK(P0, P1, t) do { if constexpr (WMASK) { if ((t) >= 4) wmask(P0, P1, kd0 + ((t) - 4) * KVBLK - qrel + 4 * hi); } } while (0)
    bool resc = false;
#define START(P0, P1) do { const float rm = rowmax(P0, P1); resc = false; \
    { const float dl = rm; mhat = fadd_s(mhat, dl); \
      _Pragma("unroll") for (int r = 0; r < 16; ++r) { P0[r] = fsub_s(P0[r], dl); P1[r] = fsub_s(P1[r], dl); } \
      _Pragma("unroll") for (int r = 0; r < 16; ++r) negm[r] = -mhat; asm volatile("" : "+v"(negm)); } \
    _Pragma("unroll") for (int r = 0; r < 16; ++r) P0[r] = __builtin_amdgcn_exp2f(P0[r]); } while (0)
#define RESC() do { if (resc) { asm volatile("s_waitcnt lgkmcnt(0)" ::: "memory"); \
      _Pragma("unroll") for (int d_ = 0; d_ < 2; ++d_) _Pragma("unroll") for (int r = 0; r < 16; ++r) o[d_][r] *= wsf[crow(r, hi)]; } } while (0)
    f32x16 pA0, pA1, pB0, pB1;
    int sl_prev = 0, sl_cur = 0, sl_next = SLOTB;
#define ROT() do { sl_prev = sl_cur; sl_cur = sl_next; sl_next = (sl_next == (NSLOT - 1) * SLOTB) ? 0 : sl_next + SLOTB; } while (0)
    DMA_K(2, 2 * SLOTB);
    WAIT_BAR(3);
    qkt(pA0, pA1, Kbase, qr, negm, r32, hi); asm volatile("s_nop 15\n\ts_nop 7" : "+v"(pA0), "+v"(pA1));
    START(pA0, pA1);
    _Pragma("unroll") for (int r = 0; r < 16; ++r) pA1[r] = __builtin_amdgcn_exp2f(pA1[r]);
    WAIT_BAR(0);
    DMA_K(3, 0); DMA_V(1, SLOTB);
    ROT();
    kload8(kf, kp0 + sl_cur);
    WAIT_BAR(2);
    s16x4 vlo[8], vhi[8]; u32x4 pw0, pw1, pw2, pw3;
#define PKW(P, B) cvtpk_s(P[B], P[B + 1])
#define PAF(k) __builtin_bit_cast(bf16x8, pw##k)
#define VFR(i) (bf16x8){vlo[i][0], vlo[i][1], vlo[i][2], vlo[i][3], vhi[i][0], vhi[i][1], vhi[i][2], vhi[i][3]}
#define PIN(x) asm volatile("" : "+v"(x))
#define MX3(a, b, c) __builtin_fmaxf(__builtin_fmaxf((a), (b)), (c))
#define GAPA(MF, A0, A1, A2, A3, W0, W1, PW) do { MF; sacc += A0; sacc += A1; sacc += A2; sacc += A3; PIN(sacc); W0; W1; PIN(PW); SBAR(); } while (0)
#define EX(v) __builtin_amdgcn_exp2f(v)
#define GAPB(MF, X, B) do { MF; X[B] = EX(X[B]); X[B + 1] = EX(X[B + 1]); X[B + 2] = EX(X[B + 2]); X[B + 3] = EX(X[B + 3]); PIN(X); SBAR(); } while (0)
#define VRD(i) do { vlo[i] = vtr(vp_ + (((i) >> 2) * 4096 + ((i) & 3) * 1024)); vhi[i] = vtr(vp_ + (((i) >> 2) * 4096 + ((i) & 3) * 1024 + 512)); } while (0)
#define KRD(G, j) do { if (G) { kload2(kf, kp0 + sl_next, j); SBAR(); } } while (0)
#define STEP(C0, C1, P0, P1, t, GK, GV, GL) do { SBAR(); \
    const lds_cptr vp_ = vp0 + sl_prev; \
    VRD(0); SBAR(); float sacc = (P0[0] + P0[1]); \
    GAPA(C0 = __builtin_amdgcn_mfma_f32_32x32x16_bf16(kf[0], qr[0], negm, 0, 0, 0), P0[2], P0[3], P0[4], P0[5],     pw0[0] = PKW(P0, 0), pw0[1] = PKW(P0, 2), pw0); \
    VRD(4); SBAR(); GAPA(C1 = __builtin_amdgcn_mfma_f32_32x32x16_bf16(kf[1], qr[0], negm, 0, 0, 0), P0[6], P0[7], P0[8], P0[9],     pw0[2] = PKW(P0, 4), pw0[3] = PKW(P0, 6), pw0); \
    VRD(1); SBAR(); GAPA(C0 = __builtin_amdgcn_mfma_f32_32x32x16_bf16(kf[2], qr[1], C0, 0, 0, 0),   P0[10], P0[11], P0[12], P0[13], pw1[0] = PKW(P0, 8), pw1[1] = PKW(P0, 10), pw1); \
    VRD(5); SBAR(); GAPA(C1 = __builtin_amdgcn_mfma_f32_32x32x16_bf16(kf[3], qr[1], C1, 0, 0, 0),   P0[14], P0[15], P1[0], P1[1],   pw1[2] = PKW(P0, 12), pw1[3] = PKW(P0, 14), pw1); \
    VRD(2); SBAR(); GAPA(C0 = __builtin_amdgcn_mfma_f32_32x32x16_bf16(kf[4], qr[2], C0, 0, 0, 0),   P1[2], P1[3], P1[4], P1[5],     pw2[0] = PKW(P1, 0), pw2[1] = PKW(P1, 2), pw2); \
    VRD(6); SBAR(); GAPA(C1 = __builtin_amdgcn_mfma_f32_32x32x16_bf16(kf[5], qr[2], C1, 0, 0, 0),   P1[6], P1[7], P1[8], P1[9],     pw2[2] = PKW(P1, 4), pw2[3] = PKW(P1, 6), pw2); \
    VRD(3); SBAR(); GAPA(C0 = __builtin_amdgcn_mfma_f32_32x32x16_bf16(kf[6], qr[3], C0, 0, 0, 0),   P1[10], P1[11], P1[12], P1[13], pw3[0] = PKW(P1, 8), pw3[1] = PKW(P1, 10), pw3); \
    VRD(7); SBAR(); GAPA(C1 = __builtin_amdgcn_mfma_f32_32x32x16_bf16(kf[7], qr[3], C1, 0, 0, 0),   P1[14], P1[15], 0.f, 0.f,       pw3[2] = PKW(P1, 12), pw3[3] = PKW(P1, 14), pw3); \
    l_reg += sacc; \
    if (GK) { DMA_K((t) + 3, sl_cur); } if (GV) { DMA_V((t) + 1, sl_next); } \
    CMASK(C0, C1, t); \
    { float a = MX3(C0[0], C0[1], C1[0]), b = MX3(C0[2], C0[3], C1[1]); a = MX3(a, C1[2], C1[3]); \
      _Pragma("unroll") for (int r = 4; r < 16; r += 4) { a = MX3(a, C0[r], C0[r + 1]); b = MX3(b, C0[r + 2], C0[r + 3]); a = MX3(a, C1[r], C1[r + 1]); b = MX3(b, C1[r + 2], C1[r + 3]); } \
      float rm = __builtin_fmaxf(a, b); { auto rr = __builtin_amdgcn_permlane32_swap(__float_as_uint(rm), __float_as_uint(rm), false, false); rm = __builtin_fmaxf(__uint_as_float(rr[0]), __uint_as_float(rr[1])); } \
      resc = false; \
      if (__builtin_expect(__any(rm > (float)THRL), 0)) { const float dl = __builtin_fmaxf(rm, 0.f); mhat += dl; \
        _Pragma("unroll") for (int r = 0; r < 16; ++r) { C0[r] -= dl; C1[r] -= dl; } \
        _Pragma("unroll") for (int r = 0; r < 16; ++r) negm[r] = -mhat; asm volatile("" : "+v"(negm)); \
        const float f = __builtin_amdgcn_exp2f(-dl); l_reg *= f; if (hi == 0) wsf[r32] = f; resc = true; } } \
    SBAR(); \
    GAPB(o[0] = __builtin_amdgcn_mfma_f32_32x32x16_bf16(PAF(0), VFR(0), o[0], 0, 0, 0), C0, 0); \
    GAPB(o[1] = __builtin_amdgcn_mfma_f32_32x32x16_bf16(PAF(0), VFR(4), o[1], 0, 0, 0), C0, 4); \
    KRD(GL, 0); GAPB(o[0] = __builtin_amdgcn_mfma_f32_32x32x16_bf16(PAF(1), VFR(1), o[0], 0, 0, 0), C0, 8); \
    KRD(GL, 1); GAPB(o[1] = __builtin_amdgcn_mfma_f32_32x32x16_bf16(PAF(1), VFR(5), o[1], 0, 0, 0), C0, 12); \
    KRD(GL, 2); GAPB(o[0] = __builtin_amdgcn_mfma_f32_32x32x16_bf16(PAF(2), VFR(2), o[0], 0, 0, 0), C1, 0); \
    KRD(GL, 3); GAPB(o[1] = __builtin_amdgcn_mfma_f32_32x32x16_bf16(PAF(2), VFR(6), o[1], 0, 0, 0), C1, 4); \
    GAPB(o[0] = __builtin_amdgcn_mfma_f32_32x32x16_bf16(PAF(3), VFR(3), o[0], 0, 0, 0), C1, 8); \
    GAPB(o[1] = __builtin_amdgcn_mfma_f32_32x32x16_bf16(PAF(3), VFR(7), o[1], 0, 0, 0), C1, 12); \
    } while (0)
    int t = 1;
    for (; t + 5 < NT; t += 2) {
        STEP(pB0, pB1, pA0, pA1, t, true, true, true);     WAIT_BAR(2); RESC(); ROT();
        STEP(pA0, pA1, pB0, pB1, t + 1, true, true, true); WAIT_BAR(2); RESC(); ROT();
    }
#define ENDW(tt) do { if ((tt) + 3 < NT) { WAIT_BAR(2); } else if ((tt) + 2 < NT) { WAIT_BAR(1); } else { WAIT_BAR(0); } } while (0)
    for (; t + 1 < NT; t += 2) {
        STEP(pB0, pB1, pA0, pA1, t, (t + 3 < NT), (t + 1 < NT), (t + 1 < NT));         ENDW(t);     RESC(); ROT();
        STEP(pA0, pA1, pB0, pB1, t + 1, (t + 4 < NT), (t + 2 < NT), (t + 2 < NT));     ENDW(t + 1); RESC(); ROT();
    }
    STEP(pB0, pB1, pA0, pA1, NT - 1, false, false, false); RESC();
    { float sacc = pB0[0] + pB0[1]; _Pragma("unroll") for (int r = 2; r < 16; ++r) sacc += pB0[r]; _Pragma("unroll") for (int r = 0; r < 16; ++r) sacc += pB1[r]; l_reg += sacc;
      pw0 = (u32x4){PKW(pB0, 0), PKW(pB0, 2), PKW(pB0, 4), PKW(pB0, 6)}; pw1 = (u32x4){PKW(pB0, 8), PKW(pB0, 10), PKW(pB0, 12), PKW(pB0, 14)}; pw2 = (u32x4){PKW(pB1, 0), PKW(pB1, 2), PKW(pB1, 4), PKW(pB1, 6)}; pw3 = (u32x4){PKW(pB1, 8), PKW(pB1, 10), PKW(pB1, 12), PKW(pB1, 14)};
      SBAR(); pv(o, vb0 + sl_cur, PAF(0), PAF(1), PAF(2), PAF(3)); }
#undef PKW
#undef PAF
#undef VFR
#undef PIN
#undef MX3
#undef GAPA
#undef GAPB
#undef EX
#undef VRD
#undef KRD
#undef STEP
#undef ENDW
    { auto rr = __builtin_amdgcn_permlane32_swap(__float_as_uint(l_reg), __float_as_uint(l_reg), false, false); l_reg = __uint_as_float(rr[0]) + __uint_as_float(rr[1]); }
    if (has_sink) l_reg += __builtin_amdgcn_exp2f(sinkl2 - mhat);
    if (hi == 0) wsf[32 + r32] = l_reg; asm volatile("s_waitcnt lgkmcnt(0)" ::: "memory");
    float rli[16];
#pragma unroll
    for (int r = 0; r < 16; ++r) rli[r] = __builtin_amdgcn_rcpf(wsf[32 + crow(r, hi)]);
    bf16* Ow = Ow0 + (long)(wid * QBLK) * YP;
    { bf16* stg = (bf16*)(shm + LDS_OST) + wid * 2048;
#pragma unroll
      for (int r = 0; r < 16; ++r) { const int orow = crow(r, hi);
#pragma unroll
        for (int d0 = 0; d0 < 2; ++d0) stg[orow * 64 + d0 * 32 + r32] = __float2bfloat16(o[d0][r] * rli[r]); }
      asm volatile("s_waitcnt lgkmcnt(0)" ::: "memory");
#pragma unroll
      for (int i = 0; i < 4; ++i) { const int row = i * 8 + (lane >> 3), ch = lane & 7; const u32x4 v = *(const u32x4*)(stg + row * 64 + ch * 8); *(u32x4*)(Ow + (long)row * YP + ch * 8) = v; } }
    asm volatile("s_waitcnt lgkmcnt(0)\n\ts_barrier" ::: "memory");
#undef DMA_K
#undef DMA_V
#undef TOFF
#undef CMASK
#undef START
#undef RESC
#undef ROT
}
constexpr int ATTN_LDS_BYTES = LDS_BYTES;
#undef SBAR
#undef WAIT_BAR
}

constexpr int NWAVES = 8, NTHREADS = NWAVES * 64;
constexpr int RING_BYTES = 131072, LDS_BYTES = 147456;
constexpr int LDSCTL_OFF = RING_BYTES, MISC_OFF = LDSCTL_OFF + 320;
#define LAS __attribute__((address_space(3)))
typedef unsigned short bf16;
typedef unsigned v4u __attribute__((ext_vector_type(4)));
typedef unsigned v2u __attribute__((ext_vector_type(2)));
typedef float f32x4 __attribute__((ext_vector_type(4)));
using pg8::cvt_pk_bf16; using pg8::bf_lo; using pg8::bf_hi;

constexpr size_t MiB = 1u << 20;
constexpr size_t WS_MOD = 0;
constexpr size_t WS_CTL = 1 * MiB, CTL_ZERO_BYTES = 16384;
constexpr size_t WS_W = 2 * MiB;
constexpr size_t LW_IN = 0;
constexpr size_t LW_POOL = LW_IN + (size_t)5120 * 1024 * 2;
constexpr size_t LW_BR = LW_POOL + (size_t)512 * 256 * 2;
constexpr size_t LW_OUT = LW_BR + (size_t)3072 * 512 * 2;
constexpr size_t LW_FF = LW_OUT + (size_t)1024 * 1024 * 2;
constexpr size_t LW_DN = LW_FF + (size_t)5632 * 1024 * 2;
constexpr size_t LW_BYTES = LW_DN + (size_t)1024 * 2816 * 2;
constexpr size_t WS_XC = WS_W + ((2 * LW_BYTES + MiB - 1) / MiB) * MiB;
constexpr size_t WS_ARENA = WS_XC + (size_t)NCTX * 1024 * 4;
constexpr size_t AR_Z = 0, AR_G = (size_t)NTOK * ZP * 2, AR_Y = AR_G + (size_t)NTOK * GP * 2, AR_H = AR_Y;
constexpr size_t AR_MRG = AR_Z;
constexpr size_t AR_U = 0, AR_SIDE = (size_t)NTOK * FF * 2, SIDE_BYTES = (size_t)(NTOK / 32) * FF * 4, AR_H2 = (size_t)NTOK * AVP * 2;
constexpr size_t AR_XF = ((AR_SIDE + 3 * SIDE_BYTES + 4095) / 4096) * 4096;
static_assert(AR_XF + (size_t)NLAT * 1024 * 4 <= AR_H2, "side buffers + XF");
constexpr size_t WS_END = WS_ARENA + (size_t)NTOK * 6656 * 2;
static_assert(AR_Y + (size_t)NTOK * YP * 2 == (size_t)NTOK * 6656 * 2 && AR_H2 + (size_t)NTOK * 1024 * 2 == (size_t)NTOK * 6656 * 2, "arena views");


#define XB_TMO      128
#define XB_XCNT(j)  (256  + 64 * (j))
#define XB_XSUB(j)  (1280 + 64 * (j))
#define XB_XGEN(j)  (2304 + 64 * (j))
#define XB_TOP      3328
#define XB_TOPGEN   3392
#define XCD_BAR_WORDS 3456
#define XB_SPIN_CAP (1u << 20)
__device__ __forceinline__ unsigned xb_ld(unsigned* p)              { return __hip_atomic_load(p, __ATOMIC_RELAXED, __HIP_MEMORY_SCOPE_AGENT); }
__device__ __forceinline__ unsigned xb_add(unsigned* p, unsigned v) { return __hip_atomic_fetch_add(p, v, __ATOMIC_RELAXED, __HIP_MEMORY_SCOPE_AGENT); }
__device__ __forceinline__ unsigned xb_xcc_id() { return (unsigned)__builtin_amdgcn_s_getreg((3 << 11) | 20) & 0xFu; }
#define XB_SPIN(cond, bar) do { unsigned _sp = 0; while (cond) { __builtin_amdgcn_s_sleep(1); \
    if ((++_sp & 255u) == 0u) { if (xb_ld(&(bar)[XB_TMO])) break; if (_sp > XB_SPIN_CAP) { atomicAdd(&(bar)[XB_TMO], 1u); break; } } } } while (0)
struct XcdBarrier { unsigned* bar; unsigned x; volatile LAS unsigned* st; };
__device__ __forceinline__ XcdBarrier xcd_barrier_post(unsigned* bar, volatile LAS unsigned* st) {
    XcdBarrier b; b.bar = bar; b.x = xb_xcc_id(); b.st = st;
    if (threadIdx.x == 0) (void)xb_add(&bar[XB_XCNT(b.x)], 1u);
    return b;
}
__device__ __forceinline__ void xcd_barrier_complete(unsigned* bar, unsigned x, unsigned& nloc, unsigned& nx) {
    const unsigned G = gridDim.x * gridDim.y * gridDim.z;
    unsigned sum, cnt, mine, sp = 0u;
    for (;;) {
        sum = 0u; cnt = 0u; mine = 0u;
#pragma unroll
        for (unsigned j = 0; j < 16; ++j) { const unsigned c = xb_ld(&bar[XB_XCNT(j)]); sum += c; cnt += (c > 0u) ? 1u : 0u; mine = (j == x) ? c : mine; }
        if (sum == G) break;
        __builtin_amdgcn_s_sleep(1);
        if ((++sp & 255u) == 0u) { if (xb_ld(&bar[XB_TMO])) break; if (sp > XB_SPIN_CAP) { atomicAdd(&bar[XB_TMO], 1u); break; } }
    }
    nloc = mine > 0u ? mine : 1u; nx = cnt > 0u ? cnt : 1u;
}
__device__ __forceinline__ void xcd_barrier(const XcdBarrier& b, int wave) {
    asm volatile("s_waitcnt vmcnt(0)" ::: "memory");
    __syncthreads();
    if (wave == 0 && lane_fresh() == 0) {
        unsigned* bar = b.bar;
        __builtin_amdgcn_s_waitcnt(0);
        unsigned nloc = b.st[0], nx = b.st[1];
        if (nloc == 0u) { xcd_barrier_complete(bar, b.x, nloc, nx); b.st[0] = nloc; b.st[1] = nx; }
        const unsigned old = xb_add(&bar[XB_XSUB(b.x)], 1u);
        const unsigned gen = old / nloc;
        if (old + 1u == (gen + 1u) * nloc) {
            __builtin_amdgcn_fence(__ATOMIC_RELEASE, "agent");
            asm volatile("s_waitcnt vmcnt(0)" ::: "memory");
            const unsigned og = xb_add(&bar[XB_TOP], 1u);
            const unsigned tg = og / nx;
            if (og + 1u == (tg + 1u) * nx) xb_add(&bar[XB_TOPGEN], 1u);
            else XB_SPIN(xb_ld(&bar[XB_TOPGEN]) == tg, bar);
            __builtin_amdgcn_fence(__ATOMIC_ACQUIRE, "agent");
            xb_add(&bar[XB_XGEN(b.x)], 1u);
            asm volatile("s_waitcnt vmcnt(0)" ::: "memory");
        } else {
            XB_SPIN(xb_ld(&bar[XB_XGEN(b.x)]) == gen, bar);
            __builtin_amdgcn_fence(__ATOMIC_ACQUIRE, "agent");
            asm volatile("s_waitcnt vmcnt(0)" ::: "memory");
        }
    }
    __syncthreads();
}

struct Args {
    const float *x, *c, *ctx, *c_ctx, *w_mod, *b_mod, *norm1_g, *norm2_g, *w_in, *w_pool_grp, *pool_scale, *win_sink, *q_norm_g, *k_norm_g,
                *w_branch, *w_gate, *b_gate, *w_out, *w_ff_gate, *w_ff_val, *conv_w, *conv_b, *w_ff_down, *final_g;
    float* out; unsigned char* ws; int ph_lo, ph_hi;
};

__device__ __forceinline__ float shx(float v, int lane, int m) { return __int_as_float(__builtin_amdgcn_ds_bpermute((lane ^ m) << 2, __float_as_int(v))); }
__device__ __forceinline__ float wave_sum(float v, int lane) {
#pragma unroll
    for (int o = 1; o < 64; o <<= 1) v += shx(v, lane, o);
    return v;
}
__device__ __forceinline__ void transpose_item(const float* W, int K, int N, bf16* WT, int ldw, int row_off, LAS float* scr, int item, int lane, bool spread = false) {
    const int nblk = N / 32, kb = item / nblk, nb = item % nblk, k0 = 64 * kb, n0 = 32 * nb;
    if (spread) row_off += 128 * (n0 >> 7);
#pragma unroll 8
    for (int i = 0; i < 32; ++i) { const int kk = 2 * i + (lane >> 5); scr[kk * 33 + (lane & 31)] = W[(size_t)(k0 + kk) * N + n0 + (lane & 31)]; }
    asm volatile("s_waitcnt lgkmcnt(0)" ::: "memory");
    const int c = lane & 7;
#pragma unroll
    for (int j = 0; j < 4; ++j) { const int n = (lane >> 3) + 8 * j; const LAS float* s = scr + (8 * c) * 33 + n;
        v4u o; o.x = cvt_pk_bf16(s[0 * 33], s[1 * 33]); o.y = cvt_pk_bf16(s[2 * 33], s[3 * 33]); o.z = cvt_pk_bf16(s[4 * 33], s[5 * 33]); o.w = cvt_pk_bf16(s[6 * 33], s[7 * 33]);
        *(v4u*)(WT + (size_t)(row_off + n0 + n) * ldw + k0 + 8 * c) = o; }
    asm volatile("s_waitcnt lgkmcnt(0)" ::: "memory");
}

__device__ __forceinline__ void prologue(const Args& A, LAS unsigned char* lds, int G, int vcu, int tid, int lane, int wave) {
    float* mod = (float*)(A.ws + WS_MOD);
    if ((int)blockIdx.x < 192) {
        LAS float* S = (LAS float*)lds; LAS float* part = (LAS float*)(lds + 17 * 1024 * 4);
        for (int idx = tid; idx < 17 * 1024; idx += NTHREADS) { const int r = idx >> 10, k = idx & 1023; const float v = (r < 16) ? A.c[r * 1024 + k] : A.c_ctx[k];
            S[idx] = v / (1.0f + __builtin_amdgcn_exp2f(-v * LOG2E)); }
        __syncthreads();
        for (int u = blockIdx.x; u < 192; u += G) {
            const int l = u / 96, n0 = (u % 96) * 64;
            float acc[17];
#pragma unroll
            for (int r = 0; r < 17; ++r) acc[r] = 0.f;
            const float* W = A.w_mod + (size_t)l * 1024 * 6144 + n0 + lane;
#pragma unroll 16
            for (int kk = 0; kk < 128; ++kk) { const int k = kk * 8 + wave; const float w = W[(size_t)k * 6144];
#pragma unroll
                for (int r = 0; r < 17; ++r) acc[r] += S[r * 1024 + k] * w; }
#pragma unroll
            for (int r = 0; r < 17; ++r) part[(wave * 17 + r) * 64 + lane] = acc[r];
            __syncthreads();
            for (int idx = tid; idx < 17 * 64; idx += NTHREADS) { const int r = idx >> 6, j = idx & 63; float s = 0.f;
#pragma unroll
                for (int w = 0; w < 8; ++w) s += part[(w * 17 + r) * 64 + j];
                mod[(size_t)(l * 17 + r) * 6144 + n0 + j] = s + A.b_mod[l * 6144 + n0 + j]; }
            __syncthreads();
        }
    }
    __syncthreads();
    LAS float* scr = (LAS float*)(lds + wave * 16384);
    const int gw = vcu * NWAVES + wave, NGW = G * NWAVES;
    constexpr int I_IN = 16 * 64, I_GATE = 16 * 32, I_BR = 8 * 32, I_OUT = 16 * 32, I_FF = 16 * 88, I_DN = 44 * 32;
    constexpr int PER_LAYER = I_IN + 3 * I_GATE + 2 * I_BR + I_OUT + 2 * I_FF + I_DN;
    for (int it = gw; it < 2 * PER_LAYER; it += NGW) {
        const int l = it / PER_LAYER; int r = it % PER_LAYER;
        unsigned char* wl = A.ws + WS_W + (size_t)l * LW_BYTES;
        if (r < I_IN) { transpose_item(A.w_in + (size_t)l * 1024 * 2048, 1024, 2048, (bf16*)(wl + LW_IN), 1024, 0, scr, r, lane); continue; } r -= I_IN;
        if (r < 3 * I_GATE) { const int i = r / I_GATE; transpose_item(A.w_gate + ((size_t)l * 3 + i) * 1024 * 1024, 1024, 1024, (bf16*)(wl + LW_IN), 1024, 2048 + i * 1024, scr, r % I_GATE, lane); continue; } r -= 3 * I_GATE;
        if (r < 2 * I_BR) { const int i = 1 + r / I_BR; transpose_item(A.w_branch + ((size_t)l * 3 + i) * 512 * 1024, 512, 1024, (bf16*)(wl + LW_BR), 512, i * 1024, scr, r % I_BR, lane); continue; } r -= 2 * I_BR;
        if (r < I_OUT) { transpose_item(A.w_out + (size_t)l * 1024 * 1024, 1024, 1024, (bf16*)(wl + LW_OUT), 1024, 0, scr, r, lane); continue; } r -= I_OUT;
        if (r < I_FF) { transpose_item(A.w_ff_gate + (size_t)l * 1024 * FF, 1024, FF, (bf16*)(wl + LW_FF), 1024, 0, scr, r, lane, true); continue; } r -= I_FF;
        if (r < I_FF) { transpose_item(A.w_ff_val + (size_t)l * 1024 * FF, 1024, FF, (bf16*)(wl + LW_FF), 1024, 128, scr, r, lane, true); continue; } r -= I_FF;
        transpose_item(A.w_ff_down + (size_t)l * FF * 1024, FF, 1024, (bf16*)(wl + LW_DN), FF, 0, scr, r, lane);
    }
}

__device__ __forceinline__ void weff_phase(const Args& A, int gw, int NGW) {
    const int lane = lane_fresh(); asm volatile("" : "+s"(gw));
    for (int task = gw; task < 2 * 4 * 16 * 8; task += NGW) {
        const int l = task >> 9, r = task & 511, g = r >> 7, nb = (r >> 3) & 15, cb = r & 7, n = nb * 64 + lane, c0 = cb * 16;
        const float* wg = A.w_pool_grp + (((size_t)l * 4 + g) * 128 + c0) * 128;
        const float* wb = A.w_branch + ((size_t)l * 3 * 512 + g * 128) * 1024 + n;
        const float* ps = A.pool_scale + (size_t)l * 512 + g * 128;
        float acc[16];
#pragma unroll
        for (int cc = 0; cc < 16; ++cc) acc[cc] = 0.f;
#pragma unroll 4
        for (int d = 0; d < 128; ++d) { const float x = wb[(size_t)d * 1024] * ps[d];
#pragma unroll
            for (int cc = 0; cc < 16; ++cc) acc[cc] += wg[cc * 128 + d] * x; }
        bf16* dst = (bf16*)(A.ws + WS_W + (size_t)l * LW_BYTES + LW_BR) + (size_t)n * 512 + g * 128 + c0;
        v4u w0, w1; w0.x = cvt_pk_bf16(acc[0], acc[1]); w0.y = cvt_pk_bf16(acc[2], acc[3]); w0.z = cvt_pk_bf16(acc[4], acc[5]); w0.w = cvt_pk_bf16(acc[6], acc[7]);
        w1.x = cvt_pk_bf16(acc[8], acc[9]); w1.y = cvt_pk_bf16(acc[10], acc[11]); w1.z = cvt_pk_bf16(acc[12], acc[13]); w1.w = cvt_pk_bf16(acc[14], acc[15]);
        *(v4u*)dst = w0; *(v4u*)(dst + 8) = w1;
    }
}

template <bool SRC_BF16>
__device__ __forceinline__ void norm_rows(const void* xlat, const void* xctx, const float* gvec, const float* modl, int which, int nrows, bf16* H, int gw, int NGW) {
    const int lane = lane_fresh(); asm volatile("" : "+s"(gw));
    constexpr int R = 4;
    for (int row0 = gw * R; row0 < nrows; row0 += NGW * R) {
        const bool lat = row0 < NLAT;
        const size_t roff = lat ? (size_t)row0 * 1024 : (size_t)(row0 - NLAT) * 1024;
        const void* srcb = lat ? xlat : xctx;
        const int b = lat ? (row0 >> 12) : NB;
        const float* shp = modl + (size_t)(b * 6 + which * 3) * 1024; const float* scp = shp + 1024;
        float v[R][2][8]; float ss[R];
#pragma unroll
        for (int r = 0; r < R; ++r)
#pragma unroll
            for (int j = 0; j < 2; ++j) { const size_t o = roff + (size_t)r * 1024 + 8 * lane + 512 * j;
                if constexpr (SRC_BF16) { const v4u w = *(const v4u*)((const bf16*)srcb + o);
                    v[r][j][0] = bf_lo(w.x); v[r][j][1] = bf_hi(w.x); v[r][j][2] = bf_lo(w.y); v[r][j][3] = bf_hi(w.y); v[r][j][4] = bf_lo(w.z); v[r][j][5] = bf_hi(w.z); v[r][j][6] = bf_lo(w.w); v[r][j][7] = bf_hi(w.w); }
                else { const f32x4 a = *(const f32x4*)((const float*)srcb + o), c = *(const f32x4*)((const float*)srcb + o + 4);
                    v[r][j][0] = a.x; v[r][j][1] = a.y; v[r][j][2] = a.z; v[r][j][3] = a.w; v[r][j][4] = c.x; v[r][j][5] = c.y; v[r][j][6] = c.z; v[r][j][7] = c.w; } }
#pragma unroll
        for (int r = 0; r < R; ++r) { float s = 0.f;
#pragma unroll
            for (int j = 0; j < 2; ++j)
#pragma unroll
                for (int i = 0; i < 8; ++i) s += v[r][j][i] * v[r][j][i];
            ss[r] = s; }
#pragma unroll
        for (int o = 1; o < 64; o <<= 1)
#pragma unroll
            for (int r = 0; r < R; ++r) ss[r] += shx(ss[r], lane, o);
#pragma unroll
        for (int j = 0; j < 2; ++j) { const int c0 = 8 * lane + 512 * j; float gm[8], sh[8];
#pragma unroll
            for (int h = 0; h < 2; ++h) { const f32x4 g = *(const f32x4*)(gvec + c0 + 4 * h), s4 = *(const f32x4*)(shp + c0 + 4 * h), sc = *(const f32x4*)(scp + c0 + 4 * h);
#pragma unroll
                for (int e = 0; e < 4; ++e) { gm[4 * h + e] = g[e] * (sc[e] + 1.0f); sh[4 * h + e] = s4[e]; } }
#pragma unroll
            for (int r = 0; r < R; ++r) { const float rstd = __builtin_amdgcn_rsqf(ss[r] * (1.f / 1024.f) + EPS); float y[8];
#pragma unroll
                for (int i = 0; i < 8; ++i) y[i] = (v[r][j][i] * rstd) * gm[i] + sh[i];
                v4u w; w.x = cvt_pk_bf16(y[0], y[1]); w.y = cvt_pk_bf16(y[2], y[3]); w.z = cvt_pk_bf16(y[4], y[5]); w.w = cvt_pk_bf16(y[6], y[7]);
                *(v4u*)(H + (size_t)(row0 + r) * 1024 + c0) = w; } }
    }
}
__device__ __forceinline__ void final_norm_rows(const float* x, float* out, const float* gvec, int gw, int NGW) {
    const int lane = lane_fresh(); asm volatile("" : "+s"(gw));
    constexpr int R = 4;
    for (int row0 = gw * R; row0 < NLAT; row0 += NGW * R) {
        f32x4 v[R][4]; float ss[R];
#pragma unroll
        for (int r = 0; r < R; ++r)
#pragma unroll
            for (int j = 0; j < 4; ++j) v[r][j] = *(const f32x4*)(x + (size_t)(row0 + r) * 1024 + 4 * lane + 256 * j);
#pragma unroll
        for (int r = 0; r < R; ++r) { float s = 0.f;
#pragma unroll
            for (int j = 0; j < 4; ++j) s += (v[r][j].x * v[r][j].x + v[r][j].y * v[r][j].y) + (v[r][j].z * v[r][j].z + v[r][j].w * v[r][j].w);
            ss[r] = s; }
#pragma unroll
        for (int o = 1; o < 64; o <<= 1)
#pragma unroll
            for (int r = 0; r < R; ++r) ss[r] += shx(ss[r], lane, o);
#pragma unroll
        for (int j = 0; j < 4; ++j) { const int c0 = 4 * lane + 256 * j; const f32x4 g = *(const f32x4*)(gvec + c0);
#pragma unroll
            for (int r = 0; r < R; ++r) { const float rstd = __builtin_amdgcn_rsqf(ss[r] * (1.f / 1024.f) + EPS); *(f32x4*)(out + (size_t)(row0 + r) * 1024 + c0) = v[r][j] * rstd * g; } }
    }
}

__device__ __forceinline__ void unpack8(const v4u w, float* v) { v[0] = bf_lo(w.x); v[1] = bf_hi(w.x); v[2] = bf_lo(w.y); v[3] = bf_hi(w.y); v[4] = bf_lo(w.z); v[5] = bf_hi(w.z); v[6] = bf_lo(w.w); v[7] = bf_hi(w.w); }
__device__ __forceinline__ v4u pack8(const float* v) { v4u w; w.x = cvt_pk_bf16(v[0], v[1]); w.y = cvt_pk_bf16(v[2], v[3]); w.z = cvt_pk_bf16(v[4], v[5]); w.w = cvt_pk_bf16(v[6], v[7]); return w; }
__device__ __forceinline__ void qk_proc(float* v, bool do_norm, const float* g, bool do_rope, bool hi_half, const float* cs, const float* sn, float scale, int lane) {
    float ss = 0.f;
#pragma unroll
    for (int i = 0; i < 8; ++i) ss += v[i] * v[i];
    ss += shx(ss, lane, 1); ss += shx(ss, lane, 2); ss += shx(ss, lane, 4);
    const float rstd = __builtin_amdgcn_rsqf(ss * (1.f / 64.f) + EPS);
#pragma unroll
    for (int i = 0; i < 8; ++i) { const float nv = v[i] * rstd * g[i]; v[i] = do_norm ? nv : v[i]; }
#pragma unroll
    for (int i = 0; i < 8; ++i) { const float pvv = shx(v[i], lane, 2);
        const float rv = hi_half ? (v[i] * cs[i] + pvv * sn[i]) : (v[i] * cs[i] - pvv * sn[i]);
        v[i] = (do_rope ? rv : v[i]) * scale; }
}
template <int W2> __device__ __forceinline__ void pool_quad(const bf16* __restrict__ Z, bf16* __restrict__ Y, int row, int t, int L, int ch) {
    int lo = t - W2; lo = lo < 0 ? 0 : lo; int hi = t + W2; hi = hi > L ? L : hi;
    const bf16* zc = Z + (size_t)(row - t) * ZP + ch;
    const v4u zero = {0u, 0u, 0u, 0u};
    v4u pw[2 * W2];
#pragma unroll
    for (int jj = 0; jj < 2 * W2; ++jj) { const int r = lo + jj; pw[jj] = (r < hi) ? *(const v4u*)(zc + (size_t)r * ZP) : zero; }
    const v4u own_w = *(const v4u*)(zc + (size_t)t * ZP);
    float acc[8];
#pragma unroll
    for (int i = 0; i < 8; ++i) acc[i] = 0.f;
#pragma unroll
    for (int jj = 0; jj < 2 * W2; ++jj) { float u[8]; unpack8(pw[jj], u);
#pragma unroll
        for (int i = 0; i < 8; ++i) acc[i] += u[i]; }
    float own[8]; unpack8(own_w, own); const float rc = 1.0f / (float)(hi - lo);
#pragma unroll
    for (int i = 0; i < 8; ++i) acc[i] = acc[i] * rc - own[i];
    *(v4u*)(Y + (size_t)row * YP + ch) = pack8(acc);
}
__device__ __forceinline__ void elem_phase(const Args& A, int layer, int nrows, int nrows_pool, bf16* Z, bf16* Y, int gw, int NGW) {
    const int lane = lane_fresh(); asm volatile("" : "+s"(gw));
    for (int q = gw; q < nrows_pool / 4; q += NGW) {
        const int row = 4 * q + (lane >> 4), c16 = (lane & 15) * 8;
        const bool lat = row < NLAT;
        const int t = lat ? (row & (SEQ - 1)) : ((row - NLAT) & (CTX - 1));
        const int L = lat ? SEQ : CTX;
        pool_quad<8>(Z, Y, row, t, L, 384 + c16);
        pool_quad<4>(Z, Y, row, t, L, 256 + c16);
        pool_quad<2>(Z, Y, row, t, L, 128 + c16);
        pool_quad<1>(Z, Y, row, t, L, c16);
    }
    const int j8 = lane & 7; const bool hi_half = (j8 >> 1) & 1; const int axis = j8 >> 2, fbase = (j8 & 1) * 8;
    float inv[8], kg[8];
#pragma unroll
    for (int i = 0; i < 8; ++i) { inv[i] = __builtin_amdgcn_exp2f(-(float)(fbase + i) * (13.287712379549449f / 16.0f)) * 0.15915494309189535f;
        kg[i] = A.k_norm_g[layer * 64 + j8 * 8 + i]; }
    for (int p = gw; p < nrows / 2; p += NGW) {
        const int row = 2 * p + (lane >> 5);
        const bool lat = row < NLAT;
        const int t = lat ? (row & (SEQ - 1)) : ((row - NLAT) & (CTX - 1));
        bf16* zrow = Z + (size_t)row * ZP;
        const int l5 = lane & 31; const bool isg = l5 >= 16; const int kcol = isg ? 1792 + (l5 - 16) * 8 : 1024 + l5 * 8;
        const v4u k_w = *(const v4u*)(zrow + kcol);
        float cs[8], sn[8];
        { const float pos = (float)(axis ? (t & 63) : (t >> 6));
#pragma unroll
          for (int i = 0; i < 8; ++i) { float r = pos * inv[i]; r = r - __builtin_floorf(r); cs[i] = __builtin_amdgcn_cosf(r); sn[i] = __builtin_amdgcn_sinf(r); } }
        float vk[8];
        unpack8(k_w, vk); qk_proc(vk, isg, kg, lat, hi_half, cs, sn, 1.0f, lane);
        *(v4u*)(zrow + kcol) = pack8(vk);
    }
}

__device__ __forceinline__ void fixup_phase(const Args& A, int layer, int nrows, bf16* U, const float* As, const float* PAs, const float* Vs, int gbase, int NT) {
    const int gtid = gbase + lane_fresh();
    const int items = (nrows / 32) * 352;
    const float* cw = A.conv_w + (size_t)layer * 3 * FF;
    for (int it = gtid; it < items; it += NT) {
        const int c8 = it % 352, brow = it / 352, side = brow & 1, col = c8 * 8;
        const int r = (brow >> 1) * 64 + (side ? 63 : 0);
        const bool lat = r < NLAT; const int L = lat ? SEQ : CTX; const int t = lat ? (r & (SEQ - 1)) : ((r - NLAT) & (CTX - 1));
        const bool has = side ? (t != L - 1) : (t != 0);
        const int nb = has ? (side ? brow + 1 : brow - 1) : brow;
        const float* wp = cw + (side ? 2 * FF : 0) + col;
        const size_t so = (size_t)brow * FF + col, sn = (size_t)nb * FF + col;
        float o[8];
#pragma unroll
        for (int h = 0; h < 2; ++h) { const f32x4 pa = *(const f32x4*)(PAs + so + 4 * h), vv = *(const f32x4*)(Vs + so + 4 * h), an = *(const f32x4*)(As + sn + 4 * h), w = *(const f32x4*)(wp + 4 * h);
#pragma unroll
            for (int e = 0; e < 4; ++e) { const float pre = pa[e] + (has ? w[e] * an[e] : 0.f); o[4 * h + e] = pre * pg8::sigmoidf_(pre) * vv[e]; } }
        *(v4u*)(U + (size_t)r * FF + col) = pack8(o);
    }
}

__device__ __forceinline__ void attention_phase(const Args& A, int layer, bool last, bf16* Z, bf16* Y, char* shm, int G, int vcu, int wave) {
    using abf = attn_body::bf16;
    asm volatile("" : "+s"(vcu), "+s"(G));
    const float* sink = A.win_sink + layer * 8;
    const int NU = NB * 8 * 16, per = (NU + G - 1) / G;
    int u0 = vcu * per, u1 = u0 + per; if (u1 > NU) u1 = NU;
    for (int u = u0; u < u1; ++u) {
        const int qb = u & 15, h = (u >> 4) & 7, b = u >> 7, kvh = h >> 2;
        const size_t qrow = (size_t)b * SEQ + qb * 256, crow0 = (size_t)NLAT + (size_t)b * CTX;
        const abf* Q = (const abf*)Z + qrow * ZP + 1280 + h * 64;
        const abf* Kc = (const abf*)Z + crow0 * ZP + 1792 + kvh * 64; const abf* Vc = (const abf*)Z + crow0 * ZP + 1920 + kvh * 64;
        const long dlat = ((long)b * SEQ - (long)crow0) * ZP;
        attn_body::attn_unit<8, false>(Q, Kc, Vc, dlat, 68, 0, false, 0.f, (abf*)Y + qrow * YP + 1024 + h * 64, shm, wave, true, A.q_norm_g + layer * 64, qb * 256);
    }
    for (int u = u0; u < u1; ++u) {
        const int qb = u & 15, h = (u >> 4) & 7, b = u >> 7, kvh = h >> 2;
        const size_t qrow = (size_t)b * SEQ + qb * 256, crow0 = (size_t)NLAT + (size_t)b * CTX;
        int tl0 = 4 * qb - 2; tl0 = tl0 < 0 ? 0 : tl0; int tl1 = 4 * qb + 6; tl1 = tl1 > 64 ? 64 : tl1;
        const abf* Q = (const abf*)Z + qrow * ZP + 512 + h * 64;
        const abf* Kc = (const abf*)Z + crow0 * ZP + 1024 + kvh * 64; const abf* Vc = (const abf*)Z + crow0 * ZP + 1152 + kvh * 64;
        const long dlat = ((long)b * SEQ + tl0 * 64 - (long)crow0) * ZP;
        attn_body::attn_unit<8, true>(Q, Kc, Vc, dlat, 4 + (tl1 - tl0), tl0 * 64 - qb * 256, true, sink[h] * LOG2E, (abf*)Y + qrow * YP + 512 + h * 64, shm, wave, true, nullptr, qb * 256);
    }
    if (!last) {
        const int NUC = 2 * NB * 8;
        for (int u = vcu; u < NUC; u += G) {
            const int mixer = u & 1, h = (u >> 1) & 7, b = u >> 4, kvh = h >> 2;
            const size_t crow0 = (size_t)NLAT + (size_t)b * CTX;
            const int qc = mixer ? 1280 : 512, kc = mixer ? 1792 : 1024, vc = mixer ? 1920 : 1152, oc = mixer ? 1024 : 512;
            attn_body::attn_unit<8, false>((const abf*)Z + crow0 * ZP + qc + h * 64, (const abf*)Z + crow0 * ZP + kc + kvh * 64, (const abf*)Z + crow0 * ZP + vc + kvh * 64, 0, 4, 0,
                                           mixer == 0, sink[h] * LOG2E, (abf*)Y + crow0 * YP + oc + h * 64, shm, wave, false, mixer ? A.q_norm_g + layer * 64 : nullptr, 0);
        }
    }
}

__global__ void __launch_bounds__(NTHREADS, 2) fwd_megakernel(Args A) {
    extern __shared__ __attribute__((aligned(16))) unsigned char lds_raw[];
    LAS unsigned char* lds = (LAS unsigned char*)lds_raw;
    const int wave = __builtin_amdgcn_readfirstlane(threadIdx.x >> 6);
    const int G = gridDim.x; const int bx = blockIdx.x; const int vcu = (G % 8 == 0) ? (bx % 8) * (G / 8) + bx / 8 : bx;
    const int gw = vcu * NWAVES + wave, NGW = G * NWAVES;
    const int lo = A.ph_lo, hi = A.ph_hi;
    int ph = 0;
#if MK_SPLIT
#define SEAM() do { ++ph; } while (0)
#else
    cg::grid_group grid = cg::this_grid();
    for (int u = threadIdx.x; u < (LDS_BYTES - LDSCTL_OFF) / 4; u += NTHREADS) ((LAS unsigned*)(lds + LDSCTL_OFF))[u] = 0u;
    __syncthreads();
    XcdBarrier bar = xcd_barrier_post((unsigned*)(A.ws + WS_CTL), (volatile LAS unsigned*)(lds + MISC_OFF) + 8);
#define SEAM() do { if (ph == 0) grid.sync(); else xcd_barrier(bar, wave); ++ph; } while (0)
#endif
#define IN() (lo <= ph && ph < hi)
    unsigned char* ws = A.ws;
    float* mod = (float*)(ws + WS_MOD);
    bf16* XB = (bf16*)A.out;
    bf16* XCB = (bf16*)(ws + WS_XC);
    unsigned char* ar = ws + WS_ARENA;
    bf16* Z = (bf16*)(ar + AR_Z); bf16* Gt = (bf16*)(ar + AR_G); bf16* Y = (bf16*)(ar + AR_Y); bf16* H = (bf16*)(ar + AR_H);
    bf16* Mrg = (bf16*)(ar + AR_MRG); bf16* U = (bf16*)(ar + AR_U); bf16* H2 = (bf16*)(ar + AR_H2);
    float* XF = (float*)(ar + AR_XF); float* SAs = (float*)(ar + AR_SIDE); float* SPA = (float*)(ar + AR_SIDE + SIDE_BYTES); float* SVs = (float*)(ar + AR_SIDE + 2 * SIDE_BYTES);

    if (IN()) for (int rep = 0; rep < ((DUP_MASK & 32) ? 2 : 1); ++rep) { const int lane = lane_fresh(); prologue(A, lds, G, vcu, wave * 64 + lane, lane, wave); __syncthreads(); }
    SEAM();
    for (int l = 0; l < 2; ++l) {
        const bool last = (l == 1);
        const int nrows_mix = NTOK, nrows_x = last ? NLAT : NTOK;
        const int nM_mix = nrows_mix / 256, nM_x = nrows_x / 256;
        const float* modl = mod + (size_t)l * 17 * 6144;
        const unsigned char* wl = ws + WS_W + (size_t)l * LW_BYTES;
        if (IN()) { if (l == 0) { norm_rows<false>(A.x, A.ctx, A.norm1_g + l * 1024, modl, 0, nrows_mix, H, gw, NGW); weff_phase(A, gw, NGW); } else norm_rows<true>(XB, XCB, A.norm1_g + l * 1024, modl, 0, nrows_mix, H, gw, NGW); }
        SEAM();
        if (IN()) for (int rep = 0; rep < ((DUP_MASK & 1) ? 2 : 1); ++rep) { pg8::Gemm g{H, (const bf16*)(wl + LW_IN), 1024, 1024, 1024, 0, 0}; pg8::Order S; if (!last) S.init(nM_mix, 20, G, bx, 1, 0); else S.init(NLAT / 256, 20, G, bx, 1, 0, 2 * (NCTX / 256));
            pg8::EpiIn E{Z, Gt, A.b_gate + (size_t)l * 3072};
            pg8::gemm_phase<pg8::EpiIn, true>(lds, g, S, E, wave); }
        SEAM();
        if (IN()) elem_phase(A, l, nrows_mix, nrows_x, Z, Y, gw, NGW);
        SEAM();
        if (IN()) { for (int rep = 0; rep < ((DUP_MASK & 2) ? 2 : 1); ++rep) attention_phase(A, l, last, Z, Y, (char*)lds_raw, G, vcu, wave);
        }
        SEAM();
        if (IN()) for (int rep = 0; rep < ((DUP_MASK & 16) ? 2 : 1); ++rep) { pg8::Gemm g{Y, (const bf16*)(wl + LW_BR), YP, 512, 512, 512, (long)1024 * 512}; pg8::Order S; S.init(nM_x, 4, G, bx, 3, 2);
            pg8::EpiMerge E{Gt, Mrg};
            pg8::gemm_phase<pg8::EpiMerge, true>(lds, g, S, E, wave); }
        SEAM();
        if (IN()) { pg8::Gemm g{Mrg, (const bf16*)(wl + LW_OUT), 1024, 1024, 1024, 0, 0}; pg8::Order S; S.init(nM_x, 4, G, bx, 1, 0);
            if (l == 0) { pg8::EpiRes<false, true> E{A.x, A.ctx, XB, XCB, modl, 2}; pg8::gemm_phase<pg8::EpiRes<false, true>, true>(lds, g, S, E, wave); }
            else { pg8::EpiRes<true, true> E{XB, XCB, XB, XCB, modl, 2}; pg8::gemm_phase<pg8::EpiRes<true, true>, true>(lds, g, S, E, wave); } }
        SEAM();
        if (IN()) norm_rows<true>(XB, XCB, A.norm2_g + l * 1024, modl, 1, nrows_x, H2, gw, NGW);
        SEAM();
        if (IN()) for (int rep = 0; rep < ((DUP_MASK & 4) ? 2 : 1); ++rep) { pg8::Gemm g{H2, (const bf16*)(wl + LW_FF), 1024, 1024, 1024, 0, 0}; pg8::Order S; S.init(nM_x, 22, G, bx, 1, 0);
            pg8::EpiFF E{U, A.conv_w + (size_t)l * 3 * FF, A.conv_b + (size_t)l * FF, SAs, SIDE_BYTES / 4};
            pg8::gemm_phase<pg8::EpiFF, true>(lds, g, S, E, wave); }
        SEAM();
        if (IN()) fixup_phase(A, l, nrows_x, U, SAs, SPA, SVs, vcu * NTHREADS + wave * 64, G * NTHREADS);
        SEAM();
        if (IN()) { pg8::Gemm g{U, (const bf16*)(wl + LW_DN), FF, FF, FF, 0, 0}; pg8::Order S; S.init(nM_x, 4, G, bx, 1, 0);
            if (!last) { pg8::EpiRes<true, true> E{XB, XCB, XB, XCB, modl, 5}; pg8::gemm_phase<pg8::EpiRes<true, true>, true>(lds, g, S, E, wave); }
            else { pg8::EpiRes<true, false> E{XB, XCB, XF, XF, modl, 5}; pg8::gemm_phase<pg8::EpiRes<true, false>, true>(lds, g, S, E, wave); } }
        SEAM();
    }
    if (IN()) final_norm_rows(XF, A.out, A.final_g, gw, NGW);
#undef IN
#undef SEAM
}
constexpr int N_PHASES = 22;

extern "C" void kernel_launch(void* const* d_in, const int* in_sizes, int n_in, void* d_out, int out_size, void* d_ws, size_t ws_size, hipStream_t stream) {
    static int grid = 0;
    if (grid == 0) {
        if (n_in != 24 || out_size != NLAT * 1024 || ws_size < WS_END) { fprintf(stderr, "kernel_launch: unexpected shapes (n_in %d out %d ws %zu need %zu)\n", n_in, out_size, ws_size, (size_t)WS_END); grid = -1; return; }
        int dev = 0, cus = 0, per_cu = 0;
        hipGetDevice(&dev); hipDeviceGetAttribute(&cus, hipDeviceAttributeMultiprocessorCount, dev);
        if (hipFuncSetAttribute((const void*)fwd_megakernel, hipFuncAttributeMaxDynamicSharedMemorySize, LDS_BYTES) != hipSuccess) { fprintf(stderr, "kernel_launch: hipFuncSetAttribute failed\n"); grid = -1; return; }
        hipOccupancyMaxActiveBlocksPerMultiprocessor(&per_cu, (const void*)fwd_megakernel, NTHREADS, LDS_BYTES);
        (void)hipGetLastError();
        if (per_cu < 1) { fprintf(stderr, "kernel_launch: occupancy query says %d blocks per CU\n", per_cu); per_cu = 1; }
        grid = cus;
    }
    if (grid < 0) return;
    Args a{};
    const float** p = (const float**)&a;
    for (int i = 0; i < 24; ++i) p[i] = (const float*)d_in[i];
    a.out = (float*)d_out; a.ws = (unsigned char*)d_ws;
#if MK_SPLIT
    for (int ph = 0; ph < N_PHASES; ++ph) { a.ph_lo = ph; a.ph_hi = ph + 1; hipLaunchKernelGGL(fwd_megakernel, dim3(grid), dim3(NTHREADS), LDS_BYTES, stream, a); }
#else
    a.ph_lo = 0; a.ph_hi = N_PHASES;
    if (hipMemsetAsync((char*)d_ws + WS_CTL, 0, CTL_ZERO_BYTES, stream) != hipSuccess) { fprintf(stderr, "kernel_launch: memset failed\n"); return; }
    void* args[] = {&a};
    hipError_t e = hipLaunchCooperativeKernel((const void*)fwd_megakernel, dim3(grid), dim3(NTHREADS), args, LDS_BYTES, stream);
    if (e != hipSuccess) fprintf(stderr, "cooperative launch failed: %s (grid %d)\n", hipGetErrorString(e), grid);
#endif
}
```

```cpp
#include <hip/hip_runtime.h>
#include <hip/hip_cooperative_groups.h>
#include <hip/hip_bf16.h>
#include <cstdio>
#include <cstdint>
#include <cmath>
namespace cg = cooperative_groups;

#ifndef DUP_MASK
#define DUP_MASK 0
#endif
#ifndef MK_SPLIT
#define MK_SPLIT 0
#endif

constexpr int DM_ = 1024, NB = 16, SEQ = 4096, CTX = 256, NLAT = NB * SEQ, NCTX = NB * CTX, NTOK = NLAT + NCTX;
constexpr int ZP = 2048, GP = 3072, YP = 1536, FF = 2816, AVP = 2 * FF;
constexpr float EPS = 1e-6f;
constexpr float LOG2E = 1.4426950408889634f;
constexpr float C2 = 0.125f * LOG2E;

__device__ __forceinline__ int lane_fresh() { int l = (int)__builtin_amdgcn_mbcnt_hi(~0u, __builtin_amdgcn_mbcnt_lo(~0u, 0u)); asm volatile("" : "+v"(l)); return l; }

namespace pg8 {
#define PG8_LAS __attribute__((address_space(3)))
typedef unsigned short bf16_t;
typedef short bf16x8 __attribute__((ext_vector_type(8)));
typedef float f32x4 __attribute__((ext_vector_type(4)));
typedef unsigned u32x4 __attribute__((ext_vector_type(4)));
typedef unsigned u32x2 __attribute__((ext_vector_type(2)));
constexpr int BM = 256, BK = 64, HALF = 128, HTB = HALF * BK * 2, STAGE_BYTES = 8 * HTB, NXCD = 8, WGM = 4;

__host__ __device__ __forceinline__ int lds_byte(int r, int c) { const int st = (r >> 4) * 2 + (c >> 5), rr = r & 15, cc = c & 31, ob = rr * 64 + cc * 2; return st * 1024 + (ob ^ (((ob >> 9) & 1) << 5)); }
__host__ __device__ __forceinline__ void stage_rc(int b, int& R, int& C) { const int st = b / 1024, sb = b % 1024, swz = sb ^ (((sb >> 9) & 1) << 5); R = (st >> 1) * 16 + swz / 64; C = (st & 1) * 32 + (swz % 64) / 2; }
__host__ __device__ __forceinline__ int perm32(int rho) { const int n = rho >> 4, i = rho & 15; return 8 * (i >> 2) + 4 * n + (i & 3); }

struct Unit { int pm, pn, g; };
struct Gemm { const bf16_t* A; const bf16_t* Bt; int lda, ldb, K; long a_goff, b_goff; };

struct Order {
    int nM, nN, nwg, G, c, sub, gmode, nextra;
    __device__ __forceinline__ void init(int nM_, int nN_, int G_, int c_, int sub_, int gmode_, int nextra_ = 0) { nM = nM_; nN = nN_; nwg = nM * nN; G = G_; c = c_; sub = sub_; gmode = gmode_; nextra = nextra_; }
    __device__ __forceinline__ bool next(int i, Unit& u) const {
        const int ti = (sub == 1) ? i : i / sub;
        const long L = (long)ti * G + c;
        if (L >= nwg) { const int j = (int)(L - nwg); if (j >= nextra) return false; u.pm = nM + (j >> 1); u.pn = (j & 1) ? 7 : 4; u.g = 0; return true; }
        int wgid = (int)L; { const int q = nwg / NXCD, r = nwg % NXCD, xcd = wgid % NXCD, off = wgid / NXCD; wgid = (xcd < r ? xcd * (q + 1) : r * (q + 1) + (xcd - r) * q) + off; }
        const int nig = WGM * nN, gid = wgid / nig, fm = gid * WGM, gsz = (nM - fm) < WGM ? (nM - fm) : WGM;
        u.pm = fm + ((wgid % nig) % gsz); u.pn = (wgid % nig) / gsz;
        u.g = (gmode == 0) ? 0 : ((gmode == 1) ? u.pn : (i - ti * sub));
        return true;
    }
};

typedef float f32x2_t __attribute__((ext_vector_type(2))); typedef __bf16 bf16x2_t __attribute__((ext_vector_type(2)));
__device__ __forceinline__ unsigned cvt_pk_bf16(float lo, float hi) { f32x2_t v = {lo, hi}; bf16x2_t b = __builtin_convertvector(v, bf16x2_t); return __builtin_bit_cast(unsigned, b); }
__device__ __forceinline__ float bf_lo(unsigned w) { return __uint_as_float(w << 16); }
__device__ __forceinline__ float bf_hi(unsigned w) { return __uint_as_float(w & 0xffff0000u); }
__device__ __forceinline__ float sigmoidf_(float x) { return __builtin_amdgcn_rcpf(1.0f + __builtin_amdgcn_exp2f(-x * 1.4426950408889634f)); }

struct EpiBf16 {
    static constexpr bool PERM = true;
    bf16_t* O; int ldc; const float* colscale;
    __device__ __forceinline__ void operator()(const f32x4 (&acc)[2][2][4][2], const Unit& u, int wr, int wc, int fr, int fq) const {
        int row0 = u.pm * BM + wr * 64 + fr; asm volatile("" : "+v"(row0)); const int col0 = u.pn * BM + wc * 32 + 8 * fq;
#pragma unroll
        for (int bj = 0; bj < 2; ++bj) {
            f32x4 s0 = (f32x4){1.f, 1.f, 1.f, 1.f}, s1 = s0;
            if (colscale) { s0 = *(const f32x4*)(colscale + col0 + bj * HALF); s1 = *(const f32x4*)(colscale + col0 + bj * HALF + 4); }
#pragma unroll
            for (int ai = 0; ai < 2; ++ai)
#pragma unroll
                for (int m = 0; m < 4; ++m) { bf16_t* rowp = O + (size_t)(row0 + ai * HALF + m * 16) * ldc + col0;
                    const f32x4 v0 = acc[ai][bj][m][0] * s0, v1 = acc[ai][bj][m][1] * s1;
                    u32x4 w; w.x = cvt_pk_bf16(v0[0], v0[1]); w.y = cvt_pk_bf16(v0[2], v0[3]); w.z = cvt_pk_bf16(v1[0], v1[1]); w.w = cvt_pk_bf16(v1[2], v1[3]);
                    *(u32x4*)(rowp + bj * HALF) = w; } }
    }
};
struct EpiIn {
    static constexpr bool PERM = true;
    bf16_t* Z; bf16_t* Gt; const float* bgate;
    __device__ __forceinline__ void operator()(const f32x4 (&acc)[2][2][4][2], const Unit& u, int wr, int wc, int fr, int fq) const {
        int row0 = u.pm * BM + wr * 64 + fr; asm volatile("" : "+v"(row0)); const bool isz = u.pn < 8;
        const int col0 = (isz ? u.pn * BM : (u.pn - 8) * BM) + wc * 32 + 8 * fq;
        bf16_t* base = isz ? Z : Gt; const int ldc = isz ? ZP : GP;
        f32x4 bv[2][2];
#pragma unroll
        for (int bj = 0; bj < 2; ++bj)
#pragma unroll
            for (int n = 0; n < 2; ++n) bv[bj][n] = isz ? (f32x4){0.f, 0.f, 0.f, 0.f} : *(const f32x4*)(bgate + col0 + bj * HALF + 4 * n) * (-1.4426950408889634f);
#pragma unroll
        for (int ai = 0; ai < 2; ++ai)
#pragma unroll
            for (int m = 0; m < 4; ++m) { bf16_t* rowp = base + (size_t)(row0 + ai * HALF + m * 16) * ldc + col0;
#pragma unroll
                for (int bj = 0; bj < 2; ++bj) { f32x4 v0 = acc[ai][bj][m][0] + bv[bj][0], v1 = acc[ai][bj][m][1] + bv[bj][1];
                    if (!isz) {
#pragma unroll
                        for (int e = 0; e < 4; ++e) { v0[e] = __builtin_amdgcn_rcpf(1.0f + __builtin_amdgcn_exp2f(v0[e])); v1[e] = __builtin_amdgcn_rcpf(1.0f + __builtin_amdgcn_exp2f(v1[e])); } }
                    u32x4 w; w.x = cvt_pk_bf16(v0[0], v0[1]); w.y = cvt_pk_bf16(v0[2], v0[3]); w.z = cvt_pk_bf16(v1[0], v1[1]); w.w = cvt_pk_bf16(v1[2], v1[3]);
                    *(u32x4*)(rowp + bj * HALF) = w; } }
    }
};
struct EpiMerge {
    static constexpr bool PERM = true;
    const bf16_t* Gt; bf16_t* Mrg;
    __device__ __forceinline__ void operator()(const f32x4 (&acc)[2][2][4][2], const Unit& u, int wr, int wc, int fr, int fq) const {
        int row0 = u.pm * BM + wr * 64 + fr; asm volatile("" : "+v"(row0)); const int col0 = u.pn * BM + wc * 32 + 8 * fq;
#pragma unroll
        for (int ai = 0; ai < 2; ++ai) {
            u32x4 gw[4][2], ow[4][2];
#pragma unroll
            for (int m = 0; m < 4; ++m) { const size_t row = (size_t)(row0 + ai * HALF + m * 16);
#pragma unroll
                for (int bj = 0; bj < 2; ++bj) { gw[m][bj] = *(const u32x4*)(Gt + row * GP + u.g * 1024 + col0 + bj * HALF);
                    if (u.g != 0) ow[m][bj] = *(const u32x4*)(Mrg + row * 1024 + col0 + bj * HALF); } }
#pragma unroll
            for (int m = 0; m < 4; ++m) { const size_t row = (size_t)(row0 + ai * HALF + m * 16);
#pragma unroll
                for (int bj = 0; bj < 2; ++bj) {
                    const u32x4 g4 = gw[m][bj];
                    const f32x4 a0 = acc[ai][bj][m][0], a1 = acc[ai][bj][m][1];
                    float v[8];
                    v[0] = bf_lo(g4.x) * a0[0]; v[1] = bf_hi(g4.x) * a0[1]; v[2] = bf_lo(g4.y) * a0[2]; v[3] = bf_hi(g4.y) * a0[3];
                    v[4] = bf_lo(g4.z) * a1[0]; v[5] = bf_hi(g4.z) * a1[1]; v[6] = bf_lo(g4.w) * a1[2]; v[7] = bf_hi(g4.w) * a1[3];
                    if (u.g != 0) { const u32x4 o4 = ow[m][bj];
                        v[0] += bf_lo(o4.x); v[1] += bf_hi(o4.x); v[2] += bf_lo(o4.y); v[3] += bf_hi(o4.y); v[4] += bf_lo(o4.z); v[5] += bf_hi(o4.z); v[6] += bf_lo(o4.w); v[7] += bf_hi(o4.w); }
                    u32x4 w; w.x = cvt_pk_bf16(v[0], v[1]); w.y = cvt_pk_bf16(v[2], v[3]); w.z = cvt_pk_bf16(v[4], v[5]); w.w = cvt_pk_bf16(v[6], v[7]);
                    *(u32x4*)(Mrg + row * 1024 + col0 + bj * HALF) = w; } }
        }
    }
};
template <bool BASE_BF16, bool OUT_BF16> struct EpiRes {
    static constexpr bool PERM = false;
    const void* base_lat; const void* base_ctx; void* out_lat; void* out_ctx; const float* modl; int gate_idx;
    __device__ __forceinline__ void operator()(const f32x4 (&acc)[2][2][4][2], const Unit& u, int wr, int wc, int fr, int fq) const {
        const bool lat = u.pm < (NLAT / BM);
        const int prow = lat ? u.pm * BM : (u.pm * BM - NLAT);
        const void* base = lat ? base_lat : base_ctx; void* out = lat ? out_lat : out_ctx;
        const int b = lat ? (u.pm * BM) / SEQ : NB;
        int col0 = u.pn * BM + wc * 32 + 4 * fq; asm volatile("" : "+v"(col0));
        const float* gp = modl + (size_t)(b * 6 + gate_idx) * 1024 + col0;
        f32x4 gv[2][2];
#pragma unroll
        for (int bj = 0; bj < 2; ++bj)
#pragma unroll
            for (int n = 0; n < 2; ++n) gv[bj][n] = *(const f32x4*)(gp + bj * HALF + n * 16);
#pragma unroll
        for (int ai = 0; ai < 2; ++ai) {
            f32x4 bs[4][2][2];
#pragma unroll
            for (int m = 0; m < 4; ++m) { const size_t off = (size_t)(prow + ai * HALF + wr * 64 + m * 16 + fr) * 1024 + col0;
#pragma unroll
                for (int bj = 0; bj < 2; ++bj)
#pragma unroll
                    for (int n = 0; n < 2; ++n) { const size_t o2 = off + bj * HALF + n * 16;
                        if constexpr (BASE_BF16) { const u32x2 w = *(const u32x2*)((const bf16_t*)base + o2); bs[m][bj][n] = (f32x4){bf_lo(w.x), bf_hi(w.x), bf_lo(w.y), bf_hi(w.y)}; }
                        else bs[m][bj][n] = *(const f32x4*)((const float*)base + o2); } }
#pragma unroll
            for (int m = 0; m < 4; ++m) { const size_t off = (size_t)(prow + ai * HALF + wr * 64 + m * 16 + fr) * 1024 + col0;
#pragma unroll
                for (int bj = 0; bj < 2; ++bj)
#pragma unroll
                    for (int n = 0; n < 2; ++n) { const size_t o2 = off + bj * HALF + n * 16;
                        const f32x4 r = bs[m][bj][n] + gv[bj][n] * acc[ai][bj][m][n];
                        if constexpr (OUT_BF16) { u32x2 w; w.x = cvt_pk_bf16(r[0], r[1]); w.y = cvt_pk_bf16(r[2], r[3]); *(u32x2*)((bf16_t*)out + o2) = w; }
                        else *(f32x4*)((float*)out + o2) = r; } }
        }
    }
};
struct EpiFF {
    static constexpr bool PERM = true;
    bf16_t* U; const float* cw; const float* cb; float* As; size_t side_elems;
    __device__ __forceinline__ void operator()(const f32x4 (&acc)[2][2][4][2], const Unit& u, int wr, int wc, int fr, int fq) const {
        const int lane = fq * 16 + fr; float* PAs = As + side_elems; float* Vs = PAs + side_elems;
        int ch0 = u.pn * 128 + wc * 32 + 8 * fq; asm volatile("" : "+v"(ch0));
#pragma unroll
        for (int h = 0; h < 2; ++h) {
            const f32x4 w0 = *(const f32x4*)(cw + ch0 + 4 * h), w1 = *(const f32x4*)(cw + 2816 + ch0 + 4 * h), w2 = *(const f32x4*)(cw + 2 * 2816 + ch0 + 4 * h), bb = *(const f32x4*)(cb + ch0 + 4 * h);
#pragma unroll
            for (int ai = 0; ai < 2; ++ai) {
                const int rblk = u.pm * 4 + ai * 2 + wr;
                float o[4][4]; f32x4 pre0, pre3;
#pragma unroll
                for (int e = 0; e < 4; ++e) {
                    float a[4], ru[4], rd[4];
#pragma unroll
                    for (int m = 0; m < 4; ++m) { a[m] = acc[ai][0][m][h][e]; ru[m] = __int_as_float(__builtin_amdgcn_mov_dpp(__float_as_int(a[m]), 0x121, 0xf, 0xf, false));
                        rd[m] = __int_as_float(__builtin_amdgcn_mov_dpp(__float_as_int(a[m]), 0x12f, 0xf, 0xf, false)); }
#pragma unroll
                    for (int m = 0; m < 4; ++m) {
                        const float ap = (fr > 0) ? ru[m] : (m > 0 ? ru[m > 0 ? m - 1 : 0] : 0.f);
                        const float an = (fr < 15) ? rd[m] : (m < 3 ? rd[m < 3 ? m + 1 : 3] : 0.f);
                        const float pre = ap * w0[e] + a[m] * w1[e] + an * w2[e] + bb[e];
                        if (m == 0) pre0[e] = pre; if (m == 3) pre3[e] = pre;
                        o[m][e] = pre * sigmoidf_(pre) * acc[ai][1][m][h][e]; }
                    __builtin_amdgcn_sched_barrier(0); }
#pragma unroll
                for (int m = 0; m < 4; ++m) { u32x2 w; w.x = cvt_pk_bf16(o[m][0], o[m][1]); w.y = cvt_pk_bf16(o[m][2], o[m][3]);
                    *(u32x2*)(U + ((size_t)rblk * 64 + m * 16 + fr) * 2816 + ch0 + 4 * h) = w; }
                if (fr == 0) { const size_t so = (size_t)(2 * rblk) * 2816 + ch0 + 4 * h; *(f32x4*)(As + so) = acc[ai][0][0][h]; *(f32x4*)(Vs + so) = acc[ai][1][0][h]; *(f32x4*)(PAs + so) = pre0; }
                if (fr == 15) { const size_t so = (size_t)(2 * rblk + 1) * 2816 + ch0 + 4 * h; *(f32x4*)(As + so) = acc[ai][0][3][h]; *(f32x4*)(Vs + so) = acc[ai][1][3][h]; *(f32x4*)(PAs + so) = pre3; }
                __builtin_amdgcn_sched_barrier(0);
            }
        }
    }
};

template <class Epi, bool ALIGN_EPI>
__device__ __forceinline__ void gemm_phase(PG8_LAS unsigned char* lds, const Gemm g, const Order& S, const Epi& E, int wid) {
    const int lane = lane_fresh(), tid = wid * 64 + lane;
    const int wr = wid >> 2, wc = wid & 3, fr = lane & 15, fq = lane >> 4;
    const int K = g.K, nt = K / BK;
    unsigned voffA[2], voffB[2];
#pragma unroll
    for (int i = 0; i < 2; ++i) { int R, C; stage_rc(tid * 16 + i * 8192, R, C); const int Rb = Epi::PERM ? ((R & ~31) + perm32(R & 31)) : R;
        voffA[i] = (unsigned)(R * g.lda + C) * 2u; voffB[i] = (unsigned)(Rb * g.ldb + C) * 2u; }
    const size_t kstep = (size_t)(BK * 2);
    const size_t hstepA = (size_t)HALF * g.lda * 2, hstepB = (size_t)HALF * g.ldb * 2;
    const size_t tstepA = 2 * hstepA, tstepB = 2 * hstepB;
    const unsigned ldsw = (unsigned)wid * 1024u;
    const int aoff = lds_byte(wr * 64 + fr, fq * 8), boff = lds_byte(wc * 32 + fr, fq * 8);
#define PG8_UA(u) ((const char*)g.A + (size_t)(u).pm * tstepA + (size_t)((long)(u).g * g.a_goff * 2))
#define PG8_UB(u) ((const char*)g.Bt + (size_t)(u).pn * tstepB + (size_t)((long)(u).g * g.b_goff * 2))
#define PG8_SA(b, h) (((b) * 2 + (h)) * HTB)
#define PG8_SB(b, h) ((4 + (b) * 2 + (h)) * HTB)
#define PG8_STAGE(bufoff, gbase, voff) do { _Pragma("unroll") for (int _i = 0; _i < 2; ++_i) \
        __builtin_amdgcn_global_load_lds((const unsigned*)((const char*)(gbase) + (voff)[_i]), (PG8_LAS unsigned*)(lds + (bufoff) + ldsw + _i * 8192), 16, 0, 0); } while (0)
#define PG8_LDA(dst, b, h) do { _Pragma("unroll") for (int m = 0; m < 4; ++m) _Pragma("unroll") for (int k = 0; k < 2; ++k) dst[m][k] = *(const PG8_LAS bf16x8*)(lds + PG8_SA(b, h) + aoff + m * 2048 + k * 1024); } while (0)
#define PG8_LDB(dst, b, h) do { _Pragma("unroll") for (int n = 0; n < 2; ++n) _Pragma("unroll") for (int k = 0; k < 2; ++k) dst[n][k] = *(const PG8_LAS bf16x8*)(lds + PG8_SB(b, h) + boff + n * 2048 + k * 1024); } while (0)
#define PG8_MMA(ai, bj, At, Bt) do { __builtin_amdgcn_s_setprio(1); _Pragma("unroll") for (int m = 0; m < 4; ++m) _Pragma("unroll") for (int n = 0; n < 2; ++n) _Pragma("unroll") for (int k = 0; k < 2; ++k) \
        acc[ai][bj][m][n] = __builtin_amdgcn_mfma_f32_16x16x32_bf16(Bt[n][k], At[m][k], acc[ai][bj][m][n], 0, 0, 0); __builtin_amdgcn_s_setprio(0); } while (0)
#define PG8_WAIT_V(n) asm volatile("s_waitcnt vmcnt(" #n ")" ::: "memory")
#define PG8_WAIT_L(n) asm volatile("s_waitcnt lgkmcnt(" #n ")" ::: "memory")
#define PG8_BAR __builtin_amdgcn_s_barrier()
#define PG8_SCHED __builtin_amdgcn_sched_barrier(0)
    Unit cur, nxt; int ui = 0;
    if (!S.next(0, cur)) return;
    f32x4 acc[2][2][4][2];
#pragma unroll
    for (int a = 0; a < 2; ++a)
#pragma unroll
        for (int b = 0; b < 2; ++b)
#pragma unroll
            for (int m = 0; m < 4; ++m)
#pragma unroll
                for (int n = 0; n < 2; ++n) acc[a][b][m][n] = (f32x4){0.f, 0.f, 0.f, 0.f};
    bf16x8 At[4][2], B0[2][2], B1[2][2];
    const char* cA = PG8_UA(cur); const char* cB = PG8_UB(cur);
    PG8_STAGE(PG8_SB(0, 0), cB, voffB); PG8_STAGE(PG8_SB(0, 1), cB + hstepB, voffB); PG8_STAGE(PG8_SA(0, 0), cA, voffA); PG8_STAGE(PG8_SA(0, 1), cA + hstepA, voffA);
    if (wr == 1) PG8_BAR;
    PG8_WAIT_V(2); PG8_BAR;
    PG8_STAGE(PG8_SB(1, 0), cB + kstep, voffB); PG8_STAGE(PG8_SA(1, 0), cA + kstep, voffA); PG8_STAGE(PG8_SB(1, 1), cB + hstepB + kstep, voffB);
    PG8_WAIT_V(6); PG8_BAR;
    for (;;) {
        const bool has_next = S.next(ui + 1, nxt);
        const char* nA = has_next ? PG8_UA(nxt) : cA; const char* nB = has_next ? PG8_UB(nxt) : cB;
        for (int t = 0; t < nt; t += 2) {
            const bool last = (t == nt - 2);
            const char* a1 = cA + (size_t)(t + 1) * kstep;
            const char* a2 = last ? nA : cA + (size_t)(t + 2) * kstep; const char* b2 = last ? nB : cB + (size_t)(t + 2) * kstep;
            const char* a3 = a2 + kstep; const char* b3 = b2 + kstep;
            PG8_LDB(B0, 0, 0); PG8_LDB(B1, 0, 1); PG8_SCHED; PG8_LDA(At, 0, 0); PG8_STAGE(PG8_SA(1, 1), a1 + hstepA, voffA);
            PG8_WAIT_V(8); PG8_WAIT_L(0); PG8_BAR; PG8_MMA(0, 0, At, B0); PG8_MMA(0, 1, At, B1); PG8_BAR; PG8_SCHED;
            PG8_LDA(At, 0, 1); PG8_STAGE(PG8_SB(0, 0), b2, voffB); PG8_STAGE(PG8_SB(0, 1), b2 + hstepB, voffB); PG8_STAGE(PG8_SA(0, 0), a2, voffA);
            PG8_WAIT_V(8); PG8_WAIT_L(0); PG8_BAR; PG8_MMA(1, 0, At, B0); PG8_MMA(1, 1, At, B1); PG8_BAR; PG8_SCHED;
            PG8_LDB(B0, 1, 0); PG8_LDB(B1, 1, 1); PG8_SCHED; PG8_LDA(At, 1, 0); PG8_STAGE(PG8_SA(0, 1), a2 + hstepA, voffA);
            PG8_WAIT_V(8); PG8_WAIT_L(0); PG8_BAR; PG8_MMA(0, 0, At, B0); PG8_MMA(0, 1, At, B1); PG8_BAR; PG8_SCHED;
            PG8_LDA(At, 1, 1); PG8_STAGE(PG8_SB(1, 0), b3, voffB); PG8_STAGE(PG8_SB(1, 1), b3 + hstepB, voffB); PG8_STAGE(PG8_SA(1, 0), a3, voffA);
            PG8_WAIT_V(8); PG8_WAIT_L(0); PG8_BAR; PG8_MMA(1, 0, At, B0); PG8_MMA(1, 1, At, B1); PG8_BAR; PG8_SCHED;
        }
        if constexpr (ALIGN_EPI) { if (wr == 0) PG8_BAR; }
        { const int l2 = lane_fresh(); E(acc, cur, wr, wc, l2 & 15, l2 >> 4); }
        if (!has_next) break;
#pragma unroll
        for (int a = 0; a < 2; ++a)
#pragma unroll
            for (int b = 0; b < 2; ++b)
#pragma unroll
                for (int m = 0; m < 4; ++m)
#pragma unroll
                    for (int n = 0; n < 2; ++n) acc[a][b][m][n] = (f32x4){0.f, 0.f, 0.f, 0.f};
        cur = nxt; cA = nA; cB = nB; ++ui;
        if constexpr (ALIGN_EPI) { if (wr == 1) PG8_BAR; }
    }
    PG8_WAIT_V(0);
    if constexpr (!ALIGN_EPI) { if (wr == 0) PG8_BAR; }
    PG8_BAR;
#undef PG8_UA
#undef PG8_UB
#undef PG8_SA
#undef PG8_SB
#undef PG8_STAGE
#undef PG8_LDA
#undef PG8_LDB
#undef PG8_MMA
#undef PG8_WAIT_V
#undef PG8_WAIT_L
#undef PG8_BAR
#undef PG8_SCHED
}
}

namespace attn_body {
using bf16 = __hip_bfloat16;
using bf16x8 = __attribute__((ext_vector_type(8))) short;
using s16x4 = __attribute__((ext_vector_type(4))) short;
using f32x16 = __attribute__((ext_vector_type(16))) float;
using u32x4 = __attribute__((ext_vector_type(4))) unsigned;
constexpr int D = 64, NW = 8, QBLK = 32, QB = QBLK * NW, KVBLK = 64;
__device__ __forceinline__ int crow(int r, int hi) { return (r & 3) + 8 * (r >> 2) + 4 * hi; }
#define SBAR() __builtin_amdgcn_sched_barrier(0)
__device__ __forceinline__ void wmask(f32x16& p0, f32x16& p1, int d0) {
    const float NEG = -INFINITY;
#pragma unroll
    for (int r = 0; r < 16; ++r) { const int d = d0 + (r & 3) + 8 * (r >> 2); if (d > 128 || d < -128) p0[r] = NEG; if (d + 32 > 128 || d + 32 < -128) p1[r] = NEG; }
}
constexpr int NSLOT = 3, SLOTB = 8192;
constexpr int LDS_K = 0, LDS_V = NSLOT * SLOTB, LDS_WS = 2 * NSLOT * SLOTB, LDS_OST = LDS_WS + NW * 64 * 4, LDS_BYTES = LDS_OST + NW * 4096;
__device__ __forceinline__ void glds16(const void* gsrc, unsigned lds_dst) { unsigned keep;
    asm volatile("s_mov_b32 %0, m0\n\ts_mov_b32 m0, %2\n\ts_nop 0\n\tglobal_load_lds_dwordx4 %1, off\n\ts_mov_b32 m0, %0" : "=&s"(keep) : "v"(gsrc), "s"(lds_dst) : "memory"); }
__device__ __forceinline__ float max3f(float a, float b, float c) { float r; asm("v_max3_f32 %0, %1, %2, %3" : "=v"(r) : "v"(a), "v"(b), "v"(c)); return r; }
__device__ __forceinline__ float max2f(float a, float b) { float r; asm("v_max_f32_e32 %0, %1, %2" : "=v"(r) : "v"(a), "v"(b)); return r; }
__device__ __forceinline__ float fadd_s(float a, float b) { float r; asm("v_add_f32_e32 %0, %1, %2" : "=v"(r) : "v"(a), "v"(b)); return r; }
__device__ __forceinline__ float fsub_s(float a, float b) { float r; asm("v_sub_f32_e32 %0, %1, %2" : "=v"(r) : "v"(a), "v"(b)); return r; }
typedef float f32x2_t __attribute__((ext_vector_type(2))); typedef __bf16 bf16x2_t __attribute__((ext_vector_type(2)));
__device__ __forceinline__ unsigned cvtpk_s(float lo, float hi) { f32x2_t v = {lo, hi}; bf16x2_t b = __builtin_convertvector(v, bf16x2_t); return __builtin_bit_cast(unsigned, b); }
#define WAIT_BAR(N) asm volatile("s_waitcnt vmcnt(" #N ") lgkmcnt(0)\n\ts_barrier" ::: "memory")

__device__ __forceinline__ void qkt(f32x16& p0, f32x16& p1, const char* Kslot, const bf16x8* qr, const f32x16& negm, int r32, int hi) {
    const char* kb = Kslot + hi * 1024 + r32 * 16;
#pragma unroll
    for (int d0 = 0; d0 < 4; ++d0) {
        const bf16x8 b0 = *reinterpret_cast<const bf16x8*>(kb + d0 * 2048);
        const bf16x8 b1 = *reinterpret_cast<const bf16x8*>(kb + d0 * 2048 + 512);
        if (d0 == 0) { p0 = __builtin_amdgcn_mfma_f32_32x32x16_bf16(b0, qr[0], negm, 0, 0, 0); p1 = __builtin_amdgcn_mfma_f32_32x32x16_bf16(b1, qr[0], negm, 0, 0, 0); }
        else { p0 = __builtin_amdgcn_mfma_f32_32x32x16_bf16(b0, qr[d0], p0, 0, 0, 0); p1 = __builtin_amdgcn_mfma_f32_32x32x16_bf16(b1, qr[d0], p1, 0, 0, 0); } }
}
typedef __attribute__((address_space(3))) const char* lds_cptr;
typedef short v4i16_t __attribute__((ext_vector_type(4)));
__device__ __forceinline__ void kload8(bf16x8* kf, lds_cptr kp) {
    kf[0] = *(const __attribute__((address_space(3))) bf16x8*)(kp);        kf[1] = *(const __attribute__((address_space(3))) bf16x8*)(kp + 512);
    kf[2] = *(const __attribute__((address_space(3))) bf16x8*)(kp + 2048); kf[3] = *(const __attribute__((address_space(3))) bf16x8*)(kp + 2560);
    kf[4] = *(const __attribute__((address_space(3))) bf16x8*)(kp + 4096); kf[5] = *(const __attribute__((address_space(3))) bf16x8*)(kp + 4608);
    kf[6] = *(const __attribute__((address_space(3))) bf16x8*)(kp + 6144); kf[7] = *(const __attribute__((address_space(3))) bf16x8*)(kp + 6656);
}
__device__ __forceinline__ void kload2(bf16x8* kf, lds_cptr kp, int j) { kf[2 * j] = *(const __attribute__((address_space(3))) bf16x8*)(kp + j * 2048); kf[2 * j + 1] = *(const __attribute__((address_space(3))) bf16x8*)(kp + j * 2048 + 512); }
__device__ __forceinline__ s16x4 vtr(lds_cptr p) { return __builtin_bit_cast(s16x4, __builtin_amdgcn_ds_read_tr16_b64_v4i16((__attribute__((address_space(3))) v4i16_t*)p)); }
__device__ __forceinline__ float rowmax(const f32x16& p0, const f32x16& p1) {
    float a = max3f(p0[0], p0[1], p1[0]), b = max3f(p0[2], p0[3], p1[1]); a = max3f(a, p1[2], p1[3]);
#pragma unroll
    for (int r = 4; r < 16; r += 4) { a = max3f(a, p0[r], p0[r + 1]); b = max3f(b, p0[r + 2], p0[r + 3]); a = max3f(a, p1[r], p1[r + 1]); b = max3f(b, p1[r + 2], p1[r + 3]); }
    const float m = max2f(a, b);
    auto rr = __builtin_amdgcn_permlane32_swap(__float_as_uint(m), __float_as_uint(m), false, false);
    return max2f(__uint_as_float(rr[0]), __uint_as_float(rr[1]));
}
__device__ __forceinline__ void pv(f32x16* o, int vb, bf16x8 pa0, bf16x8 pa1, bf16x8 pa2, bf16x8 pa3) {
#pragma unroll
    for (int d0 = 0; d0 < 2; ++d0) { s16x4 lo[4], hi[4];
#pragma unroll
        for (int ks = 0; ks < 4; ++ks) {
            asm volatile("ds_read_b64_tr_b16 %0,%1 offset:%c2" : "=&v"(lo[ks]) : "v"(vb), "i"(d0 * 4096 + ks * 1024) : "memory");
            asm volatile("ds_read_b64_tr_b16 %0,%1 offset:%c2" : "=&v"(hi[ks]) : "v"(vb), "i"(d0 * 4096 + ks * 1024 + 512) : "memory"); }
        asm volatile("s_waitcnt lgkmcnt(0)" ::: "memory"); SBAR();
#define PK(k) (bf16x8){lo[k][0], lo[k][1], lo[k][2], lo[k][3], hi[k][0], hi[k][1], hi[k][2], hi[k][3]}
        o[d0] = __builtin_amdgcn_mfma_f32_32x32x16_bf16(pa0, PK(0), o[d0], 0, 0, 0);
        o[d0] = __builtin_amdgcn_mfma_f32_32x32x16_bf16(pa1, PK(1), o[d0], 0, 0, 0);
        o[d0] = __builtin_amdgcn_mfma_f32_32x32x16_bf16(pa2, PK(2), o[d0], 0, 0, 0);
        o[d0] = __builtin_amdgcn_mfma_f32_32x32x16_bf16(pa3, PK(3), o[d0], 0, 0, 0);
#undef PK
    }
}
template <int THRL, bool WMASK> __device__ __forceinline__ void attn_unit(const bf16* Qw0, const bf16* __restrict__ Kc, const bf16* __restrict__ Vc, long dlat, int NT, int kd0,
                                                                         bool has_sink, float sinkl2, bf16* Ow0, char* shm, int wid, bool q_rope, const float* q_normg, int tpos0) {
    const int lane = lane_fresh(), r32 = lane & 31, hi = lane >> 5;
    const bf16* Qw = Qw0 + (long)(wid * QBLK) * ZP;
    const unsigned lds0 = (unsigned)(uintptr_t)shm;
    float* wsf = (float*)(shm + LDS_WS) + wid * 64;
    const bf16* ksrc = Kc + (long)lane * ZP + wid * 8;
    const bf16* vsrc = Vc + (long)(16 * (wid & 3) + (lane >> 2)) * ZP + (wid >> 2) * 32 + (lane & 3) * 8;
    const unsigned kdst = lds0 + LDS_K + wid * 1024, vdst = lds0 + LDS_V + wid * 1024;
#define TOFF(t) (((t) < 4) ? (long)(t) * (KVBLK * ZP) : dlat + (long)((t) - 4) * (KVBLK * ZP))
#define DMA_K(t, slot) glds16(ksrc + TOFF(t), (unsigned)__builtin_amdgcn_readfirstlane(kdst + (slot)))
#define DMA_V(t, slot) glds16(vsrc + TOFF(t), (unsigned)__builtin_amdgcn_readfirstlane(vdst + (slot)))
    const int vb0 = (int)(lds0 + LDS_V) + ((lane >> 4) & 1) * 32 + (lane & 3) * 8 + (4 * hi + ((lane & 15) >> 2)) * 64;
    const char* Kbase = shm + LDS_K; bf16x8 kf[8];
    const lds_cptr shm3 = (lds_cptr)shm; const lds_cptr kp0 = shm3 + LDS_K + hi * 1024 + r32 * 16; const lds_cptr vp0 = shm3 + LDS_V + ((lane >> 4) & 1) * 32 + (lane & 3) * 8 + (4 * hi + ((lane & 15) >> 2)) * 64;
    DMA_K(0, 0); DMA_V(0, 0); DMA_K(1, SLOTB);
    bf16x8 qr[4];
#pragma unroll
    for (int d0 = 0; d0 < 4; ++d0) qr[d0] = *reinterpret_cast<const bf16x8*>(&Qw[(long)r32 * ZP + d0 * 16 + hi * 8]);
    {
        float qf[4][8];
#pragma unroll
        for (int d0 = 0; d0 < 4; ++d0)
#pragma unroll
            for (int i = 0; i < 8; ++i) qf[d0][i] = __uint_as_float(((unsigned)(unsigned short)qr[d0][i]) << 16);
        if (q_normg) {
            float ssq = 0.f;
#pragma unroll
            for (int d0 = 0; d0 < 4; ++d0)
#pragma unroll
                for (int i = 0; i < 8; ++i) ssq += qf[d0][i] * qf[d0][i];
            { auto rr = __builtin_amdgcn_permlane32_swap(__float_as_uint(ssq), __float_as_uint(ssq), false, false); ssq = __uint_as_float(rr[0]) + __uint_as_float(rr[1]); }
            const float rstd = __builtin_amdgcn_rsqf(ssq * (1.f / 64.f) + EPS);
#pragma unroll
            for (int d0 = 0; d0 < 4; ++d0)
#pragma unroll
                for (int i = 0; i < 8; ++i) qf[d0][i] *= rstd * q_normg[d0 * 16 + hi * 8 + i];
        }
        if (q_rope) {
            const int t = tpos0 + wid * QBLK + r32;
#pragma unroll
            for (int a = 0; a < 2; ++a) { const float pos = (float)(a ? (t & 63) : (t >> 6));
#pragma unroll
                for (int i = 0; i < 8; ++i) { float r = pos * (__builtin_amdgcn_exp2f(-(float)(hi * 8 + i) * (13.287712379549449f / 16.0f)) * 0.15915494309189535f); r = r - __builtin_floorf(r);
                    const float c = __builtin_amdgcn_cosf(r), sn = __builtin_amdgcn_sinf(r), x1 = qf[2 * a][i], x2 = qf[2 * a + 1][i];
                    qf[2 * a][i] = x1 * c - x2 * sn; qf[2 * a + 1][i] = x2 * c + x1 * sn; } }
        }
#pragma unroll
        for (int d0 = 0; d0 < 4; ++d0) { u32x4 w; w.x = cvtpk_s(qf[d0][0] * C2, qf[d0][1] * C2); w.y = cvtpk_s(qf[d0][2] * C2, qf[d0][3] * C2); w.z = cvtpk_s(qf[d0][4] * C2, qf[d0][5] * C2); w.w = cvtpk_s(qf[d0][6] * C2, qf[d0][7] * C2);
            qr[d0] = __builtin_bit_cast(bf16x8, w); }
    }
    float mhat = 0.f, l_reg = 0.f; f32x16 o[2]; f32x16 negm;
    { float zz = 0.f; asm volatile("" : "+v"(zz));
      _Pragma("unroll") for (int r = 0; r < 16; ++r) { o[0][r] = zz; o[1][r] = zz; negm[r] = zz; } }
    asm volatile("" : "+v"(negm));
    const int qrel = wid * QBLK + r32;
#define CMASK(P0, P1, t) do { if constexpr (WMASK) { if ((t) >= 4) wmask(P0, P1, kd0 + ((t) - 4) * KVBLK - qrel + 4 * hi); } } while (0)
    bool resc = false;
#define START(P0, P1) do { const float rm = rowmax(P0, P1); resc = false; \
    { const float dl = rm; mhat = fadd_s(mhat, dl); \
      _Pragma("unroll") for (int r = 0; r < 16; ++r) { P0[r] = fsub_s(P0[r], dl); P1[r] = fsub_s(P1[r], dl); } \
      _Pragma("unroll") for (int r = 0; r < 16; ++r) negm[r] = -mhat; asm volatile("" : "+v"(negm)); } \
    _Pragma("unroll") for (int r = 0; r < 16; ++r) P0[r] = __builtin_amdgcn_exp2f(P0[r]); } while (0)
#define RESC() do { if (resc) { asm volatile("s_waitcnt lgkmcnt(0)" ::: "memory"); \
      _Pragma("unroll") for (int d_ = 0; d_ < 2; ++d_) _Pragma("unroll") for (int r = 0; r < 16; ++r) o[d_][r] *= wsf[crow(r, hi)]; } } while (0)
    f32x16 pA0, pA1, pB0, pB1;
    int sl_prev = 0, sl_cur = 0, sl_next = SLOTB;
#define ROT() do { sl_prev = sl_cur; sl_cur = sl_next; sl_next = (sl_next == (NSLOT - 1) * SLOTB) ? 0 : sl_next + SLOTB; } while (0)
    DMA_K(2, 2 * SLOTB);
    WAIT_BAR(3);
    qkt(pA0, pA1, Kbase, qr, negm, r32, hi); asm volatile("s_nop 15\n\ts_nop 7" : "+v"(pA0), "+v"(pA1));
    START(pA0, pA1);
    _Pragma("unroll") for (int r = 0; r < 16; ++r) pA1[r] = __builtin_amdgcn_exp2f(pA1[r]);
    WAIT_BAR(0);
    DMA_K(3, 0); DMA_V(1, SLOTB);
    ROT();
    kload8(kf, kp0 + sl_cur);
    WAIT_BAR(2);
    s16x4 vlo[8], vhi[8]; u32x4 pw0, pw1, pw2, pw3;
#define PKW(P, B) cvtpk_s(P[B], P[B + 1])
#define PAF(k) __builtin_bit_cast(bf16x8, pw##k)
#define VFR(i) (bf16x8){vlo[i][0], vlo[i][1], vlo[i][2], vlo[i][3], vhi[i][0], vhi[i][1], vhi[i][2], vhi[i][3]}
#define PIN(x) asm volatile("" : "+v"(x))
#define MX3(a, b, c) __builtin_fmaxf(__builtin_fmaxf((a), (b)), (c))
#define GAPA(MF, A0, A1, A2, A3, W0, W1, PW) do { MF; sacc += A0; sacc += A1; sacc += A2; sacc += A3; PIN(sacc); W0; W1; PIN(PW); SBAR(); } while (0)
#define EX(v) __builtin_amdgcn_exp2f(v)
#define GAPB(MF, X, B) do { MF; X[B] = EX(X[B]); X[B + 1] = EX(X[B + 1]); X[B + 2] = EX(X[B + 2]); X[B + 3] = EX(X[B + 3]); PIN(X); SBAR(); } while (0)
#define VRD(i) do { vlo[i] = vtr(vp_ + (((i) >> 2) * 4096 + ((i) & 3) * 1024)); vhi[i] = vtr(vp_ + (((i) >> 2) * 4096 + ((i) & 3) * 1024 + 512)); } while (0)
#define KRD(G, j) do { if (G) { kload2(kf, kp0 + sl_next, j); SBAR(); } } while (0)
#define STEP(C0, C1, P0, P1, t, GK, GV, GL) do { SBAR(); \
    const lds_cptr vp_ = vp0 + sl_prev; \
    VRD(0); SBAR(); float sacc = (P0[0] + P0[1]); \
    GAPA(C0 = __builtin_amdgcn_mfma_f32_32x32x16_bf16(kf[0], qr[0], negm, 0, 0, 0), P0[2], P0[3], P0[4], P0[5],     pw0[0] = PKW(P0, 0), pw0[1] = PKW(P0, 2), pw0); \
    VRD(4); SBAR(); GAPA(C1 = __builtin_amdgcn_mfma_f32_32x32x16_bf16(kf[1], qr[0], negm, 0, 0, 0), P0[6], P0[7], P0[8], P0[9],     pw0[2] = PKW(P0, 4), pw0[3] = PKW(P0, 6), pw0); \
    VRD(1); SBAR(); GAPA(C0 = __builtin_amdgcn_mfma_f32_32x32x16_bf16(kf[2], qr[1], C0, 0, 0, 0),   P0[10], P0[11], P0[12], P0[13], pw1[0] = PKW(P0, 8), pw1[1] = PKW(P0, 10), pw1); \
    VRD(5); SBAR(); GAPA(C1 = __builtin_amdgcn_mfma_f32_32x32x16_bf16(kf[3], qr[1], C1, 0, 0, 0),   P0[14], P0[15], P1[0], P1[1],   pw1[2] = PKW(P0, 12), pw1[3] = PKW(P0, 14), pw1); \
    VRD(2); SBAR(); GAPA(C0 = __builtin_amdgcn_mfma_f32_32x32x16_bf16(kf[4], qr[2], C0, 0, 0, 0),   P1[2], P1[3], P1[4], P1[5],     pw2[0] = PKW(P1, 0), pw2[1] = PKW(P1, 2), pw2); \
    VRD(6); SBAR(); GAPA(C1 = __builtin_amdgcn_mfma_f32_32x32x16_bf16(kf[5], qr[2], C1, 0, 0, 0),   P1[6], P1[7], P1[8], P1[9],     pw2[2] = PKW(P1, 4), pw2[3] = PKW(P1, 6), pw2); \
    VRD(3); SBAR(); GAPA(C0 = __builtin_amdgcn_mfma_f32_32x32x16_bf16(kf[6], qr[3], C0, 0, 0, 0),   P1[10], P1[11], P1[12], P1[13], pw3[0] = PKW(P1, 8), pw3[1] = PKW(P1, 10), pw3); \
    VRD(7); SBAR(); GAPA(C1 = __builtin_amdgcn_mfma_f32_32x32x16_bf16(kf[7], qr[3], C1, 0, 0, 0),   P1[14], P1[15], 0.f, 0.f,       pw3[2] = PKW(P1, 12), pw3[3] = PKW(P1, 14), pw3); \
    l_reg += sacc; \
    if (GK) { DMA_K((t) + 3, sl_cur); } if (GV) { DMA_V((t) + 1, sl_next); } \
    CMASK(C0, C1, t); \
    { float a = MX3(C0[0], C0[1], C1[0]), b = MX3(C0[2], C0[3], C1[1]); a = MX3(a, C1[2], C1[3]); \
      _Pragma("unroll") for (int r = 4; r < 16; r += 4) { a = MX3(a, C0[r], C0[r + 1]); b = MX3(b, C0[r + 2], C0[r + 3]); a = MX3(a, C1[r], C1[r + 1]); b = MX3(b, C1[r + 2], C1[r + 3]); } \
      float rm = __builtin_fmaxf(a, b); { auto rr = __builtin_amdgcn_permlane32_swap(__float_as_uint(rm), __float_as_uint(rm), false, false); rm = __builtin_fmaxf(__uint_as_float(rr[0]), __uint_as_float(rr[1])); } \
      resc = false; \
      if (__builtin_expect(__any(rm > (float)THRL), 0)) { const float dl = __builtin_fmaxf(rm, 0.f); mhat += dl; \
        _Pragma("unroll") for (int r = 0; r < 16; ++r) { C0[r] -= dl; C1[r] -= dl; } \
        _Pragma("unroll") for (int r = 0; r < 16; ++r) negm[r] = -mhat; asm volatile("" : "+v"(negm)); \
        const float f = __builtin_amdgcn_exp2f(-dl); l_reg *= f; if (hi == 0) wsf[r32] = f; resc = true; } } \
    SBAR(); \
    GAPB(o[0] = __builtin_amdgcn_mfma_f32_32x32x16_bf16(PAF(0), VFR(0), o[0], 0, 0, 0), C0, 0); \
    GAPB(o[1] = __builtin_amdgcn_mfma_f32_32x32x16_bf16(PAF(0), VFR(4), o[1], 0, 0, 0), C0, 4); \
    KRD(GL, 0); GAPB(o[0] = __builtin_amdgcn_mfma_f32_32x32x16_bf16(PAF(1), VFR(1), o[0], 0, 0, 0), C0, 8); \
    KRD(GL, 1); GAPB(o[1] = __builtin_amdgcn_mfma_f32_32x32x16_bf16(PAF(1), VFR(5), o[1], 0, 0, 0), C0, 12); \
    KRD(GL, 2); GAPB(o[0] = __builtin_amdgcn_mfma_f32_32x32x16_bf16(PAF(2), VFR(2), o[0], 0, 0, 0), C1, 0); \
    KRD(GL, 3); GAPB(o[1] = __builtin_amdgcn_mfma_f32_32x32x16_bf16(PAF(2), VFR(6), o[1], 0, 0, 0), C1, 4); \
    GAPB(o[0] = __builtin_amdgcn_mfma_f32_32x32x16_bf16(PAF(3), VFR(3), o[0], 0, 0, 0), C1, 8); \
    GAPB(o[1] = __builtin_amdgcn_mfma_f32_32x32x16_bf16(PAF(3), VFR(7), o[1], 0, 0, 0), C1, 12); \
    } while (0)
    int t = 1;
    for (; t + 5 < NT; t += 2) {
        STEP(pB0, pB1, pA0, pA1, t, true, true, true);     WAIT_BAR(2); RESC(); ROT();
        STEP(pA0, pA1, pB0, pB1, t + 1, true, true, true); WAIT_BAR(2); RESC(); ROT();
    }
#define ENDW(tt) do { if ((tt) + 3 < NT) { WAIT_BAR(2); } else if ((tt) + 2 < NT) { WAIT_BAR(1); } else { WAIT_BAR(0); } } while (0)
    for (; t + 1 < NT; t += 2) {
        STEP(pB0, pB1, pA0, pA1, t, (t + 3 < NT), (t + 1 < NT), (t + 1 < NT));         ENDW(t);     RESC(); ROT();
        STEP(pA0, pA1, pB0, pB1, t + 1, (t + 4 < NT), (t + 2 < NT), (t + 2 < NT));     ENDW(t + 1); RESC(); ROT();
    }
    STEP(pB0, pB1, pA0, pA1, NT - 1, false, false, false); RESC();
    { float sacc = pB0[0] + pB0[1]; _Pragma("unroll") for (int r = 2; r < 16; ++r) sacc += pB0[r]; _Pragma("unroll") for (int r = 0; r < 16; ++r) sacc += pB1[r]; l_reg += sacc;
      pw0 = (u32x4){PKW(pB0, 0), PKW(pB0, 2), PKW(pB0, 4), PKW(pB0, 6)}; pw1 = (u32x4){PKW(pB0, 8), PKW(pB0, 10), PKW(pB0, 12), PKW(pB0, 14)}; pw2 = (u32x4){PKW(pB1, 0), PKW(pB1, 2), PKW(pB1, 4), PKW(pB1, 6)}; pw3 = (u32x4){PKW(pB1, 8), PKW(pB1, 10), PKW(pB1, 12), PKW(pB1, 14)};
      SBAR(); pv(o, vb0 + sl_cur, PAF(0), PAF(1), PAF(2), PAF(3)); }
#undef PKW
#undef PAF
#undef VFR
#undef PIN
#undef MX3
#undef GAPA
#undef GAPB
#undef EX
#undef VRD
#undef KRD
#undef STEP
#undef ENDW
    { auto rr = __builtin_amdgcn_permlane32_swap(__float_as_uint(l_reg), __float_as_uint(l_reg), false, false); l_reg = __uint_as_float(rr[0]) + __uint_as_float(rr[1]); }
    if (has_sink) l_reg += __builtin_amdgcn_exp2f(sinkl2 - mhat);
    if (hi == 0) wsf[32 + r32] = l_reg; asm volatile("s_waitcnt lgkmcnt(0)" ::: "memory");
    float rli[16];
#pragma unroll
    for (int r = 0; r < 16; ++r) rli[r] = __builtin_amdgcn_rcpf(wsf[32 + crow(r, hi)]);
    bf16* Ow = Ow0 + (long)(wid * QBLK) * YP;
    { bf16* stg = (bf16*)(shm + LDS_OST) + wid * 2048;
#pragma unroll
      for (int r = 0; r < 16; ++r) { const int orow = crow(r, hi);
#pragma unroll
        for (int d0 = 0; d0 < 2; ++d0) stg[orow * 64 + d0 * 32 + r32] = __float2bfloat16(o[d0][r] * rli[r]); }
      asm volatile("s_waitcnt lgkmcnt(0)" ::: "memory");
#pragma unroll
      for (int i = 0; i < 4; ++i) { const int row = i * 8 + (lane >> 3), ch = lane & 7; const u32x4 v = *(const u32x4*)(stg + row * 64 + ch * 8); *(u32x4*)(Ow + (long)row * YP + ch * 8) = v; } }
    asm volatile("s_waitcnt lgkmcnt(0)\n\ts_barrier" ::: "memory");
#undef DMA_K
#undef DMA_V
#undef TOFF
#undef CMASK
#undef START
#undef RESC
#undef ROT
}
constexpr int ATTN_LDS_BYTES = LDS_BYTES;
#undef SBAR
#undef WAIT_BAR
}

constexpr int NWAVES = 8, NTHREADS = NWAVES * 64;
constexpr int RING_BYTES = 131072, LDS_BYTES = 147456;
constexpr int LDSCTL_OFF = RING_BYTES, MISC_OFF = LDSCTL_OFF + 320;
#define LAS __attribute__((address_space(3)))
typedef unsigned short bf16;
typedef unsigned v4u __attribute__((ext_vector_type(4)));
typedef unsigned v2u __attribute__((ext_vector_type(2)));
typedef float f32x4 __attribute__((ext_vector_type(4)));
using pg8::cvt_pk_bf16; using pg8::bf_lo; using pg8::bf_hi;

constexpr size_t MiB = 1u << 20;
constexpr size_t WS_MOD = 0;
constexpr size_t WS_CTL = 1 * MiB, CTL_ZERO_BYTES = 16384;
constexpr size_t WS_W = 2 * MiB;
constexpr size_t LW_IN = 0;
constexpr size_t LW_POOL = LW_IN + (size_t)5120 * 1024 * 2;
constexpr size_t LW_BR = LW_POOL + (size_t)512 * 256 * 2;
constexpr size_t LW_OUT = LW_BR + (size_t)3072 * 512 * 2;
constexpr size_t LW_FF = LW_OUT + (size_t)1024 * 1024 * 2;
constexpr size_t LW_DN = LW_FF + (size_t)5632 * 1024 * 2;
constexpr size_t LW_BYTES = LW_DN + (size_t)1024 * 2816 * 2;
constexpr size_t WS_XC = WS_W + ((2 * LW_BYTES + MiB - 1) / MiB) * MiB;
constexpr size_t WS_ARENA = WS_XC + (size_t)NCTX * 1024 * 4;
constexpr size_t AR_Z = 0, AR_G = (size_t)NTOK * ZP * 2, AR_Y = AR_G + (size_t)NTOK * GP * 2, AR_H = AR_Y;
constexpr size_t AR_MRG = AR_Z;
constexpr size_t AR_U = 0, AR_SIDE = (size_t)NTOK * FF * 2, SIDE_BYTES = (size_t)(NTOK / 32) * FF * 4, AR_H2 = (size_t)NTOK * AVP * 2;
constexpr size_t AR_XF = ((AR_SIDE + 3 * SIDE_BYTES + 4095) / 4096) * 4096;
static_assert(AR_XF + (size_t)NLAT * 1024 * 4 <= AR_H2, "side buffers + XF");
constexpr size_t WS_END = WS_ARENA + (size_t)NTOK * 6656 * 2;
static_assert(AR_Y + (size_t)NTOK * YP * 2 == (size_t)NTOK * 6656 * 2 && AR_H2 + (size_t)NTOK * 1024 * 2 == (size_t)NTOK * 6656 * 2, "arena views");


#define XB_TMO      128
#define XB_XCNT(j)  (256  + 64 * (j))
#define XB_XSUB(j)  (1280 + 64 * (j))
#define XB_XGEN(j)  (2304 + 64 * (j))
#define XB_TOP      3328
#define XB_TOPGEN   3392
#define XCD_BAR_WORDS 3456
#define XB_SPIN_CAP (1u << 20)
__device__ __forceinline__ unsigned xb_ld(unsigned* p)              { return __hip_atomic_load(p, __ATOMIC_RELAXED, __HIP_MEMORY_SCOPE_AGENT); }
__device__ __forceinline__ unsigned xb_add(unsigned* p, unsigned v) { return __hip_atomic_fetch_add(p, v, __ATOMIC_RELAXED, __HIP_MEMORY_SCOPE_AGENT); }
__device__ __forceinline__ unsigned xb_xcc_id() { return (unsigned)__builtin_amdgcn_s_getreg((3 << 11) | 20) & 0xFu; }
#define XB_SPIN(cond, bar) do { unsigned _sp = 0; while (cond) { __builtin_amdgcn_s_sleep(1); \
    if ((++_sp & 255u) == 0u) { if (xb_ld(&(bar)[XB_TMO])) break; if (_sp > XB_SPIN_CAP) { atomicAdd(&(bar)[XB_TMO], 1u); break; } } } } while (0)
struct XcdBarrier { unsigned* bar; unsigned x; volatile LAS unsigned* st; };
__device__ __forceinline__ XcdBarrier xcd_barrier_post(unsigned* bar, volatile LAS unsigned* st) {
    XcdBarrier b; b.bar = bar; b.x = xb_xcc_id(); b.st = st;
    if (threadIdx.x == 0) (void)xb_add(&bar[XB_XCNT(b.x)], 1u);
    return b;
}
__device__ __forceinline__ void xcd_barrier_complete(unsigned* bar, unsigned x, unsigned& nloc, unsigned& nx) {
    const unsigned G = gridDim.x * gridDim.y * gridDim.z;
    unsigned sum, cnt, mine, sp = 0u;
    for (;;) {
        sum = 0u; cnt = 0u; mine = 0u;
#pragma unroll
        for (unsigned j = 0; j < 16; ++j) { const unsigned c = xb_ld(&bar[XB_XCNT(j)]); sum += c; cnt += (c > 0u) ? 1u : 0u; mine = (j == x) ? c : mine; }
        if (sum == G) break;
        __builtin_amdgcn_s_sleep(1);
        if ((++sp & 255u) == 0u) { if (xb_ld(&bar[XB_TMO])) break; if (sp > XB_SPIN_CAP) { atomicAdd(&bar[XB_TMO], 1u); break; } }
    }
    nloc = mine > 0u ? mine : 1u; nx = cnt > 0u ? cnt : 1u;
}
__device__ __forceinline__ void xcd_barrier(const XcdBarrier& b, int wave) {
    asm volatile("s_waitcnt vmcnt(0)" ::: "memory");
    __syncthreads();
    if (wave == 0 && lane_fresh() == 0) {
        unsigned* bar = b.bar;
        __builtin_amdgcn_s_waitcnt(0);
        unsigned nloc = b.st[0], nx = b.st[1];
        if (nloc == 0u) { xcd_barrier_complete(bar, b.x, nloc, nx); b.st[0] = nloc; b.st[1] = nx; }
        const unsigned old = xb_add(&bar[XB_XSUB(b.x)], 1u);
        const unsigned gen = old / nloc;
        if (old + 1u == (gen + 1u) * nloc) {
            __builtin_amdgcn_fence(__ATOMIC_RELEASE, "agent");
            asm volatile("s_waitcnt vmcnt(0)" ::: "memory");
            const unsigned og = xb_add(&bar[XB_TOP], 1u);
            const unsigned tg = og / nx;
            if (og + 1u == (tg + 1u) * nx) xb_add(&bar[XB_TOPGEN], 1u);
            else XB_SPIN(xb_ld(&bar[XB_TOPGEN]) == tg, bar);
            __builtin_amdgcn_fence(__ATOMIC_ACQUIRE, "agent");
            xb_add(&bar[XB_XGEN(b.x)], 1u);
            asm volatile("s_waitcnt vmcnt(0)" ::: "memory");
        } else {
            XB_SPIN(xb_ld(&bar[XB_XGEN(b.x)]) == gen, bar);
            __builtin_amdgcn_fence(__ATOMIC_ACQUIRE, "agent");
            asm volatile("s_waitcnt vmcnt(0)" ::: "memory");
        }
    }
    __syncthreads();
}

struct Args {
    const float *x, *c, *ctx, *c_ctx, *w_mod, *b_mod, *norm1_g, *norm2_g, *w_in, *w_pool_grp, *pool_scale, *win_sink, *q_norm_g, *k_norm_g,
                *w_branch, *w_gate, *b_gate, *w_out, *w_ff_gate, *w_ff_val, *conv_w, *conv_b, *w_ff_down, *final_g;
    float* out; unsigned char* ws; int ph_lo, ph_hi;
};

__device__ __forceinline__ float shx(float v, int lane, int m) { return __int_as_float(__builtin_amdgcn_ds_bpermute((lane ^ m) << 2, __float_as_int(v))); }
__device__ __forceinline__ float wave_sum(float v, int lane) {
#pragma unroll
    for (int o = 1; o < 64; o <<= 1) v += shx(v, lane, o);
    return v;
}
__device__ __forceinline__ void transpose_item(const float* W, int K, int N, bf16* WT, int ldw, int row_off, LAS float* scr, int item, int lane, bool spread = false, float wscale = 1.0f) {
    const int nblk = N / 32, kb = item / nblk, nb = item % nblk, k0 = 64 * kb, n0 = 32 * nb;
    if (spread) row_off += 128 * (n0 >> 7);
#pragma unroll 8
    for (int i = 0; i < 32; ++i) { const int kk = 2 * i + (lane >> 5); scr[kk * 33 + (lane & 31)] = W[(size_t)(k0 + kk) * N + n0 + (lane & 31)]; }
    asm volatile("s_waitcnt lgkmcnt(0)" ::: "memory");
    const int c = lane & 7;
#pragma unroll
    for (int j = 0; j < 4; ++j) { const int n = (lane >> 3) + 8 * j; const LAS float* s = scr + (8 * c) * 33 + n;
        v4u o; o.x = cvt_pk_bf16(s[0 * 33] * wscale, s[1 * 33] * wscale); o.y = cvt_pk_bf16(s[2 * 33] * wscale, s[3 * 33] * wscale); o.z = cvt_pk_bf16(s[4 * 33] * wscale, s[5 * 33] * wscale); o.w = cvt_pk_bf16(s[6 * 33] * wscale, s[7 * 33] * wscale);
        *(v4u*)(WT + (size_t)(row_off + n0 + n) * ldw + k0 + 8 * c) = o; }
    asm volatile("s_waitcnt lgkmcnt(0)" ::: "memory");
}

__device__ __forceinline__ void prologue(const Args& A, LAS unsigned char* lds, int G, int vcu, int tid, int lane, int wave) {
    float* mod = (float*)(A.ws + WS_MOD);
    if ((int)blockIdx.x < 192) {
        LAS float* S = (LAS float*)lds; LAS float* part = (LAS float*)(lds + 17 * 1024 * 4);
        for (int idx = tid; idx < 17 * 1024; idx += NTHREADS) { const int r = idx >> 10, k = idx & 1023; const float v = (r < 16) ? A.c[r * 1024 + k] : A.c_ctx[k];
            S[idx] = v / (1.0f + __builtin_amdgcn_exp2f(-v * LOG2E)); }
        __syncthreads();
        for (int u = blockIdx.x; u < 192; u += G) {
            const int l = u / 96, n0 = (u % 96) * 64;
            float acc[17];
#pragma unroll
            for (int r = 0; r < 17; ++r) acc[r] = 0.f;
            const float* W = A.w_mod + (size_t)l * 1024 * 6144 + n0 + lane;
#pragma unroll 16
            for (int kk = 0; kk < 128; ++kk) { const int k = kk * 8 + wave; const float w = W[(size_t)k * 6144];
#pragma unroll
                for (int r = 0; r < 17; ++r) acc[r] += S[r * 1024 + k] * w; }
#pragma unroll
            for (int r = 0; r < 17; ++r) part[(wave * 17 + r) * 64 + lane] = acc[r];
            __syncthreads();
            for (int idx = tid; idx < 17 * 64; idx += NTHREADS) { const int r = idx >> 6, j = idx & 63; float s = 0.f;
#pragma unroll
                for (int w = 0; w < 8; ++w) s += part[(w * 17 + r) * 64 + j];
                mod[(size_t)(l * 17 + r) * 6144 + n0 + j] = s + A.b_mod[l * 6144 + n0 + j]; }
            __syncthreads();
        }
    }
    __syncthreads();
    LAS float* scr = (LAS float*)(lds + wave * 16384);
    const int gw = vcu * NWAVES + wave, NGW = G * NWAVES;
    constexpr int I_IN = 16 * 64, I_GATE = 16 * 32, I_BR = 8 * 32, I_OUT = 16 * 32, I_FF = 16 * 88, I_DN = 44 * 32;
    constexpr int PER_LAYER = I_IN + 3 * I_GATE + 2 * I_BR + I_OUT + 2 * I_FF + I_DN;
    for (int it = gw; it < 2 * PER_LAYER; it += NGW) {
        const int l = it / PER_LAYER; int r = it % PER_LAYER;
        unsigned char* wl = A.ws + WS_W + (size_t)l * LW_BYTES;
        if (r < I_IN) { transpose_item(A.w_in + (size_t)l * 1024 * 2048, 1024, 2048, (bf16*)(wl + LW_IN), 1024, 0, scr, r, lane); continue; } r -= I_IN;
        if (r < 3 * I_GATE) { const int i = r / I_GATE; transpose_item(A.w_gate + ((size_t)l * 3 + i) * 1024 * 1024, 1024, 1024, (bf16*)(wl + LW_IN), 1024, 2048 + i * 1024, scr, r % I_GATE, lane, false, -LOG2E); continue; } r -= 3 * I_GATE;
        if (r < 2 * I_BR) { const int i = 1 + r / I_BR; transpose_item(A.w_branch + ((size_t)l * 3 + i) * 512 * 1024, 512, 1024, (bf16*)(wl + LW_BR), 512, i * 1024, scr, r % I_BR, lane); continue; } r -= 2 * I_BR;
        if (r < I_OUT) { transpose_item(A.w_out + (size_t)l * 1024 * 1024, 1024, 1024, (bf16*)(wl + LW_OUT), 1024, 0, scr, r, lane); continue; } r -= I_OUT;
        if (r < I_FF) { transpose_item(A.w_ff_gate + (size_t)l * 1024 * FF, 1024, FF, (bf16*)(wl + LW_FF), 1024, 0, scr, r, lane, true); continue; } r -= I_FF;
        if (r < I_FF) { transpose_item(A.w_ff_val + (size_t)l * 1024 * FF, 1024, FF, (bf16*)(wl + LW_FF), 1024, 128, scr, r, lane, true); continue; } r -= I_FF;
        transpose_item(A.w_ff_down + (size_t)l * FF * 1024, FF, 1024, (bf16*)(wl + LW_DN), FF, 0, scr, r, lane);
    }
}

__device__ __forceinline__ void weff_phase(const Args& A, int gw, int NGW) {
    const int lane = lane_fresh(); asm volatile("" : "+s"(gw));
    for (int task = gw; task < 2 * 4 * 16 * 8; task += NGW) {
        const int l = task >> 9, r = task & 511, g = r >> 7, nb = (r >> 3) & 15, cb = r & 7, n = nb * 64 + lane, c0 = cb * 16;
        const float* wg = A.w_pool_grp + (((size_t)l * 4 + g) * 128 + c0) * 128;
        const float* wb = A.w_branch + ((size_t)l * 3 * 512 + g * 128) * 1024 + n;
        const float* ps = A.pool_scale + (size_t)l * 512 + g * 128;
        float acc[16];
#pragma unroll
        for (int cc = 0; cc < 16; ++cc) acc[cc] = 0.f;
#pragma unroll 4
        for (int d = 0; d < 128; ++d) { const float x = wb[(size_t)d * 1024] * ps[d];
#pragma unroll
            for (int cc = 0; cc < 16; ++cc) acc[cc] += wg[cc * 128 + d] * x; }
        bf16* dst = (bf16*)(A.ws + WS_W + (size_t)l * LW_BYTES + LW_BR) + (size_t)n * 512 + g * 128 + c0;
        v4u w0, w1; w0.x = cvt_pk_bf16(acc[0], acc[1]); w0.y = cvt_pk_bf16(acc[2], acc[3]); w0.z = cvt_pk_bf16(acc[4], acc[5]); w0.w = cvt_pk_bf16(acc[6], acc[7]);
        w1.x = cvt_pk_bf16(acc[8], acc[9]); w1.y = cvt_pk_bf16(acc[10], acc[11]); w1.z = cvt_pk_bf16(acc[12], acc[13]); w1.w = cvt_pk_bf16(acc[14], acc[15]);
        *(v4u*)dst = w0; *(v4u*)(dst + 8) = w1;
    }
}

template <bool SRC_BF16>
__device__ __forceinline__ void norm_rows(const void* xlat, const void* xctx, const float* gvec, const float* modl, int which, int nrows, bf16* H, int gw, int NGW) {
    const int lane = lane_fresh(); asm volatile("" : "+s"(gw));
    constexpr int R = 4;
    for (int row0 = gw * R; row0 < nrows; row0 += NGW * R) {
        const bool lat = row0 < NLAT;
        const size_t roff = lat ? (size_t)row0 * 1024 : (size_t)(row0 - NLAT) * 1024;
        const void* srcb = lat ? xlat : xctx;
        const int b = lat ? (row0 >> 12) : NB;
        const float* shp = modl + (size_t)(b * 6 + which * 3) * 1024; const float* scp = shp + 1024;
        float v[R][2][8]; float ss[R];
#pragma unroll
        for (int r = 0; r < R; ++r)
#pragma unroll
            for (int j = 0; j < 2; ++j) { const size_t o = roff + (size_t)r * 1024 + 8 * lane + 512 * j;
                if constexpr (SRC_BF16) { const v4u w = *(const v4u*)((const bf16*)srcb + o);
                    v[r][j][0] = bf_lo(w.x); v[r][j][1] = bf_hi(w.x); v[r][j][2] = bf_lo(w.y); v[r][j][3] = bf_hi(w.y); v[r][j][4] = bf_lo(w.z); v[r][j][5] = bf_hi(w.z); v[r][j][6] = bf_lo(w.w); v[r][j][7] = bf_hi(w.w); }
                else { const f32x4 a = *(const f32x4*)((const float*)srcb + o), c = *(const f32x4*)((const float*)srcb + o + 4);
                    v[r][j][0] = a.x; v[r][j][1] = a.y; v[r][j][2] = a.z; v[r][j][3] = a.w; v[r][j][4] = c.x; v[r][j][5] = c.y; v[r][j][6] = c.z; v[r][j][7] = c.w; } }
#pragma unroll
        for (int r = 0; r < R; ++r) { float s = 0.f;
#pragma unroll
            for (int j = 0; j < 2; ++j)
#pragma unroll
                for (int i = 0; i < 8; ++i) s += v[r][j][i] * v[r][j][i];
            ss[r] = s; }
#pragma unroll
        for (int o = 1; o < 64; o <<= 1)
#pragma unroll
            for (int r = 0; r < R; ++r) ss[r] += shx(ss[r], lane, o);
#pragma unroll
        for (int j = 0; j < 2; ++j) { const int c0 = 8 * lane + 512 * j; float gm[8], sh[8];
#pragma unroll
            for (int h = 0; h < 2; ++h) { const f32x4 g = *(const f32x4*)(gvec + c0 + 4 * h), s4 = *(const f32x4*)(shp + c0 + 4 * h), sc = *(const f32x4*)(scp + c0 + 4 * h);
#pragma unroll
                for (int e = 0; e < 4; ++e) { gm[4 * h + e] = g[e] * (sc[e] + 1.0f); sh[4 * h + e] = s4[e]; } }
#pragma unroll
            for (int r = 0; r < R; ++r) { const float rstd = __builtin_amdgcn_rsqf(ss[r] * (1.f / 1024.f) + EPS); float y[8];
#pragma unroll
                for (int i = 0; i < 8; ++i) y[i] = (v[r][j][i] * rstd) * gm[i] + sh[i];
                v4u w; w.x = cvt_pk_bf16(y[0], y[1]); w.y = cvt_pk_bf16(y[2], y[3]); w.z = cvt_pk_bf16(y[4], y[5]); w.w = cvt_pk_bf16(y[6], y[7]);
                *(v4u*)(H + (size_t)(row0 + r) * 1024 + c0) = w; } }
    }
}
__device__ __forceinline__ void final_norm_rows(const float* x, float* out, const float* gvec, int gw, int NGW) {
    const int lane = lane_fresh(); asm volatile("" : "+s"(gw));
    constexpr int R = 4;
    for (int row0 = gw * R; row0 < NLAT; row0 += NGW * R) {
        f32x4 v[R][4]; float ss[R];
#pragma unroll
        for (int r = 0; r < R; ++r)
#pragma unroll
            for (int j = 0; j < 4; ++j) v[r][j] = *(const f32x4*)(x + (size_t)(row0 + r) * 1024 + 4 * lane + 256 * j);
#pragma unroll
        for (int r = 0; r < R; ++r) { float s = 0.f;
#pragma unroll
            for (int j = 0; j < 4; ++j) s += (v[r][j].x * v[r][j].x + v[r][j].y * v[r][j].y) + (v[r][j].z * v[r][j].z + v[r][j].w * v[r][j].w);
            ss[r] = s; }
#pragma unroll
        for (int o = 1; o < 64; o <<= 1)
#pragma unroll
            for (int r = 0; r < R; ++r) ss[r] += shx(ss[r], lane, o);
#pragma unroll
        for (int j = 0; j < 4; ++j) { const int c0 = 4 * lane + 256 * j; const f32x4 g = *(const f32x4*)(gvec + c0);
#pragma unroll
            for (int r = 0; r < R; ++r) { const float rstd = __builtin_amdgcn_rsqf(ss[r] * (1.f / 1024.f) + EPS); *(f32x4*)(out + (size_t)(row0 + r) * 1024 + c0) = v[r][j] * rstd * g; } }
    }
}

__device__ __forceinline__ void unpack8(const v4u w, float* v) { v[0] = bf_lo(w.x); v[1] = bf_hi(w.x); v[2] = bf_lo(w.y); v[3] = bf_hi(w.y); v[4] = bf_lo(w.z); v[5] = bf_hi(w.z); v[6] = bf_lo(w.w); v[7] = bf_hi(w.w); }
__device__ __forceinline__ v4u pack8(const float* v) { v4u w; w.x = cvt_pk_bf16(v[0], v[1]); w.y = cvt_pk_bf16(v[2], v[3]); w.z = cvt_pk_bf16(v[4], v[5]); w.w = cvt_pk_bf16(v[6], v[7]); return w; }
__device__ __forceinline__ void qk_proc(float* v, bool do_norm, const float* g, bool do_rope, bool hi_half, const float* cs, const float* sn, float scale, int lane) {
    float ss = 0.f;
#pragma unroll
    for (int i = 0; i < 8; ++i) ss += v[i] * v[i];
    ss += shx(ss, lane, 1); ss += shx(ss, lane, 2); ss += shx(ss, lane, 4);
    const float rstd = __builtin_amdgcn_rsqf(ss * (1.f / 64.f) + EPS);
#pragma unroll
    for (int i = 0; i < 8; ++i) { const float nv = v[i] * rstd * g[i]; v[i] = do_norm ? nv : v[i]; }
#pragma unroll
    for (int i = 0; i < 8; ++i) { const float pvv = shx(v[i], lane, 2);
        const float rv = hi_half ? (v[i] * cs[i] + pvv * sn[i]) : (v[i] * cs[i] - pvv * sn[i]);
        v[i] = (do_rope ? rv : v[i]) * scale; }
}
template <int W2> __device__ __forceinline__ void pool_quad(const bf16* __restrict__ Z, bf16* __restrict__ Y, int row, int t, int L, int ch) {
    int lo = t - W2; lo = lo < 0 ? 0 : lo; int hi = t + W2; hi = hi > L ? L : hi;
    const bf16* zc = Z + (size_t)(row - t) * ZP + ch;
    const v4u zero = {0u, 0u, 0u, 0u};
    v4u pw[2 * W2];
#pragma unroll
    for (int jj = 0; jj < 2 * W2; ++jj) { const int r = lo + jj; pw[jj] = (r < hi) ? *(const v4u*)(zc + (size_t)r * ZP) : zero; }
    const v4u own_w = *(const v4u*)(zc + (size_t)t * ZP);
    float acc[8];
#pragma unroll
    for (int i = 0; i < 8; ++i) acc[i] = 0.f;
#pragma unroll
    for (int jj = 0; jj < 2 * W2; ++jj) { float u[8]; unpack8(pw[jj], u);
#pragma unroll
        for (int i = 0; i < 8; ++i) acc[i] += u[i]; }
    float own[8]; unpack8(own_w, own); const float rc = 1.0f / (float)(hi - lo);
#pragma unroll
    for (int i = 0; i < 8; ++i) acc[i] = acc[i] * rc - own[i];
    *(v4u*)(Y + (size_t)row * YP + ch) = pack8(acc);
}
__device__ __forceinline__ void elem_phase(const Args& A, int layer, int nrows, int nrows_pool, bf16* Z, bf16* Y, int gw, int NGW) {
    const int lane = lane_fresh(); asm volatile("" : "+s"(gw));
    for (int q = gw; q < nrows_pool / 4; q += NGW) {
        const int row = 4 * q + (lane >> 4), c16 = (lane & 15) * 8;
        const bool lat = row < NLAT;
        const int t = lat ? (row & (SEQ - 1)) : ((row - NLAT) & (CTX - 1));
        const int L = lat ? SEQ : CTX;
        pool_quad<8>(Z, Y, row, t, L, 384 + c16);
        pool_quad<4>(Z, Y, row, t, L, 256 + c16);
        pool_quad<2>(Z, Y, row, t, L, 128 + c16);
        pool_quad<1>(Z, Y, row, t, L, c16);
    }
    const int j8 = lane & 7; const bool hi_half = (j8 >> 1) & 1; const int axis = j8 >> 2, fbase = (j8 & 1) * 8;
    float inv[8], kg[8];
#pragma unroll
    for (int i = 0; i < 8; ++i) { inv[i] = __builtin_amdgcn_exp2f(-(float)(fbase + i) * (13.287712379549449f / 16.0f)) * 0.15915494309189535f;
        kg[i] = A.k_norm_g[layer * 64 + j8 * 8 + i]; }
    for (int p = gw; p < nrows / 2; p += NGW) {
        const int row = 2 * p + (lane >> 5);
        const bool lat = row < NLAT;
        const int t = lat ? (row & (SEQ - 1)) : ((row - NLAT) & (CTX - 1));
        bf16* zrow = Z + (size_t)row * ZP;
        const int l5 = lane & 31; const bool isg = l5 >= 16; const int kcol = isg ? 1792 + (l5 - 16) * 8 : 1024 + l5 * 8;
        const v4u k_w = *(const v4u*)(zrow + kcol);
        float cs[8], sn[8];
        { const float pos = (float)(axis ? (t & 63) : (t >> 6));
#pragma unroll
          for (int i = 0; i < 8; ++i) { float r = pos * inv[i]; r = r - __builtin_floorf(r); cs[i] = __builtin_amdgcn_cosf(r); sn[i] = __builtin_amdgcn_sinf(r); } }
        float vk[8];
        unpack8(k_w, vk); qk_proc(vk, isg, kg, lat, hi_half, cs, sn, 1.0f, lane);
        *(v4u*)(zrow + kcol) = pack8(vk);
    }
}

__device__ __forceinline__ void fixup_phase(const Args& A, int layer, int nrows, bf16* U, const float* As, const float* PAs, const float* Vs, int gbase, int NT) {
    const int gtid = gbase + lane_fresh();
    const int items = (nrows / 32) * 352;
    const float* cw = A.conv_w + (size_t)layer * 3 * FF;
    for (int it = gtid; it < items; it += NT) {
        const int c8 = it % 352, brow = it / 352, side = brow & 1, col = c8 * 8;
        const int r = (brow >> 1) * 64 + (side ? 63 : 0);
        const bool lat = r < NLAT; const int L = lat ? SEQ : CTX; const int t = lat ? (r & (SEQ - 1)) : ((r - NLAT) & (CTX - 1));
        const bool has = side ? (t != L - 1) : (t != 0);
        const int nb = has ? (side ? brow + 1 : brow - 1) : brow;
        const float* wp = cw + (side ? 2 * FF : 0) + col;
        const size_t so = (size_t)brow * FF + col, sn = (size_t)nb * FF + col;
        float o[8];
#pragma unroll
        for (int h = 0; h < 2; ++h) { const f32x4 pa = *(const f32x4*)(PAs + so + 4 * h), vv = *(const f32x4*)(Vs + so + 4 * h), an = *(const f32x4*)(As + sn + 4 * h), w = *(const f32x4*)(wp + 4 * h);
#pragma unroll
            for (int e = 0; e < 4; ++e) { const float pre = pa[e] + (has ? w[e] * an[e] : 0.f); o[4 * h + e] = pre * pg8::sigmoidf_(pre) * vv[e]; } }
        *(v4u*)(U + (size_t)r * FF + col) = pack8(o);
    }
}

__device__ __forceinline__ void attention_phase(const Args& A, int layer, bool last, bf16* Z, bf16* Y, char* shm, int G, int vcu, int wave) {
    using abf = attn_body::bf16;
    asm volatile("" : "+s"(vcu), "+s"(G));
    const float* sink = A.win_sink + layer * 8;
    const int NU = NB * 8 * 16, per = (NU + G - 1) / G;
    int u0 = vcu * per, u1 = u0 + per; if (u1 > NU) u1 = NU;
    for (int u = u0; u < u1; ++u) {
        const int qb = u & 15, h = (u >> 4) & 7, b = u >> 7, kvh = h >> 2;
        const size_t qrow = (size_t)b * SEQ + qb * 256, crow0 = (size_t)NLAT + (size_t)b * CTX;
        const abf* Q = (const abf*)Z + qrow * ZP + 1280 + h * 64;
        const abf* Kc = (const abf*)Z + crow0 * ZP + 1792 + kvh * 64; const abf* Vc = (const abf*)Z + crow0 * ZP + 1920 + kvh * 64;
        const long dlat = ((long)b * SEQ - (long)crow0) * ZP;
        attn_body::attn_unit<8, false>(Q, Kc, Vc, dlat, 68, 0, false, 0.f, (abf*)Y + qrow * YP + 1024 + h * 64, shm, wave, true, A.q_norm_g + layer * 64, qb * 256);
    }
    for (int u = u0; u < u1; ++u) {
        const int qb = u & 15, h = (u >> 4) & 7, b = u >> 7, kvh = h >> 2;
        const size_t qrow = (size_t)b * SEQ + qb * 256, crow0 = (size_t)NLAT + (size_t)b * CTX;
        int tl0 = 4 * qb - 2; tl0 = tl0 < 0 ? 0 : tl0; int tl1 = 4 * qb + 6; tl1 = tl1 > 64 ? 64 : tl1;
        const abf* Q = (const abf*)Z + qrow * ZP + 512 + h * 64;
        const abf* Kc = (const abf*)Z + crow0 * ZP + 1024 + kvh * 64; const abf* Vc = (const abf*)Z + crow0 * ZP + 1152 + kvh * 64;
        const long dlat = ((long)b * SEQ + tl0 * 64 - (long)crow0) * ZP;
        attn_body::attn_unit<8, true>(Q, Kc, Vc, dlat, 4 + (tl1 - tl0), tl0 * 64 - qb * 256, true, sink[h] * LOG2E, (abf*)Y + qrow * YP + 512 + h * 64, shm, wave, true, nullptr, qb * 256);
    }
    if (!last) {
        const int NUC = 2 * NB * 8;
        for (int u = vcu; u < NUC; u += G) {
            const int mixer = u & 1, h = (u >> 1) & 7, b = u >> 4, kvh = h >> 2;
            const size_t crow0 = (size_t)NLAT + (size_t)b * CTX;
            const int qc = mixer ? 1280 : 512, kc = mixer ? 1792 : 1024, vc = mixer ? 1920 : 1152, oc = mixer ? 1024 : 512;
            attn_body::attn_unit<8, false>((const abf*)Z + crow0 * ZP + qc + h * 64, (const abf*)Z + crow0 * ZP + kc + kvh * 64, (const abf*)Z + crow0 * ZP + vc + kvh * 64, 0, 4, 0,
                                           mixer == 0, sink[h] * LOG2E, (abf*)Y + crow0 * YP + oc + h * 64, shm, wave, false, mixer ? A.q_norm_g + layer * 64 : nullptr, 0);
        }
    }
}

__global__ void __launch_bounds__(NTHREADS, 2) fwd_megakernel(Args A) {
    extern __shared__ __attribute__((aligned(16))) unsigned char lds_raw[];
    LAS unsigned char* lds = (LAS unsigned char*)lds_raw;
    const int wave = __builtin_amdgcn_readfirstlane(threadIdx.x >> 6);
    const int G = gridDim.x; const int bx = blockIdx.x; const int vcu = (G % 8 == 0) ? (bx % 8) * (G / 8) + bx / 8 : bx;
    const int gw = vcu * NWAVES + wave, NGW = G * NWAVES;
    const int lo = A.ph_lo, hi = A.ph_hi;
    int ph = 0;
#if MK_SPLIT
#define SEAM() do { ++ph; } while (0)
#else
    cg::grid_group grid = cg::this_grid();
    for (int u = threadIdx.x; u < (LDS_BYTES - LDSCTL_OFF) / 4; u += NTHREADS) ((LAS unsigned*)(lds + LDSCTL_OFF))[u] = 0u;
    __syncthreads();
    XcdBarrier bar = xcd_barrier_post((unsigned*)(A.ws + WS_CTL), (volatile LAS unsigned*)(lds + MISC_OFF) + 8);
#define SEAM() do { if (ph == 0) grid.sync(); else xcd_barrier(bar, wave); ++ph; } while (0)
#endif
#define IN() (lo <= ph && ph < hi)
    unsigned char* ws = A.ws;
    float* mod = (float*)(ws + WS_MOD);
    bf16* XB = (bf16*)A.out;
    bf16* XCB = (bf16*)(ws + WS_XC);
    unsigned char* ar = ws + WS_ARENA;
    bf16* Z = (bf16*)(ar + AR_Z); bf16* Gt = (bf16*)(ar + AR_G); bf16* Y = (bf16*)(ar + AR_Y); bf16* H = (bf16*)(ar + AR_H);
    bf16* Mrg = (bf16*)(ar + AR_MRG); bf16* U = (bf16*)(ar + AR_U); bf16* H2 = (bf16*)(ar + AR_H2);
    float* XF = (float*)(ar + AR_XF); float* SAs = (float*)(ar + AR_SIDE); float* SPA = (float*)(ar + AR_SIDE + SIDE_BYTES); float* SVs = (float*)(ar + AR_SIDE + 2 * SIDE_BYTES);

    if (IN()) for (int rep = 0; rep < ((DUP_MASK & 32) ? 2 : 1); ++rep) { const int lane = lane_fresh(); prologue(A, lds, G, vcu, wave * 64 + lane, lane, wave); __syncthreads(); }
    SEAM();
    for (int l = 0; l < 2; ++l) {
        const bool last = (l == 1);
        const int nrows_mix = NTOK, nrows_x = last ? NLAT : NTOK;
        const int nM_mix = nrows_mix / 256, nM_x = nrows_x / 256;
        const float* modl = mod + (size_t)l * 17 * 6144;
        const unsigned char* wl = ws + WS_W + (size_t)l * LW_BYTES;
        if (IN()) { if (l == 0) { norm_rows<false>(A.x, A.ctx, A.norm1_g + l * 1024, modl, 0, nrows_mix, H, gw, NGW); weff_phase(A, gw, NGW); } else norm_rows<true>(XB, XCB, A.norm1_g + l * 1024, modl, 0, nrows_mix, H, gw, NGW); }
        SEAM();
        if (IN()) for (int rep = 0; rep < ((DUP_MASK & 1) ? 2 : 1); ++rep) { pg8::Gemm g{H, (const bf16*)(wl + LW_IN), 1024, 1024, 1024, 0, 0}; pg8::Order S; if (!last) S.init(nM_mix, 20, G, bx, 1, 0); else S.init(NLAT / 256, 20, G, bx, 1, 0, 2 * (NCTX / 256));
            pg8::EpiIn E{Z, Gt, A.b_gate + (size_t)l * 3072};
            pg8::gemm_phase<pg8::EpiIn, true>(lds, g, S, E, wave); }
        SEAM();
        if (IN()) elem_phase(A, l, nrows_mix, nrows_x, Z, Y, gw, NGW);
        SEAM();
        if (IN()) { for (int rep = 0; rep < ((DUP_MASK & 2) ? 2 : 1); ++rep) attention_phase(A, l, last, Z, Y, (char*)lds_raw, G, vcu, wave);
        }
        SEAM();
        if (IN()) for (int rep = 0; rep < ((DUP_MASK & 16) ? 2 : 1); ++rep) { pg8::Gemm g{Y, (const bf16*)(wl + LW_BR), YP, 512, 512, 512, (long)1024 * 512}; pg8::Order S; S.init(nM_x, 4, G, bx, 3, 2);
            pg8::EpiMerge E{Gt, Mrg};
            pg8::gemm_phase<pg8::EpiMerge, true>(lds, g, S, E, wave); }
        SEAM();
        if (IN()) { pg8::Gemm g{Mrg, (const bf16*)(wl + LW_OUT), 1024, 1024, 1024, 0, 0}; pg8::Order S; S.init(nM_x, 4, G, bx, 1, 0);
            if (l == 0) { pg8::EpiRes<false, true> E{A.x, A.ctx, XB, XCB, modl, 2}; pg8::gemm_phase<pg8::EpiRes<false, true>, true>(lds, g, S, E, wave); }
            else { pg8::EpiRes<true, true> E{XB, XCB, XB, XCB, modl, 2}; pg8::gemm_phase<pg8::EpiRes<true, true>, true>(lds, g, S, E, wave); } }
        SEAM();
        if (IN()) norm_rows<true>(XB, XCB, A.norm2_g + l * 1024, modl, 1, nrows_x, H2, gw, NGW);
        SEAM();
        if (IN()) for (int rep = 0; rep < ((DUP_MASK & 4) ? 2 : 1); ++rep) { pg8::Gemm g{H2, (const bf16*)(wl + LW_FF), 1024, 1024, 1024, 0, 0}; pg8::Order S; S.init(nM_x, 22, G, bx, 1, 0);
            pg8::EpiFF E{U, A.conv_w + (size_t)l * 3 * FF, A.conv_b + (size_t)l * FF, SAs, SIDE_BYTES / 4};
            pg8::gemm_phase<pg8::EpiFF, true>(lds, g, S, E, wave); }
        SEAM();
        if (IN()) fixup_phase(A, l, nrows_x, U, SAs, SPA, SVs, vcu * NTHREADS + wave * 64, G * NTHREADS);
        SEAM();
        if (IN()) { pg8::Gemm g{U, (const bf16*)(wl + LW_DN), FF, FF, FF, 0, 0}; pg8::Order S; S.init(nM_x, 4, G, bx, 1, 0);
            if (!last) { pg8::EpiRes<true, true> E{XB, XCB, XB, XCB, modl, 5}; pg8::gemm_phase<pg8::EpiRes<true, true>, true>(lds, g, S, E, wave); }
            else { pg8::EpiRes<true, false> E{XB, XCB, XF, XF, modl, 5}; pg8::gemm_phase<pg8::EpiRes<true, false>, true>(lds, g, S, E, wave); } }
        SEAM();
    }
    if (IN()) final_norm_rows(XF, A.out, A.final_g, gw, NGW);
#undef IN
#undef SEAM
}
constexpr int N_PHASES = 22;

extern "C" void kernel_launch(void* const* d_in, const int* in_sizes, int n_in, void* d_out, int out_size, void* d_ws, size_t ws_size, hipStream_t stream) {
    static int grid = 0;
    if (grid == 0) {
        if (n_in != 24 || out_size != NLAT * 1024 || ws_size < WS_END) { fprintf(stderr, "kernel_launch: unexpected shapes (n_in %d out %d ws %zu need %zu)\n", n_in, out_size, ws_size, (size_t)WS_END); grid = -1; return; }
        int dev = 0, cus = 0, per_cu = 0;
        hipGetDevice(&dev); hipDeviceGetAttribute(&cus, hipDeviceAttributeMultiprocessorCount, dev);
        if (hipFuncSetAttribute((const void*)fwd_megakernel, hipFuncAttributeMaxDynamicSharedMemorySize, LDS_BYTES) != hipSuccess) { fprintf(stderr, "kernel_launch: hipFuncSetAttribute failed\n"); grid = -1; return; }
        hipOccupancyMaxActiveBlocksPerMultiprocessor(&per_cu, (const void*)fwd_megakernel, NTHREADS, LDS_BYTES);
        (void)hipGetLastError();
        if (per_cu < 1) { fprintf(stderr, "kernel_launch: occupancy query says %d blocks per CU\n", per_cu); per_cu = 1; }
        grid = cus;
    }
    if (grid < 0) return;
    Args a{};
    const float** p = (const float**)&a;
    for (int i = 0; i < 24; ++i) p[i] = (const float*)d_in[i];
    a.out = (float*)d_out; a.ws = (unsigned char*)d_ws;
#if MK_SPLIT
    for (int ph = 0; ph < N_PHASES; ++ph) { a.ph_lo = ph; a.ph_hi = ph + 1; hipLaunchKernelGGL(fwd_megakernel, dim3(grid), dim3(NTHREADS), LDS_BYTES, stream, a); }
#else
    a.ph_lo = 0; a.ph_hi = N_PHASES;
    if (hipMemsetAsync((char*)d_ws + WS_CTL, 0, CTL_ZERO_BYTES, stream) != hipSuccess) { fprintf(stderr, "kernel_launch: memset failed\n"); return; }
    void* args[] = {&a};
    hipError_t e = hipLaunchCooperativeKernel((const void*)fwd_megakernel, dim3(grid), dim3(NTHREADS), args, LDS_BYTES, stream);
    if (e != hipSuccess) fprintf(stderr, "cooperative launch failed: %s (grid %d)\n", hipGetErrorString(e), grid);
#endif
}
```
